# Optimizing an MI355X kernel written in HIP

```python
import math
import jax, jax.numpy as jnp
from jax import lax
import numpy as np

D_MODEL = 2048
BATCH = 2
SEQ = 4096
DEPTH = 2

HEAD_DIM = 64
D_MIX = D_MODEL
GROUP_WIDTH = D_MIX // 4
SSD_HEADS = GROUP_WIDTH // HEAD_DIM
SSD_GROUPS = 2
SSD_STATE = 128
SSD_CONV_K = 4
SSD_CHUNK = 128
SSD_BC = SSD_GROUPS * SSD_STATE
SSD_CONV_DIM = GROUP_WIDTH + 2 * SSD_BC
SB_HEADS = GROUP_WIDTH // HEAD_DIM
Q_BLOCK = 128
DIL_HEADS = GROUP_WIDTH // HEAD_DIM
DIL_PAIRS = ((128, 1), (512, 4), (2048, 16))
POOL_WINDOWS = (2, 4, 8, 16)
POOL_GROUPS = len(POOL_WINDOWS)
POOL_CH = GROUP_WIDTH // POOL_GROUPS
IN_SIZES = (GROUP_WIDTH, SSD_CONV_DIM, SSD_HEADS, 3 * GROUP_WIDTH, 3 * GROUP_WIDTH, GROUP_WIDTH)
D_IN = sum(IN_SIZES)
IN_SPLITS = tuple(int(v) for v in np.cumsum(IN_SIZES)[:-1])
N_EXPERT_GROUPS = 8
EXPERTS_PER_GROUP = 8
N_EXPERTS = N_EXPERT_GROUPS * EXPERTS_PER_GROUP
TOP_K = 2
D_FF_EXPERT = D_MODEL // 4
MOE_BLOCK = 128
RMS_EPS = 1e-6

kernel_name = 'hybrid_parallel_heads_ssd_sb_dilated_pool_hmoe'


def rms_norm(x, g):
    xf = x.astype(jnp.float32)
    y = xf * lax.rsqrt(jnp.mean(xf * xf, axis=-1, keepdims=True) + RMS_EPS)
    return (y * g.astype(jnp.float32)).astype(x.dtype)


def causal_depthwise_conv(u, w, b):
    c = u.shape[-1]
    y = lax.conv_general_dilated(u, w[:, None, :], window_strides=(1,),
                                 padding=((w.shape[0] - 1, 0),),
                                 dimension_numbers=('NWC', 'WIO', 'NWC'),
                                 feature_group_count=c)
    return y + b


def ssd_chunked(x, dt, a, bm, cm):
    b, s, nh, p = x.shape
    g, n = bm.shape[2], bm.shape[3]
    hg = nh // g
    L = SSD_CHUNK
    nc = s // L
    xdt = (x * dt[..., None]).reshape(b, nc, L, g, hg, p)
    acs = jnp.cumsum((dt * a).reshape(b, nc, L, g, hg), axis=2)
    bc = bm.reshape(b, nc, L, g, n)
    cc = cm.reshape(b, nc, L, g, n)
    causal = jnp.tril(jnp.ones((L, L), dtype=bool))[None, None, :, :, None, None]
    seg = acs[:, :, :, None] - acs[:, :, None, :]
    decay = jnp.exp(jnp.where(causal, seg, -jnp.inf))
    cb = jnp.einsum('bclgn,bcsgn->bclsg', cc, bc)
    y_diag = jnp.einsum('bclsgh,bcsghp->bclghp', cb[..., None] * decay, xdt)
    decay_to_end = jnp.exp(acs[:, :, -1:] - acs)
    states = jnp.einsum('bclgn,bclghp->bcghpn', bc, decay_to_end[..., None] * xdt)
    chunk_decay = jnp.exp(acs[:, :, -1])

    def step(h, inp):
        st, dec = inp
        return h * dec[..., None, None] + st, h

    h0 = jnp.zeros((b, g, hg, p, n), jnp.float32)
    _, prev = lax.scan(step, h0, (jnp.moveaxis(states, 1, 0), jnp.moveaxis(chunk_decay, 1, 0)))
    prev = jnp.moveaxis(prev, 0, 1)
    y_off = jnp.einsum('bclgn,bcghpn->bclghp', cc, prev) * jnp.exp(acs)[..., None]
    return (y_diag + y_off).reshape(b, s, nh, p)


def ssd_mixer(z, xbc, dt_raw, conv_w, conv_b, dt_bias, a_log, d_skip, norm_g):
    b, s, _ = z.shape
    f32 = jnp.float32
    xbc = jax.nn.silu(causal_depthwise_conv(xbc, conv_w, conv_b)).astype(f32)
    xs, bm, cm = jnp.split(xbc, [GROUP_WIDTH, GROUP_WIDTH + SSD_BC], axis=-1)
    xs = xs.reshape(b, s, SSD_HEADS, HEAD_DIM)
    bm = bm.reshape(b, s, SSD_GROUPS, SSD_STATE)
    cm = cm.reshape(b, s, SSD_GROUPS, SSD_STATE)
    dt = jax.nn.softplus((dt_raw + dt_bias).astype(f32))
    a = -jnp.exp(a_log.astype(f32))
    y = ssd_chunked(xs, dt, a, bm, cm)
    y = y + xs * d_skip.astype(f32)[:, None]
    y = y.reshape(b, s, GROUP_WIDTH) * jax.nn.silu(z.astype(f32))
    return rms_norm(y, norm_g).astype(z.dtype)


def stick_breaking_attention(q, k, v):
    b, s, h, d = q.shape
    scale = d ** -0.5
    key_pos = jnp.arange(s)

    def block(i):
        t0 = i * Q_BLOCK
        qb = lax.dynamic_slice_in_dim(q, t0, Q_BLOCK, axis=1)
        z = jnp.einsum('bqhd,bkhd->bhqk', qb, k).astype(jnp.float32) * scale
        q_pos = t0 + jnp.arange(Q_BLOCK)
        earlier = key_pos[None, :] < q_pos[:, None]
        log_stay = jnp.where(earlier, jax.nn.log_sigmoid(-z), 0.0)
        between = lax.cumsum(log_stay, axis=3, reverse=True) - log_stay
        log_w = jnp.where(earlier, jax.nn.log_sigmoid(z) + between, -jnp.inf)
        w = jnp.exp(log_w).astype(v.dtype)
        return jnp.einsum('bhqk,bkhd->bqhd', w, v)

    out = lax.map(block, jnp.arange(s // Q_BLOCK))
    return jnp.moveaxis(out, 0, 1).reshape(b, s, h, d)


def dilated_attention(q, k, v):
    b, s, h, d = q.shape
    scale = d ** -0.5

    def block(i):
        t0 = i * Q_BLOCK
        q_pos = t0 + jnp.arange(Q_BLOCK)
        qb = lax.dynamic_slice_in_dim(q, t0, Q_BLOCK, axis=1)
        outs, lses = [], []
        for window, dil in DIL_PAIRS:
            key_pos = q_pos[:, None] - dil * jnp.arange(window // dil + 1)[None, :]
            valid = key_pos >= 0
            idx = jnp.maximum(key_pos, 0)
            kg = k[:, idx]
            vg = v[:, idx]
            sc = jnp.einsum('bqhd,bqjhd->bhqj', qb, kg).astype(jnp.float32) * scale
            sc = jnp.where(valid[None, None], sc, -jnp.inf)
            lse = jax.nn.logsumexp(sc, axis=-1)
            pr = jnp.exp(sc - lse[..., None]).astype(v.dtype)
            outs.append(jnp.einsum('bhqj,bqjhd->bqhd', pr, vg).astype(jnp.float32))
            lses.append(lse)
        mix = jax.nn.softmax(jnp.stack(lses), axis=0)
        o = jnp.einsum('rbhq,rbqhd->bqhd', mix, jnp.stack(outs))
        return o.astype(v.dtype)

    out = lax.map(block, jnp.arange(s // Q_BLOCK))
    return jnp.moveaxis(out, 0, 1).reshape(b, s, h, d)


def pool_mixer(u, pool_w, pool_scale):
    b, s, c = u.shape
    ug = u.reshape(b, s, POOL_GROUPS, POOL_CH).astype(jnp.float32)
    csum = jnp.concatenate([jnp.zeros((b, 1, POOL_GROUPS, POOL_CH), jnp.float32),
                            jnp.cumsum(ug, axis=1)], axis=1)
    pos = jnp.arange(s)
    outs = []
    for g, w in enumerate(POOL_WINDOWS):
        lo = jnp.maximum(pos + 1 - w, 0)
        cnt = (pos + 1 - lo).astype(jnp.float32)
        mean = (csum[:, 1:, g] - csum[:, lo, g]) / cnt[None, :, None]
        outs.append(mean - ug[:, :, g])
    pooled = jnp.stack(outs, axis=2).astype(u.dtype)
    y = jnp.einsum('bsgc,gce->bsge', pooled, pool_w)
    return y.reshape(b, s, c) * pool_scale


def hierarchical_moe(h, rg_w, rg_b, re_w, re_b, w_gate, w_up, w_down):
    b, s, d = h.shape
    f32 = jnp.float32
    tok = h.reshape(b * s, d)
    n_tok = b * s
    grp_prob = jax.nn.softmax((tok @ rg_w).astype(f32) + rg_b, axis=-1)
    grp_p, grp_idx = lax.top_k(grp_prob, 1)
    exp_logits = ((tok @ re_w).astype(f32) + re_b).reshape(n_tok, N_EXPERT_GROUPS, EXPERTS_PER_GROUP)
    in_grp = jnp.take_along_axis(exp_logits, grp_idx[:, :, None], axis=1)[:, 0]
    e_p, e_idx = lax.top_k(jax.nn.softmax(in_grp, axis=-1), TOP_K)
    gate = grp_p * e_p / jnp.sum(e_p, axis=-1, keepdims=True)
    expert = grp_idx * EXPERTS_PER_GROUP + e_idx
    n_asg = n_tok * TOP_K
    flat_e = expert.reshape(-1).astype(jnp.int32)
    flat_t = jnp.repeat(jnp.arange(n_tok, dtype=jnp.int32), TOP_K)
    flat_g = gate.reshape(-1)
    order = jnp.argsort(flat_e)
    se, st, sg = flat_e[order], flat_t[order], flat_g[order]
    counts = jnp.bincount(flat_e, length=N_EXPERTS).astype(jnp.int32)
    padded = (counts + MOE_BLOCK - 1) // MOE_BLOCK * MOE_BLOCK
    pad_end = jnp.cumsum(padded)
    pad_start = pad_end - padded
    start = jnp.cumsum(counts) - counts
    dest = pad_start[se] + jnp.arange(n_asg, dtype=jnp.int32) - start[se]
    n_blocks = -(-(n_asg + N_EXPERTS * (MOE_BLOCK - 1)) // MOE_BLOCK)
    rows = n_blocks * MOE_BLOCK
    buf_tok = jnp.zeros((rows,), jnp.int32).at[dest].set(st)
    buf_gate = jnp.zeros((rows,), f32).at[dest].set(sg)
    blk_start = jnp.arange(n_blocks, dtype=jnp.int32) * MOE_BLOCK
    blk_expert = jnp.minimum(jnp.searchsorted(pad_end, blk_start, side='right'), N_EXPERTS - 1)

    def run_block(args):
        t_idx, g, e = args
        xb = tok[t_idx]
        hid = jax.nn.silu(xb @ w_gate[e]) * (xb @ w_up[e])
        return (hid @ w_down[e]) * g[:, None].astype(xb.dtype)

    ys = lax.map(run_block, (buf_tok.reshape(n_blocks, MOE_BLOCK),
                             buf_gate.reshape(n_blocks, MOE_BLOCK), blk_expert))
    out = jnp.zeros_like(tok).at[buf_tok].add(ys.reshape(rows, d))
    return out.reshape(b, s, d)


def setup_inputs(seed: int = 0) -> dict:
    key = jax.random.key(seed)
    ks = jax.random.split(key, 32)
    f32 = jnp.float32
    L = DEPTH

    def nrm(k, shape, scale):
        return jax.random.normal(k, shape, f32) * scale

    def gain(k, shape):
        return 1.0 + 0.02 * jax.random.normal(k, shape, f32)

    dt0 = jnp.exp(jax.random.uniform(ks[6], (L, SSD_HEADS), f32, math.log(1e-3), math.log(1e-1)))
    return {
        'x': jax.random.normal(ks[0], (BATCH, SEQ, D_MODEL), f32),
        'norm1_g': gain(ks[1], (L, D_MODEL)),
        'w_in': nrm(ks[2], (L, D_MODEL, D_IN), D_MODEL ** -0.5),
        'ssd_conv_w': nrm(ks[3], (L, SSD_CONV_K, SSD_CONV_DIM), SSD_CONV_K ** -0.5),
        'ssd_conv_b': nrm(ks[4], (L, SSD_CONV_DIM), 0.02),
        'ssd_dt_bias': dt0 + jnp.log(-jnp.expm1(-dt0)),
        'ssd_a_log': jnp.log(jax.random.uniform(ks[7], (L, SSD_HEADS), f32, 1.0, 16.0)),
        'ssd_d': gain(ks[8], (L, SSD_HEADS)),
        'ssd_norm_g': gain(ks[9], (L, GROUP_WIDTH)),
        'sb_q_norm_g': gain(ks[10], (L, HEAD_DIM)),
        'sb_k_norm_g': gain(ks[11], (L, HEAD_DIM)),
        'sb_out_norm_g': gain(ks[12], (L, GROUP_WIDTH)),
        'dil_q_norm_g': gain(ks[13], (L, HEAD_DIM)),
        'dil_k_norm_g': gain(ks[14], (L, HEAD_DIM)),
        'dil_out_norm_g': gain(ks[15], (L, GROUP_WIDTH)),
        'pool_w': nrm(ks[16], (L, POOL_GROUPS, POOL_CH, POOL_CH), POOL_CH ** -0.5),
        'pool_scale': gain(ks[17], (L, GROUP_WIDTH)),
        'w_out': nrm(ks[18], (L, D_MIX, D_MODEL), D_MIX ** -0.5),
        'norm2_g': gain(ks[19], (L, D_MODEL)),
        'router_grp_w': nrm(ks[20], (L, D_MODEL, N_EXPERT_GROUPS), D_MODEL ** -0.5),
        'router_grp_b': nrm(ks[21], (L, N_EXPERT_GROUPS), 0.01),
        'router_exp_w': nrm(ks[22], (L, D_MODEL, N_EXPERTS), D_MODEL ** -0.5),
        'router_exp_b': nrm(ks[23], (L, N_EXPERTS), 0.01),
        'moe_w_gate': nrm(ks[24], (L, N_EXPERTS, D_MODEL, D_FF_EXPERT), D_MODEL ** -0.5),
        'moe_w_up': nrm(ks[25], (L, N_EXPERTS, D_MODEL, D_FF_EXPERT), D_MODEL ** -0.5),
        'moe_w_down': nrm(ks[26], (L, N_EXPERTS, D_FF_EXPERT, D_MODEL), D_FF_EXPERT ** -0.5),
    }


def reference(x, norm1_g, w_in, ssd_conv_w, ssd_conv_b, ssd_dt_bias, ssd_a_log, ssd_d, ssd_norm_g,
              sb_q_norm_g, sb_k_norm_g, sb_out_norm_g, dil_q_norm_g, dil_k_norm_g, dil_out_norm_g,
              pool_w, pool_scale, w_out, norm2_g, router_grp_w, router_grp_b, router_exp_w,
              router_exp_b, moe_w_gate, moe_w_up, moe_w_down):
    b, s, _ = x.shape
    for l in range(DEPTH):
        h = rms_norm(x, norm1_g[l])
        proj = h @ w_in[l]
        z, xbc, dt_raw, sb_qkv, dil_qkv, pool_in = jnp.split(proj, IN_SPLITS, axis=-1)

        y_ssd = ssd_mixer(z, xbc, dt_raw, ssd_conv_w[l], ssd_conv_b[l], ssd_dt_bias[l],
                          ssd_a_log[l], ssd_d[l], ssd_norm_g[l])

        q, k, v = [t.reshape(b, s, SB_HEADS, HEAD_DIM) for t in jnp.split(sb_qkv, 3, axis=-1)]
        q = rms_norm(q, sb_q_norm_g[l])
        k = rms_norm(k, sb_k_norm_g[l])
        y_sb = rms_norm(stick_breaking_attention(q, k, v).reshape(b, s, GROUP_WIDTH), sb_out_norm_g[l])

        q, k, v = [t.reshape(b, s, DIL_HEADS, HEAD_DIM) for t in jnp.split(dil_qkv, 3, axis=-1)]
        q = rms_norm(q, dil_q_norm_g[l])
        k = rms_norm(k, dil_k_norm_g[l])
        y_dil = rms_norm(dilated_attention(q, k, v).reshape(b, s, GROUP_WIDTH), dil_out_norm_g[l])

        y_pool = pool_mixer(pool_in, pool_w[l], pool_scale[l])

        mixed = jnp.concatenate([y_ssd, y_sb, y_dil, y_pool], axis=-1)
        x = x + mixed @ w_out[l]
        h2 = rms_norm(x, norm2_g[l])
        x = x + hierarchical_moe(h2, router_grp_w[l], router_grp_b[l], router_exp_w[l],
                                 router_exp_b[l], moe_w_gate[l], moe_w_up[l], moe_w_down[l])
    return x
```

```cpp
#include <hip/hip_runtime.h>
#include <hip/hip_bf16.h>
#include <stdint.h>

typedef unsigned short u16;
using bf16x8 = __attribute__((ext_vector_type(8))) short;
using f32x4  = __attribute__((ext_vector_type(4))) float;

constexpr int NB = 2, SEQ = 4096, T = NB * SEQ, D = 2048, DIN = 5128, DP = 5120;
constexpr int GW = 512;
constexpr int NE = 64, DFF = 512;
constexpr int MAXBLK = 192;
constexpr float EPS = 1e-6f;
constexpr int C_Z = 0, C_XBC = 512, C_SB = 1536, C_DIL = 3072, C_POOL = 4608;

__device__ __forceinline__ u16 f2bf(float f) { unsigned u = __float_as_uint(f); u += 0x7fffu + ((u >> 16) & 1u); return (u16)(u >> 16); }
__device__ __forceinline__ float bf2f(u16 h) { return __uint_as_float(((unsigned)h) << 16); }
__device__ __forceinline__ float wave_sum(float v) { for (int o = 32; o > 0; o >>= 1) v += __shfl_xor(v, o); return v; }
__device__ __forceinline__ float block_sum(float v, float* red) {
    v = wave_sum(v); const int w = threadIdx.x >> 6, l = threadIdx.x & 63;
    __syncthreads(); if (l == 0) red[w] = v; __syncthreads();
    float s = 0.f; for (int i = 0; i < (int)(blockDim.x >> 6); ++i) s += red[i]; return s;
}
__device__ __forceinline__ float siluf(float x) { return x / (1.f + __expf(-x)); }
__device__ __forceinline__ float softplusf(float x) { return fmaxf(x, 0.f) + log1pf(__expf(-fabsf(x))); }

__global__ void k_transpose_cvt(const float* __restrict__ in, u16* __restrict__ out, int K, int ldin, int n0, int r0, long in_bs, long out_bs) {
    __shared__ float tile[32][33];
    in += (long)blockIdx.z * in_bs; out += (long)blockIdx.z * out_bs;
    const int kb = blockIdx.y * 32, nb = blockIdx.x * 32, tx = threadIdx.x & 31, ty = threadIdx.x >> 5;
    for (int i = ty; i < 32; i += 8) tile[i][tx] = in[(long)(kb + i) * ldin + n0 + nb + tx];
    __syncthreads();
    for (int i = ty; i < 32; i += 8) out[(long)(r0 + nb + i) * K + kb + tx] = f2bf(tile[tx][i]);
}
__global__ void k_router_t(const float* __restrict__ rg, const float* __restrict__ re, float* __restrict__ RT) {
    const int i = blockIdx.x * 256 + threadIdx.x; if (i >= 72 * D) return;
    const int c = i / D, k = i % D;
    RT[i] = (c < 8) ? rg[k * 8 + c] : re[k * 64 + (c - 8)];
}

__global__ void __launch_bounds__(256) k_rmsnorm1(const float* __restrict__ X, const float* __restrict__ g, const float* __restrict__ Win,
                                                  u16* __restrict__ HB, float* __restrict__ DTR) {
    __shared__ float red[8];
    const int t = blockIdx.x; const float* x = X + (long)t * D;
    float v[8]; float ss = 0.f;
    for (int i = 0; i < 8; ++i) { v[i] = x[threadIdx.x + 256 * i]; ss += v[i] * v[i]; }
    ss = block_sum(ss, red);
    const float r = rsqrtf(ss / D + EPS);
    float dp[8] = {0, 0, 0, 0, 0, 0, 0, 0};
    for (int i = 0; i < 8; ++i) {
        const int k = threadIdx.x + 256 * i; const float h = v[i] * r * g[k];
        HB[(long)t * D + k] = f2bf(h);
        const float* w = Win + (long)k * DIN + 1536;
        for (int j = 0; j < 8; ++j) dp[j] += h * w[j];
    }
    for (int j = 0; j < 8; ++j) { const float s = block_sum(dp[j], red); if (threadIdx.x == 0) DTR[t * 8 + j] = s; }
}

template <int EPI>
__global__ void __launch_bounds__(256, 2) k_gemm128(const u16* __restrict__ A, const u16* __restrict__ Bt, float* __restrict__ C,
                                                   int M, int N, int K, const int* __restrict__ blk_e, const int* __restrict__ nblk) {
    extern __shared__ __attribute__((aligned(16))) u16 shm[];
    constexpr int BM = 128, BK = 32, HT = BM * BK;
    const int nn = N / BM; const int mb = blockIdx.x / nn, nbk = blockIdx.x % nn;
    if (blk_e) { if (mb >= *nblk) return; Bt += (long)blk_e[mb] * N * K; }
    const int brow = mb * BM, bcol = nbk * BM;
    const int wid = threadIdx.x >> 6, lane = threadIdx.x & 63, wr = wid >> 1, wc = wid & 1, fr = lane & 15, fq = lane >> 4;
    u16* SA = shm; u16* SB = shm + HT;
    f32x4 acc[4][4] = {};
    bf16x8 At[4], Bl[4];
    for (int t = 0; t < K / BK; ++t) {
        for (int i = 0; i < 2; ++i) {
            const int b = threadIdx.x * 16 + i * 4096, r = b / 64, c = (b % 64) / 2;
            __builtin_amdgcn_global_load_lds((const unsigned*)(A + (long)(brow + r) * K + t * BK + c), (__attribute__((address_space(3))) unsigned*)((char*)SA + b), 16, 0, 0);
            __builtin_amdgcn_global_load_lds((const unsigned*)(Bt + (long)(bcol + r) * K + t * BK + c), (__attribute__((address_space(3))) unsigned*)((char*)SB + b), 16, 0, 0);
        }
        asm volatile("s_waitcnt vmcnt(0)" ::: "memory"); __syncthreads();
        for (int m = 0; m < 4; ++m) At[m] = *reinterpret_cast<const bf16x8*>((char*)SA + (wr * 64 + m * 16 + fr) * BK * 2 + fq * 16);
        for (int m = 0; m < 4; ++m) Bl[m] = *reinterpret_cast<const bf16x8*>((char*)SB + (wc * 64 + m * 16 + fr) * BK * 2 + fq * 16);
        asm volatile("s_waitcnt lgkmcnt(0)" ::: "memory"); __builtin_amdgcn_sched_barrier(0);
        for (int m = 0; m < 4; ++m) for (int n = 0; n < 4; ++n)
            acc[m][n] = __builtin_amdgcn_mfma_f32_16x16x32_bf16(At[m], Bl[n], acc[m][n], 0, 0, 0);
        __syncthreads();
    }
    for (int m = 0; m < 4; ++m) for (int n = 0; n < 4; ++n) for (int j = 0; j < 4; ++j) {
        float* p = C + (long)(brow + wr * 64 + m * 16 + fq * 4 + j) * N + (bcol + wc * 64 + n * 16 + fr);
        if (EPI == 0) *p = acc[m][n][j]; else *p += acc[m][n][j];
    }
}

__global__ void __launch_bounds__(256) k_qknorm(float* __restrict__ P, const float* __restrict__ sbq, const float* __restrict__ sbk,
                                                const float* __restrict__ dq, const float* __restrict__ dk) {
    const int wv = blockIdx.x * 4 + (threadIdx.x >> 6), lane = threadIdx.x & 63;
    const int t = wv / 32, r = wv % 32, which = r / 8, h = r % 8;
    const int col = (which == 0 ? C_SB : which == 1 ? C_SB + 512 : which == 2 ? C_DIL : C_DIL + 512) + h * 64 + lane;
    const float* g = which == 0 ? sbq : which == 1 ? sbk : which == 2 ? dq : dk;
    float* p = P + (long)t * DP + col; const float v = *p;
    const float ss = wave_sum(v * v);
    *p = v * rsqrtf(ss / 64.f + EPS) * g[lane];
}

__global__ void __launch_bounds__(256) k_ssd_conv(const float* __restrict__ P, const float* __restrict__ cw, const float* __restrict__ cb, float* __restrict__ XBC) {
    const int i = blockIdx.x * 256 + threadIdx.x; const int t = i / 1024, c = i % 1024; const int s = t % SEQ;
    float a = cb[c];
    for (int k = 0; k < 4; ++k) { const int ss = s - 3 + k; if (ss >= 0) a += cw[k * 1024 + c] * P[(long)(t - 3 + k) * DP + C_XBC + c]; }
    XBC[i] = siluf(a);
}
__global__ void __launch_bounds__(256) k_ssd_scan(const float* __restrict__ XBC, const float* __restrict__ DTR, const float* __restrict__ dtb,
                                                  const float* __restrict__ alog, float* __restrict__ YS) {
    constexpr int TS = 32;
    __shared__ float sB[TS][128], sC[TS][128], sX[TS][64], sDT[TS];
    const int b = blockIdx.x / 8, h = blockIdx.x % 8, g = h / 4;
    const int p = threadIdx.x >> 2, q = threadIdx.x & 3;
    const float a = -__expf(alog[h]); const float bias = dtb[h];
    float st[32]; for (int i = 0; i < 32; ++i) st[i] = 0.f;
    for (int s0 = 0; s0 < SEQ; s0 += TS) {
        __syncthreads();
        for (int i = threadIdx.x; i < TS * 128; i += 256) { const int ts = i / 128, n = i % 128; const long tt = (long)b * SEQ + s0 + ts;
            sB[ts][n] = XBC[tt * 1024 + 512 + g * 128 + n]; sC[ts][n] = XBC[tt * 1024 + 768 + g * 128 + n]; }
        for (int i = threadIdx.x; i < TS * 64; i += 256) { const int ts = i / 64, pp = i % 64; sX[ts][pp] = XBC[((long)b * SEQ + s0 + ts) * 1024 + h * 64 + pp]; }
        if (threadIdx.x < TS) sDT[threadIdx.x] = softplusf(DTR[((long)b * SEQ + s0 + threadIdx.x) * 8 + h] + bias);
        __syncthreads();
        for (int ts = 0; ts < TS; ++ts) {
            const float dt = sDT[ts]; const float dec = __expf(dt * a); const float xdt = sX[ts][p] * dt;
            float y = 0.f;
            for (int i = 0; i < 32; ++i) { st[i] = st[i] * dec + xdt * sB[ts][q * 32 + i]; y += sC[ts][q * 32 + i] * st[i]; }
            y += __shfl_xor(y, 1); y += __shfl_xor(y, 2);
            if (q == 0) YS[((long)b * SEQ + s0 + ts) * 512 + h * 64 + p] = y;
        }
    }
}
__global__ void __launch_bounds__(256) k_ssd_out(const float* __restrict__ YS, const float* __restrict__ XBC, const float* __restrict__ P,
                                                 const float* __restrict__ dsk, const float* __restrict__ ng, u16* __restrict__ MIXED) {
    __shared__ float red[8];
    const int t = blockIdx.x; float v[2]; float ss = 0.f;
    for (int i = 0; i < 2; ++i) { const int c = threadIdx.x + 256 * i; const float xs = XBC[(long)t * 1024 + c];
        const float y = (YS[(long)t * 512 + c] + xs * dsk[c / 64]) * siluf(P[(long)t * DP + C_Z + c]); v[i] = y; ss += y * y; }
    ss = block_sum(ss, red); const float r = rsqrtf(ss / 512.f + EPS);
    for (int i = 0; i < 2; ++i) { const int c = threadIdx.x + 256 * i; MIXED[(long)t * D + c] = f2bf(v[i] * r * ng[c]); }
}

__global__ void __launch_bounds__(64) k_sb(const float* __restrict__ P, float* __restrict__ O) {
    const int blk = blockIdx.x; const int b = blk / (8 * 64), h = (blk / 64) % 8, t0 = (blk % 64) * 64; const int lane = threadIdx.x;
    const int t = t0 + lane;
    const float* base = P + (long)b * SEQ * DP;
    float q[64], acc[64];
    { const float* qp = base + (long)t * DP + C_SB + h * 64; for (int d = 0; d < 64; ++d) { q[d] = qp[d] * 0.125f; acc[d] = 0.f; } }
    float run = 0.f;
    for (int s = t0 + 62; s >= 0; --s) {
        const float* kp = base + (long)s * DP + C_SB + 512 + h * 64; const float* vp = kp + 512;
        float z = 0.f; for (int d = 0; d < 64; ++d) z += q[d] * kp[d];
        const bool act = s < t; const float sp = softplusf(z);
        const float w = act ? __expf((z - sp) + run) : 0.f;
        for (int d = 0; d < 64; ++d) acc[d] += w * vp[d];
        if (act) run -= sp;
        if (__all(act && run < -104.f)) break;
    }
    float* op = O + ((long)b * SEQ + t) * 512 + h * 64; for (int d = 0; d < 64; ++d) op[d] = acc[d];
}
__global__ void __launch_bounds__(64) k_dil(const float* __restrict__ P, float* __restrict__ O) {
    const int blk = blockIdx.x; const int b = blk / (8 * 64), h = (blk / 64) % 8, t0 = (blk % 64) * 64; const int t = t0 + threadIdx.x;
    const float* base = P + (long)b * SEQ * DP;
    float q[64], acc[64];
    { const float* qp = base + (long)t * DP + C_DIL + h * 64; for (int d = 0; d < 64; ++d) { q[d] = qp[d] * 0.125f; acc[d] = 0.f; } }
    float m = -1e30f, l = 0.f;
    for (int br = 0; br < 3; ++br) {
        const int dil = br == 0 ? 1 : br == 1 ? 4 : 16;
        for (int j = 0; j <= 128; ++j) {
            const int s = t - dil * j; if (s < 0) break;
            const float* kp = base + (long)s * DP + C_DIL + 512 + h * 64; const float* vp = kp + 512;
            float z = 0.f; for (int d = 0; d < 64; ++d) z += q[d] * kp[d];
            const float mn = fmaxf(m, z); const float al = __expf(m - mn), w = __expf(z - mn);
            l = l * al + w; for (int d = 0; d < 64; ++d) acc[d] = acc[d] * al + w * vp[d];
            m = mn;
        }
    }
    const float inv = 1.f / l;
    float* op = O + ((long)b * SEQ + t) * 512 + h * 64; for (int d = 0; d < 64; ++d) op[d] = acc[d] * inv;
}
__global__ void __launch_bounds__(256) k_norm512(const float* __restrict__ O, const float* __restrict__ g, u16* __restrict__ MIXED, int col0) {
    __shared__ float red[8];
    const int t = blockIdx.x; float v[2]; float ss = 0.f;
    for (int i = 0; i < 2; ++i) { v[i] = O[(long)t * 512 + threadIdx.x + 256 * i]; ss += v[i] * v[i]; }
    ss = block_sum(ss, red); const float r = rsqrtf(ss / 512.f + EPS);
    for (int i = 0; i < 2; ++i) { const int c = threadIdx.x + 256 * i; MIXED[(long)t * D + col0 + c] = f2bf(v[i] * r * g[c]); }
}
__global__ void __launch_bounds__(512) k_pool(const float* __restrict__ P, const float* __restrict__ pw, const float* __restrict__ psc, u16* __restrict__ MIXED) {
    __shared__ float pooled[512];
    const int t = blockIdx.x, s = t % SEQ, c = threadIdx.x, g = c / 128;
    const int w = 2 << g; const int lo = max(s + 1 - w, 0); const int cnt = s + 1 - lo;
    float sum = 0.f; for (int i = 0; i < cnt; ++i) sum += P[(long)(t - i) * DP + C_POOL + c];
    pooled[c] = sum / (float)cnt - P[(long)t * DP + C_POOL + c];
    __syncthreads();
    const int e = c % 128; float y = 0.f;
    for (int cc = 0; cc < 128; ++cc) y += pooled[g * 128 + cc] * pw[(g * 128 + cc) * 128 + e];
    MIXED[(long)t * D + 1536 + c] = f2bf(y * psc[c]);
}

__global__ void __launch_bounds__(256) k_rmsnorm2_router(const float* __restrict__ X, const float* __restrict__ g, const float* __restrict__ RT,
                                                         const float* __restrict__ rgb, const float* __restrict__ reb, u16* __restrict__ HB,
                                                         int* __restrict__ cnt, int* __restrict__ tok_e, int* __restrict__ tok_pos, float* __restrict__ tok_g) {
    __shared__ float red[8]; __shared__ float hn[D]; __shared__ float lg[72];
    const int t = blockIdx.x; const float* x = X + (long)t * D;
    float v[8]; float ss = 0.f;
    for (int i = 0; i < 8; ++i) { v[i] = x[threadIdx.x + 256 * i]; ss += v[i] * v[i]; }
    ss = block_sum(ss, red); const float r = rsqrtf(ss / D + EPS);
    for (int i = 0; i < 8; ++i) { const int k = threadIdx.x + 256 * i; const float h = v[i] * r * g[k]; hn[k] = h; HB[(long)t * D + k] = f2bf(h); }
    __syncthreads();
    const int wv = threadIdx.x >> 6, lane = threadIdx.x & 63;
    for (int c = wv * 18; c < wv * 18 + 18; ++c) {
        float s = 0.f; for (int i = 0; i < 32; ++i) s += hn[lane + 64 * i] * RT[(long)c * D + lane + 64 * i];
        s = wave_sum(s); if (lane == 0) lg[c] = s + (c < 8 ? rgb[c] : reb[c - 8]);
    }
    __syncthreads();
    if (threadIdx.x == 0) {
        int gi = 0; float gm = lg[0]; for (int j = 1; j < 8; ++j) if (lg[j] > gm) { gm = lg[j]; gi = j; }
        float gs = 0.f; for (int j = 0; j < 8; ++j) gs += __expf(lg[j] - gm);
        const float gp = 1.f / gs;
        const float* el = lg + 8 + gi * 8;
        int i1 = 0; float m1 = el[0]; for (int j = 1; j < 8; ++j) if (el[j] > m1) { m1 = el[j]; i1 = j; }
        int i2 = -1; float m2 = -1e30f; for (int j = 0; j < 8; ++j) if (j != i1 && el[j] > m2) { m2 = el[j]; i2 = j; }
        const float p2 = __expf(m2 - m1); const float g1 = gp / (1.f + p2), g2 = gp * p2 / (1.f + p2);
        const int e1 = gi * 8 + i1, e2 = gi * 8 + i2;
        tok_e[t * 2] = e1; tok_e[t * 2 + 1] = e2; tok_g[t * 2] = g1; tok_g[t * 2 + 1] = g2;
        tok_pos[t * 2] = atomicAdd(&cnt[e1], 1); tok_pos[t * 2 + 1] = atomicAdd(&cnt[e2], 1);
    }
}
__global__ void k_moe_offsets(const int* __restrict__ cnt, int* __restrict__ pad_start, int* __restrict__ blk_e, int* __restrict__ nblk) {
    if (threadIdx.x == 0) {
        int off = 0;
        for (int e = 0; e < NE; ++e) { pad_start[e] = off; const int nb = (cnt[e] + 127) / 128; for (int i = 0; i < nb; ++i) blk_e[off / 128 + i] = e; off += nb * 128; }
        *nblk = off / 128;
    }
}
__global__ void __launch_bounds__(256) k_moe_gather(const u16* __restrict__ HB, const int* __restrict__ tok_e, const int* __restrict__ tok_pos,
                                                    const int* __restrict__ pad_start, u16* __restrict__ XG, int* __restrict__ tok_row) {
    const int a = blockIdx.x, t = a >> 1; const int row = pad_start[tok_e[a]] + tok_pos[a];
    if (threadIdx.x == 0) tok_row[a] = row;
    const uint4* src = (const uint4*)(HB + (long)t * D); uint4* dst = (uint4*)(XG + (long)row * D);
    dst[threadIdx.x] = src[threadIdx.x];
}
__global__ void __launch_bounds__(256) k_swiglu(const float* __restrict__ G, const float* __restrict__ U, u16* __restrict__ H, const int* __restrict__ nblk) {
    const long i = (long)blockIdx.x * 256 + threadIdx.x; if (i >= (long)(*nblk) * 128 * DFF) return;
    H[i] = f2bf(siluf(G[i]) * U[i]);
}
__global__ void __launch_bounds__(256) k_moe_combine(float* __restrict__ X, const float* __restrict__ Y, const int* __restrict__ tok_row, const float* __restrict__ tok_g) {
    const int t = blockIdx.x; const int r0 = tok_row[2 * t], r1 = tok_row[2 * t + 1]; const float g0 = tok_g[2 * t], g1 = tok_g[2 * t + 1];
    for (int i = 0; i < 8; ++i) { const int k = threadIdx.x + 256 * i; X[(long)t * D + k] += g0 * Y[(long)r0 * D + k] + g1 * Y[(long)r1 * D + k]; }
}

extern "C" void kernel_launch(void* const* d_in, const int* in_sizes, int n_in, void* d_out, int out_size, void* d_ws, size_t ws_size, hipStream_t stream) {
    const float* x_in = (const float*)d_in[0];
    const float* norm1_g = (const float*)d_in[1];   const float* w_in = (const float*)d_in[2];
    const float* conv_w = (const float*)d_in[3];    const float* conv_b = (const float*)d_in[4];
    const float* dt_bias = (const float*)d_in[5];   const float* a_log = (const float*)d_in[6];
    const float* ssd_d = (const float*)d_in[7];     const float* ssd_ng = (const float*)d_in[8];
    const float* sbq_g = (const float*)d_in[9];     const float* sbk_g = (const float*)d_in[10];   const float* sbo_g = (const float*)d_in[11];
    const float* dq_g = (const float*)d_in[12];     const float* dk_g = (const float*)d_in[13];    const float* do_g = (const float*)d_in[14];
    const float* pool_w = (const float*)d_in[15];   const float* pool_sc = (const float*)d_in[16];
    const float* w_out = (const float*)d_in[17];    const float* norm2_g = (const float*)d_in[18];
    const float* rg_w = (const float*)d_in[19];     const float* rg_b = (const float*)d_in[20];
    const float* re_w = (const float*)d_in[21];     const float* re_b = (const float*)d_in[22];
    const float* wg = (const float*)d_in[23];       const float* wu = (const float*)d_in[24];      const float* wd = (const float*)d_in[25];
    float* X = (float*)d_out;

    char* ws = (char*)d_ws; size_t off = 0;
    auto alloc = [&](size_t bytes) { void* p = ws + off; off += (bytes + 255) & ~(size_t)255; return p; };
    int* ctrl = (int*)alloc(4096);
    int* cnt = ctrl; int* pad_start = ctrl + 64; int* nblk = ctrl + 128; int* blk_e = ctrl + 256;
    u16* HB = (u16*)alloc((size_t)T * D * 2);
    u16* MIXED = (u16*)alloc((size_t)T * D * 2);
    float* PROJ = (float*)alloc((size_t)T * DP * 4);
    float* DTR = (float*)alloc((size_t)T * 8 * 4);
    float* XBC = (float*)alloc((size_t)T * 1024 * 4);
    float* YS = (float*)alloc((size_t)T * 512 * 4);
    float* OA = (float*)alloc((size_t)T * 512 * 4);
    u16* WinT = (u16*)alloc((size_t)DP * D * 2);
    u16* WoutT = (u16*)alloc((size_t)D * D * 2);
    float* RT = (float*)alloc((size_t)72 * D * 4);
    u16* WgT = (u16*)alloc((size_t)NE * DFF * D * 2);
    u16* WuT = (u16*)alloc((size_t)NE * DFF * D * 2);
    u16* WdT = (u16*)alloc((size_t)NE * D * DFF * 2);
    int* tok_e = (int*)alloc((size_t)T * 2 * 4); int* tok_pos = (int*)alloc((size_t)T * 2 * 4); int* tok_row = (int*)alloc((size_t)T * 2 * 4);
    float* tok_g = (float*)alloc((size_t)T * 2 * 4);
    u16* XG = (u16*)alloc((size_t)MAXBLK * 128 * D * 2);
    float* Gb = (float*)alloc((size_t)MAXBLK * 128 * DFF * 4);
    float* Ub = (float*)alloc((size_t)MAXBLK * 128 * DFF * 4);
    u16* Hb = (u16*)alloc((size_t)MAXBLK * 128 * DFF * 2);
    float* Yb = (float*)alloc((size_t)MAXBLK * 128 * D * 4);
    if (off > ws_size) return;

    hipMemcpyAsync(X, x_in, (size_t)T * D * 4, hipMemcpyDeviceToDevice, stream);
    constexpr int SHM = 2 * 128 * 32 * 2;
    for (int l = 0; l < 2; ++l) {
        const float* Win_l = w_in + (size_t)l * D * DIN;
        k_transpose_cvt<<<dim3(1536 / 32, D / 32, 1), 256, 0, stream>>>(Win_l, WinT, D, DIN, 0, 0, 0, 0);
        k_transpose_cvt<<<dim3(3584 / 32, D / 32, 1), 256, 0, stream>>>(Win_l, WinT, D, DIN, 1544, 1536, 0, 0);
        k_transpose_cvt<<<dim3(D / 32, D / 32, 1), 256, 0, stream>>>(w_out + (size_t)l * D * D, WoutT, D, D, 0, 0, 0, 0);
        k_transpose_cvt<<<dim3(DFF / 32, D / 32, NE), 256, 0, stream>>>(wg + (size_t)l * NE * D * DFF, WgT, D, DFF, 0, 0, (long)D * DFF, (long)D * DFF);
        k_transpose_cvt<<<dim3(DFF / 32, D / 32, NE), 256, 0, stream>>>(wu + (size_t)l * NE * D * DFF, WuT, D, DFF, 0, 0, (long)D * DFF, (long)D * DFF);
        k_transpose_cvt<<<dim3(D / 32, DFF / 32, NE), 256, 0, stream>>>(wd + (size_t)l * NE * DFF * D, WdT, DFF, D, 0, 0, (long)D * DFF, (long)D * DFF);
        k_router_t<<<(72 * D + 255) / 256, 256, 0, stream>>>(rg_w + (size_t)l * D * 8, re_w + (size_t)l * D * 64, RT);
        k_rmsnorm1<<<T, 256, 0, stream>>>(X, norm1_g + l * D, Win_l, HB, DTR);
        k_gemm128<0><<<(T / 128) * (DP / 128), 256, SHM, stream>>>(HB, WinT, PROJ, T, DP, D, nullptr, nullptr);
        k_qknorm<<<T * 32 / 4, 256, 0, stream>>>(PROJ, sbq_g + l * 64, sbk_g + l * 64, dq_g + l * 64, dk_g + l * 64);
        k_ssd_conv<<<T * 1024 / 256, 256, 0, stream>>>(PROJ, conv_w + l * 4 * 1024, conv_b + l * 1024, XBC);
        k_ssd_scan<<<NB * 8, 256, 0, stream>>>(XBC, DTR, dt_bias + l * 8, a_log + l * 8, YS);
        k_ssd_out<<<T, 256, 0, stream>>>(YS, XBC, PROJ, ssd_d + l * 8, ssd_ng + l * 512, MIXED);
        k_sb<<<NB * 8 * 64, 64, 0, stream>>>(PROJ, OA);
        k_norm512<<<T, 256, 0, stream>>>(OA, sbo_g + l * 512, MIXED, 512);
        k_dil<<<NB * 8 * 64, 64, 0, stream>>>(PROJ, OA);
        k_norm512<<<T, 256, 0, stream>>>(OA, do_g + l * 512, MIXED, 1024);
        k_pool<<<T, 512, 0, stream>>>(PROJ, pool_w + (size_t)l * 4 * 128 * 128, pool_sc + l * 512, MIXED);
        k_gemm128<1><<<(T / 128) * (D / 128), 256, SHM, stream>>>(MIXED, WoutT, X, T, D, D, nullptr, nullptr);
        hipMemsetAsync(ctrl, 0, 4096, stream);
        k_rmsnorm2_router<<<T, 256, 0, stream>>>(X, norm2_g + l * D, RT, rg_b + l * 8, re_b + l * 64, HB, cnt, tok_e, tok_pos, tok_g);
        k_moe_offsets<<<1, 64, 0, stream>>>(cnt, pad_start, blk_e, nblk);
        k_moe_gather<<<T * 2, 256, 0, stream>>>(HB, tok_e, tok_pos, pad_start, XG, tok_row);
        k_gemm128<0><<<MAXBLK * (DFF / 128), 256, SHM, stream>>>(XG, WgT, Gb, MAXBLK * 128, DFF, D, blk_e, nblk);
        k_gemm128<0><<<MAXBLK * (DFF / 128), 256, SHM, stream>>>(XG, WuT, Ub, MAXBLK * 128, DFF, D, blk_e, nblk);
        k_swiglu<<<MAXBLK * 128 * DFF / 256, 256, 0, stream>>>(Gb, Ub, Hb, nblk);
        k_gemm128<0><<<MAXBLK * (D / 128), 256, SHM, stream>>>(Hb, WdT, Yb, MAXBLK * 128, D, DFF, blk_e, nblk);
        k_moe_combine<<<T, 256, 0, stream>>>(X, Yb, tok_row, tok_g);
    }
}
```

```cpp
#include <hip/hip_runtime.h>
#include <hip/hip_bf16.h>
#include <stdint.h>
#include <stdio.h>

typedef unsigned short u16;
using bf16x8 = __attribute__((ext_vector_type(8))) short;
using f32x4  = __attribute__((ext_vector_type(4))) float;
#define LAS __attribute__((address_space(3)))

constexpr int NB = 2, SEQ = 4096, T = NB * SEQ, D = 2048, DIN = 5128, DP = 5120;
constexpr int NE = 64, DFF = 512;
constexpr int MAXBLK = 128;
constexpr float EPS = 1e-6f;
constexpr int C_Z = 0, C_XBC = 512, C_SB = 1536, C_DIL = 3072, C_POOL = 4608;
constexpr int NTHR = 512, NWAVE = 8;
constexpr int LDS_BYTES = 16 + 131072;

__device__ __forceinline__ u16 f2bf(float f) { unsigned u = __float_as_uint(f); u += 0x7fffu + ((u >> 16) & 1u); return (u16)(u >> 16); }
__device__ __forceinline__ unsigned pk2(float lo, float hi) { return (unsigned)f2bf(lo) | ((unsigned)f2bf(hi) << 16); }
template <int O> __device__ __forceinline__ float swz_xor(float v) { return __int_as_float(__builtin_amdgcn_ds_swizzle(__float_as_int(v), (O << 10) | 0x1F)); }
__device__ __forceinline__ float rdlane(float v, int l) { return __int_as_float(__builtin_amdgcn_readlane(__float_as_int(v), l)); }
__device__ __forceinline__ float wave_sum(float v) {
    v += swz_xor<1>(v); v += swz_xor<2>(v); v += swz_xor<4>(v); v += swz_xor<8>(v); v += swz_xor<16>(v);
    return rdlane(v, 0) + rdlane(v, 32);
}
__device__ __forceinline__ float siluf(float x) { return x / (1.f + __expf(-x)); }
__device__ __forceinline__ float softplusf(float x) { return fmaxf(x, 0.f) + log1pf(__expf(-fabsf(x))); }

#define XB_TMO      128
#define XB_XCNT(j)  (256  + 64 * (j))
#define XB_XSUB(j)  (1280 + 64 * (j))
#define XB_XGEN(j)  (2304 + 64 * (j))
#define XB_TOP      3328
#define XB_TOPGEN   3392
#define XCD_BAR_WORDS 3456
#define XB_SPIN_CAP (1u << 18)
__device__ __forceinline__ unsigned xb_ld(unsigned* p)              { return __hip_atomic_load(p, __ATOMIC_RELAXED, __HIP_MEMORY_SCOPE_AGENT); }
__device__ __forceinline__ unsigned xb_add(unsigned* p, unsigned v) { return __hip_atomic_fetch_add(p, v, __ATOMIC_RELAXED, __HIP_MEMORY_SCOPE_AGENT); }
__device__ __forceinline__ unsigned xb_xcc_id() { return (unsigned)__builtin_amdgcn_s_getreg((3 << 11) | 20) & 0xFu; }
#define XB_SPIN(cond, bar) do { unsigned _sp = 0; while (cond) { __builtin_amdgcn_s_sleep(1); \
    if ((++_sp & 255u) == 0u) { if (xb_ld(&(bar)[XB_TMO])) break; if (_sp > XB_SPIN_CAP) { atomicAdd(&(bar)[XB_TMO], 1u); break; } } } } while (0)
struct XcdBarrier { unsigned* bar; unsigned x; volatile LAS unsigned* st; };
__device__ __forceinline__ XcdBarrier xcd_barrier_post(unsigned* bar, volatile LAS unsigned* st) {
    XcdBarrier b; b.bar = bar; b.x = xb_xcc_id(); b.st = st;
    if (threadIdx.x == 0) (void)xb_add(&bar[XB_XCNT(b.x)], 1u);
    return b;
}
__device__ __forceinline__ void xcd_barrier_complete(unsigned* bar, unsigned x, unsigned& nloc, unsigned& nx) {
    const unsigned G = gridDim.x * gridDim.y * gridDim.z;
    unsigned sum, cnt, mine, sp = 0u;
    for (;;) {
        sum = 0u; cnt = 0u; mine = 0u;
#pragma unroll
        for (unsigned j = 0; j < 16; ++j) { const unsigned c = xb_ld(&bar[XB_XCNT(j)]); sum += c; cnt += (c > 0u) ? 1u : 0u; mine = (j == x) ? c : mine; }
        if (sum == G) break;
        __builtin_amdgcn_s_sleep(1);
        if ((++sp & 255u) == 0u) { if (xb_ld(&bar[XB_TMO])) break; if (sp > XB_SPIN_CAP) { atomicAdd(&bar[XB_TMO], 1u); break; } }
    }
    nloc = mine > 0u ? mine : 1u; nx = cnt > 0u ? cnt : 1u;
}
__device__ __forceinline__ void xcd_barrier(const XcdBarrier& b) {
    asm volatile("s_waitcnt vmcnt(0)" ::: "memory");
    __syncthreads();
    if (threadIdx.x == 0) {
        unsigned* bar = b.bar;
        __builtin_amdgcn_s_waitcnt(0);
        unsigned nloc = b.st[0], nx = b.st[1];
        if (nloc == 0u) { xcd_barrier_complete(bar, b.x, nloc, nx); b.st[0] = nloc; b.st[1] = nx; }
        const unsigned old = xb_add(&bar[XB_XSUB(b.x)], 1u);
        const unsigned gen = old / nloc;
        if (old + 1u == (gen + 1u) * nloc) {
            __builtin_amdgcn_fence(__ATOMIC_RELEASE, "agent");
            asm volatile("s_waitcnt vmcnt(0)" ::: "memory");
            const unsigned og = xb_add(&bar[XB_TOP], 1u);
            const unsigned tg = og / nx;
            if (og + 1u == (tg + 1u) * nx) xb_add(&bar[XB_TOPGEN], 1u);
            else XB_SPIN(xb_ld(&bar[XB_TOPGEN]) == tg, bar);
            __builtin_amdgcn_fence(__ATOMIC_ACQUIRE, "agent");
            xb_add(&bar[XB_XGEN(b.x)], 1u);
            asm volatile("s_waitcnt vmcnt(0)" ::: "memory");
        } else {
            XB_SPIN(xb_ld(&bar[XB_XGEN(b.x)]) == gen, bar);
            __builtin_amdgcn_fence(__ATOMIC_ACQUIRE, "agent");
            asm volatile("s_waitcnt vmcnt(0)" ::: "memory");
        }
    }
    __syncthreads();
}

struct Params {
    const float *x_in, *norm1_g, *w_in, *conv_w, *conv_b, *dt_bias, *a_log, *ssd_d, *ssd_ng, *sbq_g, *sbk_g, *sbo_g, *dq_g, *dk_g, *do_g,
                *pool_w, *pool_sc, *w_out, *norm2_g, *rg_w, *rg_b, *re_w, *re_b, *wg, *wu, *wd;
    float* X; unsigned* bar; int* ctrl;
    u16 *HB, *MIXED, *WinT, *WoutT, *WguT, *WdT, *XG, *Hb;
    float *PROJ, *DTR, *XBC, *YS, *OSB, *ODIL, *RT, *WDT, *tok_g, *Yb;
    int *tok_e, *tok_pos, *tok_row;
};
constexpr int CTRL_INTS = 1024;

namespace pg8 {
#define PG8_LAS __attribute__((address_space(3)))
typedef unsigned short bf16_t;
typedef short bf16x8 __attribute__((ext_vector_type(8)));
typedef float f32x4 __attribute__((ext_vector_type(4)));
typedef unsigned u32x4 __attribute__((ext_vector_type(4)));
constexpr int BM = 256, BK = 64, HALF = 128, HTB = HALF * BK * 2  , STAGE_BYTES = 8 * HTB, NXCD = 8, WGM = 8;

__host__ __device__ __forceinline__ int lds_byte(int r, int c) { const int st = (r >> 4) * 2 + (c >> 5), rr = r & 15, cc = c & 31, ob = rr * 64 + cc * 2; return st * 1024 + (ob ^ (((ob >> 9) & 1) << 5)); }
__host__ __device__ __forceinline__ void stage_rc(int b, int& R, int& C) { const int st = b / 1024, sb = b % 1024, swz = sb ^ (((sb >> 9) & 1) << 5); R = (st >> 1) * 16 + swz / 64; C = (st & 1) * 32 + (swz % 64) / 2; }
__host__ __device__ __forceinline__ int perm32(int rho) { const int n = rho >> 4, i = rho & 15; return 8 * (i >> 2) + 4 * n + (i & 3); }

struct Unit { int pm, pn; };
struct Gemm { const bf16_t* A; const bf16_t* Bt; int M, N, K; };

struct StaticOrder {
    int nM, nN, nwg, G, c;
    __host__ __device__ void init(int M, int N, int G_, int c_) { nM = M / BM; nN = N / BM; nwg = nM * nN; G = G_; c = c_; }
    __host__ __device__ bool next(int i, Unit& u) const {
        const long L = (long)i * G + c; if (L >= nwg) return false;
        int wgid = (int)L; { const int q = nwg / NXCD, r = nwg % NXCD, xcd = wgid % NXCD, off = wgid / NXCD; wgid = (xcd < r ? xcd * (q + 1) : r * (q + 1) + (xcd - r) * q) + off; }
        const int nig = WGM * nN, gid = wgid / nig, fm = gid * WGM, gsz = (nM - fm) < WGM ? (nM - fm) : WGM;
        u.pm = fm + ((wgid % nig) % gsz); u.pn = (wgid % nig) / gsz; return true;
    }
    __device__ __forceinline__ void a_ready(const Unit&) const {}
    __device__ __forceinline__ void done(const Unit&) const {}
};
__device__ __forceinline__ unsigned cvt_pk_bf16(float lo, float hi) { unsigned r; asm volatile("v_cvt_pk_bf16_f32 %0, %1, %2" : "=v"(r) : "v"(lo), "v"(hi)); return r; }
typedef float f32x2 __attribute__((ext_vector_type(2)));
struct EpiF32 {
    static constexpr bool PERM = false, AFTER_DRAIN = false;
    float* C; int ldc; const float* bias;
    __device__ __forceinline__ void operator()(const f32x4 (&acc)[2][2][4][2], const Unit& u, int wr, int wc, int fr, int fq) const {
        const int row0 = u.pm * BM + wr * 64 + fr, col0 = u.pn * BM + wc * 32 + 4 * fq;
        f32x4 bv[2][2];
#pragma unroll
        for (int bj = 0; bj < 2; ++bj)
#pragma unroll
            for (int n = 0; n < 2; ++n) bv[bj][n] = bias ? *(const f32x4*)(bias + col0 + bj * HALF + n * 16) : (f32x4){0.f, 0.f, 0.f, 0.f};
#pragma unroll
        for (int ai = 0; ai < 2; ++ai)
#pragma unroll
            for (int m = 0; m < 4; ++m) { float* rowp = C + (size_t)(row0 + ai * HALF + m * 16) * ldc + col0;
#pragma unroll
                for (int bj = 0; bj < 2; ++bj)
#pragma unroll
                    for (int n = 0; n < 2; ++n) *(f32x4*)(rowp + bj * HALF + n * 16) = acc[ai][bj][m][n] + bv[bj][n]; }
    }
};
template <class Epi, class Sched, bool STAMP = false>
__device__ __forceinline__ void gemm_phase(PG8_LAS unsigned char* lds, const Gemm g, const Sched& S, const Epi& E, unsigned long long* stamps) {
    int tid = threadIdx.x; asm volatile("" : "+v"(tid));
    const int wid = __builtin_amdgcn_readfirstlane(tid >> 6), lane = tid & 63, wr = wid >> 2, wc = wid & 3, fr = lane & 15, fq = lane >> 4;
    const int K = g.K, nt = K / BK;
    int ts_lo = 0, ts_hi = 0, nts = 0; const unsigned long long rt_entry = STAMP ? (unsigned long long)wall_clock64() : 0ull;
#define PG8_STAMP() do { if (STAMP && wid == 0 && nts < 64) { const unsigned long long _c = (unsigned long long)clock64(); \
        ts_lo = (lane == nts) ? (int)(unsigned)_c : ts_lo; ts_hi = (lane == nts) ? (int)(unsigned)(_c >> 32) : ts_hi; ++nts; } } while (0)
    PG8_STAMP();
    unsigned voffA[2], voffB[2];
#pragma unroll
    for (int i = 0; i < 2; ++i) { int R, C; stage_rc(tid * 16 + i * 8192, R, C); const int Rb = Epi::PERM ? ((R & ~31) + perm32(R & 31)) : R;
        voffA[i] = (unsigned)(R * K + C) * 2u; voffB[i] = (unsigned)(Rb * K + C) * 2u; }
    const size_t kstep = (size_t)(BK * 2);
    const size_t hstep = (size_t)HALF * K * 2;
    const size_t tstep = 2 * hstep;
    const unsigned ldsw = (unsigned)wid * 1024u;
    const int aoff = lds_byte(wr * 64 + fr, fq * 8), boff = lds_byte(wc * 32 + fr, fq * 8);
#define PG8_SA(b, h) (((b) * 2 + (h)) * HTB)
#define PG8_SB(b, h) ((4 + (b) * 2 + (h)) * HTB)
#define PG8_STAGE(bufoff, gbase, voff) do { _Pragma("unroll") for (int _i = 0; _i < 2; ++_i) \
        __builtin_amdgcn_global_load_lds((const unsigned*)((const char*)(gbase) + (voff)[_i]), (PG8_LAS unsigned*)(lds + (bufoff) + ldsw + _i * 8192), 16, 0, 0); } while (0)
#define PG8_LDA(dst, b, h) do { _Pragma("unroll") for (int m = 0; m < 4; ++m) _Pragma("unroll") for (int k = 0; k < 2; ++k) dst[m][k] = *(const PG8_LAS bf16x8*)(lds + PG8_SA(b, h) + aoff + m * 2048 + k * 1024); } while (0)
#define PG8_LDB(dst, b, h) do { _Pragma("unroll") for (int n = 0; n < 2; ++n) _Pragma("unroll") for (int k = 0; k < 2; ++k) dst[n][k] = *(const PG8_LAS bf16x8*)(lds + PG8_SB(b, h) + boff + n * 2048 + k * 1024); } while (0)
#define PG8_MMA(ai, bj, At, Bt) do { __builtin_amdgcn_s_setprio(1); _Pragma("unroll") for (int m = 0; m < 4; ++m) _Pragma("unroll") for (int n = 0; n < 2; ++n) _Pragma("unroll") for (int k = 0; k < 2; ++k) \
        acc[ai][bj][m][n] = __builtin_amdgcn_mfma_f32_16x16x32_bf16(Bt[n][k], At[m][k], acc[ai][bj][m][n], 0, 0, 0); __builtin_amdgcn_s_setprio(0); } while (0)
#define PG8_WAIT_V(n) asm volatile("s_waitcnt vmcnt(" #n ")" ::: "memory")
#define PG8_WAIT_L(n) asm volatile("s_waitcnt lgkmcnt(" #n ")" ::: "memory")
#define PG8_BAR __builtin_amdgcn_s_barrier()
#define PG8_SCHED __builtin_amdgcn_sched_barrier(0)
    Unit cur, nxt; int ui = 0;
    if (!S.next(0, cur)) return;
    f32x4 acc[2][2][4][2];
#pragma unroll
    for (int a = 0; a < 2; ++a)
#pragma unroll
        for (int b = 0; b < 2; ++b)
#pragma unroll
            for (int m = 0; m < 4; ++m)
#pragma unroll
                for (int n = 0; n < 2; ++n) acc[a][b][m][n] = (f32x4){0.f, 0.f, 0.f, 0.f};
    bf16x8 At[4][2], B0[2][2], B1[2][2];
    const char* cA = (const char*)g.A + (size_t)cur.pm * tstep; const char* cB = (const char*)g.Bt + (size_t)cur.pn * tstep;
    S.a_ready(cur);
    PG8_STAGE(PG8_SB(0, 0), cB, voffB); PG8_STAGE(PG8_SA(0, 0), cA, voffA); PG8_STAGE(PG8_SB(0, 1), cB + hstep, voffB); PG8_STAGE(PG8_SA(0, 1), cA + hstep, voffA);
    if (wr == 1) PG8_BAR;
    PG8_WAIT_V(4); PG8_BAR;
    PG8_STAGE(PG8_SB(1, 0), cB + kstep, voffB); PG8_STAGE(PG8_SA(1, 0), cA + kstep, voffA); PG8_STAGE(PG8_SB(1, 1), cB + hstep + kstep, voffB);
    PG8_WAIT_V(6); PG8_BAR;
    PG8_STAMP();
    for (;;) {
        const bool has_next = S.next(ui + 1, nxt);
        const char* nA = has_next ? (const char*)g.A + (size_t)nxt.pm * tstep : cA; const char* nB = has_next ? (const char*)g.Bt + (size_t)nxt.pn * tstep : cB;
        for (int t = 0; t < nt; t += 2) {
            const bool last = (t == nt - 2);
            const char* a1 = cA + (size_t)(t + 1) * kstep;
            const char* a2 = last ? nA : cA + (size_t)(t + 2) * kstep; const char* b2 = last ? nB : cB + (size_t)(t + 2) * kstep;
            const char* a3 = a2 + kstep; const char* b3 = b2 + kstep;
            if (last && has_next) S.a_ready(nxt);
            PG8_LDB(B0, 0, 0); PG8_SCHED; PG8_LDA(At, 0, 0); PG8_STAGE(PG8_SA(1, 1), a1 + hstep, voffA);
            PG8_WAIT_L(8); PG8_BAR; PG8_WAIT_L(0); PG8_MMA(0, 0, At, B0); PG8_BAR; PG8_SCHED;
            PG8_LDB(B1, 0, 1); PG8_STAGE(PG8_SB(0, 0), b2, voffB);
            PG8_BAR; PG8_WAIT_L(0); PG8_MMA(0, 1, At, B1); PG8_BAR;
            PG8_LDA(At, 0, 1); PG8_STAGE(PG8_SA(0, 0), a2, voffA);
            PG8_BAR; PG8_WAIT_L(0); PG8_MMA(1, 0, At, B0); PG8_BAR; PG8_SCHED;
            PG8_STAGE(PG8_SB(0, 1), b2 + hstep, voffB);
            PG8_WAIT_V(6); PG8_BAR; PG8_MMA(1, 1, At, B1); PG8_BAR;
            PG8_LDB(B0, 1, 0); PG8_SCHED; PG8_LDA(At, 1, 0); PG8_STAGE(PG8_SA(0, 1), a2 + hstep, voffA);
            PG8_WAIT_L(8); PG8_BAR; PG8_WAIT_L(0); PG8_MMA(0, 0, At, B0); PG8_BAR; PG8_SCHED;
            PG8_LDB(B1, 1, 1); PG8_STAGE(PG8_SB(1, 0), b3, voffB);
            PG8_BAR; PG8_WAIT_L(0); PG8_MMA(0, 1, At, B1); PG8_BAR;
            PG8_LDA(At, 1, 1); PG8_STAGE(PG8_SA(1, 0), a3, voffA);
            PG8_BAR; PG8_WAIT_L(0); PG8_MMA(1, 0, At, B0); PG8_BAR; PG8_SCHED;
            PG8_STAGE(PG8_SB(1, 1), b3 + hstep, voffB);
            PG8_WAIT_V(6); PG8_BAR; PG8_MMA(1, 1, At, B1); PG8_BAR;
        }
        PG8_STAMP();
        if constexpr (!Epi::AFTER_DRAIN) { E(acc, cur, wr, wc, fr, fq); S.done(cur); }
        PG8_STAMP();
        if (!has_next) break;
#pragma unroll
        for (int a = 0; a < 2; ++a)
#pragma unroll
            for (int b = 0; b < 2; ++b)
#pragma unroll
                for (int m = 0; m < 4; ++m)
#pragma unroll
                    for (int n = 0; n < 2; ++n) acc[a][b][m][n] = (f32x4){0.f, 0.f, 0.f, 0.f};
        cur = nxt; cA = nA; cB = nB; ++ui;
    }
    PG8_WAIT_V(0);
    if (wr == 0) PG8_BAR;
    PG8_BAR;
    if constexpr (Epi::AFTER_DRAIN) { E.fused(acc, cur, wr, wc, fr, fq, lds, wid, lane); S.done(cur); }
    PG8_STAMP();
    if (STAMP && wid == 0) { stamps[lane] = lane < nts ? (((unsigned long long)(unsigned)ts_hi << 32) | (unsigned)ts_lo) : 0ull;
        if (lane == 62) stamps[62] = rt_entry; if (lane == 63) stamps[63] = (unsigned long long)wall_clock64(); }
#undef PG8_STAMP
#undef PG8_SA
#undef PG8_SB
#undef PG8_STAGE
#undef PG8_LDA
#undef PG8_LDB
#undef PG8_MMA
#undef PG8_WAIT_V
#undef PG8_WAIT_L
#undef PG8_BAR
#undef PG8_SCHED
}
}

namespace pg8 {
struct EpiAddF32 {
    static constexpr bool PERM = false, AFTER_DRAIN = false;
    float* C; int ldc;
    __device__ __forceinline__ void operator()(const f32x4 (&acc)[2][2][4][2], const Unit& u, int wr, int wc, int fr, int fq) const {
        const int row0 = u.pm * BM + wr * 64 + fr, col0 = u.pn * BM + wc * 32 + 4 * fq;
#pragma unroll
        for (int ai = 0; ai < 2; ++ai)
#pragma unroll
            for (int m = 0; m < 4; ++m) { float* rowp = C + (size_t)(row0 + ai * HALF + m * 16) * ldc + col0;
#pragma unroll
                for (int bj = 0; bj < 2; ++bj)
#pragma unroll
                    for (int n = 0; n < 2; ++n) { f32x4* q = (f32x4*)(rowp + bj * HALF + n * 16); *q = *q + acc[ai][bj][m][n]; } }
    }
};
struct EpiDownF32 {
    static constexpr bool PERM = false, AFTER_DRAIN = false;
    float* C;
    __device__ __forceinline__ void operator()(const f32x4 (&acc)[2][2][4][2], const Unit& u, int wr, int wc, int fr, int fq) const {
        const int row0 = u.pm * BM + wr * 64 + fr, col0 = (u.pn & 7) * BM + wc * 32 + 4 * fq;
#pragma unroll
        for (int ai = 0; ai < 2; ++ai)
#pragma unroll
            for (int m = 0; m < 4; ++m) { float* rowp = C + (size_t)(row0 + ai * HALF + m * 16) * 2048 + col0;
#pragma unroll
                for (int bj = 0; bj < 2; ++bj)
#pragma unroll
                    for (int n = 0; n < 2; ++n) *(f32x4*)(rowp + bj * HALF + n * 16) = acc[ai][bj][m][n]; }
    }
};
struct EpiSwiglu {
    static constexpr bool PERM = true, AFTER_DRAIN = false;
    bf16_t* H;
    __device__ __forceinline__ void operator()(const f32x4 (&acc)[2][2][4][2], const Unit& u, int wr, int wc, int fr, int fq) const {
        const int row0 = u.pm * BM + wr * 64 + fr, col0 = (u.pn & 3) * 128 + wc * 32 + 8 * fq;
#pragma unroll
        for (int ai = 0; ai < 2; ++ai)
#pragma unroll
            for (int m = 0; m < 4; ++m) { bf16_t* rowp = H + (size_t)(row0 + ai * HALF + m * 16) * 512 + col0;
                float h[8];
#pragma unroll
                for (int n = 0; n < 2; ++n)
#pragma unroll
                    for (int j = 0; j < 4; ++j) { const float g = acc[ai][0][m][n][j], up = acc[ai][1][m][n][j]; h[n * 4 + j] = g / (1.f + __expf(-g)) * up; }
                u32x4 w; w.x = cvt_pk_bf16(h[0], h[1]); w.y = cvt_pk_bf16(h[2], h[3]); w.z = cvt_pk_bf16(h[4], h[5]); w.w = cvt_pk_bf16(h[6], h[7]);
                *(u32x4*)rowp = w; }
    }
};
struct MoeOrder {
    const int* blk_e; int ntile, G, c, shift;
    __device__ __forceinline__ bool next(int i, Unit& u) const {
        const int L = i * G + c; if (L >= ntile) return false;
        const int mb = L >> shift, nt = L & ((1 << shift) - 1);
        u.pm = mb; u.pn = (blk_e[mb] << shift) + nt; return true;
    }
    __device__ __forceinline__ void a_ready(const Unit&) const {}
    __device__ __forceinline__ void done(const Unit&) const {}
};
}

__device__ __forceinline__ void transpose_item(const float* __restrict__ W, int ldin, int n0, int K, u16* __restrict__ WT, int row0, int nbn, int item, float* scr, int lane, int ilv = -1) {
    const int kb = item / nbn, nb = item % nbn, k0 = 64 * kb, nn = 32 * nb;
    const int rb = ilv < 0 ? row0 + nn : row0 + (nn >> 7) * 256 + ilv * 128 + (nn & 127);
#pragma unroll 8
    for (int i = 0; i < 32; ++i) { const int kk = 2 * i + (lane >> 5); scr[kk * 33 + (lane & 31)] = W[(size_t)(k0 + kk) * ldin + n0 + nn + (lane & 31)]; }
    asm volatile("s_waitcnt lgkmcnt(0)" ::: "memory");
    const int c = lane & 7;
#pragma unroll
    for (int j = 0; j < 4; ++j) { const int n = (lane >> 3) + 8 * j; const float* s = scr + (8 * c) * 33 + n;
        uint4 o; o.x = pk2(s[0 * 33], s[1 * 33]); o.y = pk2(s[2 * 33], s[3 * 33]); o.z = pk2(s[4 * 33], s[5 * 33]); o.w = pk2(s[6 * 33], s[7 * 33]);
        *(uint4*)(WT + (size_t)(rb + n) * K + k0 + 8 * c) = o; }
    asm volatile("s_waitcnt lgkmcnt(0)" ::: "memory");
}
__device__ __forceinline__ void convert_moe_weights(const float* wg, const float* wu, const float* wd, u16* WguT, u16* WdT, int l, float* scr, int gw, int NGW, int lane) {
    constexpr int IPE = 512;
    for (int it = gw; it < 3 * NE * IPE; it += NGW) {
        const int which = it / (NE * IPE), r = it % (NE * IPE), e = r / IPE, item = r % IPE;
        const size_t eo = ((size_t)l * NE + e) * (size_t)D * DFF;
        if (which == 0)      transpose_item(wg + eo, DFF, 0, D, WguT + (size_t)e * 1024 * D, 0, DFF / 32, item, scr, lane, 0);
        else if (which == 1) transpose_item(wu + eo, DFF, 0, D, WguT + (size_t)e * 1024 * D, 0, DFF / 32, item, scr, lane, 1);
        else                 transpose_item(wd + eo, D, 0, DFF, WdT + (size_t)e * D * DFF, 0, D / 32, item, scr, lane);
    }
}

typedef const Params __attribute__((address_space(4)))* KP;
#define PARAMS KP kp_ = (KP)__builtin_amdgcn_kernarg_segment_ptr(); asm volatile("" : "+s"(kp_)); const __attribute__((address_space(4))) Params& p = *kp_;
__global__ void __launch_bounds__(NTHR, 2) mega(Params pk_unused) {
    extern __shared__ __attribute__((aligned(16))) char smem[];
    if (threadIdx.x == 0) *(uint4*)smem = make_uint4(0u, 0u, 0u, 0u);
    __syncthreads();
    XcdBarrier bar; { PARAMS bar = xcd_barrier_post(p.bar, (volatile LAS unsigned*)smem); }
    char* lds = smem + 16;
    LAS unsigned char* glds = (LAS unsigned char*)(smem + 16);
    const int G = gridDim.x, NGW = G * NWAVE;
    const long gsize = (long)G * NTHR;
#define IDS PARAMS int tid = threadIdx.x; asm volatile("" : "+v"(tid)); const int wave = tid >> 6, lane = tid & 63; const int gw = blockIdx.x * NWAVE + wave; const long gtid = (long)blockIdx.x * NTHR + tid; (void)wave; (void)lane; (void)gw; (void)gtid;

    { IDS
        const float4* s = (const float4*)p.x_in; float4* d = (float4*)p.X;
        for (long i = gtid; i < (long)T * D / 4; i += gsize) d[i] = s[i];
        float* scr = (float*)lds + wave * (64 * 33);
        constexpr int I_A = 32 * 48, I_B = 32 * 112, I_O = 32 * 64, I_L = I_A + I_B + I_O;
        for (int it = gw; it < 2 * I_L; it += NGW) {
            const int l = it / I_L; int r = it % I_L;
            const float* Wl = p.w_in + (size_t)l * D * DIN; u16* WTl = p.WinT + (size_t)l * DP * D;
            if (r < I_A) { transpose_item(Wl, DIN, 0, D, WTl, 0, 48, r, scr, lane); continue; } r -= I_A;
            if (r < I_B) { transpose_item(Wl, DIN, 1544, D, WTl, 1536, 112, r, scr, lane); continue; } r -= I_B;
            transpose_item(p.w_out + (size_t)l * D * D, D, 0, D, p.WoutT + (size_t)l * D * D, 0, 64, r, scr, lane);
        }
        convert_moe_weights(p.wg, p.wu, p.wd, p.WguT, p.WdT, 0, scr, gw, NGW, lane);
        for (long i = gtid; i < 2L * 72 * D; i += gsize) { const int l = (int)(i / (72 * D)), r = (int)(i % (72 * D)), c = r / D, k = r % D;
            p.RT[i] = (c < 8) ? p.rg_w[(size_t)l * D * 8 + k * 8 + c] : p.re_w[(size_t)l * D * 64 + k * 64 + (c - 8)]; }
        for (long i = gtid; i < 2L * 8 * D; i += gsize) { const int l = (int)(i / (8 * D)), r = (int)(i % (8 * D)), j = r / D, k = r % D;
            p.WDT[i] = p.w_in[(size_t)l * D * DIN + (size_t)k * DIN + 1536 + j]; }
    }
    xcd_barrier(bar);

#pragma unroll 1
    for (int l = 0; l < 2; ++l) {
        { IDS
            const float* g1 = p.norm1_g + l * D; const float* wdt = p.WDT + (size_t)l * 8 * D;
            for (int t = gw; t < T; t += NGW) {
                float4* xr = (float4*)(p.X + (size_t)t * D) + lane;
                float4 v[8]; float ss = 0.f;
#pragma unroll
                for (int j = 0; j < 8; ++j) v[j] = xr[64 * j];
                if (l > 0) {
                    const int r0 = p.tok_row[2 * t], r1 = p.tok_row[2 * t + 1]; const float g0 = p.tok_g[2 * t], gg1 = p.tok_g[2 * t + 1];
                    const float4* y0 = (const float4*)(p.Yb + (size_t)r0 * D) + lane; const float4* y1 = (const float4*)(p.Yb + (size_t)r1 * D) + lane;
#pragma unroll
                    for (int j = 0; j < 8; ++j) { const float4 a = y0[64 * j], b = y1[64 * j];
                        v[j].x += g0 * a.x + gg1 * b.x; v[j].y += g0 * a.y + gg1 * b.y; v[j].z += g0 * a.z + gg1 * b.z; v[j].w += g0 * a.w + gg1 * b.w; xr[64 * j] = v[j]; }
                }
#pragma unroll
                for (int j = 0; j < 8; ++j) ss += v[j].x * v[j].x + v[j].y * v[j].y + v[j].z * v[j].z + v[j].w * v[j].w;
                const float r = rsqrtf(wave_sum(ss) / D + EPS);
                uint2* hb = (uint2*)(p.HB + (size_t)t * D) + lane;
#pragma unroll
                for (int j = 0; j < 8; ++j) {
                    const float4 gg = ((const float4*)g1)[lane + 64 * j];
                    v[j].x *= r * gg.x; v[j].y *= r * gg.y; v[j].z *= r * gg.z; v[j].w *= r * gg.w;
                    hb[64 * j] = make_uint2(pk2(v[j].x, v[j].y), pk2(v[j].z, v[j].w));
                }
#pragma unroll 1
                for (int q = 0; q < 8; ++q) {
                    const float4* w = (const float4*)(wdt + q * D) + lane; float s = 0.f;
#pragma unroll
                    for (int j = 0; j < 8; ++j) { const float4 ww = w[64 * j]; s += v[j].x * ww.x + v[j].y * ww.y + v[j].z * ww.z + v[j].w * ww.w; }
                    s = wave_sum(s); if (lane == 0) p.DTR[t * 8 + q] = s;
                }
            }
            if (l == 1) { float* scr = (float*)lds + wave * (64 * 33); convert_moe_weights(p.wg, p.wu, p.wd, p.WguT, p.WdT, 1, scr, gw, NGW, lane); }
        }
        xcd_barrier(bar);
        {
            PARAMS
            pg8::Gemm g{p.HB, p.WinT + (size_t)l * DP * D, T, DP, D};
            pg8::StaticOrder so; so.init(T, DP, G, blockIdx.x);
            pg8::EpiF32 ep{p.PROJ, DP, nullptr};
            pg8::gemm_phase(glds, g, so, ep, nullptr);
        }
        xcd_barrier(bar);
        { IDS
            for (int it = gw; it < T * 32; it += NGW) {
                const int t = it >> 5, r = it & 31, which = r >> 3, h = r & 7;
                const int col = (which == 0 ? C_SB : which == 1 ? C_SB + 512 : which == 2 ? C_DIL : C_DIL + 512) + h * 64 + lane;
                const float* g = (which == 0 ? p.sbq_g : which == 1 ? p.sbk_g : which == 2 ? p.dq_g : p.dk_g) + l * 64;
                float* q = p.PROJ + (size_t)t * DP + col; const float v = *q;
                const float ss = wave_sum(v * v);
                *q = v * rsqrtf(ss / 64.f + EPS) * g[lane];
            }
            const float* cw = p.conv_w + l * 4 * 1024; const float* cb = p.conv_b + l * 1024;
            for (long i = gtid; i < (long)T * 1024; i += gsize) {
                const int t = (int)(i >> 10), c = (int)(i & 1023), s = t % SEQ;
                float a = cb[c];
#pragma unroll
                for (int k = 0; k < 4; ++k) { const int ss = s - 3 + k; if (ss >= 0) a += cw[k * 1024 + c] * p.PROJ[(size_t)(t - 3 + k) * DP + C_XBC + c]; }
                p.XBC[i] = siluf(a);
            }
            float* pooled = (float*)lds;
            const float* pw = p.pool_w + (size_t)l * 4 * 128 * 128; const float* psc = p.pool_sc + l * 512;
            for (int t = blockIdx.x; t < T; t += G) {
                const int s = t % SEQ, c = tid, g = c >> 7;
                const int w = 2 << g; const int lo = max(s + 1 - w, 0); const int cn = s + 1 - lo;
                float sum = 0.f; for (int i = 0; i < cn; ++i) sum += p.PROJ[(size_t)(t - i) * DP + C_POOL + c];
                __syncthreads();
                pooled[c] = sum / (float)cn - p.PROJ[(size_t)t * DP + C_POOL + c];
                __syncthreads();
                const int e = c & 127; float y = 0.f;
                for (int cc = 0; cc < 128; ++cc) y += pooled[g * 128 + cc] * pw[(g * 128 + cc) * 128 + e];
                p.MIXED[(size_t)t * D + 1536 + c] = f2bf(y * psc[c]);
            }
        }
        xcd_barrier(bar);
        { IDS
        if (blockIdx.x < 16) {
            constexpr int TS = 32;
            float* sB = (float*)lds; float* sC = sB + TS * 128; float* sX = sC + TS * 128; float* sDT = sX + TS * 64;
            const int b = blockIdx.x >> 3, h = blockIdx.x & 7, g = h >> 2;
            const int pp = tid >> 3, q = tid & 7;
            const float a = -__expf(p.a_log[l * 8 + h]); const float bias = p.dt_bias[l * 8 + h];
            float st[16];
#pragma unroll
            for (int i = 0; i < 16; ++i) st[i] = 0.f;
            for (int s0 = 0; s0 < SEQ; s0 += TS) {
                __syncthreads();
                for (int i = tid; i < TS * 128; i += NTHR) { const int ts = i >> 7, n = i & 127; const size_t tt = (size_t)b * SEQ + s0 + ts;
                    sB[i] = p.XBC[tt * 1024 + 512 + g * 128 + n]; sC[i] = p.XBC[tt * 1024 + 768 + g * 128 + n]; }
                for (int i = tid; i < TS * 64; i += NTHR) { const int ts = i >> 6, c = i & 63; sX[i] = p.XBC[((size_t)b * SEQ + s0 + ts) * 1024 + h * 64 + c]; }
                if (tid < TS) sDT[tid] = softplusf(p.DTR[((size_t)b * SEQ + s0 + tid) * 8 + h] + bias);
                __syncthreads();
                for (int ts = 0; ts < TS; ++ts) {
                    const float dt = sDT[ts]; const float dec = __expf(dt * a); const float xdt = sX[ts * 64 + pp] * dt;
                    float y = 0.f;
#pragma unroll
                    for (int i = 0; i < 16; ++i) { st[i] = st[i] * dec + xdt * sB[ts * 128 + q * 16 + i]; y += sC[ts * 128 + q * 16 + i] * st[i]; }
                    y += swz_xor<1>(y); y += swz_xor<2>(y); y += swz_xor<4>(y);
                    if (q == 0) p.YS[((size_t)b * SEQ + s0 + ts) * 512 + h * 64 + pp] = y;
                }
            }
        } else {
            for (int u = (blockIdx.x - 16) * NWAVE + wave; u < 2048; u += (G - 16) * NWAVE) {
                const int isdil = u >> 10, v = u & 1023; const int b = v >> 9, h = (v >> 6) & 7, t0 = (v & 63) * 64; const int t = t0 + lane;
                const float* base = p.PROJ + (size_t)b * SEQ * DP;
                float q[64], acc[64];
                const int cq = isdil ? C_DIL : C_SB;
                { const float* qp = base + (size_t)t * DP + cq + h * 64;
#pragma unroll
                  for (int d = 0; d < 64; ++d) { q[d] = qp[d] * 0.125f; acc[d] = 0.f; } }
                if (!isdil) {
                    float run = 0.f;
                    int zoff = 0; asm volatile("" : "+v"(zoff));
                    for (int s = t0 + 62; s >= 0; --s) {
                        const float* kp = base + (size_t)(s + zoff) * DP + C_SB + 512 + h * 64; const float* vp = kp + 512;
                        float z = 0.f;
#pragma unroll
                        for (int d = 0; d < 64; ++d) z += q[d] * kp[d];
                        const bool act = s < t; const float sp = softplusf(z);
                        const float w = act ? __expf((z - sp) + run) : 0.f;
#pragma unroll
                        for (int d = 0; d < 64; ++d) acc[d] += w * vp[d];
                        if (act) run -= sp;
                        if (__all(act && run < -104.f)) break;
                    }
                    float* op = p.OSB + ((size_t)b * SEQ + t) * 512 + h * 64;
#pragma unroll
                    for (int d = 0; d < 64; ++d) op[d] = acc[d];
                } else {
                    float m = -1e30f, ls = 0.f;
                    for (int br = 0; br < 3; ++br) {
                        const int dil = br == 0 ? 1 : br == 1 ? 4 : 16;
                        for (int j = 0; j <= 128; ++j) {
                            const int s = t - dil * j; if (s < 0) break;
                            const float* kp = base + (size_t)s * DP + C_DIL + 512 + h * 64; const float* vp = kp + 512;
                            float z = 0.f;
#pragma unroll
                            for (int d = 0; d < 64; ++d) z += q[d] * kp[d];
                            const float mn = fmaxf(m, z); const float al = __expf(m - mn), w = __expf(z - mn);
                            ls = ls * al + w;
#pragma unroll
                            for (int d = 0; d < 64; ++d) acc[d] = acc[d] * al + w * vp[d];
                            m = mn;
                        }
                    }
                    const float inv = 1.f / ls;
                    float* op = p.ODIL + ((size_t)b * SEQ + t) * 512 + h * 64;
#pragma unroll
                    for (int d = 0; d < 64; ++d) op[d] = acc[d] * inv;
                }
            }
        }
        }
        xcd_barrier(bar);
        { IDS
            for (int it = gw; it < 3 * T; it += NGW) {
                const int which = it / T, t = it % T;
                float v[8]; float ss = 0.f;
                const float* g;
                if (which == 0) {
                    g = p.ssd_ng + l * 512;
#pragma unroll
                    for (int i = 0; i < 8; ++i) { const int c = lane + 64 * i; const float xs = p.XBC[(size_t)t * 1024 + c];
                        v[i] = (p.YS[(size_t)t * 512 + c] + xs * p.ssd_d[l * 8 + (c >> 6)]) * siluf(p.PROJ[(size_t)t * DP + C_Z + c]); }
                } else {
                    const float* O = which == 1 ? p.OSB : p.ODIL; g = (which == 1 ? p.sbo_g : p.do_g) + l * 512;
#pragma unroll
                    for (int i = 0; i < 8; ++i) v[i] = O[(size_t)t * 512 + lane + 64 * i];
                }
#pragma unroll
                for (int i = 0; i < 8; ++i) ss += v[i] * v[i];
                const float r = rsqrtf(wave_sum(ss) / 512.f + EPS);
#pragma unroll
                for (int i = 0; i < 8; ++i) { const int c = lane + 64 * i; p.MIXED[(size_t)t * D + which * 512 + c] = f2bf(v[i] * r * g[c]); }
            }
        }
        xcd_barrier(bar);
        {
            PARAMS
            pg8::Gemm g{p.MIXED, p.WoutT + (size_t)l * D * D, T, D, D};
            pg8::StaticOrder so; so.init(T, D, G, blockIdx.x);
            pg8::EpiAddF32 ep{p.X, D};
            pg8::gemm_phase(glds, g, so, ep, nullptr);
        }
        xcd_barrier(bar);
        { IDS
            const float* g2 = p.norm2_g + l * D; const float* RTl = p.RT + (size_t)l * 72 * D; int* cnt = p.ctrl + l * 64;
            for (int t = gw; t < T; t += NGW) {
                const float4* xr = (const float4*)(p.X + (size_t)t * D) + lane;
                float4 v[8]; float ss = 0.f;
#pragma unroll
                for (int j = 0; j < 8; ++j) { v[j] = xr[64 * j]; ss += v[j].x * v[j].x + v[j].y * v[j].y + v[j].z * v[j].z + v[j].w * v[j].w; }
                const float r = rsqrtf(wave_sum(ss) / D + EPS);
                uint2* hb = (uint2*)(p.HB + (size_t)t * D) + lane;
#pragma unroll
                for (int j = 0; j < 8; ++j) { const float4 gg = ((const float4*)g2)[lane + 64 * j];
                    v[j].x *= r * gg.x; v[j].y *= r * gg.y; v[j].z *= r * gg.z; v[j].w *= r * gg.w;
                    hb[64 * j] = make_uint2(pk2(v[j].x, v[j].y), pk2(v[j].z, v[j].w)); }
                float mylg = 0.f;
                float glg = 0.f;
                for (int c = 0; c < 72; ++c) {
                    const float4* w = (const float4*)(RTl + (size_t)c * D) + lane; float s = 0.f;
#pragma unroll
                    for (int j = 0; j < 8; ++j) { const float4 ww = w[64 * j]; s += v[j].x * ww.x + v[j].y * ww.y + v[j].z * ww.z + v[j].w * ww.w; }
                    s = wave_sum(s);
                    if (c < 8) { if (lane == c) glg = s + p.rg_b[l * 8 + c]; } else { if (lane == c - 8) mylg = s + p.re_b[l * 64 + c - 8]; }
                }
                float gl[8];
#pragma unroll
                for (int j = 0; j < 8; ++j) gl[j] = rdlane(glg, j);
                int gi = 0; float gm = gl[0];
#pragma unroll
                for (int j = 1; j < 8; ++j) if (gl[j] > gm) { gm = gl[j]; gi = j; }
                float gs = 0.f;
#pragma unroll
                for (int j = 0; j < 8; ++j) gs += __expf(gl[j] - gm);
                const float gp = 1.f / gs;
                float el[8];
#pragma unroll
                for (int j = 0; j < 8; ++j) el[j] = rdlane(mylg, __builtin_amdgcn_readfirstlane(gi) * 8 + j);
                int i1 = 0; float m1 = el[0];
#pragma unroll
                for (int j = 1; j < 8; ++j) if (el[j] > m1) { m1 = el[j]; i1 = j; }
                int i2 = -1; float m2 = -1e30f;
#pragma unroll
                for (int j = 0; j < 8; ++j) if (j != i1 && el[j] > m2) { m2 = el[j]; i2 = j; }
                if (lane == 0) {
                    const float p2 = __expf(m2 - m1); const float ga = gp / (1.f + p2), gb = gp * p2 / (1.f + p2);
                    const int e1 = gi * 8 + i1, e2 = gi * 8 + i2;
                    p.tok_e[t * 2] = e1; p.tok_e[t * 2 + 1] = e2; p.tok_g[t * 2] = ga; p.tok_g[t * 2 + 1] = gb;
                    p.tok_pos[t * 2] = atomicAdd(&cnt[e1], 1); p.tok_pos[t * 2 + 1] = atomicAdd(&cnt[e2], 1);
                }
            }
        }
        xcd_barrier(bar);
        { IDS
            int* pstart = (int*)lds; int* cnt = p.ctrl + l * 64; int* nblk_p = p.ctrl + 128; int* blk_e = p.ctrl + 256;
            __syncthreads();
            if (tid == 0) {
                int off = 0;
                for (int e = 0; e < NE; ++e) { pstart[e] = off; const int nb = (cnt[e] + 255) >> 8;
                    if (blockIdx.x == 0) for (int i = 0; i < nb; ++i) blk_e[(off >> 8) + i] = e;
                    off += nb << 8; }
                if (blockIdx.x == 0) *nblk_p = off >> 8;
            }
            __syncthreads();
            for (int a = gw; a < 2 * T; a += NGW) {
                const int t = a >> 1; const int row = pstart[p.tok_e[a]] + p.tok_pos[a];
                if (lane == 0) p.tok_row[a] = row;
                const uint4* src = (const uint4*)(p.HB + (size_t)t * D) + lane; uint4* dst = (uint4*)(p.XG + (size_t)row * D) + lane;
#pragma unroll
                for (int j = 0; j < 4; ++j) dst[64 * j] = src[64 * j];
            }
            __syncthreads();
        }
        xcd_barrier(bar);
        {
            PARAMS
            pg8::Gemm g{p.XG, p.WguT, MAXBLK * 256, NE * 1024, D};
            pg8::MoeOrder mo{p.ctrl + 256, p.ctrl[128] * 4, G, (int)blockIdx.x, 2};
            pg8::EpiSwiglu ep{p.Hb};
            pg8::gemm_phase(glds, g, mo, ep, nullptr);
        }
        xcd_barrier(bar);
        {
            PARAMS
            pg8::Gemm g{p.Hb, p.WdT, MAXBLK * 256, NE * D, DFF};
            pg8::MoeOrder mo{p.ctrl + 256, p.ctrl[128] * 8, G, (int)blockIdx.x, 3};
            pg8::EpiDownF32 ep{p.Yb};
            pg8::gemm_phase(glds, g, mo, ep, nullptr);
        }
        xcd_barrier(bar);
    }
    { IDS
    for (int t = gw; t < T; t += NGW) {
        float4* xr = (float4*)(p.X + (size_t)t * D) + lane;
        const int r0 = p.tok_row[2 * t], r1 = p.tok_row[2 * t + 1]; const float g0 = p.tok_g[2 * t], g1 = p.tok_g[2 * t + 1];
        const float4* y0 = (const float4*)(p.Yb + (size_t)r0 * D) + lane; const float4* y1 = (const float4*)(p.Yb + (size_t)r1 * D) + lane;
#pragma unroll
        for (int j = 0; j < 8; ++j) { float4 v = xr[64 * j]; const float4 a = y0[64 * j], b = y1[64 * j];
            v.x += g0 * a.x + g1 * b.x; v.y += g0 * a.y + g1 * b.y; v.z += g0 * a.z + g1 * b.z; v.w += g0 * a.w + g1 * b.w; xr[64 * j] = v; }
    }
    }
}

extern "C" void kernel_launch(void* const* d_in, const int* in_sizes, int n_in, void* d_out, int out_size, void* d_ws, size_t ws_size, hipStream_t stream) {
    Params p{};
    const float** pin = (const float**)&p;
    for (int i = 0; i < 26; ++i) pin[i] = (const float*)d_in[i];
    p.X = (float*)d_out;
    char* ws = (char*)d_ws; size_t off = 0;
    auto alloc = [&](size_t bytes) { void* q = ws + off; off += (bytes + 255) & ~(size_t)255; return q; };
    constexpr size_t CTL_BYTES = (size_t)XCD_BAR_WORDS * 4 + CTRL_INTS * 4;
    p.bar = (unsigned*)alloc(CTL_BYTES); p.ctrl = (int*)(p.bar + XCD_BAR_WORDS);
    p.HB = (u16*)alloc((size_t)T * D * 2);
    p.MIXED = (u16*)alloc((size_t)T * D * 2);
    p.PROJ = (float*)alloc((size_t)T * DP * 4);
    p.DTR = (float*)alloc((size_t)T * 8 * 4);
    p.XBC = (float*)alloc((size_t)T * 1024 * 4);
    p.YS = (float*)alloc((size_t)T * 512 * 4);
    p.OSB = (float*)alloc((size_t)T * 512 * 4);
    p.ODIL = (float*)alloc((size_t)T * 512 * 4);
    p.WinT = (u16*)alloc((size_t)2 * DP * D * 2);
    p.WoutT = (u16*)alloc((size_t)2 * D * D * 2);
    p.RT = (float*)alloc((size_t)2 * 72 * D * 4);
    p.WDT = (float*)alloc((size_t)2 * 8 * D * 4);
    p.WguT = (u16*)alloc((size_t)NE * 2 * DFF * D * 2);
    p.WdT = (u16*)alloc((size_t)NE * D * DFF * 2);
    p.tok_e = (int*)alloc((size_t)T * 2 * 4); p.tok_pos = (int*)alloc((size_t)T * 2 * 4); p.tok_row = (int*)alloc((size_t)T * 2 * 4);
    p.tok_g = (float*)alloc((size_t)T * 2 * 4);
    p.XG = (u16*)alloc((size_t)MAXBLK * 256 * D * 2);
    p.Hb = (u16*)alloc((size_t)MAXBLK * 256 * DFF * 2);
    p.Yb = (float*)alloc((size_t)MAXBLK * 256 * D * 4);
    static int grid = 0;
    if (grid == 0) {
        if (off > ws_size || n_in != 26) { fprintf(stderr, "kernel_launch: workspace too small (%zu > %zu) or n_in %d\n", off, ws_size, n_in); grid = -1; return; }
        int dev = 0, cus = 0, per_cu = 0;
        if (hipGetDevice(&dev) != hipSuccess || hipDeviceGetAttribute(&cus, hipDeviceAttributeMultiprocessorCount, dev) != hipSuccess) { grid = -1; return; }
        if (hipFuncSetAttribute((const void*)mega, hipFuncAttributeMaxDynamicSharedMemorySize, LDS_BYTES) != hipSuccess) { fprintf(stderr, "hipFuncSetAttribute failed\n"); grid = -1; return; }
        if (hipOccupancyMaxActiveBlocksPerMultiprocessor(&per_cu, (const void*)mega, NTHR, LDS_BYTES) != hipSuccess || per_cu < 1)
            fprintf(stderr, "kernel_launch: occupancy query reports %d blocks per CU\n", per_cu);
        (void)hipGetLastError();
        grid = cus;
    }
    if (grid < 0) return;
    if (hipMemsetAsync(p.bar, 0, CTL_BYTES, stream) != hipSuccess) return;
    hipLaunchKernelGGL(mega, dim3(grid), dim3(NTHR), LDS_BYTES, stream, p);
}
```

```cpp
#include <hip/hip_runtime.h>
#include <hip/hip_bf16.h>
#include <stdint.h>
#include <stdio.h>

typedef unsigned short u16;
using bf16x8 = __attribute__((ext_vector_type(8))) short;
using f32x4  = __attribute__((ext_vector_type(4))) float;
#define LAS __attribute__((address_space(3)))

constexpr int NB = 2, SEQ = 4096, T = NB * SEQ, D = 2048, DIN = 5128, DP = 5120;
constexpr int NE = 64, DFF = 512;
constexpr int MAXBLK = 128;
constexpr float EPS = 1e-6f;
constexpr int C_Z = 0, C_XBC = 512, C_SB = 1536, C_DIL = 3072, C_POOL = 4608;
constexpr int NTHR = 512, NWAVE = 8;
constexpr int LDS_BYTES = 16 + 131072;

__device__ __forceinline__ float bf2f(u16 h) { return __uint_as_float(((unsigned)h) << 16); }
__device__ __forceinline__ u16 f2bf(float f) { unsigned u = __float_as_uint(f); u += 0x7fffu + ((u >> 16) & 1u); return (u16)(u >> 16); }
__device__ __forceinline__ unsigned pk2(float lo, float hi) { return (unsigned)f2bf(lo) | ((unsigned)f2bf(hi) << 16); }
template <int O> __device__ __forceinline__ float swz_xor(float v) { return __int_as_float(__builtin_amdgcn_ds_swizzle(__float_as_int(v), (O << 10) | 0x1F)); }
__device__ __forceinline__ float rdlane(float v, int l) { return __int_as_float(__builtin_amdgcn_readlane(__float_as_int(v), l)); }
__device__ __forceinline__ float wave_sum(float v) {
    v += swz_xor<1>(v); v += swz_xor<2>(v); v += swz_xor<4>(v); v += swz_xor<8>(v); v += swz_xor<16>(v);
    return rdlane(v, 0) + rdlane(v, 32);
}
__device__ __forceinline__ float siluf(float x) { return x / (1.f + __expf(-x)); }
__device__ __forceinline__ float softplusf(float x) { return fmaxf(x, 0.f) + log1pf(__expf(-fabsf(x))); }

#define XB_TMO      128
#define XB_XCNT(j)  (256  + 64 * (j))
#define XB_XSUB(j)  (1280 + 64 * (j))
#define XB_XGEN(j)  (2304 + 64 * (j))
#define XB_TOP      3328
#define XB_TOPGEN   3392
#define XCD_BAR_WORDS 3456
#define XB_SPIN_CAP (1u << 18)
__device__ __forceinline__ unsigned xb_ld(unsigned* p)              { return __hip_atomic_load(p, __ATOMIC_RELAXED, __HIP_MEMORY_SCOPE_AGENT); }
__device__ __forceinline__ unsigned xb_add(unsigned* p, unsigned v) { return __hip_atomic_fetch_add(p, v, __ATOMIC_RELAXED, __HIP_MEMORY_SCOPE_AGENT); }
__device__ __forceinline__ unsigned xb_xcc_id() { return (unsigned)__builtin_amdgcn_s_getreg((3 << 11) | 20) & 0xFu; }
#define XB_SPIN(cond, bar) do { unsigned _sp = 0; while (cond) { __builtin_amdgcn_s_sleep(1); \
    if ((++_sp & 255u) == 0u) { if (xb_ld(&(bar)[XB_TMO])) break; if (_sp > XB_SPIN_CAP) { atomicAdd(&(bar)[XB_TMO], 1u); break; } } } } while (0)
struct XcdBarrier { unsigned* bar; unsigned x; volatile LAS unsigned* st; };
__device__ __forceinline__ XcdBarrier xcd_barrier_post(unsigned* bar, volatile LAS unsigned* st) {
    XcdBarrier b; b.bar = bar; b.x = xb_xcc_id(); b.st = st;
    if (threadIdx.x == 0) (void)xb_add(&bar[XB_XCNT(b.x)], 1u);
    return b;
}
__device__ __forceinline__ void xcd_barrier_complete(unsigned* bar, unsigned x, unsigned& nloc, unsigned& nx) {
    const unsigned G = gridDim.x * gridDim.y * gridDim.z;
    unsigned sum, cnt, mine, sp = 0u;
    for (;;) {
        sum = 0u; cnt = 0u; mine = 0u;
#pragma unroll
        for (unsigned j = 0; j < 16; ++j) { const unsigned c = xb_ld(&bar[XB_XCNT(j)]); sum += c; cnt += (c > 0u) ? 1u : 0u; mine = (j == x) ? c : mine; }
        if (sum == G) break;
        __builtin_amdgcn_s_sleep(1);
        if ((++sp & 255u) == 0u) { if (xb_ld(&bar[XB_TMO])) break; if (sp > XB_SPIN_CAP) { atomicAdd(&bar[XB_TMO], 1u); break; } }
    }
    nloc = mine > 0u ? mine : 1u; nx = cnt > 0u ? cnt : 1u;
}
__device__ __forceinline__ void xcd_barrier(const XcdBarrier& b) {
    asm volatile("s_waitcnt vmcnt(0)" ::: "memory");
    __syncthreads();
    if (threadIdx.x == 0) {
        unsigned* bar = b.bar; unsigned bx = b.x;
        asm volatile("" : "+s"(bar), "+s"(bx));
        __builtin_amdgcn_s_waitcnt(0);
        unsigned nloc = b.st[0], nx = b.st[1];
        if (nloc == 0u) { xcd_barrier_complete(bar, bx, nloc, nx); b.st[0] = nloc; b.st[1] = nx; }
        const unsigned old = xb_add(&bar[XB_XSUB(bx)], 1u);
        const unsigned gen = old / nloc;
        if (old + 1u == (gen + 1u) * nloc) {
            __builtin_amdgcn_fence(__ATOMIC_RELEASE, "agent");
            asm volatile("s_waitcnt vmcnt(0)" ::: "memory");
            const unsigned og = xb_add(&bar[XB_TOP], 1u);
            const unsigned tg = og / nx;
            if (og + 1u == (tg + 1u) * nx) xb_add(&bar[XB_TOPGEN], 1u);
            else XB_SPIN(xb_ld(&bar[XB_TOPGEN]) == tg, bar);
            __builtin_amdgcn_fence(__ATOMIC_ACQUIRE, "agent");
            xb_add(&bar[XB_XGEN(bx)], 1u);
            asm volatile("s_waitcnt vmcnt(0)" ::: "memory");
        } else {
            XB_SPIN(xb_ld(&bar[XB_XGEN(bx)]) == gen, bar);
            __builtin_amdgcn_fence(__ATOMIC_ACQUIRE, "agent");
            asm volatile("s_waitcnt vmcnt(0)" ::: "memory");
        }
    }
    __syncthreads();
}

struct Params {
    const float *x_in, *norm1_g, *w_in, *conv_w, *conv_b, *dt_bias, *a_log, *ssd_d, *ssd_ng, *sbq_g, *sbk_g, *sbo_g, *dq_g, *dk_g, *do_g,
                *pool_w, *pool_sc, *w_out, *norm2_g, *rg_w, *rg_b, *re_w, *re_b, *wg, *wu, *wd;
    float* X; unsigned* bar; int* ctrl;
    u16 *HB, *MIXED, *WinT, *WoutT, *WguT, *WdT, *XG, *Hb;
    u16* PROJ; float *DTR, *XBC, *YS, *RT, *WDT, *tok_g, *Yb;
    int *tok_e, *tok_pos, *tok_row;
};
constexpr int CTRL_INTS = 1024;

namespace pg8 {
#define PG8_LAS __attribute__((address_space(3)))
typedef unsigned short bf16_t;
typedef short bf16x8 __attribute__((ext_vector_type(8)));
typedef float f32x4 __attribute__((ext_vector_type(4)));
typedef unsigned u32x4 __attribute__((ext_vector_type(4)));
constexpr int BM = 256, BK = 64, HALF = 128, HTB = HALF * BK * 2  , STAGE_BYTES = 8 * HTB, NXCD = 8, WGM = 8;

__host__ __device__ __forceinline__ int lds_byte(int r, int c) { const int st = (r >> 4) * 2 + (c >> 5), rr = r & 15, cc = c & 31, ob = rr * 64 + cc * 2; return st * 1024 + (ob ^ (((ob >> 9) & 1) << 5)); }
__host__ __device__ __forceinline__ void stage_rc(int b, int& R, int& C) { const int st = b / 1024, sb = b % 1024, swz = sb ^ (((sb >> 9) & 1) << 5); R = (st >> 1) * 16 + swz / 64; C = (st & 1) * 32 + (swz % 64) / 2; }
__host__ __device__ __forceinline__ int perm32(int rho) { const int n = rho >> 4, i = rho & 15; return 8 * (i >> 2) + 4 * n + (i & 3); }

struct Unit { int pm, pn; };
struct Gemm { const bf16_t* A; const bf16_t* Bt; int M, N, K; };

struct StaticOrder {
    int nM, nN, nwg, G, c;
    __host__ __device__ void init(int M, int N, int G_, int c_) { nM = M / BM; nN = N / BM; nwg = nM * nN; G = G_; c = c_; }
    __host__ __device__ bool next(int i, Unit& u) const {
        const long L = (long)i * G + c; if (L >= nwg) return false;
        int wgid = (int)L; { const int q = nwg / NXCD, r = nwg % NXCD, xcd = wgid % NXCD, off = wgid / NXCD; wgid = (xcd < r ? xcd * (q + 1) : r * (q + 1) + (xcd - r) * q) + off; }
        const int nig = WGM * nN, gid = wgid / nig, fm = gid * WGM, gsz = (nM - fm) < WGM ? (nM - fm) : WGM;
        u.pm = fm + ((wgid % nig) % gsz); u.pn = (wgid % nig) / gsz; return true;
    }
    __device__ __forceinline__ void a_ready(const Unit&) const {}
    __device__ __forceinline__ void done(const Unit&) const {}
};
__device__ __forceinline__ unsigned cvt_pk_bf16(float lo, float hi) { unsigned r; asm volatile("v_cvt_pk_bf16_f32 %0, %1, %2" : "=v"(r) : "v"(lo), "v"(hi)); return r; }
typedef float f32x2 __attribute__((ext_vector_type(2)));
struct EpiF32 {
    static constexpr bool PERM = false, AFTER_DRAIN = false;
    float* C; int ldc; const float* bias;
    __device__ __forceinline__ void operator()(const f32x4 (&acc)[2][2][4][2], const Unit& u, int wr, int wc, int fr, int fq) const {
        const int row0 = u.pm * BM + wr * 64 + fr, col0 = u.pn * BM + wc * 32 + 4 * fq;
        f32x4 bv[2][2];
#pragma unroll
        for (int bj = 0; bj < 2; ++bj)
#pragma unroll
            for (int n = 0; n < 2; ++n) bv[bj][n] = bias ? *(const f32x4*)(bias + col0 + bj * HALF + n * 16) : (f32x4){0.f, 0.f, 0.f, 0.f};
#pragma unroll
        for (int ai = 0; ai < 2; ++ai)
#pragma unroll
            for (int m = 0; m < 4; ++m) { float* rowp = C + (size_t)(row0 + ai * HALF + m * 16) * ldc + col0;
#pragma unroll
                for (int bj = 0; bj < 2; ++bj)
#pragma unroll
                    for (int n = 0; n < 2; ++n) *(f32x4*)(rowp + bj * HALF + n * 16) = acc[ai][bj][m][n] + bv[bj][n]; }
    }
};
template <class Epi, class Sched, bool STAMP = false>
__device__ __forceinline__ void gemm_phase(PG8_LAS unsigned char* lds, const Gemm g, const Sched& S, const Epi& E, unsigned long long* stamps) {
    int tid = threadIdx.x; asm volatile("" : "+v"(tid));
    const int wid = __builtin_amdgcn_readfirstlane(tid >> 6), lane = tid & 63, wr = wid >> 2, wc = wid & 3, fr = lane & 15, fq = lane >> 4;
    const int K = g.K, nt = K / BK;
    int ts_lo = 0, ts_hi = 0, nts = 0; const unsigned long long rt_entry = STAMP ? (unsigned long long)wall_clock64() : 0ull;
#define PG8_STAMP() do { if (STAMP && wid == 0 && nts < 64) { const unsigned long long _c = (unsigned long long)clock64(); \
        ts_lo = (lane == nts) ? (int)(unsigned)_c : ts_lo; ts_hi = (lane == nts) ? (int)(unsigned)(_c >> 32) : ts_hi; ++nts; } } while (0)
    PG8_STAMP();
    unsigned voffA[2], voffB[2];
#pragma unroll
    for (int i = 0; i < 2; ++i) { int R, C; stage_rc(tid * 16 + i * 8192, R, C); const int Rb = Epi::PERM ? ((R & ~31) + perm32(R & 31)) : R;
        voffA[i] = (unsigned)(R * K + C) * 2u; voffB[i] = (unsigned)(Rb * K + C) * 2u; }
    const size_t kstep = (size_t)(BK * 2);
    const size_t hstep = (size_t)HALF * K * 2;
    const size_t tstep = 2 * hstep;
    const unsigned ldsw = (unsigned)wid * 1024u;
    const int aoff = lds_byte(wr * 64 + fr, fq * 8), boff = lds_byte(wc * 32 + fr, fq * 8);
#define PG8_SA(b, h) (((b) * 2 + (h)) * HTB)
#define PG8_SB(b, h) ((4 + (b) * 2 + (h)) * HTB)
#define PG8_STAGE(bufoff, gbase, voff) do { _Pragma("unroll") for (int _i = 0; _i < 2; ++_i) \
        __builtin_amdgcn_global_load_lds((const unsigned*)((const char*)(gbase) + (voff)[_i]), (PG8_LAS unsigned*)(lds + (bufoff) + ldsw + _i * 8192), 16, 0, 0); } while (0)
#define PG8_LDA(dst, b, h) do { _Pragma("unroll") for (int m = 0; m < 4; ++m) _Pragma("unroll") for (int k = 0; k < 2; ++k) dst[m][k] = *(const PG8_LAS bf16x8*)(lds + PG8_SA(b, h) + aoff + m * 2048 + k * 1024); } while (0)
#define PG8_LDB(dst, b, h) do { _Pragma("unroll") for (int n = 0; n < 2; ++n) _Pragma("unroll") for (int k = 0; k < 2; ++k) dst[n][k] = *(const PG8_LAS bf16x8*)(lds + PG8_SB(b, h) + boff + n * 2048 + k * 1024); } while (0)
#define PG8_MMA(ai, bj, At, Bt) do { __builtin_amdgcn_s_setprio(1); _Pragma("unroll") for (int m = 0; m < 4; ++m) _Pragma("unroll") for (int n = 0; n < 2; ++n) _Pragma("unroll") for (int k = 0; k < 2; ++k) \
        acc[ai][bj][m][n] = __builtin_amdgcn_mfma_f32_16x16x32_bf16(Bt[n][k], At[m][k], acc[ai][bj][m][n], 0, 0, 0); __builtin_amdgcn_s_setprio(0); } while (0)
#define PG8_WAIT_V(n) asm volatile("s_waitcnt vmcnt(" #n ")" ::: "memory")
#define PG8_WAIT_L(n) asm volatile("s_waitcnt lgkmcnt(" #n ")" ::: "memory")
#define PG8_BAR __builtin_amdgcn_s_barrier()
#define PG8_SCHED __builtin_amdgcn_sched_barrier(0)
    Unit cur, nxt; int ui = 0;
    if (!S.next(0, cur)) return;
    f32x4 acc[2][2][4][2];
#pragma unroll
    for (int a = 0; a < 2; ++a)
#pragma unroll
        for (int b = 0; b < 2; ++b)
#pragma unroll
            for (int m = 0; m < 4; ++m)
#pragma unroll
                for (int n = 0; n < 2; ++n) acc[a][b][m][n] = (f32x4){0.f, 0.f, 0.f, 0.f};
    bf16x8 At[4][2], B0[2][2], B1[2][2];
    const char* cA = (const char*)g.A + (size_t)cur.pm * tstep; const char* cB = (const char*)g.Bt + (size_t)cur.pn * tstep;
    S.a_ready(cur);
    PG8_STAGE(PG8_SB(0, 0), cB, voffB); PG8_STAGE(PG8_SA(0, 0), cA, voffA); PG8_STAGE(PG8_SB(0, 1), cB + hstep, voffB); PG8_STAGE(PG8_SA(0, 1), cA + hstep, voffA);
    if (wr == 1) PG8_BAR;
    PG8_WAIT_V(4); PG8_BAR;
    PG8_STAGE(PG8_SB(1, 0), cB + kstep, voffB); PG8_STAGE(PG8_SA(1, 0), cA + kstep, voffA); PG8_STAGE(PG8_SB(1, 1), cB + hstep + kstep, voffB);
    PG8_WAIT_V(6); PG8_BAR;
    PG8_STAMP();
    for (;;) {
        const bool has_next = S.next(ui + 1, nxt);
        const char* nA = has_next ? (const char*)g.A + (size_t)nxt.pm * tstep : cA; const char* nB = has_next ? (const char*)g.Bt + (size_t)nxt.pn * tstep : cB;
        for (int t = 0; t < nt; t += 2) {
            const bool last = (t == nt - 2);
            const char* a1 = cA + (size_t)(t + 1) * kstep;
            const char* a2 = last ? nA : cA + (size_t)(t + 2) * kstep; const char* b2 = last ? nB : cB + (size_t)(t + 2) * kstep;
            const char* a3 = a2 + kstep; const char* b3 = b2 + kstep;
            if (last && has_next) S.a_ready(nxt);
            PG8_LDB(B0, 0, 0); PG8_SCHED; PG8_LDA(At, 0, 0); PG8_STAGE(PG8_SA(1, 1), a1 + hstep, voffA);
            PG8_WAIT_L(8); PG8_BAR; PG8_WAIT_L(0); PG8_MMA(0, 0, At, B0); PG8_BAR; PG8_SCHED;
            PG8_LDB(B1, 0, 1); PG8_STAGE(PG8_SB(0, 0), b2, voffB);
            PG8_BAR; PG8_WAIT_L(0); PG8_MMA(0, 1, At, B1); PG8_BAR;
            PG8_LDA(At, 0, 1); PG8_STAGE(PG8_SA(0, 0), a2, voffA);
            PG8_BAR; PG8_WAIT_L(0); PG8_MMA(1, 0, At, B0); PG8_BAR; PG8_SCHED;
            PG8_STAGE(PG8_SB(0, 1), b2 + hstep, voffB);
            PG8_WAIT_V(6); PG8_BAR; PG8_MMA(1, 1, At, B1); PG8_BAR;
            PG8_LDB(B0, 1, 0); PG8_SCHED; PG8_LDA(At, 1, 0); PG8_STAGE(PG8_SA(0, 1), a2 + hstep, voffA);
            PG8_WAIT_L(8); PG8_BAR; PG8_WAIT_L(0); PG8_MMA(0, 0, At, B0); PG8_BAR; PG8_SCHED;
            PG8_LDB(B1, 1, 1); PG8_STAGE(PG8_SB(1, 0), b3, voffB);
            PG8_BAR; PG8_WAIT_L(0); PG8_MMA(0, 1, At, B1); PG8_BAR;
            PG8_LDA(At, 1, 1); PG8_STAGE(PG8_SA(1, 0), a3, voffA);
            PG8_BAR; PG8_WAIT_L(0); PG8_MMA(1, 0, At, B0); PG8_BAR; PG8_SCHED;
            PG8_STAGE(PG8_SB(1, 1), b3 + hstep, voffB);
            PG8_WAIT_V(6); PG8_BAR; PG8_MMA(1, 1, At, B1); PG8_BAR;
        }
        PG8_STAMP();
        if constexpr (!Epi::AFTER_DRAIN) { E(acc, cur, wr, wc, fr, fq); S.done(cur); }
        PG8_STAMP();
        if (!has_next) break;
#pragma unroll
        for (int a = 0; a < 2; ++a)
#pragma unroll
            for (int b = 0; b < 2; ++b)
#pragma unroll
                for (int m = 0; m < 4; ++m)
#pragma unroll
                    for (int n = 0; n < 2; ++n) acc[a][b][m][n] = (f32x4){0.f, 0.f, 0.f, 0.f};
        cur = nxt; cA = nA; cB = nB; ++ui;
    }
    PG8_WAIT_V(0);
    if (wr == 0) PG8_BAR;
    PG8_BAR;
    if constexpr (Epi::AFTER_DRAIN) { E.fused(acc, cur, wr, wc, fr, fq, lds, wid, lane); S.done(cur); }
    PG8_STAMP();
    if (STAMP && wid == 0) { stamps[lane] = lane < nts ? (((unsigned long long)(unsigned)ts_hi << 32) | (unsigned)ts_lo) : 0ull;
        if (lane == 62) stamps[62] = rt_entry; if (lane == 63) stamps[63] = (unsigned long long)wall_clock64(); }
#undef PG8_STAMP
#undef PG8_SA
#undef PG8_SB
#undef PG8_STAGE
#undef PG8_LDA
#undef PG8_LDB
#undef PG8_MMA
#undef PG8_WAIT_V
#undef PG8_WAIT_L
#undef PG8_BAR
#undef PG8_SCHED
}
}

namespace pg8 {
struct EpiStoreBf16 {
    static constexpr bool PERM = true, AFTER_DRAIN = false;
    bf16_t* O; int ldc;
    __device__ __forceinline__ void operator()(const f32x4 (&acc)[2][2][4][2], const Unit& u, int wr, int wc, int fr, int fq) const {
        const int row0 = u.pm * BM + wr * 64 + fr, col0 = u.pn * BM + wc * 32 + 8 * fq;
#pragma unroll
        for (int ai = 0; ai < 2; ++ai)
#pragma unroll
            for (int m = 0; m < 4; ++m) { bf16_t* rowp = O + (size_t)(row0 + ai * HALF + m * 16) * ldc + col0;
#pragma unroll
                for (int bj = 0; bj < 2; ++bj) { const f32x4 v0 = acc[ai][bj][m][0], v1 = acc[ai][bj][m][1];
                    u32x4 w; w.x = cvt_pk_bf16(v0[0], v0[1]); w.y = cvt_pk_bf16(v0[2], v0[3]); w.z = cvt_pk_bf16(v1[0], v1[1]); w.w = cvt_pk_bf16(v1[2], v1[3]);
                    *(u32x4*)(rowp + bj * HALF) = w; } }
    }
};
struct EpiAddF32 {
    static constexpr bool PERM = false, AFTER_DRAIN = false;
    float* C; int ldc;
    __device__ __forceinline__ void operator()(const f32x4 (&acc)[2][2][4][2], const Unit& u, int wr, int wc, int fr, int fq) const {
        const int row0 = u.pm * BM + wr * 64 + fr, col0 = u.pn * BM + wc * 32 + 4 * fq;
#pragma unroll
        for (int ai = 0; ai < 2; ++ai)
#pragma unroll
            for (int m = 0; m < 4; ++m) { float* rowp = C + (size_t)(row0 + ai * HALF + m * 16) * ldc + col0;
#pragma unroll
                for (int bj = 0; bj < 2; ++bj)
#pragma unroll
                    for (int n = 0; n < 2; ++n) { f32x4* q = (f32x4*)(rowp + bj * HALF + n * 16); *q = *q + acc[ai][bj][m][n]; } }
    }
};
struct EpiDownF32 {
    static constexpr bool PERM = false, AFTER_DRAIN = false;
    float* C;
    __device__ __forceinline__ void operator()(const f32x4 (&acc)[2][2][4][2], const Unit& u, int wr, int wc, int fr, int fq) const {
        const int row0 = u.pm * BM + wr * 64 + fr, col0 = (u.pn & 7) * BM + wc * 32 + 4 * fq;
#pragma unroll
        for (int ai = 0; ai < 2; ++ai)
#pragma unroll
            for (int m = 0; m < 4; ++m) { float* rowp = C + (size_t)(row0 + ai * HALF + m * 16) * 2048 + col0;
#pragma unroll
                for (int bj = 0; bj < 2; ++bj)
#pragma unroll
                    for (int n = 0; n < 2; ++n) *(f32x4*)(rowp + bj * HALF + n * 16) = acc[ai][bj][m][n]; }
    }
};
struct EpiSwiglu {
    static constexpr bool PERM = true, AFTER_DRAIN = false;
    bf16_t* H;
    __device__ __forceinline__ void operator()(const f32x4 (&acc)[2][2][4][2], const Unit& u, int wr, int wc, int fr, int fq) const {
        const int row0 = u.pm * BM + wr * 64 + fr, col0 = (u.pn & 3) * 128 + wc * 32 + 8 * fq;
#pragma unroll
        for (int ai = 0; ai < 2; ++ai)
#pragma unroll
            for (int m = 0; m < 4; ++m) { bf16_t* rowp = H + (size_t)(row0 + ai * HALF + m * 16) * 512 + col0;
                float h[8];
#pragma unroll
                for (int n = 0; n < 2; ++n)
#pragma unroll
                    for (int j = 0; j < 4; ++j) { const float g = acc[ai][0][m][n][j], up = acc[ai][1][m][n][j]; h[n * 4 + j] = g / (1.f + __expf(-g)) * up; }
                u32x4 w; w.x = cvt_pk_bf16(h[0], h[1]); w.y = cvt_pk_bf16(h[2], h[3]); w.z = cvt_pk_bf16(h[4], h[5]); w.w = cvt_pk_bf16(h[6], h[7]);
                *(u32x4*)rowp = w; }
    }
};
struct MoeOrder {
    const int* blk_e; int ntile, G, c, shift;
    __device__ __forceinline__ bool next(int i, Unit& u) const {
        const int L = i * G + c; if (L >= ntile) return false;
        const int mb = L >> shift, nt = L & ((1 << shift) - 1);
        u.pm = mb; u.pn = (blk_e[mb] << shift) + nt; return true;
    }
    __device__ __forceinline__ void a_ready(const Unit&) const {}
    __device__ __forceinline__ void done(const Unit&) const {}
};
}

__device__ __forceinline__ void transpose_item(const float* __restrict__ W, int ldin, int n0, int K, u16* __restrict__ WT, int row0, int nbn, int item, float* scr, int lane, int ilv = -1) {
    const int kb = item / nbn, nb = item % nbn, k0 = 64 * kb, nn = 32 * nb;
    const int rb = ilv < 0 ? row0 + nn : row0 + (nn >> 7) * 256 + ilv * 128 + (nn & 127);
#pragma unroll 8
    for (int i = 0; i < 32; ++i) { const int kk = 2 * i + (lane >> 5); scr[kk * 33 + (lane & 31)] = W[(size_t)(k0 + kk) * ldin + n0 + nn + (lane & 31)]; }
    asm volatile("s_waitcnt lgkmcnt(0)" ::: "memory");
    const int c = lane & 7;
#pragma unroll
    for (int j = 0; j < 4; ++j) { const int n = (lane >> 3) + 8 * j; const float* s = scr + (8 * c) * 33 + n;
        uint4 o; o.x = pk2(s[0 * 33], s[1 * 33]); o.y = pk2(s[2 * 33], s[3 * 33]); o.z = pk2(s[4 * 33], s[5 * 33]); o.w = pk2(s[6 * 33], s[7 * 33]);
        *(uint4*)(WT + (size_t)(rb + n) * K + k0 + 8 * c) = o; }
    asm volatile("s_waitcnt lgkmcnt(0)" ::: "memory");
}
__device__ __forceinline__ void convert_moe_weights(const float* wg, const float* wu, const float* wd, u16* WguT, u16* WdT, int l, float* scr, int gw, int NGW, int lane) {
    constexpr int IPE = 512;
    for (int it = gw; it < 3 * NE * IPE; it += NGW) {
        const int which = it / (NE * IPE), r = it % (NE * IPE), e = r / IPE, item = r % IPE;
        const size_t eo = ((size_t)l * NE + e) * (size_t)D * DFF;
        if (which == 0)      transpose_item(wg + eo, DFF, 0, D, WguT + (size_t)e * 1024 * D, 0, DFF / 32, item, scr, lane, 0);
        else if (which == 1) transpose_item(wu + eo, DFF, 0, D, WguT + (size_t)e * 1024 * D, 0, DFF / 32, item, scr, lane, 1);
        else                 transpose_item(wd + eo, D, 0, DFF, WdT + (size_t)e * D * DFF, 0, D / 32, item, scr, lane);
    }
}


constexpr int ATT_RS = 144;
constexpr int ATT_VBYTES = 32 * ATT_RS;
typedef long long i64;
typedef unsigned u32x4v __attribute__((ext_vector_type(4)));
__device__ __forceinline__ float bperm(int srclane, float v) { return __int_as_float(__builtin_amdgcn_ds_bpermute(srclane << 2, __float_as_int(v))); }
__device__ __forceinline__ float softplus_fast(float z) { return fmaxf(z, 0.f) + __logf(1.f + __expf(-fabsf(z))); }
__device__ __forceinline__ void vt_frags(unsigned vaddr, int lane, bf16x8 (&vf)[4]) {
    const unsigned a = vaddr + (unsigned)((4 * (lane >> 4) + ((lane & 15) >> 2)) * ATT_RS + (lane & 3) * 8);
    i64 r0, r1, r2, r3, r4, r5, r6, r7;
    asm volatile("s_waitcnt lgkmcnt(0)\n\t"
                 "ds_read_b64_tr_b16 %0, %8\n\tds_read_b64_tr_b16 %1, %8 offset:2304\n\t"
                 "ds_read_b64_tr_b16 %2, %8 offset:32\n\tds_read_b64_tr_b16 %3, %8 offset:2336\n\t"
                 "ds_read_b64_tr_b16 %4, %8 offset:64\n\tds_read_b64_tr_b16 %5, %8 offset:2368\n\t"
                 "ds_read_b64_tr_b16 %6, %8 offset:96\n\tds_read_b64_tr_b16 %7, %8 offset:2400\n\t"
                 "s_waitcnt lgkmcnt(0)"
                 : "=&v"(r0), "=&v"(r1), "=&v"(r2), "=&v"(r3), "=&v"(r4), "=&v"(r5), "=&v"(r6), "=&v"(r7) : "v"(a) : "memory");
    typedef i64 i64x2 __attribute__((ext_vector_type(2)));
    i64x2 t; t.x = r0; t.y = r1; vf[0] = __builtin_bit_cast(bf16x8, t); t.x = r2; t.y = r3; vf[1] = __builtin_bit_cast(bf16x8, t);
    t.x = r4; t.y = r5; vf[2] = __builtin_bit_cast(bf16x8, t); t.x = r6; t.y = r7; vf[3] = __builtin_bit_cast(bf16x8, t);
}
__device__ __forceinline__ bf16x8 pack8(const float (&a)[4], const float (&b)[4]) {
    u32x4v w; w.x = pk2(a[0], a[1]); w.y = pk2(a[2], a[3]); w.z = pk2(b[0], b[1]); w.w = pk2(b[2], b[3]);
    return __builtin_bit_cast(bf16x8, w);
}
__device__ __forceinline__ void store_out_tile(const f32x4 (&o)[4], float scale, const float* __restrict__ gain, u16* __restrict__ dst  , int g) {
#pragma unroll
    for (int dt = 0; dt < 4; ++dt) { const float4 gg = *(const float4*)(gain + dt * 16 + 4 * g);
        *(uint2*)(dst + dt * 16 + 4 * g) = make_uint2(pk2(o[dt][0] * scale * gg.x, o[dt][1] * scale * gg.y), pk2(o[dt][2] * scale * gg.z, o[dt][3] * scale * gg.w)); }
}

__device__ __forceinline__ void sb_unit(const u16* __restrict__ PROJ, int b, int qb, int h, int lane, LAS char* vl, LAS float* red,
                                        const float* __restrict__ gout, u16* __restrict__ MIXED) {
    const int li = lane & 15, g = lane >> 4; const size_t tb = (size_t)b * SEQ; const int q0 = qb * 64;
    const u16* Qp = PROJ + C_SB + h * 64; const u16* Kp = Qp + 512; const u16* Vp = Qp + 1024;
    const unsigned vaddr = (unsigned)(size_t)vl;
    bf16x8 qf[4][2];
#pragma unroll
    for (int qt = 0; qt < 4; ++qt)
#pragma unroll
        for (int s = 0; s < 2; ++s) qf[qt][s] = *(const bf16x8*)(Qp + (tb + q0 + qt * 16 + li) * DP + 32 * s + 8 * g);
    f32x4 acc[4][4];
#pragma unroll
    for (int qt = 0; qt < 4; ++qt)
#pragma unroll
        for (int dt = 0; dt < 4; ++dt) acc[qt][dt] = (f32x4){0.f, 0.f, 0.f, 0.f};
    float carry[4] = {0.f, 0.f, 0.f, 0.f};
    for (int k0 = q0 + 32; k0 >= 0; k0 -= 32) {
        bf16x8 kf[2][2];
#pragma unroll
        for (int kt = 0; kt < 2; ++kt)
#pragma unroll
            for (int s = 0; s < 2; ++s) kf[kt][s] = *(const bf16x8*)(Kp + (tb + k0 + kt * 16 + li) * DP + 32 * s + 8 * g);
#pragma unroll
        for (int u = 0; u < 4; ++u) { const int c = lane + 64 * u, row = c >> 3, cc = c & 7;
            *(LAS u32x4v*)(vl + row * ATT_RS + cc * 16) = *(const u32x4v*)(Vp + (tb + k0 + row) * DP + cc * 8); }
        bf16x8 pf[4];
#pragma unroll
        for (int qt = 0; qt < 4; ++qt) {
            const int qpos = q0 + qt * 16 + li;
            float w[2][4];
#pragma unroll
            for (int kt = 1; kt >= 0; --kt) {
                f32x4 st = __builtin_amdgcn_mfma_f32_16x16x32_bf16(kf[kt][0], qf[qt][0], (f32x4){0.f, 0.f, 0.f, 0.f}, 0, 0, 0);
                st = __builtin_amdgcn_mfma_f32_16x16x32_bf16(kf[kt][1], qf[qt][1], st, 0, 0, 0);
                const int kb = k0 + kt * 16 + 4 * g;
                float sp[4];
#pragma unroll
                for (int r = 0; r < 4; ++r) sp[r] = (kb + r < qpos) ? softplus_fast(st[r]) : 0.f;
                const float G = (sp[0] + sp[1]) + (sp[2] + sp[3]);
                const float x1 = bperm(lane ^ 16, G), hs = G + x1, x2 = bperm(lane ^ 32, hs);
                float rs = carry[qt] + (g == 3 ? 0.f : g == 2 ? x1 : g == 1 ? x2 : x1 + x2);
#pragma unroll
                for (int r = 3; r >= 0; --r) { w[kt][r] = (kb + r < qpos) ? __expf(st[r] - sp[r] - rs) : 0.f; rs += sp[r]; }
                carry[qt] += hs + x2;
            }
            pf[qt] = pack8(w[0], w[1]);
        }
        bf16x8 vf[4]; vt_frags(vaddr, lane, vf);
#pragma unroll
        for (int qt = 0; qt < 4; ++qt)
#pragma unroll
            for (int dt = 0; dt < 4; ++dt) acc[qt][dt] = __builtin_amdgcn_mfma_f32_16x16x32_bf16(vf[dt], pf[qt], acc[qt][dt], 0, 0, 0);
        if (k0 + 32 <= q0 && __all(fminf(fminf(carry[0], carry[1]), fminf(carry[2], carry[3])) > 104.f)) break;
    }
    float ss[4];
#pragma unroll
    for (int qt = 0; qt < 4; ++qt) { float s = 0.f;
#pragma unroll
        for (int dt = 0; dt < 4; ++dt) s += (acc[qt][dt][0] * acc[qt][dt][0] + acc[qt][dt][1] * acc[qt][dt][1]) + (acc[qt][dt][2] * acc[qt][dt][2] + acc[qt][dt][3] * acc[qt][dt][3]);
        s += bperm(lane ^ 16, s); s += bperm(lane ^ 32, s); ss[qt] = s;
        if (g == 0) red[h * 64 + qt * 16 + li] = s; }
    __syncthreads();
#pragma unroll
    for (int qt = 0; qt < 4; ++qt) { float tot = 0.f;
#pragma unroll
        for (int hh = 0; hh < 8; ++hh) tot += red[hh * 64 + qt * 16 + li];
        const float sc = rsqrtf(tot / 512.f + EPS);
        store_out_tile(acc[qt], sc, gout + h * 64, MIXED + (tb + q0 + qt * 16 + li) * D + 512 + h * 64, g); }
}

__device__ __forceinline__ void dil_unit(const u16* __restrict__ PROJ, int b, int w, int r, int h, int lane, LAS char* vl, LAS float* red,
                                         const float* __restrict__ gout, u16* __restrict__ MIXED) {
    const int li = lane & 15, g = lane >> 4; const size_t tb = (size_t)b * SEQ; const int qpos = w * 256 + r + 16 * li;
    const u16* Qp = PROJ + C_DIL + h * 64; const u16* Kp = Qp + 512; const u16* Vp = Qp + 1024;
    const unsigned vaddr = (unsigned)(size_t)vl;
    bf16x8 qf[2];
#pragma unroll
    for (int s = 0; s < 2; ++s) qf[s] = *(const bf16x8*)(Qp + (tb + qpos) * DP + 32 * s + 8 * g);
    f32x4 acc[4];
#pragma unroll
    for (int dt = 0; dt < 4; ++dt) acc[dt] = (f32x4){0.f, 0.f, 0.f, 0.f};
    float mrun = -1e30f, lrun = 0.f;
#pragma unroll 1
    for (int br = 0; br < 3; ++br) {
        const int dsh = br == 0 ? 4 : br == 1 ? 2 : 0;
        const int nstep = br == 0 ? 5 : br == 1 ? 6 : 12;
        const int base = w * 256 + r - (128 << dsh);
        const int rat = li << (4 - dsh);
#pragma unroll 1
        for (int st_ = 0; st_ < nstep; ++st_) {
            const int m0 = st_ * 32;
            if (base + ((m0 + 31) << dsh) < 0) continue;
            bf16x8 kf[2][2];
#pragma unroll
            for (int kt = 0; kt < 2; ++kt) { int pos = base + ((m0 + kt * 16 + li) << dsh); pos = min(max(pos, 0), SEQ - 1);
#pragma unroll
                for (int s = 0; s < 2; ++s) kf[kt][s] = *(const bf16x8*)(Kp + (tb + pos) * DP + 32 * s + 8 * g); }
#pragma unroll
            for (int u = 0; u < 4; ++u) { const int c = lane + 64 * u, row = c >> 3, cc = c & 7; int pos = base + ((m0 + row) << dsh); pos = min(max(pos, 0), SEQ - 1);
                *(LAS u32x4v*)(vl + row * ATT_RS + cc * 16) = *(const u32x4v*)(Vp + (tb + pos) * DP + cc * 8); }
            float z[2][4]; bool ok[2][4]; float zmax = -1e30f;
#pragma unroll
            for (int kt = 0; kt < 2; ++kt) {
                f32x4 st = __builtin_amdgcn_mfma_f32_16x16x32_bf16(kf[kt][0], qf[0], (f32x4){0.f, 0.f, 0.f, 0.f}, 0, 0, 0);
                st = __builtin_amdgcn_mfma_f32_16x16x32_bf16(kf[kt][1], qf[1], st, 0, 0, 0);
#pragma unroll
                for (int rr = 0; rr < 4; ++rr) { const int m = m0 + kt * 16 + 4 * g + rr; const int dm = m - rat;
                    ok[kt][rr] = (dm >= 0) && (dm <= 128) && (base + (m << dsh) >= 0);
                    z[kt][rr] = st[rr]; if (ok[kt][rr]) zmax = fmaxf(zmax, st[rr]); }
            }
            zmax = fmaxf(zmax, bperm(lane ^ 16, zmax)); zmax = fmaxf(zmax, bperm(lane ^ 32, zmax));
            const float mn = fmaxf(mrun, zmax); const float al = __expf(mrun - mn); mrun = mn;
            float pw[2][4]; float ps = 0.f;
#pragma unroll
            for (int kt = 0; kt < 2; ++kt)
#pragma unroll
                for (int rr = 0; rr < 4; ++rr) { pw[kt][rr] = ok[kt][rr] ? __expf(z[kt][rr] - mn) : 0.f; ps += pw[kt][rr]; }
            lrun = lrun * al + ps;
#pragma unroll
            for (int dt = 0; dt < 4; ++dt) acc[dt] = acc[dt] * al;
            const bf16x8 pf = pack8(pw[0], pw[1]);
            bf16x8 vf[4]; vt_frags(vaddr, lane, vf);
#pragma unroll
            for (int dt = 0; dt < 4; ++dt) acc[dt] = __builtin_amdgcn_mfma_f32_16x16x32_bf16(vf[dt], pf, acc[dt], 0, 0, 0);
        }
    }
    lrun += bperm(lane ^ 16, lrun); lrun += bperm(lane ^ 32, lrun);
    const float inv = 1.f / lrun;
    float s = 0.f;
#pragma unroll
    for (int dt = 0; dt < 4; ++dt) { acc[dt] = acc[dt] * inv; s += (acc[dt][0] * acc[dt][0] + acc[dt][1] * acc[dt][1]) + (acc[dt][2] * acc[dt][2] + acc[dt][3] * acc[dt][3]); }
    s += bperm(lane ^ 16, s); s += bperm(lane ^ 32, s);
    if (g == 0) red[h * 64 + li] = s;
    __syncthreads();
    float tot = 0.f;
#pragma unroll
    for (int hh = 0; hh < 8; ++hh) tot += red[hh * 64 + li];
    const float sc = rsqrtf(tot / 512.f + EPS);
    store_out_tile(acc, sc, gout + h * 64, MIXED + (tb + qpos) * D + 1024 + h * 64, g);
}

typedef const Params __attribute__((address_space(4)))* KP;
#define PARAMS KP kp_ = (KP)__builtin_amdgcn_kernarg_segment_ptr(); asm volatile("" : "+s"(kp_)); const __attribute__((address_space(4))) Params& p = *kp_;
__global__ void __launch_bounds__(NTHR, 2) mega(Params pk_unused) {
    extern __shared__ __attribute__((aligned(16))) char smem[];
    if (threadIdx.x == 0) *(uint4*)smem = make_uint4(0u, 0u, 0u, 0u);
    __syncthreads();
    XcdBarrier bar; { PARAMS bar = xcd_barrier_post(p.bar, (volatile LAS unsigned*)smem); }
    char* lds = smem + 16;
    LAS unsigned char* glds = (LAS unsigned char*)(smem + 16);
    const int G = gridDim.x, NGW = G * NWAVE;
    const long gsize = (long)G * NTHR;
#define IDS PARAMS int tid = threadIdx.x; asm volatile("" : "+v"(tid)); const int wave = tid >> 6, lane = tid & 63; const int gw = blockIdx.x * NWAVE + wave; const long gtid = (long)blockIdx.x * NTHR + tid; (void)wave; (void)lane; (void)gw; (void)gtid;

    { IDS
        const float4* s = (const float4*)p.x_in; float4* d = (float4*)p.X;
        for (long i = gtid; i < (long)T * D / 4; i += gsize) d[i] = s[i];
        float* scr = (float*)lds + wave * (64 * 33);
        constexpr int I_A = 32 * 48, I_B = 32 * 112, I_O = 32 * 64, I_L = I_A + I_B + I_O;
        for (int it = gw; it < 2 * I_L; it += NGW) {
            const int l = it / I_L; int r = it % I_L;
            const float* Wl = p.w_in + (size_t)l * D * DIN; u16* WTl = p.WinT + (size_t)l * DP * D;
            if (r < I_A) { transpose_item(Wl, DIN, 0, D, WTl, 0, 48, r, scr, lane); continue; } r -= I_A;
            if (r < I_B) { transpose_item(Wl, DIN, 1544, D, WTl, 1536, 112, r, scr, lane); continue; } r -= I_B;
            transpose_item(p.w_out + (size_t)l * D * D, D, 0, D, p.WoutT + (size_t)l * D * D, 0, 64, r, scr, lane);
        }
        convert_moe_weights(p.wg, p.wu, p.wd, p.WguT, p.WdT, 0, scr, gw, NGW, lane);
        for (long i = gtid; i < 2L * 72 * D; i += gsize) { const int l = (int)(i / (72 * D)), r = (int)(i % (72 * D)), c = r / D, k = r % D;
            p.RT[i] = (c < 8) ? p.rg_w[(size_t)l * D * 8 + k * 8 + c] : p.re_w[(size_t)l * D * 64 + k * 64 + (c - 8)]; }
        for (long i = gtid; i < 2L * 8 * D; i += gsize) { const int l = (int)(i / (8 * D)), r = (int)(i % (8 * D)), j = r / D, k = r % D;
            p.WDT[i] = p.w_in[(size_t)l * D * DIN + (size_t)k * DIN + 1536 + j]; }
    }
    xcd_barrier(bar);

#pragma unroll 1
    for (int l = 0; l < 2; ++l) {
        { IDS
            const float* g1 = p.norm1_g + l * D; const float* wdt = p.WDT + (size_t)l * 8 * D;
            for (int t = gw; t < T; t += NGW) {
                float4* xr = (float4*)(p.X + (size_t)t * D) + lane;
                float4 v[8]; float ss = 0.f;
#pragma unroll
                for (int j = 0; j < 8; ++j) v[j] = xr[64 * j];
                if (l > 0) {
                    const int r0 = p.tok_row[2 * t], r1 = p.tok_row[2 * t + 1]; const float g0 = p.tok_g[2 * t], gg1 = p.tok_g[2 * t + 1];
                    const float4* y0 = (const float4*)(p.Yb + (size_t)r0 * D) + lane; const float4* y1 = (const float4*)(p.Yb + (size_t)r1 * D) + lane;
#pragma unroll
                    for (int j = 0; j < 8; ++j) { const float4 a = y0[64 * j], b = y1[64 * j];
                        v[j].x += g0 * a.x + gg1 * b.x; v[j].y += g0 * a.y + gg1 * b.y; v[j].z += g0 * a.z + gg1 * b.z; v[j].w += g0 * a.w + gg1 * b.w; xr[64 * j] = v[j]; }
                }
#pragma unroll
                for (int j = 0; j < 8; ++j) ss += v[j].x * v[j].x + v[j].y * v[j].y + v[j].z * v[j].z + v[j].w * v[j].w;
                const float r = rsqrtf(wave_sum(ss) / D + EPS);
                uint2* hb = (uint2*)(p.HB + (size_t)t * D) + lane;
#pragma unroll
                for (int j = 0; j < 8; ++j) {
                    const float4 gg = ((const float4*)g1)[lane + 64 * j];
                    v[j].x *= r * gg.x; v[j].y *= r * gg.y; v[j].z *= r * gg.z; v[j].w *= r * gg.w;
                    hb[64 * j] = make_uint2(pk2(v[j].x, v[j].y), pk2(v[j].z, v[j].w));
                }
#pragma unroll 1
                for (int q = 0; q < 8; ++q) {
                    const float4* w = (const float4*)(wdt + q * D) + lane; float s = 0.f;
#pragma unroll
                    for (int j = 0; j < 8; ++j) { const float4 ww = w[64 * j]; s += v[j].x * ww.x + v[j].y * ww.y + v[j].z * ww.z + v[j].w * ww.w; }
                    s = wave_sum(s); if (lane == 0) p.DTR[t * 8 + q] = s;
                }
            }
            if (l == 1) { float* scr = (float*)lds + wave * (64 * 33); convert_moe_weights(p.wg, p.wu, p.wd, p.WguT, p.WdT, 1, scr, gw, NGW, lane); }
        }
        xcd_barrier(bar);
        {
            PARAMS
            pg8::Gemm g{p.HB, p.WinT + (size_t)l * DP * D, T, DP, D};
            pg8::StaticOrder so; so.init(T, DP, G, blockIdx.x);
            pg8::EpiStoreBf16 ep{p.PROJ, DP};
            pg8::gemm_phase(glds, g, so, ep, nullptr);
        }
        xcd_barrier(bar);
        { IDS
            for (int it = gw; it < T * 32; it += NGW) {
                const int t = it >> 5, r = it & 31, which = r >> 3, h = r & 7;
                const int col = (which == 0 ? C_SB : which == 1 ? C_SB + 512 : which == 2 ? C_DIL : C_DIL + 512) + h * 64 + lane;
                const float* g = (which == 0 ? p.sbq_g : which == 1 ? p.sbk_g : which == 2 ? p.dq_g : p.dk_g) + l * 64;
                u16* q = p.PROJ + (size_t)t * DP + col; const float v = bf2f(*q);
                const float ss = wave_sum(v * v);
                *q = f2bf(v * rsqrtf(ss / 64.f + EPS) * g[lane] * ((which & 1) ? 1.f : 0.125f));
            }
            const float* cw = p.conv_w + l * 4 * 1024; const float* cb = p.conv_b + l * 1024;
            for (long i = gtid; i < (long)T * 1024; i += gsize) {
                const int t = (int)(i >> 10), c = (int)(i & 1023), s = t % SEQ;
                float a = cb[c];
#pragma unroll
                for (int k = 0; k < 4; ++k) { const int ss = s - 3 + k; if (ss >= 0) a += cw[k * 1024 + c] * bf2f(p.PROJ[(size_t)(t - 3 + k) * DP + C_XBC + c]); }
                p.XBC[i] = siluf(a);
            }
            float* pooled = (float*)lds;
            const float* pw = p.pool_w + (size_t)l * 4 * 128 * 128; const float* psc = p.pool_sc + l * 512;
            for (int t = blockIdx.x; t < T; t += G) {
                const int s = t % SEQ, c = tid, g = c >> 7;
                const int w = 2 << g; const int lo = max(s + 1 - w, 0); const int cn = s + 1 - lo;
                float sum = 0.f; for (int i = 0; i < cn; ++i) sum += bf2f(p.PROJ[(size_t)(t - i) * DP + C_POOL + c]);
                __syncthreads();
                pooled[c] = sum / (float)cn - bf2f(p.PROJ[(size_t)t * DP + C_POOL + c]);
                __syncthreads();
                const int e = c & 127; float y = 0.f;
                for (int cc = 0; cc < 128; ++cc) y += pooled[g * 128 + cc] * pw[(g * 128 + cc) * 128 + e];
                p.MIXED[(size_t)t * D + 1536 + c] = f2bf(y * psc[c]);
            }
        }
        xcd_barrier(bar);
        { IDS
        if (blockIdx.x < 16) {
            constexpr int TS = 32;
            float* sB = (float*)lds; float* sC = sB + TS * 128; float* sX = sC + TS * 128; float* sDT = sX + TS * 64;
            const int b = blockIdx.x >> 3, h = blockIdx.x & 7, g = h >> 2;
            const int pp = tid >> 3, q = tid & 7;
            const float a = -__expf(p.a_log[l * 8 + h]); const float bias = p.dt_bias[l * 8 + h];
            float st[16];
#pragma unroll
            for (int i = 0; i < 16; ++i) st[i] = 0.f;
            for (int s0 = 0; s0 < SEQ; s0 += TS) {
                __syncthreads();
                for (int i = tid; i < TS * 128; i += NTHR) { const int ts = i >> 7, n = i & 127; const size_t tt = (size_t)b * SEQ + s0 + ts;
                    sB[i] = p.XBC[tt * 1024 + 512 + g * 128 + n]; sC[i] = p.XBC[tt * 1024 + 768 + g * 128 + n]; }
                for (int i = tid; i < TS * 64; i += NTHR) { const int ts = i >> 6, c = i & 63; sX[i] = p.XBC[((size_t)b * SEQ + s0 + ts) * 1024 + h * 64 + c]; }
                if (tid < TS) sDT[tid] = softplusf(p.DTR[((size_t)b * SEQ + s0 + tid) * 8 + h] + bias);
                __syncthreads();
                for (int ts = 0; ts < TS; ++ts) {
                    const float dt = sDT[ts]; const float dec = __expf(dt * a); const float xdt = sX[ts * 64 + pp] * dt;
                    float y = 0.f;
#pragma unroll
                    for (int i = 0; i < 16; ++i) { st[i] = st[i] * dec + xdt * sB[ts * 128 + q * 16 + i]; y += sC[ts * 128 + q * 16 + i] * st[i]; }
                    y += swz_xor<1>(y); y += swz_xor<2>(y); y += swz_xor<4>(y);
                    if (q == 0) p.YS[((size_t)b * SEQ + s0 + ts) * 512 + h * 64 + pp] = y;
                }
            }
        } else {
            LAS char* vl = (LAS char*)(smem + 16) + wave * ATT_VBYTES;
            LAS float* red = (LAS float*)((LAS char*)(smem + 16) + NWAVE * ATT_VBYTES);
            int par = 0;
            for (int u = blockIdx.x - 16; u < 128 + 512; u += G - 16, par ^= 1) {
                if (u < 128) sb_unit(p.PROJ, u >> 6, u & 63, wave, lane, vl, red + par * 512, p.sbo_g + l * 512, p.MIXED);
                else { const int v = u - 128; dil_unit(p.PROJ, v >> 8, (v >> 4) & 15, v & 15, wave, lane, vl, red + par * 512, p.do_g + l * 512, p.MIXED); }
            }
        }
        }
        xcd_barrier(bar);
        { IDS
            for (int it = gw; it < T; it += NGW) {
                const int which = 0, t = it;
                float v[8]; float ss = 0.f;
                const float* g;
                if (which == 0) {
                    g = p.ssd_ng + l * 512;
#pragma unroll
                    for (int i = 0; i < 8; ++i) { const int c = lane + 64 * i; const float xs = p.XBC[(size_t)t * 1024 + c];
                        v[i] = (p.YS[(size_t)t * 512 + c] + xs * p.ssd_d[l * 8 + (c >> 6)]) * siluf(bf2f(p.PROJ[(size_t)t * DP + C_Z + c])); }
                }
#pragma unroll
                for (int i = 0; i < 8; ++i) ss += v[i] * v[i];
                const float r = rsqrtf(wave_sum(ss) / 512.f + EPS);
#pragma unroll
                for (int i = 0; i < 8; ++i) { const int c = lane + 64 * i; p.MIXED[(size_t)t * D + which * 512 + c] = f2bf(v[i] * r * g[c]); }
            }
        }
        xcd_barrier(bar);
        {
            PARAMS
            pg8::Gemm g{p.MIXED, p.WoutT + (size_t)l * D * D, T, D, D};
            pg8::StaticOrder so; so.init(T, D, G, blockIdx.x);
            pg8::EpiAddF32 ep{p.X, D};
            pg8::gemm_phase(glds, g, so, ep, nullptr);
        }
        xcd_barrier(bar);
        { IDS
            const float* g2 = p.norm2_g + l * D; const float* RTl = p.RT + (size_t)l * 72 * D; int* cnt = p.ctrl + l * 64;
            for (int t = gw; t < T; t += NGW) {
                const float4* xr = (const float4*)(p.X + (size_t)t * D) + lane;
                float4 v[8]; float ss = 0.f;
#pragma unroll
                for (int j = 0; j < 8; ++j) { v[j] = xr[64 * j]; ss += v[j].x * v[j].x + v[j].y * v[j].y + v[j].z * v[j].z + v[j].w * v[j].w; }
                const float r = rsqrtf(wave_sum(ss) / D + EPS);
                uint2* hb = (uint2*)(p.HB + (size_t)t * D) + lane;
#pragma unroll
                for (int j = 0; j < 8; ++j) { const float4 gg = ((const float4*)g2)[lane + 64 * j];
                    v[j].x *= r * gg.x; v[j].y *= r * gg.y; v[j].z *= r * gg.z; v[j].w *= r * gg.w;
                    hb[64 * j] = make_uint2(pk2(v[j].x, v[j].y), pk2(v[j].z, v[j].w)); }
                float mylg = 0.f;
                float glg = 0.f;
                for (int c = 0; c < 72; ++c) {
                    const float4* w = (const float4*)(RTl + (size_t)c * D) + lane; float s = 0.f;
#pragma unroll
                    for (int j = 0; j < 8; ++j) { const float4 ww = w[64 * j]; s += v[j].x * ww.x + v[j].y * ww.y + v[j].z * ww.z + v[j].w * ww.w; }
                    s = wave_sum(s);
                    if (c < 8) { if (lane == c) glg = s + p.rg_b[l * 8 + c]; } else { if (lane == c - 8) mylg = s + p.re_b[l * 64 + c - 8]; }
                }
                float gl[8];
#pragma unroll
                for (int j = 0; j < 8; ++j) gl[j] = rdlane(glg, j);
                int gi = 0; float gm = gl[0];
#pragma unroll
                for (int j = 1; j < 8; ++j) if (gl[j] > gm) { gm = gl[j]; gi = j; }
                float gs = 0.f;
#pragma unroll
                for (int j = 0; j < 8; ++j) gs += __expf(gl[j] - gm);
                const float gp = 1.f / gs;
                float el[8];
#pragma unroll
                for (int j = 0; j < 8; ++j) el[j] = rdlane(mylg, __builtin_amdgcn_readfirstlane(gi) * 8 + j);
                int i1 = 0; float m1 = el[0];
#pragma unroll
                for (int j = 1; j < 8; ++j) if (el[j] > m1) { m1 = el[j]; i1 = j; }
                int i2 = -1; float m2 = -1e30f;
#pragma unroll
                for (int j = 0; j < 8; ++j) if (j != i1 && el[j] > m2) { m2 = el[j]; i2 = j; }
                if (lane == 0) {
                    const float p2 = __expf(m2 - m1); const float ga = gp / (1.f + p2), gb = gp * p2 / (1.f + p2);
                    const int e1 = gi * 8 + i1, e2 = gi * 8 + i2;
                    p.tok_e[t * 2] = e1; p.tok_e[t * 2 + 1] = e2; p.tok_g[t * 2] = ga; p.tok_g[t * 2 + 1] = gb;
                    p.tok_pos[t * 2] = atomicAdd(&cnt[e1], 1); p.tok_pos[t * 2 + 1] = atomicAdd(&cnt[e2], 1);
                }
            }
        }
        xcd_barrier(bar);
        { IDS
            int* pstart = (int*)lds; int* cnt = p.ctrl + l * 64; int* nblk_p = p.ctrl + 128; int* blk_e = p.ctrl + 256;
            __syncthreads();
            if (tid == 0) {
                int off = 0;
                for (int e = 0; e < NE; ++e) { pstart[e] = off; const int nb = (cnt[e] + 255) >> 8;
                    if (blockIdx.x == 0) for (int i = 0; i < nb; ++i) blk_e[(off >> 8) + i] = e;
                    off += nb << 8; }
                if (blockIdx.x == 0) *nblk_p = off >> 8;
            }
            __syncthreads();
            for (int a = gw; a < 2 * T; a += NGW) {
                const int t = a >> 1; const int row = pstart[p.tok_e[a]] + p.tok_pos[a];
                if (lane == 0) p.tok_row[a] = row;
                const uint4* src = (const uint4*)(p.HB + (size_t)t * D) + lane; uint4* dst = (uint4*)(p.XG + (size_t)row * D) + lane;
#pragma unroll
                for (int j = 0; j < 4; ++j) dst[64 * j] = src[64 * j];
            }
            __syncthreads();
        }
        xcd_barrier(bar);
        {
            PARAMS
            pg8::Gemm g{p.XG, p.WguT, MAXBLK * 256, NE * 1024, D};
            pg8::MoeOrder mo{p.ctrl + 256, p.ctrl[128] * 4, G, (int)blockIdx.x, 2};
            pg8::EpiSwiglu ep{p.Hb};
            pg8::gemm_phase(glds, g, mo, ep, nullptr);
        }
        xcd_barrier(bar);
        {
            PARAMS
            pg8::Gemm g{p.Hb, p.WdT, MAXBLK * 256, NE * D, DFF};
            pg8::MoeOrder mo{p.ctrl + 256, p.ctrl[128] * 8, G, (int)blockIdx.x, 3};
            pg8::EpiDownF32 ep{p.Yb};
            pg8::gemm_phase(glds, g, mo, ep, nullptr);
        }
        xcd_barrier(bar);
    }
    { IDS
    for (int t = gw; t < T; t += NGW) {
        float4* xr = (float4*)(p.X + (size_t)t * D) + lane;
        const int r0 = p.tok_row[2 * t], r1 = p.tok_row[2 * t + 1]; const float g0 = p.tok_g[2 * t], g1 = p.tok_g[2 * t + 1];
        const float4* y0 = (const float4*)(p.Yb + (size_t)r0 * D) + lane; const float4* y1 = (const float4*)(p.Yb + (size_t)r1 * D) + lane;
#pragma unroll
        for (int j = 0; j < 8; ++j) { float4 v = xr[64 * j]; const float4 a = y0[64 * j], b = y1[64 * j];
            v.x += g0 * a.x + g1 * b.x; v.y += g0 * a.y + g1 * b.y; v.z += g0 * a.z + g1 * b.z; v.w += g0 * a.w + g1 * b.w; xr[64 * j] = v; }
    }
    }
}

extern "C" void kernel_launch(void* const* d_in, const int* in_sizes, int n_in, void* d_out, int out_size, void* d_ws, size_t ws_size, hipStream_t stream) {
    Params p{};
    const float** pin = (const float**)&p;
    for (int i = 0; i < 26; ++i) pin[i] = (const float*)d_in[i];
    p.X = (float*)d_out;
    char* ws = (char*)d_ws; size_t off = 0;
    auto alloc = [&](size_t bytes) { void* q = ws + off; off += (bytes + 255) & ~(size_t)255; return q; };
    constexpr size_t CTL_BYTES = (size_t)XCD_BAR_WORDS * 4 + CTRL_INTS * 4;
    p.bar = (unsigned*)alloc(CTL_BYTES); p.ctrl = (int*)(p.bar + XCD_BAR_WORDS);
    p.HB = (u16*)alloc((size_t)T * D * 2);
    p.MIXED = (u16*)alloc((size_t)T * D * 2);
    p.PROJ = (u16*)alloc((size_t)T * DP * 2);
    p.DTR = (float*)alloc((size_t)T * 8 * 4);
    p.XBC = (float*)alloc((size_t)T * 1024 * 4);
    p.YS = (float*)alloc((size_t)T * 512 * 4);
    p.WinT = (u16*)alloc((size_t)2 * DP * D * 2);
    p.WoutT = (u16*)alloc((size_t)2 * D * D * 2);
    p.RT = (float*)alloc((size_t)2 * 72 * D * 4);
    p.WDT = (float*)alloc((size_t)2 * 8 * D * 4);
    p.WguT = (u16*)alloc((size_t)NE * 2 * DFF * D * 2);
    p.WdT = (u16*)alloc((size_t)NE * D * DFF * 2);
    p.tok_e = (int*)alloc((size_t)T * 2 * 4); p.tok_pos = (int*)alloc((size_t)T * 2 * 4); p.tok_row = (int*)alloc((size_t)T * 2 * 4);
    p.tok_g = (float*)alloc((size_t)T * 2 * 4);
    p.XG = (u16*)alloc((size_t)MAXBLK * 256 * D * 2);
    p.Hb = (u16*)alloc((size_t)MAXBLK * 256 * DFF * 2);
    p.Yb = (float*)alloc((size_t)MAXBLK * 256 * D * 4);
    static int grid = 0;
    if (grid == 0) {
        if (off > ws_size || n_in != 26) { fprintf(stderr, "kernel_launch: workspace too small (%zu > %zu) or n_in %d\n", off, ws_size, n_in); grid = -1; return; }
        int dev = 0, cus = 0, per_cu = 0;
        if (hipGetDevice(&dev) != hipSuccess || hipDeviceGetAttribute(&cus, hipDeviceAttributeMultiprocessorCount, dev) != hipSuccess) { grid = -1; return; }
        if (hipFuncSetAttribute((const void*)mega, hipFuncAttributeMaxDynamicSharedMemorySize, LDS_BYTES) != hipSuccess) { fprintf(stderr, "hipFuncSetAttribute failed\n"); grid = -1; return; }
        if (hipOccupancyMaxActiveBlocksPerMultiprocessor(&per_cu, (const void*)mega, NTHR, LDS_BYTES) != hipSuccess || per_cu < 1)
            fprintf(stderr, "kernel_launch: occupancy query reports %d blocks per CU\n", per_cu);
        (void)hipGetLastError();
        grid = cus;
    }
    if (grid < 0) return;
    if (hipMemsetAsync(p.bar, 0, CTL_BYTES, stream) != hipSuccess) return;
    hipLaunchKernelGGL(mega, dim3(grid), dim3(NTHR), LDS_BYTES, stream, p);
}
```

```cpp
#include <hip/hip_runtime.h>
#include <hip/hip_bf16.h>
#include <stdint.h>
#include <stdio.h>

typedef unsigned short u16;
using bf16x8 = __attribute__((ext_vector_type(8))) short;
using f32x4  = __attribute__((ext_vector_type(4))) float;
#define LAS __attribute__((address_space(3)))

constexpr int NB = 2, SEQ = 4096, T = NB * SEQ, D = 2048, DIN = 5128, DP = 5120;
constexpr int NE = 64, DFF = 512;
constexpr int MAXBLK = 128;
constexpr float EPS = 1e-6f;
constexpr int C_Z = 0, C_XBC = 512, C_SB = 1536, C_DIL = 3072, C_POOL = 4608;
constexpr int NTHR = 512, NWAVE = 8;
constexpr int LDS_BYTES = 16 + 131072;

__device__ __forceinline__ float bf2f(u16 h) { return __uint_as_float(((unsigned)h) << 16); }
__device__ __forceinline__ u16 f2bf(float f) { unsigned u = __float_as_uint(f); u += 0x7fffu + ((u >> 16) & 1u); return (u16)(u >> 16); }
__device__ __forceinline__ unsigned pk2(float lo, float hi) { return (unsigned)f2bf(lo) | ((unsigned)f2bf(hi) << 16); }
template <int O> __device__ __forceinline__ float swz_xor(float v) { return __int_as_float(__builtin_amdgcn_ds_swizzle(__float_as_int(v), (O << 10) | 0x1F)); }
__device__ __forceinline__ float rdlane(float v, int l) { return __int_as_float(__builtin_amdgcn_readlane(__float_as_int(v), l)); }
__device__ __forceinline__ float wave_sum(float v) {
    v += swz_xor<1>(v); v += swz_xor<2>(v); v += swz_xor<4>(v); v += swz_xor<8>(v); v += swz_xor<16>(v);
    return rdlane(v, 0) + rdlane(v, 32);
}
__device__ __forceinline__ float siluf(float x) { return x / (1.f + __expf(-x)); }
__device__ __forceinline__ float softplusf(float x) { return fmaxf(x, 0.f) + log1pf(__expf(-fabsf(x))); }

#define XB_TMO      128
#define XB_XCNT(j)  (256  + 64 * (j))
#define XB_XSUB(j)  (1280 + 64 * (j))
#define XB_XGEN(j)  (2304 + 64 * (j))
#define XB_TOP      3328
#define XB_TOPGEN   3392
#define XCD_BAR_WORDS 3456
#define XB_SPIN_CAP (1u << 18)
__device__ __forceinline__ unsigned xb_ld(unsigned* p)              { return __hip_atomic_load(p, __ATOMIC_RELAXED, __HIP_MEMORY_SCOPE_AGENT); }
__device__ __forceinline__ unsigned xb_add(unsigned* p, unsigned v) { return __hip_atomic_fetch_add(p, v, __ATOMIC_RELAXED, __HIP_MEMORY_SCOPE_AGENT); }
__device__ __forceinline__ unsigned xb_xcc_id() { return (unsigned)__builtin_amdgcn_s_getreg((3 << 11) | 20) & 0xFu; }
#define XB_SPIN(cond, bar) do { unsigned _sp = 0; while (cond) { __builtin_amdgcn_s_sleep(1); \
    if ((++_sp & 255u) == 0u) { if (xb_ld(&(bar)[XB_TMO])) break; if (_sp > XB_SPIN_CAP) { atomicAdd(&(bar)[XB_TMO], 1u); break; } } } } while (0)
struct XcdBarrier { unsigned* bar; unsigned x; volatile LAS unsigned* st; };
__device__ __forceinline__ XcdBarrier xcd_barrier_post(unsigned* bar, volatile LAS unsigned* st) {
    XcdBarrier b; b.bar = bar; b.x = xb_xcc_id(); b.st = st;
    if (threadIdx.x == 0) (void)xb_add(&bar[XB_XCNT(b.x)], 1u);
    return b;
}
__device__ __forceinline__ void xcd_barrier_complete(unsigned* bar, unsigned x, unsigned& nloc, unsigned& nx) {
    const unsigned G = gridDim.x * gridDim.y * gridDim.z;
    unsigned sum, cnt, mine, sp = 0u;
    for (;;) {
        sum = 0u; cnt = 0u; mine = 0u;
#pragma unroll
        for (unsigned j = 0; j < 16; ++j) { const unsigned c = xb_ld(&bar[XB_XCNT(j)]); sum += c; cnt += (c > 0u) ? 1u : 0u; mine = (j == x) ? c : mine; }
        if (sum == G) break;
        __builtin_amdgcn_s_sleep(1);
        if ((++sp & 255u) == 0u) { if (xb_ld(&bar[XB_TMO])) break; if (sp > XB_SPIN_CAP) { atomicAdd(&bar[XB_TMO], 1u); break; } }
    }
    nloc = mine > 0u ? mine : 1u; nx = cnt > 0u ? cnt : 1u;
}
__device__ __forceinline__ void xcd_barrier(const XcdBarrier& b) {
    asm volatile("s_waitcnt vmcnt(0)" ::: "memory");
    __syncthreads();
    if (threadIdx.x == 0) {
        unsigned* bar = b.bar; unsigned bx = b.x;
        asm volatile("" : "+s"(bar), "+s"(bx));
        __builtin_amdgcn_s_waitcnt(0);
        unsigned nloc = b.st[0], nx = b.st[1];
        if (nloc == 0u) { xcd_barrier_complete(bar, bx, nloc, nx); b.st[0] = nloc; b.st[1] = nx; }
        const unsigned old = xb_add(&bar[XB_XSUB(bx)], 1u);
        const unsigned gen = old / nloc;
        if (old + 1u == (gen + 1u) * nloc) {
            __builtin_amdgcn_fence(__ATOMIC_RELEASE, "agent");
            asm volatile("s_waitcnt vmcnt(0)" ::: "memory");
            const unsigned og = xb_add(&bar[XB_TOP], 1u);
            const unsigned tg = og / nx;
            if (og + 1u == (tg + 1u) * nx) xb_add(&bar[XB_TOPGEN], 1u);
            else XB_SPIN(xb_ld(&bar[XB_TOPGEN]) == tg, bar);
            __builtin_amdgcn_fence(__ATOMIC_ACQUIRE, "agent");
            xb_add(&bar[XB_XGEN(bx)], 1u);
            asm volatile("s_waitcnt vmcnt(0)" ::: "memory");
        } else {
            XB_SPIN(xb_ld(&bar[XB_XGEN(bx)]) == gen, bar);
            __builtin_amdgcn_fence(__ATOMIC_ACQUIRE, "agent");
            asm volatile("s_waitcnt vmcnt(0)" ::: "memory");
        }
    }
    __syncthreads();
}

struct Params {
    const float *x_in, *norm1_g, *w_in, *conv_w, *conv_b, *dt_bias, *a_log, *ssd_d, *ssd_ng, *sbq_g, *sbk_g, *sbo_g, *dq_g, *dk_g, *do_g,
                *pool_w, *pool_sc, *w_out, *norm2_g, *rg_w, *rg_b, *re_w, *re_b, *wg, *wu, *wd;
    float* X; unsigned* bar; int* ctrl;
    u16 *HB, *MIXED, *WinT, *WoutT, *WguT, *WdT, *XG, *Hb;
    u16 *PROJ, *PREV, *CG; float *DTR, *YD, *SS, *ATOT, *ACS, *RT, *WDT, *tok_g, *Yb;
    int *tok_e, *tok_pos, *tok_row;
};
constexpr int CTRL_INTS = 1024;

namespace pg8 {
#define PG8_LAS __attribute__((address_space(3)))
typedef unsigned short bf16_t;
typedef short bf16x8 __attribute__((ext_vector_type(8)));
typedef float f32x4 __attribute__((ext_vector_type(4)));
typedef unsigned u32x4 __attribute__((ext_vector_type(4)));
constexpr int BM = 256, BK = 64, HALF = 128, HTB = HALF * BK * 2  , STAGE_BYTES = 8 * HTB, NXCD = 8, WGM = 8;

__host__ __device__ __forceinline__ int lds_byte(int r, int c) { const int st = (r >> 4) * 2 + (c >> 5), rr = r & 15, cc = c & 31, ob = rr * 64 + cc * 2; return st * 1024 + (ob ^ (((ob >> 9) & 1) << 5)); }
__host__ __device__ __forceinline__ void stage_rc(int b, int& R, int& C) { const int st = b / 1024, sb = b % 1024, swz = sb ^ (((sb >> 9) & 1) << 5); R = (st >> 1) * 16 + swz / 64; C = (st & 1) * 32 + (swz % 64) / 2; }
__host__ __device__ __forceinline__ int perm32(int rho) { const int n = rho >> 4, i = rho & 15; return 8 * (i >> 2) + 4 * n + (i & 3); }

struct Unit { int pm, pn; };
struct Gemm { const bf16_t* A; const bf16_t* Bt; int M, N, K; };

struct StaticOrder {
    int nM, nN, nwg, G, c;
    __host__ __device__ void init(int M, int N, int G_, int c_) { nM = M / BM; nN = N / BM; nwg = nM * nN; G = G_; c = c_; }
    __host__ __device__ bool next(int i, Unit& u) const {
        const long L = (long)i * G + c; if (L >= nwg) return false;
        int wgid = (int)L; { const int q = nwg / NXCD, r = nwg % NXCD, xcd = wgid % NXCD, off = wgid / NXCD; wgid = (xcd < r ? xcd * (q + 1) : r * (q + 1) + (xcd - r) * q) + off; }
        const int nig = WGM * nN, gid = wgid / nig, fm = gid * WGM, gsz = (nM - fm) < WGM ? (nM - fm) : WGM;
        u.pm = fm + ((wgid % nig) % gsz); u.pn = (wgid % nig) / gsz; return true;
    }
    __device__ __forceinline__ void a_ready(const Unit&) const {}
    __device__ __forceinline__ void done(const Unit&) const {}
};
__device__ __forceinline__ unsigned cvt_pk_bf16(float lo, float hi) { unsigned r; asm volatile("v_cvt_pk_bf16_f32 %0, %1, %2" : "=v"(r) : "v"(lo), "v"(hi)); return r; }
typedef float f32x2 __attribute__((ext_vector_type(2)));
struct EpiF32 {
    static constexpr bool PERM = false, AFTER_DRAIN = false;
    float* C; int ldc; const float* bias;
    __device__ __forceinline__ void operator()(const f32x4 (&acc)[2][2][4][2], const Unit& u, int wr, int wc, int fr, int fq) const {
        const int row0 = u.pm * BM + wr * 64 + fr, col0 = u.pn * BM + wc * 32 + 4 * fq;
        f32x4 bv[2][2];
#pragma unroll
        for (int bj = 0; bj < 2; ++bj)
#pragma unroll
            for (int n = 0; n < 2; ++n) bv[bj][n] = bias ? *(const f32x4*)(bias + col0 + bj * HALF + n * 16) : (f32x4){0.f, 0.f, 0.f, 0.f};
#pragma unroll
        for (int ai = 0; ai < 2; ++ai)
#pragma unroll
            for (int m = 0; m < 4; ++m) { float* rowp = C + (size_t)(row0 + ai * HALF + m * 16) * ldc + col0;
#pragma unroll
                for (int bj = 0; bj < 2; ++bj)
#pragma unroll
                    for (int n = 0; n < 2; ++n) *(f32x4*)(rowp + bj * HALF + n * 16) = acc[ai][bj][m][n] + bv[bj][n]; }
    }
};
template <class Epi, class Sched, bool STAMP = false>
__device__ __forceinline__ void gemm_phase(PG8_LAS unsigned char* lds, const Gemm g, const Sched& S, const Epi& E, unsigned long long* stamps) {
    int tid = threadIdx.x; asm volatile("" : "+v"(tid));
    const int wid = __builtin_amdgcn_readfirstlane(tid >> 6), lane = tid & 63, wr = wid >> 2, wc = wid & 3, fr = lane & 15, fq = lane >> 4;
    const int K = g.K, nt = K / BK;
    int ts_lo = 0, ts_hi = 0, nts = 0; const unsigned long long rt_entry = STAMP ? (unsigned long long)wall_clock64() : 0ull;
#define PG8_STAMP() do { if (STAMP && wid == 0 && nts < 64) { const unsigned long long _c = (unsigned long long)clock64(); \
        ts_lo = (lane == nts) ? (int)(unsigned)_c : ts_lo; ts_hi = (lane == nts) ? (int)(unsigned)(_c >> 32) : ts_hi; ++nts; } } while (0)
    PG8_STAMP();
    unsigned voffA[2], voffB[2];
#pragma unroll
    for (int i = 0; i < 2; ++i) { int R, C; stage_rc(tid * 16 + i * 8192, R, C); const int Rb = Epi::PERM ? ((R & ~31) + perm32(R & 31)) : R;
        voffA[i] = (unsigned)(R * K + C) * 2u; voffB[i] = (unsigned)(Rb * K + C) * 2u; }
    const size_t kstep = (size_t)(BK * 2);
    const size_t hstep = (size_t)HALF * K * 2;
    const size_t tstep = 2 * hstep;
    const unsigned ldsw = (unsigned)wid * 1024u;
    const int aoff = lds_byte(wr * 64 + fr, fq * 8), boff = lds_byte(wc * 32 + fr, fq * 8);
#define PG8_SA(b, h) (((b) * 2 + (h)) * HTB)
#define PG8_SB(b, h) ((4 + (b) * 2 + (h)) * HTB)
#define PG8_STAGE(bufoff, gbase, voff) do { _Pragma("unroll") for (int _i = 0; _i < 2; ++_i) \
        __builtin_amdgcn_global_load_lds((const unsigned*)((const char*)(gbase) + (voff)[_i]), (PG8_LAS unsigned*)(lds + (bufoff) + ldsw + _i * 8192), 16, 0, 0); } while (0)
#define PG8_LDA(dst, b, h) do { _Pragma("unroll") for (int m = 0; m < 4; ++m) _Pragma("unroll") for (int k = 0; k < 2; ++k) dst[m][k] = *(const PG8_LAS bf16x8*)(lds + PG8_SA(b, h) + aoff + m * 2048 + k * 1024); } while (0)
#define PG8_LDB(dst, b, h) do { _Pragma("unroll") for (int n = 0; n < 2; ++n) _Pragma("unroll") for (int k = 0; k < 2; ++k) dst[n][k] = *(const PG8_LAS bf16x8*)(lds + PG8_SB(b, h) + boff + n * 2048 + k * 1024); } while (0)
#define PG8_MMA(ai, bj, At, Bt) do { __builtin_amdgcn_s_setprio(1); _Pragma("unroll") for (int m = 0; m < 4; ++m) _Pragma("unroll") for (int n = 0; n < 2; ++n) _Pragma("unroll") for (int k = 0; k < 2; ++k) \
        acc[ai][bj][m][n] = __builtin_amdgcn_mfma_f32_16x16x32_bf16(Bt[n][k], At[m][k], acc[ai][bj][m][n], 0, 0, 0); __builtin_amdgcn_s_setprio(0); } while (0)
#define PG8_WAIT_V(n) asm volatile("s_waitcnt vmcnt(" #n ")" ::: "memory")
#define PG8_WAIT_L(n) asm volatile("s_waitcnt lgkmcnt(" #n ")" ::: "memory")
#define PG8_BAR __builtin_amdgcn_s_barrier()
#define PG8_SCHED __builtin_amdgcn_sched_barrier(0)
    Unit cur, nxt; int ui = 0;
    if (!S.next(0, cur)) return;
    f32x4 acc[2][2][4][2];
#pragma unroll
    for (int a = 0; a < 2; ++a)
#pragma unroll
        for (int b = 0; b < 2; ++b)
#pragma unroll
            for (int m = 0; m < 4; ++m)
#pragma unroll
                for (int n = 0; n < 2; ++n) acc[a][b][m][n] = (f32x4){0.f, 0.f, 0.f, 0.f};
    bf16x8 At[4][2], B0[2][2], B1[2][2];
    const char* cA = (const char*)g.A + (size_t)cur.pm * tstep; const char* cB = (const char*)g.Bt + (size_t)cur.pn * tstep;
    S.a_ready(cur);
    PG8_STAGE(PG8_SB(0, 0), cB, voffB); PG8_STAGE(PG8_SA(0, 0), cA, voffA); PG8_STAGE(PG8_SB(0, 1), cB + hstep, voffB); PG8_STAGE(PG8_SA(0, 1), cA + hstep, voffA);
    if (wr == 1) PG8_BAR;
    PG8_WAIT_V(4); PG8_BAR;
    PG8_STAGE(PG8_SB(1, 0), cB + kstep, voffB); PG8_STAGE(PG8_SA(1, 0), cA + kstep, voffA); PG8_STAGE(PG8_SB(1, 1), cB + hstep + kstep, voffB);
    PG8_WAIT_V(6); PG8_BAR;
    PG8_STAMP();
    for (;;) {
        const bool has_next = S.next(ui + 1, nxt);
        const char* nA = has_next ? (const char*)g.A + (size_t)nxt.pm * tstep : cA; const char* nB = has_next ? (const char*)g.Bt + (size_t)nxt.pn * tstep : cB;
        for (int t = 0; t < nt; t += 2) {
            const bool last = (t == nt - 2);
            const char* a1 = cA + (size_t)(t + 1) * kstep;
            const char* a2 = last ? nA : cA + (size_t)(t + 2) * kstep; const char* b2 = last ? nB : cB + (size_t)(t + 2) * kstep;
            const char* a3 = a2 + kstep; const char* b3 = b2 + kstep;
            if (last && has_next) S.a_ready(nxt);
            PG8_LDB(B0, 0, 0); PG8_SCHED; PG8_LDA(At, 0, 0); PG8_STAGE(PG8_SA(1, 1), a1 + hstep, voffA);
            PG8_WAIT_L(8); PG8_BAR; PG8_WAIT_L(0); PG8_MMA(0, 0, At, B0); PG8_BAR; PG8_SCHED;
            PG8_LDB(B1, 0, 1); PG8_STAGE(PG8_SB(0, 0), b2, voffB);
            PG8_BAR; PG8_WAIT_L(0); PG8_MMA(0, 1, At, B1); PG8_BAR;
            PG8_LDA(At, 0, 1); PG8_STAGE(PG8_SA(0, 0), a2, voffA);
            PG8_BAR; PG8_WAIT_L(0); PG8_MMA(1, 0, At, B0); PG8_BAR; PG8_SCHED;
            PG8_STAGE(PG8_SB(0, 1), b2 + hstep, voffB);
            PG8_WAIT_V(6); PG8_BAR; PG8_MMA(1, 1, At, B1); PG8_BAR;
            PG8_LDB(B0, 1, 0); PG8_SCHED; PG8_LDA(At, 1, 0); PG8_STAGE(PG8_SA(0, 1), a2 + hstep, voffA);
            PG8_WAIT_L(8); PG8_BAR; PG8_WAIT_L(0); PG8_MMA(0, 0, At, B0); PG8_BAR; PG8_SCHED;
            PG8_LDB(B1, 1, 1); PG8_STAGE(PG8_SB(1, 0), b3, voffB);
            PG8_BAR; PG8_WAIT_L(0); PG8_MMA(0, 1, At, B1); PG8_BAR;
            PG8_LDA(At, 1, 1); PG8_STAGE(PG8_SA(1, 0), a3, voffA);
            PG8_BAR; PG8_WAIT_L(0); PG8_MMA(1, 0, At, B0); PG8_BAR; PG8_SCHED;
            PG8_STAGE(PG8_SB(1, 1), b3 + hstep, voffB);
            PG8_WAIT_V(6); PG8_BAR; PG8_MMA(1, 1, At, B1); PG8_BAR;
        }
        PG8_STAMP();
        if constexpr (!Epi::AFTER_DRAIN) { E(acc, cur, wr, wc, fr, fq); S.done(cur); }
        PG8_STAMP();
        if (!has_next) break;
#pragma unroll
        for (int a = 0; a < 2; ++a)
#pragma unroll
            for (int b = 0; b < 2; ++b)
#pragma unroll
                for (int m = 0; m < 4; ++m)
#pragma unroll
                    for (int n = 0; n < 2; ++n) acc[a][b][m][n] = (f32x4){0.f, 0.f, 0.f, 0.f};
        cur = nxt; cA = nA; cB = nB; ++ui;
    }
    PG8_WAIT_V(0);
    if (wr == 0) PG8_BAR;
    PG8_BAR;
    if constexpr (Epi::AFTER_DRAIN) { E.fused(acc, cur, wr, wc, fr, fq, lds, wid, lane); S.done(cur); }
    PG8_STAMP();
    if (STAMP && wid == 0) { stamps[lane] = lane < nts ? (((unsigned long long)(unsigned)ts_hi << 32) | (unsigned)ts_lo) : 0ull;
        if (lane == 62) stamps[62] = rt_entry; if (lane == 63) stamps[63] = (unsigned long long)wall_clock64(); }
#undef PG8_STAMP
#undef PG8_SA
#undef PG8_SB
#undef PG8_STAGE
#undef PG8_LDA
#undef PG8_LDB
#undef PG8_MMA
#undef PG8_WAIT_V
#undef PG8_WAIT_L
#undef PG8_BAR
#undef PG8_SCHED
}
}

namespace pg8 {
struct EpiStoreBf16 {
    static constexpr bool PERM = true, AFTER_DRAIN = false;
    bf16_t* O; int ldc;
    __device__ __forceinline__ void operator()(const f32x4 (&acc)[2][2][4][2], const Unit& u, int wr, int wc, int fr, int fq) const {
        const int row0 = u.pm * BM + wr * 64 + fr, col0 = u.pn * BM + wc * 32 + 8 * fq;
#pragma unroll
        for (int ai = 0; ai < 2; ++ai)
#pragma unroll
            for (int m = 0; m < 4; ++m) { bf16_t* rowp = O + (size_t)(row0 + ai * HALF + m * 16) * ldc + col0;
#pragma unroll
                for (int bj = 0; bj < 2; ++bj) { const f32x4 v0 = acc[ai][bj][m][0], v1 = acc[ai][bj][m][1];
                    u32x4 w; w.x = cvt_pk_bf16(v0[0], v0[1]); w.y = cvt_pk_bf16(v0[2], v0[3]); w.z = cvt_pk_bf16(v1[0], v1[1]); w.w = cvt_pk_bf16(v1[2], v1[3]);
                    *(u32x4*)(rowp + bj * HALF) = w; } }
    }
};
struct EpiAddF32 {
    static constexpr bool PERM = false, AFTER_DRAIN = false;
    float* C; int ldc;
    __device__ __forceinline__ void operator()(const f32x4 (&acc)[2][2][4][2], const Unit& u, int wr, int wc, int fr, int fq) const {
        const int row0 = u.pm * BM + wr * 64 + fr, col0 = u.pn * BM + wc * 32 + 4 * fq;
#pragma unroll
        for (int ai = 0; ai < 2; ++ai)
#pragma unroll
            for (int m = 0; m < 4; ++m) { float* rowp = C + (size_t)(row0 + ai * HALF + m * 16) * ldc + col0;
#pragma unroll
                for (int bj = 0; bj < 2; ++bj)
#pragma unroll
                    for (int n = 0; n < 2; ++n) { f32x4* q = (f32x4*)(rowp + bj * HALF + n * 16); *q = *q + acc[ai][bj][m][n]; } }
    }
};
struct EpiDownF32 {
    static constexpr bool PERM = false, AFTER_DRAIN = false;
    float* C;
    __device__ __forceinline__ void operator()(const f32x4 (&acc)[2][2][4][2], const Unit& u, int wr, int wc, int fr, int fq) const {
        const int row0 = u.pm * BM + wr * 64 + fr, col0 = (u.pn & 7) * BM + wc * 32 + 4 * fq;
#pragma unroll
        for (int ai = 0; ai < 2; ++ai)
#pragma unroll
            for (int m = 0; m < 4; ++m) { float* rowp = C + (size_t)(row0 + ai * HALF + m * 16) * 2048 + col0;
#pragma unroll
                for (int bj = 0; bj < 2; ++bj)
#pragma unroll
                    for (int n = 0; n < 2; ++n) *(f32x4*)(rowp + bj * HALF + n * 16) = acc[ai][bj][m][n]; }
    }
};
struct EpiSwiglu {
    static constexpr bool PERM = true, AFTER_DRAIN = false;
    bf16_t* H;
    __device__ __forceinline__ void operator()(const f32x4 (&acc)[2][2][4][2], const Unit& u, int wr, int wc, int fr, int fq) const {
        const int row0 = u.pm * BM + wr * 64 + fr, col0 = (u.pn & 3) * 128 + wc * 32 + 8 * fq;
#pragma unroll
        for (int ai = 0; ai < 2; ++ai)
#pragma unroll
            for (int m = 0; m < 4; ++m) { bf16_t* rowp = H + (size_t)(row0 + ai * HALF + m * 16) * 512 + col0;
                float h[8];
#pragma unroll
                for (int n = 0; n < 2; ++n)
#pragma unroll
                    for (int j = 0; j < 4; ++j) { const float g = acc[ai][0][m][n][j], up = acc[ai][1][m][n][j]; h[n * 4 + j] = g / (1.f + __expf(-g)) * up; }
                u32x4 w; w.x = cvt_pk_bf16(h[0], h[1]); w.y = cvt_pk_bf16(h[2], h[3]); w.z = cvt_pk_bf16(h[4], h[5]); w.w = cvt_pk_bf16(h[6], h[7]);
                *(u32x4*)rowp = w; }
    }
};
struct MoeOrder {
    const int* blk_e; int ntile, G, c, shift;
    __device__ __forceinline__ bool next(int i, Unit& u) const {
        const int L = i * G + c; if (L >= ntile) return false;
        const int mb = L >> shift, nt = L & ((1 << shift) - 1);
        u.pm = mb; u.pn = (blk_e[mb] << shift) + nt; return true;
    }
    __device__ __forceinline__ void a_ready(const Unit&) const {}
    __device__ __forceinline__ void done(const Unit&) const {}
};
}

__device__ __forceinline__ void transpose_item(const float* __restrict__ W, int ldin, int n0, int K, u16* __restrict__ WT, int row0, int nbn, int item, float* scr, int lane, int ilv = -1) {
    const int kb = item / nbn, nb = item % nbn, k0 = 64 * kb, nn = 32 * nb;
    const int rb = ilv < 0 ? row0 + nn : row0 + (nn >> 7) * 256 + ilv * 128 + (nn & 127);
#pragma unroll 8
    for (int i = 0; i < 32; ++i) { const int kk = 2 * i + (lane >> 5); scr[kk * 33 + (lane & 31)] = W[(size_t)(k0 + kk) * ldin + n0 + nn + (lane & 31)]; }
    asm volatile("s_waitcnt lgkmcnt(0)" ::: "memory");
    const int c = lane & 7;
#pragma unroll
    for (int j = 0; j < 4; ++j) { const int n = (lane >> 3) + 8 * j; const float* s = scr + (8 * c) * 33 + n;
        uint4 o; o.x = pk2(s[0 * 33], s[1 * 33]); o.y = pk2(s[2 * 33], s[3 * 33]); o.z = pk2(s[4 * 33], s[5 * 33]); o.w = pk2(s[6 * 33], s[7 * 33]);
        *(uint4*)(WT + (size_t)(rb + n) * K + k0 + 8 * c) = o; }
    asm volatile("s_waitcnt lgkmcnt(0)" ::: "memory");
}
__device__ __forceinline__ void convert_moe_weights(const float* wg, const float* wu, const float* wd, u16* WguT, u16* WdT, int l, float* scr, int gw, int NGW, int lane) {
    constexpr int IPE = 512;
    for (int it = gw; it < 3 * NE * IPE; it += NGW) {
        const int which = it / (NE * IPE), r = it % (NE * IPE), e = r / IPE, item = r % IPE;
        const size_t eo = ((size_t)l * NE + e) * (size_t)D * DFF;
        if (which == 0)      transpose_item(wg + eo, DFF, 0, D, WguT + (size_t)e * 1024 * D, 0, DFF / 32, item, scr, lane, 0);
        else if (which == 1) transpose_item(wu + eo, DFF, 0, D, WguT + (size_t)e * 1024 * D, 0, DFF / 32, item, scr, lane, 1);
        else                 transpose_item(wd + eo, D, 0, DFF, WdT + (size_t)e * D * DFF, 0, D / 32, item, scr, lane);
    }
}


constexpr int ATT_RS = 144;
constexpr int ATT_VBYTES = 32 * ATT_RS;
typedef long long i64;
typedef unsigned u32x4v __attribute__((ext_vector_type(4)));
typedef unsigned u32x2v __attribute__((ext_vector_type(2)));
__device__ __forceinline__ float bperm(int srclane, float v) { return __int_as_float(__builtin_amdgcn_ds_bpermute(srclane << 2, __float_as_int(v))); }
__device__ __forceinline__ float softplus_fast(float z) { return fmaxf(z, 0.f) + __logf(1.f + __expf(-fabsf(z))); }
__device__ __forceinline__ void vt_frags(unsigned vaddr, int lane, bf16x8 (&vf)[4]) {
    const unsigned a = vaddr + (unsigned)((4 * (lane >> 4) + ((lane & 15) >> 2)) * ATT_RS + (lane & 3) * 8);
    i64 r0, r1, r2, r3, r4, r5, r6, r7;
    asm volatile("s_waitcnt lgkmcnt(0)\n\t"
                 "ds_read_b64_tr_b16 %0, %8\n\tds_read_b64_tr_b16 %1, %8 offset:2304\n\t"
                 "ds_read_b64_tr_b16 %2, %8 offset:32\n\tds_read_b64_tr_b16 %3, %8 offset:2336\n\t"
                 "ds_read_b64_tr_b16 %4, %8 offset:64\n\tds_read_b64_tr_b16 %5, %8 offset:2368\n\t"
                 "ds_read_b64_tr_b16 %6, %8 offset:96\n\tds_read_b64_tr_b16 %7, %8 offset:2400\n\t"
                 "s_waitcnt lgkmcnt(0)"
                 : "=&v"(r0), "=&v"(r1), "=&v"(r2), "=&v"(r3), "=&v"(r4), "=&v"(r5), "=&v"(r6), "=&v"(r7) : "v"(a) : "memory");
    typedef i64 i64x2 __attribute__((ext_vector_type(2)));
    i64x2 t; t.x = r0; t.y = r1; vf[0] = __builtin_bit_cast(bf16x8, t); t.x = r2; t.y = r3; vf[1] = __builtin_bit_cast(bf16x8, t);
    t.x = r4; t.y = r5; vf[2] = __builtin_bit_cast(bf16x8, t); t.x = r6; t.y = r7; vf[3] = __builtin_bit_cast(bf16x8, t);
}
__device__ __forceinline__ bf16x8 pack8(const float (&a)[4], const float (&b)[4]) {
    u32x4v w; w.x = pk2(a[0], a[1]); w.y = pk2(a[2], a[3]); w.z = pk2(b[0], b[1]); w.w = pk2(b[2], b[3]);
    return __builtin_bit_cast(bf16x8, w);
}
__device__ __forceinline__ void store_out_tile(const f32x4 (&o)[4], float scale, const float* __restrict__ gain, u16* __restrict__ dst  , int g) {
#pragma unroll
    for (int dt = 0; dt < 4; ++dt) { const float4 gg = *(const float4*)(gain + dt * 16 + 4 * g);
        *(uint2*)(dst + dt * 16 + 4 * g) = make_uint2(pk2(o[dt][0] * scale * gg.x, o[dt][1] * scale * gg.y), pk2(o[dt][2] * scale * gg.z, o[dt][3] * scale * gg.w)); }
}

__device__ __forceinline__ void sb_unit(const u16* __restrict__ PROJ, int b, int qb, int h, int lane, LAS char* vl, LAS float* red,
                                        const float* __restrict__ gout, u16* __restrict__ MIXED) {
    const int li = lane & 15, g = lane >> 4; const size_t tb = (size_t)b * SEQ; const int q0 = qb * 64;
    const u16* Qp = PROJ + C_SB + h * 64; const u16* Kp = Qp + 512; const u16* Vp = Qp + 1024;
    const unsigned vaddr = (unsigned)(size_t)vl;
    bf16x8 qf[4][2];
#pragma unroll
    for (int qt = 0; qt < 4; ++qt)
#pragma unroll
        for (int s = 0; s < 2; ++s) qf[qt][s] = *(const bf16x8*)(Qp + (tb + q0 + qt * 16 + li) * DP + 32 * s + 8 * g);
    f32x4 acc[4][4];
#pragma unroll
    for (int qt = 0; qt < 4; ++qt)
#pragma unroll
        for (int dt = 0; dt < 4; ++dt) acc[qt][dt] = (f32x4){0.f, 0.f, 0.f, 0.f};
    float carry[4] = {0.f, 0.f, 0.f, 0.f};
    for (int k0 = q0 + 32; k0 >= 0; k0 -= 32) {
        bf16x8 kf[2][2];
#pragma unroll
        for (int kt = 0; kt < 2; ++kt)
#pragma unroll
            for (int s = 0; s < 2; ++s) kf[kt][s] = *(const bf16x8*)(Kp + (tb + k0 + kt * 16 + li) * DP + 32 * s + 8 * g);
#pragma unroll
        for (int u = 0; u < 4; ++u) { const int c = lane + 64 * u, row = c >> 3, cc = c & 7;
            *(LAS u32x4v*)(vl + row * ATT_RS + cc * 16) = *(const u32x4v*)(Vp + (tb + k0 + row) * DP + cc * 8); }
        bf16x8 pf[4];
#pragma unroll
        for (int qt = 0; qt < 4; ++qt) {
            const int qpos = q0 + qt * 16 + li;
            float w[2][4];
#pragma unroll
            for (int kt = 1; kt >= 0; --kt) {
                f32x4 st = __builtin_amdgcn_mfma_f32_16x16x32_bf16(kf[kt][0], qf[qt][0], (f32x4){0.f, 0.f, 0.f, 0.f}, 0, 0, 0);
                st = __builtin_amdgcn_mfma_f32_16x16x32_bf16(kf[kt][1], qf[qt][1], st, 0, 0, 0);
                const int kb = k0 + kt * 16 + 4 * g;
                float sp[4];
#pragma unroll
                for (int r = 0; r < 4; ++r) sp[r] = (kb + r < qpos) ? softplus_fast(st[r]) : 0.f;
                const float G = (sp[0] + sp[1]) + (sp[2] + sp[3]);
                const float x1 = bperm(lane ^ 16, G), hs = G + x1, x2 = bperm(lane ^ 32, hs);
                float rs = carry[qt] + (g == 3 ? 0.f : g == 2 ? x1 : g == 1 ? x2 : x1 + x2);
#pragma unroll
                for (int r = 3; r >= 0; --r) { w[kt][r] = (kb + r < qpos) ? __expf(st[r] - sp[r] - rs) : 0.f; rs += sp[r]; }
                carry[qt] += hs + x2;
            }
            pf[qt] = pack8(w[0], w[1]);
        }
        bf16x8 vf[4]; vt_frags(vaddr, lane, vf);
#pragma unroll
        for (int qt = 0; qt < 4; ++qt)
#pragma unroll
            for (int dt = 0; dt < 4; ++dt) acc[qt][dt] = __builtin_amdgcn_mfma_f32_16x16x32_bf16(vf[dt], pf[qt], acc[qt][dt], 0, 0, 0);
        if (k0 + 32 <= q0 && __all(fminf(fminf(carry[0], carry[1]), fminf(carry[2], carry[3])) > 104.f)) break;
    }
    float ss[4];
#pragma unroll
    for (int qt = 0; qt < 4; ++qt) { float s = 0.f;
#pragma unroll
        for (int dt = 0; dt < 4; ++dt) s += (acc[qt][dt][0] * acc[qt][dt][0] + acc[qt][dt][1] * acc[qt][dt][1]) + (acc[qt][dt][2] * acc[qt][dt][2] + acc[qt][dt][3] * acc[qt][dt][3]);
        s += bperm(lane ^ 16, s); s += bperm(lane ^ 32, s); ss[qt] = s;
        if (g == 0) red[h * 64 + qt * 16 + li] = s; }
    __syncthreads();
#pragma unroll
    for (int qt = 0; qt < 4; ++qt) { float tot = 0.f;
#pragma unroll
        for (int hh = 0; hh < 8; ++hh) tot += red[hh * 64 + qt * 16 + li];
        const float sc = rsqrtf(tot / 512.f + EPS);
        store_out_tile(acc[qt], sc, gout + h * 64, MIXED + (tb + q0 + qt * 16 + li) * D + 512 + h * 64, g); }
}

__device__ __forceinline__ void dil_unit(const u16* __restrict__ PROJ, int b, int w, int r, int h, int lane, LAS char* vl, LAS float* red,
                                         const float* __restrict__ gout, u16* __restrict__ MIXED) {
    const int li = lane & 15, g = lane >> 4; const size_t tb = (size_t)b * SEQ; const int qpos = w * 256 + r + 16 * li;
    const u16* Qp = PROJ + C_DIL + h * 64; const u16* Kp = Qp + 512; const u16* Vp = Qp + 1024;
    const unsigned vaddr = (unsigned)(size_t)vl;
    bf16x8 qf[2];
#pragma unroll
    for (int s = 0; s < 2; ++s) qf[s] = *(const bf16x8*)(Qp + (tb + qpos) * DP + 32 * s + 8 * g);
    f32x4 acc[4];
#pragma unroll
    for (int dt = 0; dt < 4; ++dt) acc[dt] = (f32x4){0.f, 0.f, 0.f, 0.f};
    float mrun = -1e30f, lrun = 0.f;
#pragma unroll 1
    for (int br = 0; br < 3; ++br) {
        const int dsh = br == 0 ? 4 : br == 1 ? 2 : 0;
        const int nstep = br == 0 ? 5 : br == 1 ? 6 : 12;
        const int base = w * 256 + r - (128 << dsh);
        const int rat = li << (4 - dsh);
#pragma unroll 1
        for (int st_ = 0; st_ < nstep; ++st_) {
            const int m0 = st_ * 32;
            if (base + ((m0 + 31) << dsh) < 0) continue;
            bf16x8 kf[2][2];
#pragma unroll
            for (int kt = 0; kt < 2; ++kt) { int pos = base + ((m0 + kt * 16 + li) << dsh); pos = min(max(pos, 0), SEQ - 1);
#pragma unroll
                for (int s = 0; s < 2; ++s) kf[kt][s] = *(const bf16x8*)(Kp + (tb + pos) * DP + 32 * s + 8 * g); }
#pragma unroll
            for (int u = 0; u < 4; ++u) { const int c = lane + 64 * u, row = c >> 3, cc = c & 7; int pos = base + ((m0 + row) << dsh); pos = min(max(pos, 0), SEQ - 1);
                *(LAS u32x4v*)(vl + row * ATT_RS + cc * 16) = *(const u32x4v*)(Vp + (tb + pos) * DP + cc * 8); }
            float z[2][4]; bool ok[2][4]; float zmax = -1e30f;
#pragma unroll
            for (int kt = 0; kt < 2; ++kt) {
                f32x4 st = __builtin_amdgcn_mfma_f32_16x16x32_bf16(kf[kt][0], qf[0], (f32x4){0.f, 0.f, 0.f, 0.f}, 0, 0, 0);
                st = __builtin_amdgcn_mfma_f32_16x16x32_bf16(kf[kt][1], qf[1], st, 0, 0, 0);
#pragma unroll
                for (int rr = 0; rr < 4; ++rr) { const int m = m0 + kt * 16 + 4 * g + rr; const int dm = m - rat;
                    ok[kt][rr] = (dm >= 0) && (dm <= 128) && (base + (m << dsh) >= 0);
                    z[kt][rr] = st[rr]; if (ok[kt][rr]) zmax = fmaxf(zmax, st[rr]); }
            }
            zmax = fmaxf(zmax, bperm(lane ^ 16, zmax)); zmax = fmaxf(zmax, bperm(lane ^ 32, zmax));
            const float mn = fmaxf(mrun, zmax); const float al = __expf(mrun - mn); mrun = mn;
            float pw[2][4]; float ps = 0.f;
#pragma unroll
            for (int kt = 0; kt < 2; ++kt)
#pragma unroll
                for (int rr = 0; rr < 4; ++rr) { pw[kt][rr] = ok[kt][rr] ? __expf(z[kt][rr] - mn) : 0.f; ps += pw[kt][rr]; }
            lrun = lrun * al + ps;
#pragma unroll
            for (int dt = 0; dt < 4; ++dt) acc[dt] = acc[dt] * al;
            const bf16x8 pf = pack8(pw[0], pw[1]);
            bf16x8 vf[4]; vt_frags(vaddr, lane, vf);
#pragma unroll
            for (int dt = 0; dt < 4; ++dt) acc[dt] = __builtin_amdgcn_mfma_f32_16x16x32_bf16(vf[dt], pf, acc[dt], 0, 0, 0);
        }
    }
    lrun += bperm(lane ^ 16, lrun); lrun += bperm(lane ^ 32, lrun);
    const float inv = 1.f / lrun;
    float s = 0.f;
#pragma unroll
    for (int dt = 0; dt < 4; ++dt) { acc[dt] = acc[dt] * inv; s += (acc[dt][0] * acc[dt][0] + acc[dt][1] * acc[dt][1]) + (acc[dt][2] * acc[dt][2] + acc[dt][3] * acc[dt][3]); }
    s += bperm(lane ^ 16, s); s += bperm(lane ^ 32, s);
    if (g == 0) red[h * 64 + li] = s;
    __syncthreads();
    float tot = 0.f;
#pragma unroll
    for (int hh = 0; hh < 8; ++hh) tot += red[hh * 64 + li];
    const float sc = rsqrtf(tot / 512.f + EPS);
    store_out_tile(acc, sc, gout + h * 64, MIXED + (tb + qpos) * D + 1024 + h * 64, g);
}


template <int RS> __device__ __forceinline__ void tr_frags4(unsigned addr, int lane, bf16x8 (&f)[4]) {
    const unsigned a = addr + (unsigned)((4 * (lane >> 4) + ((lane & 15) >> 2)) * RS + (lane & 3) * 8);
    i64 r0, r1, r2, r3, r4, r5, r6, r7;
    asm volatile("s_waitcnt lgkmcnt(0)\n\t"
                 "ds_read_b64_tr_b16 %0, %8\n\tds_read_b64_tr_b16 %1, %8 offset:%9\n\t"
                 "ds_read_b64_tr_b16 %2, %8 offset:32\n\tds_read_b64_tr_b16 %3, %8 offset:%10\n\t"
                 "ds_read_b64_tr_b16 %4, %8 offset:64\n\tds_read_b64_tr_b16 %5, %8 offset:%11\n\t"
                 "ds_read_b64_tr_b16 %6, %8 offset:96\n\tds_read_b64_tr_b16 %7, %8 offset:%12\n\t"
                 "s_waitcnt lgkmcnt(0)"
                 : "=&v"(r0), "=&v"(r1), "=&v"(r2), "=&v"(r3), "=&v"(r4), "=&v"(r5), "=&v"(r6), "=&v"(r7)
                 : "v"(a), "i"(16 * RS), "i"(16 * RS + 32), "i"(16 * RS + 64), "i"(16 * RS + 96) : "memory");
    typedef i64 i64x2 __attribute__((ext_vector_type(2)));
    i64x2 t; t.x = r0; t.y = r1; f[0] = __builtin_bit_cast(bf16x8, t); t.x = r2; t.y = r3; f[1] = __builtin_bit_cast(bf16x8, t);
    t.x = r4; t.y = r5; f[2] = __builtin_bit_cast(bf16x8, t); t.x = r6; t.y = r7; f[3] = __builtin_bit_cast(bf16x8, t);
}
template <int RS> __device__ __forceinline__ bf16x8 tr_frag1(unsigned addr, int lane) {
    const unsigned a = addr + (unsigned)((4 * (lane >> 4) + ((lane & 15) >> 2)) * RS + (lane & 3) * 8);
    i64 r0, r1;
    asm volatile("s_waitcnt lgkmcnt(0)\n\tds_read_b64_tr_b16 %0, %2\n\tds_read_b64_tr_b16 %1, %2 offset:%3\n\ts_waitcnt lgkmcnt(0)"
                 : "=&v"(r0), "=&v"(r1) : "v"(a), "i"(16 * RS) : "memory");
    typedef i64 i64x2 __attribute__((ext_vector_type(2)));
    i64x2 t; t.x = r0; t.y = r1; return __builtin_bit_cast(bf16x8, t);
}
constexpr int SSD_RB = 272, SSD_RX = 144;
constexpr int SSD_OFF_B = 0, SSD_OFF_C = 128 * SSD_RB, SSD_OFF_X = 2 * 128 * SSD_RB, SSD_OFF_XW = SSD_OFF_X + 128 * SSD_RX, SSD_OFF_F = SSD_OFF_XW + 128 * SSD_RX;
__device__ __forceinline__ void ssd_chunk_unit(const u16* __restrict__ PROJ, const float* __restrict__ DTR, const float* __restrict__ cw, const float* __restrict__ cb,
                                               float dtbias, float aneg, float dskip, int b, int c, int h, int tid, LAS char* L,
                                               float* __restrict__ YD, float* __restrict__ SS, float* __restrict__ ATOT, float* __restrict__ ACS, u16* __restrict__ CG) {
    const int wave = tid >> 6, lane = tid & 63, li = lane & 15, g = lane >> 4, grp = h >> 2;
    const size_t t0 = (size_t)b * SEQ + (size_t)c * 128;
    LAS float* acs = (LAS float*)(L + SSD_OFF_F); LAS float* dts = acs + 128; LAS float* wls = acs + 256;
    __syncthreads();
    if (wave == 0) {
        const float d0 = softplusf(DTR[(t0 + 2 * lane) * 8 + h] + dtbias), d1 = softplusf(DTR[(t0 + 2 * lane + 1) * 8 + h] + dtbias);
        const float a0 = d0 * aneg, a1 = d1 * aneg;
        float v = a0 + a1;
#pragma unroll
        for (int o = 1; o < 64; o <<= 1) { const float t = bperm(lane - o, v); if (lane >= o) v += t; }
        acs[2 * lane] = v - a1; acs[2 * lane + 1] = v; dts[2 * lane] = d0; dts[2 * lane + 1] = d1;
    }
    __syncthreads();
    if (tid < 128) { const float a = acs[tid]; wls[tid] = dts[tid] * __expf(acs[127] - a); ACS[(t0 + tid) * 8 + h] = a; if (tid == 0) ATOT[((size_t)b * 32 + c) * 8 + h] = acs[127]; }
    __syncthreads();
    for (int it = tid; it < 128 * 40; it += NTHR) {
        const int tl = it / 40, cg = it % 40;
        const int ch = cg < 8 ? h * 64 + cg * 8 : cg < 24 ? 512 + grp * 128 + (cg - 8) * 8 : 768 + grp * 128 + (cg - 24) * 8;
        const int sl = c * 128 + tl;
        float a[8];
        { const float4 b0 = *(const float4*)(cb + ch), b1 = *(const float4*)(cb + ch + 4); a[0] = b0.x; a[1] = b0.y; a[2] = b0.z; a[3] = b0.w; a[4] = b1.x; a[5] = b1.y; a[6] = b1.z; a[7] = b1.w; }
#pragma unroll
        for (int k = 0; k < 4; ++k) if (sl - 3 + k >= 0) {
            const bf16x8 u = *(const bf16x8*)(PROJ + (t0 + tl - 3 + k) * DP + C_XBC + ch);
            const float4 w0 = *(const float4*)(cw + k * 1024 + ch), w1 = *(const float4*)(cw + k * 1024 + ch + 4);
            a[0] += w0.x * bf2f((u16)u[0]); a[1] += w0.y * bf2f((u16)u[1]); a[2] += w0.z * bf2f((u16)u[2]); a[3] += w0.w * bf2f((u16)u[3]);
            a[4] += w1.x * bf2f((u16)u[4]); a[5] += w1.y * bf2f((u16)u[5]); a[6] += w1.z * bf2f((u16)u[6]); a[7] += w1.w * bf2f((u16)u[7]);
        }
#pragma unroll
        for (int j = 0; j < 8; ++j) a[j] = siluf(a[j]);
        u32x4v o; o.x = pk2(a[0], a[1]); o.y = pk2(a[2], a[3]); o.z = pk2(a[4], a[5]); o.w = pk2(a[6], a[7]);
        if (cg < 8) {
            *(LAS u32x4v*)(L + SSD_OFF_X + tl * SSD_RX + cg * 16) = o;
            const float wl = wls[tl]; u32x4v ow; ow.x = pk2(a[0] * wl, a[1] * wl); ow.y = pk2(a[2] * wl, a[3] * wl); ow.z = pk2(a[4] * wl, a[5] * wl); ow.w = pk2(a[6] * wl, a[7] * wl);
            *(LAS u32x4v*)(L + SSD_OFF_XW + tl * SSD_RX + cg * 16) = ow;
        } else if (cg < 24) *(LAS u32x4v*)(L + SSD_OFF_B + tl * SSD_RB + (cg - 8) * 16) = o;
        else { *(LAS u32x4v*)(L + SSD_OFF_C + tl * SSD_RB + (cg - 24) * 16) = o;
               if ((h & 3) == 0) *(u32x4v*)(CG + (t0 + tl) * 256 + grp * 128 + (cg - 24) * 8) = o; }
    }
    __syncthreads();
    const unsigned Lb = (unsigned)(size_t)L;
    {
        const int lt = wave, lrow = lt * 16 + li; const float acl = acs[lrow];
        bf16x8 cf[4];
#pragma unroll
        for (int ks = 0; ks < 4; ++ks) cf[ks] = *(const LAS bf16x8*)(L + SSD_OFF_C + lrow * SSD_RB + ks * 64 + g * 16);
        f32x4 acc[4];
#pragma unroll
        for (int pt = 0; pt < 4; ++pt) acc[pt] = (f32x4){0.f, 0.f, 0.f, 0.f};
        for (int s0 = 0; s0 <= lt * 16; s0 += 32) {
            float w[2][4];
#pragma unroll
            for (int kt = 0; kt < 2; ++kt) {
                f32x4 st = (f32x4){0.f, 0.f, 0.f, 0.f};
#pragma unroll
                for (int ks = 0; ks < 4; ++ks) { const bf16x8 bfr = *(const LAS bf16x8*)(L + SSD_OFF_B + (s0 + kt * 16 + li) * SSD_RB + ks * 64 + g * 16);
                    st = __builtin_amdgcn_mfma_f32_16x16x32_bf16(bfr, cf[ks], st, 0, 0, 0); }
                const int sb = s0 + kt * 16 + 4 * g;
                const f32x4 as4 = *(const LAS f32x4*)(acs + sb), dt4 = *(const LAS f32x4*)(dts + sb);
#pragma unroll
                for (int r = 0; r < 4; ++r) w[kt][r] = (sb + r <= lrow) ? st[r] * __expf(acl - as4[r]) * dt4[r] : 0.f;
            }
            const bf16x8 pf = pack8(w[0], w[1]);
            bf16x8 xf[4]; tr_frags4<SSD_RX>(Lb + SSD_OFF_X + s0 * SSD_RX, lane, xf);
#pragma unroll
            for (int pt = 0; pt < 4; ++pt) acc[pt] = __builtin_amdgcn_mfma_f32_16x16x32_bf16(xf[pt], pf, acc[pt], 0, 0, 0);
        }
#pragma unroll
        for (int pt = 0; pt < 4; ++pt) {
            const u32x2v xr = *(const LAS u32x2v*)(L + SSD_OFF_X + lrow * SSD_RX + (pt * 16 + 4 * g) * 2);
            float4 o; o.x = acc[pt][0] + dskip * __uint_as_float(xr.x << 16); o.y = acc[pt][1] + dskip * __uint_as_float(xr.x & 0xffff0000u);
            o.z = acc[pt][2] + dskip * __uint_as_float(xr.y << 16); o.w = acc[pt][3] + dskip * __uint_as_float(xr.y & 0xffff0000u);
            *(float4*)(YD + (t0 + lrow) * 512 + h * 64 + pt * 16 + 4 * g) = o;
        }
    }
    {
        f32x4 acc[4];
#pragma unroll
        for (int pt = 0; pt < 4; ++pt) acc[pt] = (f32x4){0.f, 0.f, 0.f, 0.f};
#pragma unroll
        for (int ks = 0; ks < 4; ++ks) {
            const bf16x8 bt = tr_frag1<SSD_RB>(Lb + SSD_OFF_B + ks * 32 * SSD_RB + wave * 32, lane);
            bf16x8 xf[4]; tr_frags4<SSD_RX>(Lb + SSD_OFF_XW + ks * 32 * SSD_RX, lane, xf);
#pragma unroll
            for (int pt = 0; pt < 4; ++pt) acc[pt] = __builtin_amdgcn_mfma_f32_16x16x32_bf16(bt, xf[pt], acc[pt], 0, 0, 0);
        }
        float* so = SS + ((((size_t)b * 32 + c) * 8 + h) << 13);
#pragma unroll
        for (int pt = 0; pt < 4; ++pt) *(float4*)(so + (pt * 16 + li) * 128 + wave * 16 + 4 * g) = make_float4(acc[pt][0], acc[pt][1], acc[pt][2], acc[pt][3]);
    }
}
__device__ __forceinline__ void ssd_out_unit(const u16* __restrict__ PROJ, const u16* __restrict__ PREV, const u16* __restrict__ CG, const float* __restrict__ YD,
                                             const float* __restrict__ ACS, const float* __restrict__ ng, int b, int j, int h, int lane, LAS float* red, u16* __restrict__ MIXED) {
    const int li = lane & 15, g = lane >> 4, grp = h >> 2, c = j >> 2; const size_t t0 = (size_t)b * SEQ + (size_t)j * 32;
    const u16* pv = PREV + ((((size_t)b * 32 + c) * 8 + h) << 13);
    f32x4 acc[4][2];
#pragma unroll
    for (int pt = 0; pt < 4; ++pt) { acc[pt][0] = (f32x4){0.f, 0.f, 0.f, 0.f}; acc[pt][1] = (f32x4){0.f, 0.f, 0.f, 0.f}; }
#pragma unroll
    for (int ks = 0; ks < 4; ++ks) {
        bf16x8 cf[2];
#pragma unroll
        for (int lt = 0; lt < 2; ++lt) cf[lt] = *(const bf16x8*)(CG + (t0 + lt * 16 + li) * 256 + grp * 128 + ks * 32 + g * 8);
#pragma unroll
        for (int pt = 0; pt < 4; ++pt) { const bf16x8 pf = *(const bf16x8*)(pv + (pt * 16 + li) * 128 + ks * 32 + g * 8);
            acc[pt][0] = __builtin_amdgcn_mfma_f32_16x16x32_bf16(pf, cf[0], acc[pt][0], 0, 0, 0);
            acc[pt][1] = __builtin_amdgcn_mfma_f32_16x16x32_bf16(pf, cf[1], acc[pt][1], 0, 0, 0); }
    }
    float ssq[2];
#pragma unroll
    for (int lt = 0; lt < 2; ++lt) {
        const size_t t = t0 + lt * 16 + li; const float ea = __expf(ACS[t * 8 + h]); float s = 0.f;
#pragma unroll
        for (int pt = 0; pt < 4; ++pt) {
            const int col = h * 64 + pt * 16 + 4 * g;
            const float4 yd = *(const float4*)(YD + t * 512 + col); const uint2 zr = *(const uint2*)(PROJ + t * DP + C_Z + col);
            f32x4 y; y[0] = (yd.x + ea * acc[pt][lt][0]) * siluf(__uint_as_float(zr.x << 16)); y[1] = (yd.y + ea * acc[pt][lt][1]) * siluf(__uint_as_float(zr.x & 0xffff0000u));
            y[2] = (yd.z + ea * acc[pt][lt][2]) * siluf(__uint_as_float(zr.y << 16)); y[3] = (yd.w + ea * acc[pt][lt][3]) * siluf(__uint_as_float(zr.y & 0xffff0000u));
            acc[pt][lt] = y; s += (y[0] * y[0] + y[1] * y[1]) + (y[2] * y[2] + y[3] * y[3]);
        }
        s += bperm(lane ^ 16, s); s += bperm(lane ^ 32, s); ssq[lt] = s;
        if (g == 0) red[h * 64 + lt * 16 + li] = s;
    }
    __syncthreads();
#pragma unroll
    for (int lt = 0; lt < 2; ++lt) {
        float tot = 0.f;
#pragma unroll
        for (int hh = 0; hh < 8; ++hh) tot += red[hh * 64 + lt * 16 + li];
        const float sc = rsqrtf(tot / 512.f + EPS);
        f32x4 o[4];
#pragma unroll
        for (int pt = 0; pt < 4; ++pt) o[pt] = acc[pt][lt];
        store_out_tile(o, sc, ng + h * 64, MIXED + (t0 + lt * 16 + li) * D + h * 64, g);
    }
}

typedef const Params __attribute__((address_space(4)))* KP;
#define PARAMS KP kp_ = (KP)__builtin_amdgcn_kernarg_segment_ptr(); asm volatile("" : "+s"(kp_)); const __attribute__((address_space(4))) Params& p = *kp_;
__global__ void __launch_bounds__(NTHR, 2) mega(Params pk_unused) {
    extern __shared__ __attribute__((aligned(16))) char smem[];
    if (threadIdx.x == 0) *(uint4*)smem = make_uint4(0u, 0u, 0u, 0u);
    __syncthreads();
    XcdBarrier bar; { PARAMS bar = xcd_barrier_post(p.bar, (volatile LAS unsigned*)smem); }
    char* lds = smem + 16;
    LAS unsigned char* glds = (LAS unsigned char*)(smem + 16);
    const int G = gridDim.x, NGW = G * NWAVE;
    const long gsize = (long)G * NTHR;
#define IDS PARAMS int tid = threadIdx.x; asm volatile("" : "+v"(tid)); const int wave = tid >> 6, lane = tid & 63; const int gw = blockIdx.x * NWAVE + wave; const long gtid = (long)blockIdx.x * NTHR + tid; (void)wave; (void)lane; (void)gw; (void)gtid;

    { IDS
        const float4* s = (const float4*)p.x_in; float4* d = (float4*)p.X;
        for (long i = gtid; i < (long)T * D / 4; i += gsize) d[i] = s[i];
        float* scr = (float*)lds + wave * (64 * 33);
        constexpr int I_A = 32 * 48, I_B = 32 * 112, I_O = 32 * 64, I_L = I_A + I_B + I_O;
        for (int it = gw; it < 2 * I_L; it += NGW) {
            const int l = it / I_L; int r = it % I_L;
            const float* Wl = p.w_in + (size_t)l * D * DIN; u16* WTl = p.WinT + (size_t)l * DP * D;
            if (r < I_A) { transpose_item(Wl, DIN, 0, D, WTl, 0, 48, r, scr, lane); continue; } r -= I_A;
            if (r < I_B) { transpose_item(Wl, DIN, 1544, D, WTl, 1536, 112, r, scr, lane); continue; } r -= I_B;
            transpose_item(p.w_out + (size_t)l * D * D, D, 0, D, p.WoutT + (size_t)l * D * D, 0, 64, r, scr, lane);
        }
        convert_moe_weights(p.wg, p.wu, p.wd, p.WguT, p.WdT, 0, scr, gw, NGW, lane);
        for (long i = gtid; i < 2L * 72 * D; i += gsize) { const int l = (int)(i / (72 * D)), r = (int)(i % (72 * D)), c = r / D, k = r % D;
            p.RT[i] = (c < 8) ? p.rg_w[(size_t)l * D * 8 + k * 8 + c] : p.re_w[(size_t)l * D * 64 + k * 64 + (c - 8)]; }
        for (long i = gtid; i < 2L * 8 * D; i += gsize) { const int l = (int)(i / (8 * D)), r = (int)(i % (8 * D)), j = r / D, k = r % D;
            p.WDT[i] = p.w_in[(size_t)l * D * DIN + (size_t)k * DIN + 1536 + j]; }
    }
    xcd_barrier(bar);

#pragma unroll 1
    for (int l = 0; l < 2; ++l) {
        { IDS
            const float* g1 = p.norm1_g + l * D; const float* wdt = p.WDT + (size_t)l * 8 * D;
            for (int t = gw; t < T; t += NGW) {
                float4* xr = (float4*)(p.X + (size_t)t * D) + lane;
                float4 v[8]; float ss = 0.f;
#pragma unroll
                for (int j = 0; j < 8; ++j) v[j] = xr[64 * j];
                if (l > 0) {
                    const int r0 = p.tok_row[2 * t], r1 = p.tok_row[2 * t + 1]; const float g0 = p.tok_g[2 * t], gg1 = p.tok_g[2 * t + 1];
                    const float4* y0 = (const float4*)(p.Yb + (size_t)r0 * D) + lane; const float4* y1 = (const float4*)(p.Yb + (size_t)r1 * D) + lane;
#pragma unroll
                    for (int j = 0; j < 8; ++j) { const float4 a = y0[64 * j], b = y1[64 * j];
                        v[j].x += g0 * a.x + gg1 * b.x; v[j].y += g0 * a.y + gg1 * b.y; v[j].z += g0 * a.z + gg1 * b.z; v[j].w += g0 * a.w + gg1 * b.w; xr[64 * j] = v[j]; }
                }
#pragma unroll
                for (int j = 0; j < 8; ++j) ss += v[j].x * v[j].x + v[j].y * v[j].y + v[j].z * v[j].z + v[j].w * v[j].w;
                const float r = rsqrtf(wave_sum(ss) / D + EPS);
                uint2* hb = (uint2*)(p.HB + (size_t)t * D) + lane;
#pragma unroll
                for (int j = 0; j < 8; ++j) {
                    const float4 gg = ((const float4*)g1)[lane + 64 * j];
                    v[j].x *= r * gg.x; v[j].y *= r * gg.y; v[j].z *= r * gg.z; v[j].w *= r * gg.w;
                    hb[64 * j] = make_uint2(pk2(v[j].x, v[j].y), pk2(v[j].z, v[j].w));
                }
#pragma unroll 1
                for (int q = 0; q < 8; ++q) {
                    const float4* w = (const float4*)(wdt + q * D) + lane; float s = 0.f;
#pragma unroll
                    for (int j = 0; j < 8; ++j) { const float4 ww = w[64 * j]; s += v[j].x * ww.x + v[j].y * ww.y + v[j].z * ww.z + v[j].w * ww.w; }
                    s = wave_sum(s); if (lane == 0) p.DTR[t * 8 + q] = s;
                }
            }
            if (l == 1) { float* scr = (float*)lds + wave * (64 * 33); convert_moe_weights(p.wg, p.wu, p.wd, p.WguT, p.WdT, 1, scr, gw, NGW, lane); }
        }
        xcd_barrier(bar);
        {
            PARAMS
            pg8::Gemm g{p.HB, p.WinT + (size_t)l * DP * D, T, DP, D};
            pg8::StaticOrder so; so.init(T, DP, G, blockIdx.x);
            pg8::EpiStoreBf16 ep{p.PROJ, DP};
            pg8::gemm_phase(glds, g, so, ep, nullptr);
        }
        xcd_barrier(bar);
        { IDS
            for (int it = gw; it < T * 32; it += NGW) {
                const int t = it >> 5, r = it & 31, which = r >> 3, h = r & 7;
                const int col = (which == 0 ? C_SB : which == 1 ? C_SB + 512 : which == 2 ? C_DIL : C_DIL + 512) + h * 64 + lane;
                const float* g = (which == 0 ? p.sbq_g : which == 1 ? p.sbk_g : which == 2 ? p.dq_g : p.dk_g) + l * 64;
                u16* q = p.PROJ + (size_t)t * DP + col; const float v = bf2f(*q);
                const float ss = wave_sum(v * v);
                *q = f2bf(v * rsqrtf(ss / 64.f + EPS) * g[lane] * ((which & 1) ? 1.f : 0.125f));
            }
            for (int u = blockIdx.x; u < NB * 32 * 8; u += G) {
                const int b = u >> 8, c = (u >> 3) & 31, h = u & 7;
                ssd_chunk_unit(p.PROJ, p.DTR, p.conv_w + l * 4 * 1024, p.conv_b + l * 1024, p.dt_bias[l * 8 + h], -__expf(p.a_log[l * 8 + h]), p.ssd_d[l * 8 + h],
                               b, c, h, tid, (LAS char*)(smem + 16), p.YD, p.SS, p.ATOT, p.ACS, p.CG);
            }
            __syncthreads();
            float* pooled = (float*)lds;
            const float* pw = p.pool_w + (size_t)l * 4 * 128 * 128; const float* psc = p.pool_sc + l * 512;
            for (int t = blockIdx.x; t < T; t += G) {
                const int s = t % SEQ, c = tid, g = c >> 7;
                const int w = 2 << g; const int lo = max(s + 1 - w, 0); const int cn = s + 1 - lo;
                float sum = 0.f; for (int i = 0; i < cn; ++i) sum += bf2f(p.PROJ[(size_t)(t - i) * DP + C_POOL + c]);
                __syncthreads();
                pooled[c] = sum / (float)cn - bf2f(p.PROJ[(size_t)t * DP + C_POOL + c]);
                __syncthreads();
                const int e = c & 127; float y = 0.f;
                for (int cc = 0; cc < 128; ++cc) y += pooled[g * 128 + cc] * pw[(g * 128 + cc) * 128 + e];
                p.MIXED[(size_t)t * D + 1536 + c] = f2bf(y * psc[c]);
            }
        }
        xcd_barrier(bar);
        { IDS
        {
            for (int e = (int)gtid; e < NB * 8 * 8192; e += (int)gsize) {
                const int b = e >> 16, h = (e >> 13) & 7, pn = e & 8191; float st = 0.f;
#pragma unroll 8
                for (int c = 0; c < 32; ++c) { const size_t cu = ((size_t)b * 32 + c) * 8 + h; const size_t idx = (cu << 13) + pn;
                    p.PREV[idx] = f2bf(st); st = st * __expf(p.ATOT[cu]) + p.SS[idx]; }
            }
            LAS char* vl = (LAS char*)(smem + 16) + wave * ATT_VBYTES;
            LAS float* red = (LAS float*)((LAS char*)(smem + 16) + NWAVE * ATT_VBYTES);
            int par = 0;
            for (int u = blockIdx.x; u < 128 + 512; u += G, par ^= 1) {
                if (u < 128) sb_unit(p.PROJ, u >> 6, u & 63, wave, lane, vl, red + par * 512, p.sbo_g + l * 512, p.MIXED);
                else { const int v = u - 128; dil_unit(p.PROJ, v >> 8, (v >> 4) & 15, v & 15, wave, lane, vl, red + par * 512, p.do_g + l * 512, p.MIXED); }
            }
        }
        }
        xcd_barrier(bar);
        { IDS
            LAS float* red = (LAS float*)(smem + 16);
            int par = 0;
            for (int u = blockIdx.x; u < NB * 128; u += G, par ^= 1)
                ssd_out_unit(p.PROJ, p.PREV, p.CG, p.YD, p.ACS, p.ssd_ng + l * 512, u >> 7, u & 127, wave, lane, red + par * 512, p.MIXED);
        }
        xcd_barrier(bar);
        {
            PARAMS
            pg8::Gemm g{p.MIXED, p.WoutT + (size_t)l * D * D, T, D, D};
            pg8::StaticOrder so; so.init(T, D, G, blockIdx.x);
            pg8::EpiAddF32 ep{p.X, D};
            pg8::gemm_phase(glds, g, so, ep, nullptr);
        }
        xcd_barrier(bar);
        { IDS
            const float* g2 = p.norm2_g + l * D; const float* RTl = p.RT + (size_t)l * 72 * D; int* cnt = p.ctrl + l * 64;
            for (int t = gw; t < T; t += NGW) {
                const float4* xr = (const float4*)(p.X + (size_t)t * D) + lane;
                float4 v[8]; float ss = 0.f;
#pragma unroll
                for (int j = 0; j < 8; ++j) { v[j] = xr[64 * j]; ss += v[j].x * v[j].x + v[j].y * v[j].y + v[j].z * v[j].z + v[j].w * v[j].w; }
                const float r = rsqrtf(wave_sum(ss) / D + EPS);
                uint2* hb = (uint2*)(p.HB + (size_t)t * D) + lane;
#pragma unroll
                for (int j = 0; j < 8; ++j) { const float4 gg = ((const float4*)g2)[lane + 64 * j];
                    v[j].x *= r * gg.x; v[j].y *= r * gg.y; v[j].z *= r * gg.z; v[j].w *= r * gg.w;
                    hb[64 * j] = make_uint2(pk2(v[j].x, v[j].y), pk2(v[j].z, v[j].w)); }
                float mylg = 0.f;
                float glg = 0.f;
                for (int c = 0; c < 72; ++c) {
                    const float4* w = (const float4*)(RTl + (size_t)c * D) + lane; float s = 0.f;
#pragma unroll
                    for (int j = 0; j < 8; ++j) { const float4 ww = w[64 * j]; s += v[j].x * ww.x + v[j].y * ww.y + v[j].z * ww.z + v[j].w * ww.w; }
                    s = wave_sum(s);
                    if (c < 8) { if (lane == c) glg = s + p.rg_b[l * 8 + c]; } else { if (lane == c - 8) mylg = s + p.re_b[l * 64 + c - 8]; }
                }
                float gl[8];
#pragma unroll
                for (int j = 0; j < 8; ++j) gl[j] = rdlane(glg, j);
                int gi = 0; float gm = gl[0];
#pragma unroll
                for (int j = 1; j < 8; ++j) if (gl[j] > gm) { gm = gl[j]; gi = j; }
                float gs = 0.f;
#pragma unroll
                for (int j = 0; j < 8; ++j) gs += __expf(gl[j] - gm);
                const float gp = 1.f / gs;
                float el[8];
#pragma unroll
                for (int j = 0; j < 8; ++j) el[j] = rdlane(mylg, __builtin_amdgcn_readfirstlane(gi) * 8 + j);
                int i1 = 0; float m1 = el[0];
#pragma unroll
                for (int j = 1; j < 8; ++j) if (el[j] > m1) { m1 = el[j]; i1 = j; }
                int i2 = -1; float m2 = -1e30f;
#pragma unroll
                for (int j = 0; j < 8; ++j) if (j != i1 && el[j] > m2) { m2 = el[j]; i2 = j; }
                if (lane == 0) {
                    const float p2 = __expf(m2 - m1); const float ga = gp / (1.f + p2), gb = gp * p2 / (1.f + p2);
                    const int e1 = gi * 8 + i1, e2 = gi * 8 + i2;
                    p.tok_e[t * 2] = e1; p.tok_e[t * 2 + 1] = e2; p.tok_g[t * 2] = ga; p.tok_g[t * 2 + 1] = gb;
                    p.tok_pos[t * 2] = atomicAdd(&cnt[e1], 1); p.tok_pos[t * 2 + 1] = atomicAdd(&cnt[e2], 1);
                }
            }
        }
        xcd_barrier(bar);
        { IDS
            int* pstart = (int*)lds; int* cnt = p.ctrl + l * 64; int* nblk_p = p.ctrl + 128; int* blk_e = p.ctrl + 256;
            __syncthreads();
            if (tid == 0) {
                int off = 0;
                for (int e = 0; e < NE; ++e) { pstart[e] = off; const int nb = (cnt[e] + 255) >> 8;
                    if (blockIdx.x == 0) for (int i = 0; i < nb; ++i) blk_e[(off >> 8) + i] = e;
                    off += nb << 8; }
                if (blockIdx.x == 0) *nblk_p = off >> 8;
            }
            __syncthreads();
            for (int a = gw; a < 2 * T; a += NGW) {
                const int t = a >> 1; const int row = pstart[p.tok_e[a]] + p.tok_pos[a];
                if (lane == 0) p.tok_row[a] = row;
                const uint4* src = (const uint4*)(p.HB + (size_t)t * D) + lane; uint4* dst = (uint4*)(p.XG + (size_t)row * D) + lane;
#pragma unroll
                for (int j = 0; j < 4; ++j) dst[64 * j] = src[64 * j];
            }
            __syncthreads();
        }
        xcd_barrier(bar);
        {
            PARAMS
            pg8::Gemm g{p.XG, p.WguT, MAXBLK * 256, NE * 1024, D};
            pg8::MoeOrder mo{p.ctrl + 256, p.ctrl[128] * 4, G, (int)blockIdx.x, 2};
            pg8::EpiSwiglu ep{p.Hb};
            pg8::gemm_phase(glds, g, mo, ep, nullptr);
        }
        xcd_barrier(bar);
        {
            PARAMS
            pg8::Gemm g{p.Hb, p.WdT, MAXBLK * 256, NE * D, DFF};
            pg8::MoeOrder mo{p.ctrl + 256, p.ctrl[128] * 8, G, (int)blockIdx.x, 3};
            pg8::EpiDownF32 ep{p.Yb};
            pg8::gemm_phase(glds, g, mo, ep, nullptr);
        }
        xcd_barrier(bar);
    }
    { IDS
    for (int t = gw; t < T; t += NGW) {
        float4* xr = (float4*)(p.X + (size_t)t * D) + lane;
        const int r0 = p.tok_row[2 * t], r1 = p.tok_row[2 * t + 1]; const float g0 = p.tok_g[2 * t], g1 = p.tok_g[2 * t + 1];
        const float4* y0 = (const float4*)(p.Yb + (size_t)r0 * D) + lane; const float4* y1 = (const float4*)(p.Yb + (size_t)r1 * D) + lane;
#pragma unroll
        for (int j = 0; j < 8; ++j) { float4 v = xr[64 * j]; const float4 a = y0[64 * j], b = y1[64 * j];
            v.x += g0 * a.x + g1 * b.x; v.y += g0 * a.y + g1 * b.y; v.z += g0 * a.z + g1 * b.z; v.w += g0 * a.w + g1 * b.w; xr[64 * j] = v; }
    }
    }
}

extern "C" void kernel_launch(void* const* d_in, const int* in_sizes, int n_in, void* d_out, int out_size, void* d_ws, size_t ws_size, hipStream_t stream) {
    Params p{};
    const float** pin = (const float**)&p;
    for (int i = 0; i < 26; ++i) pin[i] = (const float*)d_in[i];
    p.X = (float*)d_out;
    char* ws = (char*)d_ws; size_t off = 0;
    auto alloc = [&](size_t bytes) { void* q = ws + off; off += (bytes + 255) & ~(size_t)255; return q; };
    constexpr size_t CTL_BYTES = (size_t)XCD_BAR_WORDS * 4 + CTRL_INTS * 4;
    p.bar = (unsigned*)alloc(CTL_BYTES); p.ctrl = (int*)(p.bar + XCD_BAR_WORDS);
    p.HB = (u16*)alloc((size_t)T * D * 2);
    p.MIXED = (u16*)alloc((size_t)T * D * 2);
    p.PROJ = (u16*)alloc((size_t)T * DP * 2);
    p.DTR = (float*)alloc((size_t)T * 8 * 4);
    p.YD = (float*)alloc((size_t)T * 512 * 4);
    p.SS = (float*)alloc((size_t)NB * 32 * 8 * 8192 * 4);
    p.PREV = (u16*)alloc((size_t)NB * 32 * 8 * 8192 * 2);
    p.ATOT = (float*)alloc((size_t)NB * 32 * 8 * 4);
    p.ACS = (float*)alloc((size_t)T * 8 * 4);
    p.CG = (u16*)alloc((size_t)T * 256 * 2);
    p.WinT = (u16*)alloc((size_t)2 * DP * D * 2);
    p.WoutT = (u16*)alloc((size_t)2 * D * D * 2);
    p.RT = (float*)alloc((size_t)2 * 72 * D * 4);
    p.WDT = (float*)alloc((size_t)2 * 8 * D * 4);
    p.WguT = (u16*)alloc((size_t)NE * 2 * DFF * D * 2);
    p.WdT = (u16*)alloc((size_t)NE * D * DFF * 2);
    p.tok_e = (int*)alloc((size_t)T * 2 * 4); p.tok_pos = (int*)alloc((size_t)T * 2 * 4); p.tok_row = (int*)alloc((size_t)T * 2 * 4);
    p.tok_g = (float*)alloc((size_t)T * 2 * 4);
    p.XG = (u16*)alloc((size_t)MAXBLK * 256 * D * 2);
    p.Hb = (u16*)alloc((size_t)MAXBLK * 256 * DFF * 2);
    p.Yb = (float*)alloc((size_t)MAXBLK * 256 * D * 4);
    static int grid = 0;
    if (grid == 0) {
        if (off > ws_size || n_in != 26) { fprintf(stderr, "kernel_launch: workspace too small (%zu > %zu) or n_in %d\n", off, ws_size, n_in); grid = -1; return; }
        int dev = 0, cus = 0, per_cu = 0;
        if (hipGetDevice(&dev) != hipSuccess || hipDeviceGetAttribute(&cus, hipDeviceAttributeMultiprocessorCount, dev) != hipSuccess) { grid = -1; return; }
        if (hipFuncSetAttribute((const void*)mega, hipFuncAttributeMaxDynamicSharedMemorySize, LDS_BYTES) != hipSuccess) { fprintf(stderr, "hipFuncSetAttribute failed\n"); grid = -1; return; }
        if (hipOccupancyMaxActiveBlocksPerMultiprocessor(&per_cu, (const void*)mega, NTHR, LDS_BYTES) != hipSuccess || per_cu < 1)
            fprintf(stderr, "kernel_launch: occupancy query reports %d blocks per CU\n", per_cu);
        (void)hipGetLastError();
        grid = cus;
    }
    if (grid < 0) return;
    if (hipMemsetAsync(p.bar, 0, CTL_BYTES, stream) != hipSuccess) return;
    hipLaunchKernelGGL(mega, dim3(grid), dim3(NTHR), LDS_BYTES, stream, p);
}
```

```cpp
#include <hip/hip_runtime.h>
#include <hip/hip_bf16.h>
#include <stdint.h>
#include <stdio.h>

typedef unsigned short u16;
using bf16x8 = __attribute__((ext_vector_type(8))) short;
using f32x4  = __attribute__((ext_vector_type(4))) float;
#define LAS __attribute__((address_space(3)))

constexpr int NB = 2, SEQ = 4096, T = NB * SEQ, D = 2048, DIN = 5128, DP = 5120;
constexpr int NE = 64, DFF = 512;
constexpr int MAXBLK = 128;
constexpr float EPS = 1e-6f;
constexpr int C_Z = 0, C_XBC = 512, C_SB = 1536, C_DIL = 3072, C_POOL = 4608;
constexpr int NTHR = 512, NWAVE = 8;
constexpr int LDS_BYTES = 16 + 131072;

__device__ __forceinline__ float bf2f(u16 h) { return __uint_as_float(((unsigned)h) << 16); }
__device__ __forceinline__ u16 f2bf(float f) { unsigned u = __float_as_uint(f); u += 0x7fffu + ((u >> 16) & 1u); return (u16)(u >> 16); }
__device__ __forceinline__ unsigned pk2(float lo, float hi) { return (unsigned)f2bf(lo) | ((unsigned)f2bf(hi) << 16); }
template <int O> __device__ __forceinline__ float swz_xor(float v) { return __int_as_float(__builtin_amdgcn_ds_swizzle(__float_as_int(v), (O << 10) | 0x1F)); }
__device__ __forceinline__ float rdlane(float v, int l) { return __int_as_float(__builtin_amdgcn_readlane(__float_as_int(v), l)); }
__device__ __forceinline__ float wave_sum(float v) {
    v += swz_xor<1>(v); v += swz_xor<2>(v); v += swz_xor<4>(v); v += swz_xor<8>(v); v += swz_xor<16>(v);
    return rdlane(v, 0) + rdlane(v, 32);
}
__device__ __forceinline__ float siluf(float x) { return x / (1.f + __expf(-x)); }
__device__ __forceinline__ float softplusf(float x) { return fmaxf(x, 0.f) + log1pf(__expf(-fabsf(x))); }

#define XB_TMO      128
#define XB_XCNT(j)  (256  + 64 * (j))
#define XB_XSUB(j)  (1280 + 64 * (j))
#define XB_XGEN(j)  (2304 + 64 * (j))
#define XB_TOP      3328
#define XB_TOPGEN   3392
#define XCD_BAR_WORDS 3456
#define XB_SPIN_CAP (1u << 18)
__device__ __forceinline__ unsigned xb_ld(unsigned* p)              { return __hip_atomic_load(p, __ATOMIC_RELAXED, __HIP_MEMORY_SCOPE_AGENT); }
__device__ __forceinline__ unsigned xb_add(unsigned* p, unsigned v) { return __hip_atomic_fetch_add(p, v, __ATOMIC_RELAXED, __HIP_MEMORY_SCOPE_AGENT); }
__device__ __forceinline__ unsigned xb_xcc_id() { return (unsigned)__builtin_amdgcn_s_getreg((3 << 11) | 20) & 0xFu; }
#define XB_SPIN(cond, bar) do { unsigned _sp = 0; while (cond) { __builtin_amdgcn_s_sleep(1); \
    if ((++_sp & 255u) == 0u) { if (xb_ld(&(bar)[XB_TMO])) break; if (_sp > XB_SPIN_CAP) { atomicAdd(&(bar)[XB_TMO], 1u); break; } } } } while (0)
struct XcdBarrier { unsigned* bar; unsigned x; volatile LAS unsigned* st; };
__device__ __forceinline__ XcdBarrier xcd_barrier_post(unsigned* bar, volatile LAS unsigned* st) {
    XcdBarrier b; b.bar = bar; b.x = xb_xcc_id(); b.st = st;
    if (threadIdx.x == 0) (void)xb_add(&bar[XB_XCNT(b.x)], 1u);
    return b;
}
__device__ __forceinline__ void xcd_barrier_complete(unsigned* bar, unsigned x, unsigned& nloc, unsigned& nx) {
    const unsigned G = gridDim.x * gridDim.y * gridDim.z;
    unsigned sum, cnt, mine, sp = 0u;
    for (;;) {
        sum = 0u; cnt = 0u; mine = 0u;
#pragma unroll
        for (unsigned j = 0; j < 16; ++j) { const unsigned c = xb_ld(&bar[XB_XCNT(j)]); sum += c; cnt += (c > 0u) ? 1u : 0u; mine = (j == x) ? c : mine; }
        if (sum == G) break;
        __builtin_amdgcn_s_sleep(1);
        if ((++sp & 255u) == 0u) { if (xb_ld(&bar[XB_TMO])) break; if (sp > XB_SPIN_CAP) { atomicAdd(&bar[XB_TMO], 1u); break; } }
    }
    nloc = mine > 0u ? mine : 1u; nx = cnt > 0u ? cnt : 1u;
}
__device__ __forceinline__ void xcd_barrier(const XcdBarrier& b) {
    asm volatile("s_waitcnt vmcnt(0)" ::: "memory");
    __syncthreads();
    if (threadIdx.x == 0) {
        unsigned* bar = b.bar; unsigned bx = b.x;
        asm volatile("" : "+s"(bar), "+s"(bx));
        __builtin_amdgcn_s_waitcnt(0);
        unsigned nloc = b.st[0], nx = b.st[1];
        if (nloc == 0u) { xcd_barrier_complete(bar, bx, nloc, nx); b.st[0] = nloc; b.st[1] = nx; }
        const unsigned old = xb_add(&bar[XB_XSUB(bx)], 1u);
        const unsigned gen = old / nloc;
        if (old + 1u == (gen + 1u) * nloc) {
            __builtin_amdgcn_fence(__ATOMIC_RELEASE, "agent");
            asm volatile("s_waitcnt vmcnt(0)" ::: "memory");
            const unsigned og = xb_add(&bar[XB_TOP], 1u);
            const unsigned tg = og / nx;
            if (og + 1u == (tg + 1u) * nx) xb_add(&bar[XB_TOPGEN], 1u);
            else XB_SPIN(xb_ld(&bar[XB_TOPGEN]) == tg, bar);
            __builtin_amdgcn_fence(__ATOMIC_ACQUIRE, "agent");
            xb_add(&bar[XB_XGEN(bx)], 1u);
            asm volatile("s_waitcnt vmcnt(0)" ::: "memory");
        } else {
            XB_SPIN(xb_ld(&bar[XB_XGEN(bx)]) == gen, bar);
            __builtin_amdgcn_fence(__ATOMIC_ACQUIRE, "agent");
            asm volatile("s_waitcnt vmcnt(0)" ::: "memory");
        }
    }
    __syncthreads();
}

struct Params {
    const float *x_in, *norm1_g, *w_in, *conv_w, *conv_b, *dt_bias, *a_log, *ssd_d, *ssd_ng, *sbq_g, *sbk_g, *sbo_g, *dq_g, *dk_g, *do_g,
                *pool_w, *pool_sc, *w_out, *norm2_g, *rg_w, *rg_b, *re_w, *re_b, *wg, *wu, *wd;
    float* X; unsigned* bar; int* ctrl;
    u16 *HB, *MIXED, *WinT, *WoutT, *WguT, *WdT, *XG, *Hb;
    u16 *PROJ, *PREV, *CG, *WpT; float *DTR, *YD, *SS, *ATOT, *ACS, *RT, *WDT, *tok_g, *Yb;
    int *tok_e, *tok_pos, *tok_row;
};
constexpr int CTRL_INTS = 1024;

namespace pg8 {
#define PG8_LAS __attribute__((address_space(3)))
typedef unsigned short bf16_t;
typedef short bf16x8 __attribute__((ext_vector_type(8)));
typedef float f32x4 __attribute__((ext_vector_type(4)));
typedef unsigned u32x4 __attribute__((ext_vector_type(4)));
constexpr int BM = 256, BK = 64, HALF = 128, HTB = HALF * BK * 2  , STAGE_BYTES = 8 * HTB, NXCD = 8, WGM = 8;

__host__ __device__ __forceinline__ int lds_byte(int r, int c) { const int st = (r >> 4) * 2 + (c >> 5), rr = r & 15, cc = c & 31, ob = rr * 64 + cc * 2; return st * 1024 + (ob ^ (((ob >> 9) & 1) << 5)); }
__host__ __device__ __forceinline__ void stage_rc(int b, int& R, int& C) { const int st = b / 1024, sb = b % 1024, swz = sb ^ (((sb >> 9) & 1) << 5); R = (st >> 1) * 16 + swz / 64; C = (st & 1) * 32 + (swz % 64) / 2; }
__host__ __device__ __forceinline__ int perm32(int rho) { const int n = rho >> 4, i = rho & 15; return 8 * (i >> 2) + 4 * n + (i & 3); }

struct Unit { int pm, pn; };
struct Gemm { const bf16_t* A; const bf16_t* Bt; int M, N, K; };

struct StaticOrder {
    int nM, nN, nwg, G, c;
    __host__ __device__ void init(int M, int N, int G_, int c_) { nM = M / BM; nN = N / BM; nwg = nM * nN; G = G_; c = c_; }
    __host__ __device__ bool next(int i, Unit& u) const {
        const long L = (long)i * G + c; if (L >= nwg) return false;
        int wgid = (int)L; { const int q = nwg / NXCD, r = nwg % NXCD, xcd = wgid % NXCD, off = wgid / NXCD; wgid = (xcd < r ? xcd * (q + 1) : r * (q + 1) + (xcd - r) * q) + off; }
        const int nig = WGM * nN, gid = wgid / nig, fm = gid * WGM, gsz = (nM - fm) < WGM ? (nM - fm) : WGM;
        u.pm = fm + ((wgid % nig) % gsz); u.pn = (wgid % nig) / gsz; return true;
    }
    __device__ __forceinline__ void a_ready(const Unit&) const {}
    __device__ __forceinline__ void done(const Unit&) const {}
};
__device__ __forceinline__ unsigned cvt_pk_bf16(float lo, float hi) { unsigned r; asm volatile("v_cvt_pk_bf16_f32 %0, %1, %2" : "=v"(r) : "v"(lo), "v"(hi)); return r; }
typedef float f32x2 __attribute__((ext_vector_type(2)));
struct EpiF32 {
    static constexpr bool PERM = false, AFTER_DRAIN = false;
    float* C; int ldc; const float* bias;
    __device__ __forceinline__ void operator()(const f32x4 (&acc)[2][2][4][2], const Unit& u, int wr, int wc, int fr, int fq) const {
        const int row0 = u.pm * BM + wr * 64 + fr, col0 = u.pn * BM + wc * 32 + 4 * fq;
        f32x4 bv[2][2];
#pragma unroll
        for (int bj = 0; bj < 2; ++bj)
#pragma unroll
            for (int n = 0; n < 2; ++n) bv[bj][n] = bias ? *(const f32x4*)(bias + col0 + bj * HALF + n * 16) : (f32x4){0.f, 0.f, 0.f, 0.f};
#pragma unroll
        for (int ai = 0; ai < 2; ++ai)
#pragma unroll
            for (int m = 0; m < 4; ++m) { float* rowp = C + (size_t)(row0 + ai * HALF + m * 16) * ldc + col0;
#pragma unroll
                for (int bj = 0; bj < 2; ++bj)
#pragma unroll
                    for (int n = 0; n < 2; ++n) *(f32x4*)(rowp + bj * HALF + n * 16) = acc[ai][bj][m][n] + bv[bj][n]; }
    }
};
template <class Epi, class Sched, bool STAMP = false>
__device__ __forceinline__ void gemm_phase(PG8_LAS unsigned char* lds, const Gemm g, const Sched& S, const Epi& E, unsigned long long* stamps) {
    int tid = threadIdx.x; asm volatile("" : "+v"(tid));
    const int wid = __builtin_amdgcn_readfirstlane(tid >> 6), lane = tid & 63, wr = wid >> 2, wc = wid & 3, fr = lane & 15, fq = lane >> 4;
    const int K = g.K, nt = K / BK;
    int ts_lo = 0, ts_hi = 0, nts = 0; const unsigned long long rt_entry = STAMP ? (unsigned long long)wall_clock64() : 0ull;
#define PG8_STAMP() do { if (STAMP && wid == 0 && nts < 64) { const unsigned long long _c = (unsigned long long)clock64(); \
        ts_lo = (lane == nts) ? (int)(unsigned)_c : ts_lo; ts_hi = (lane == nts) ? (int)(unsigned)(_c >> 32) : ts_hi; ++nts; } } while (0)
    PG8_STAMP();
    unsigned voffA[2], voffB[2];
#pragma unroll
    for (int i = 0; i < 2; ++i) { int R, C; stage_rc(tid * 16 + i * 8192, R, C); const int Rb = Epi::PERM ? ((R & ~31) + perm32(R & 31)) : R;
        voffA[i] = (unsigned)(R * K + C) * 2u; voffB[i] = (unsigned)(Rb * K + C) * 2u; }
    const size_t kstep = (size_t)(BK * 2);
    const size_t hstep = (size_t)HALF * K * 2;
    const size_t tstep = 2 * hstep;
    const unsigned ldsw = (unsigned)wid * 1024u;
    const int aoff = lds_byte(wr * 64 + fr, fq * 8), boff = lds_byte(wc * 32 + fr, fq * 8);
#define PG8_SA(b, h) (((b) * 2 + (h)) * HTB)
#define PG8_SB(b, h) ((4 + (b) * 2 + (h)) * HTB)
#define PG8_STAGE(bufoff, gbase, voff) do { _Pragma("unroll") for (int _i = 0; _i < 2; ++_i) \
        __builtin_amdgcn_global_load_lds((const unsigned*)((const char*)(gbase) + (voff)[_i]), (PG8_LAS unsigned*)(lds + (bufoff) + ldsw + _i * 8192), 16, 0, 0); } while (0)
#define PG8_LDA(dst, b, h) do { _Pragma("unroll") for (int m = 0; m < 4; ++m) _Pragma("unroll") for (int k = 0; k < 2; ++k) dst[m][k] = *(const PG8_LAS bf16x8*)(lds + PG8_SA(b, h) + aoff + m * 2048 + k * 1024); } while (0)
#define PG8_LDB(dst, b, h) do { _Pragma("unroll") for (int n = 0; n < 2; ++n) _Pragma("unroll") for (int k = 0; k < 2; ++k) dst[n][k] = *(const PG8_LAS bf16x8*)(lds + PG8_SB(b, h) + boff + n * 2048 + k * 1024); } while (0)
#define PG8_MMA(ai, bj, At, Bt) do { __builtin_amdgcn_s_setprio(1); _Pragma("unroll") for (int m = 0; m < 4; ++m) _Pragma("unroll") for (int n = 0; n < 2; ++n) _Pragma("unroll") for (int k = 0; k < 2; ++k) \
        acc[ai][bj][m][n] = __builtin_amdgcn_mfma_f32_16x16x32_bf16(Bt[n][k], At[m][k], acc[ai][bj][m][n], 0, 0, 0); __builtin_amdgcn_s_setprio(0); } while (0)
#define PG8_WAIT_V(n) asm volatile("s_waitcnt vmcnt(" #n ")" ::: "memory")
#define PG8_WAIT_L(n) asm volatile("s_waitcnt lgkmcnt(" #n ")" ::: "memory")
#define PG8_BAR __builtin_amdgcn_s_barrier()
#define PG8_SCHED __builtin_amdgcn_sched_barrier(0)
    Unit cur, nxt; int ui = 0;
    if (!S.next(0, cur)) return;
    f32x4 acc[2][2][4][2];
#pragma unroll
    for (int a = 0; a < 2; ++a)
#pragma unroll
        for (int b = 0; b < 2; ++b)
#pragma unroll
            for (int m = 0; m < 4; ++m)
#pragma unroll
                for (int n = 0; n < 2; ++n) acc[a][b][m][n] = (f32x4){0.f, 0.f, 0.f, 0.f};
    bf16x8 At[4][2], B0[2][2], B1[2][2];
    const char* cA = (const char*)g.A + (size_t)cur.pm * tstep; const char* cB = (const char*)g.Bt + (size_t)cur.pn * tstep;
    S.a_ready(cur);
    PG8_STAGE(PG8_SB(0, 0), cB, voffB); PG8_STAGE(PG8_SA(0, 0), cA, voffA); PG8_STAGE(PG8_SB(0, 1), cB + hstep, voffB); PG8_STAGE(PG8_SA(0, 1), cA + hstep, voffA);
    if (wr == 1) PG8_BAR;
    PG8_WAIT_V(4); PG8_BAR;
    PG8_STAGE(PG8_SB(1, 0), cB + kstep, voffB); PG8_STAGE(PG8_SA(1, 0), cA + kstep, voffA); PG8_STAGE(PG8_SB(1, 1), cB + hstep + kstep, voffB);
    PG8_WAIT_V(6); PG8_BAR;
    PG8_STAMP();
    for (;;) {
        const bool has_next = S.next(ui + 1, nxt);
        const char* nA = has_next ? (const char*)g.A + (size_t)nxt.pm * tstep : cA; const char* nB = has_next ? (const char*)g.Bt + (size_t)nxt.pn * tstep : cB;
        for (int t = 0; t < nt; t += 2) {
            const bool last = (t == nt - 2);
            const char* a1 = cA + (size_t)(t + 1) * kstep;
            const char* a2 = last ? nA : cA + (size_t)(t + 2) * kstep; const char* b2 = last ? nB : cB + (size_t)(t + 2) * kstep;
            const char* a3 = a2 + kstep; const char* b3 = b2 + kstep;
            if (last && has_next) S.a_ready(nxt);
            PG8_LDB(B0, 0, 0); PG8_SCHED; PG8_LDA(At, 0, 0); PG8_STAGE(PG8_SA(1, 1), a1 + hstep, voffA);
            PG8_WAIT_L(8); PG8_BAR; PG8_WAIT_L(0); PG8_MMA(0, 0, At, B0); PG8_BAR; PG8_SCHED;
            PG8_LDB(B1, 0, 1); PG8_STAGE(PG8_SB(0, 0), b2, voffB);
            PG8_BAR; PG8_WAIT_L(0); PG8_MMA(0, 1, At, B1); PG8_BAR;
            PG8_LDA(At, 0, 1); PG8_STAGE(PG8_SA(0, 0), a2, voffA);
            PG8_BAR; PG8_WAIT_L(0); PG8_MMA(1, 0, At, B0); PG8_BAR; PG8_SCHED;
            PG8_STAGE(PG8_SB(0, 1), b2 + hstep, voffB);
            PG8_WAIT_V(6); PG8_BAR; PG8_MMA(1, 1, At, B1); PG8_BAR;
            PG8_LDB(B0, 1, 0); PG8_SCHED; PG8_LDA(At, 1, 0); PG8_STAGE(PG8_SA(0, 1), a2 + hstep, voffA);
            PG8_WAIT_L(8); PG8_BAR; PG8_WAIT_L(0); PG8_MMA(0, 0, At, B0); PG8_BAR; PG8_SCHED;
            PG8_LDB(B1, 1, 1); PG8_STAGE(PG8_SB(1, 0), b3, voffB);
            PG8_BAR; PG8_WAIT_L(0); PG8_MMA(0, 1, At, B1); PG8_BAR;
            PG8_LDA(At, 1, 1); PG8_STAGE(PG8_SA(1, 0), a3, voffA);
            PG8_BAR; PG8_WAIT_L(0); PG8_MMA(1, 0, At, B0); PG8_BAR; PG8_SCHED;
            PG8_STAGE(PG8_SB(1, 1), b3 + hstep, voffB);
            PG8_WAIT_V(6); PG8_BAR; PG8_MMA(1, 1, At, B1); PG8_BAR;
        }
        PG8_STAMP();
        if constexpr (!Epi::AFTER_DRAIN) { E(acc, cur, wr, wc, fr, fq); S.done(cur); }
        PG8_STAMP();
        if (!has_next) break;
#pragma unroll
        for (int a = 0; a < 2; ++a)
#pragma unroll
            for (int b = 0; b < 2; ++b)
#pragma unroll
                for (int m = 0; m < 4; ++m)
#pragma unroll
                    for (int n = 0; n < 2; ++n) acc[a][b][m][n] = (f32x4){0.f, 0.f, 0.f, 0.f};
        cur = nxt; cA = nA; cB = nB; ++ui;
    }
    PG8_WAIT_V(0);
    if (wr == 0) PG8_BAR;
    PG8_BAR;
    if constexpr (Epi::AFTER_DRAIN) { E.fused(acc, cur, wr, wc, fr, fq, lds, wid, lane); S.done(cur); }
    PG8_STAMP();
    if (STAMP && wid == 0) { stamps[lane] = lane < nts ? (((unsigned long long)(unsigned)ts_hi << 32) | (unsigned)ts_lo) : 0ull;
        if (lane == 62) stamps[62] = rt_entry; if (lane == 63) stamps[63] = (unsigned long long)wall_clock64(); }
#undef PG8_STAMP
#undef PG8_SA
#undef PG8_SB
#undef PG8_STAGE
#undef PG8_LDA
#undef PG8_LDB
#undef PG8_MMA
#undef PG8_WAIT_V
#undef PG8_WAIT_L
#undef PG8_BAR
#undef PG8_SCHED
}
}

namespace pg8 {
struct EpiStoreBf16 {
    static constexpr bool PERM = true, AFTER_DRAIN = false;
    bf16_t* O; int ldc;
    __device__ __forceinline__ void operator()(const f32x4 (&acc)[2][2][4][2], const Unit& u, int wr, int wc, int fr, int fq) const {
        const int row0 = u.pm * BM + wr * 64 + fr, col0 = u.pn * BM + wc * 32 + 8 * fq;
#pragma unroll
        for (int ai = 0; ai < 2; ++ai)
#pragma unroll
            for (int m = 0; m < 4; ++m) { bf16_t* rowp = O + (size_t)(row0 + ai * HALF + m * 16) * ldc + col0;
#pragma unroll
                for (int bj = 0; bj < 2; ++bj) { const f32x4 v0 = acc[ai][bj][m][0], v1 = acc[ai][bj][m][1];
                    u32x4 w; w.x = cvt_pk_bf16(v0[0], v0[1]); w.y = cvt_pk_bf16(v0[2], v0[3]); w.z = cvt_pk_bf16(v1[0], v1[1]); w.w = cvt_pk_bf16(v1[2], v1[3]);
                    *(u32x4*)(rowp + bj * HALF) = w; } }
    }
};
struct EpiAddF32 {
    static constexpr bool PERM = false, AFTER_DRAIN = false;
    float* C; int ldc;
    __device__ __forceinline__ void operator()(const f32x4 (&acc)[2][2][4][2], const Unit& u, int wr, int wc, int fr, int fq) const {
        const int row0 = u.pm * BM + wr * 64 + fr, col0 = u.pn * BM + wc * 32 + 4 * fq;
#pragma unroll
        for (int ai = 0; ai < 2; ++ai)
#pragma unroll
            for (int m = 0; m < 4; ++m) { float* rowp = C + (size_t)(row0 + ai * HALF + m * 16) * ldc + col0;
#pragma unroll
                for (int bj = 0; bj < 2; ++bj)
#pragma unroll
                    for (int n = 0; n < 2; ++n) { f32x4* q = (f32x4*)(rowp + bj * HALF + n * 16); *q = *q + acc[ai][bj][m][n]; } }
    }
};
struct EpiDownF32 {
    static constexpr bool PERM = false, AFTER_DRAIN = false;
    float* C;
    __device__ __forceinline__ void operator()(const f32x4 (&acc)[2][2][4][2], const Unit& u, int wr, int wc, int fr, int fq) const {
        const int row0 = u.pm * BM + wr * 64 + fr, col0 = (u.pn & 7) * BM + wc * 32 + 4 * fq;
#pragma unroll
        for (int ai = 0; ai < 2; ++ai)
#pragma unroll
            for (int m = 0; m < 4; ++m) { float* rowp = C + (size_t)(row0 + ai * HALF + m * 16) * 2048 + col0;
#pragma unroll
                for (int bj = 0; bj < 2; ++bj)
#pragma unroll
                    for (int n = 0; n < 2; ++n) *(f32x4*)(rowp + bj * HALF + n * 16) = acc[ai][bj][m][n]; }
    }
};
struct EpiSwiglu {
    static constexpr bool PERM = true, AFTER_DRAIN = false;
    bf16_t* H;
    __device__ __forceinline__ void operator()(const f32x4 (&acc)[2][2][4][2], const Unit& u, int wr, int wc, int fr, int fq) const {
        const int row0 = u.pm * BM + wr * 64 + fr, col0 = (u.pn & 3) * 128 + wc * 32 + 8 * fq;
#pragma unroll
        for (int ai = 0; ai < 2; ++ai)
#pragma unroll
            for (int m = 0; m < 4; ++m) { bf16_t* rowp = H + (size_t)(row0 + ai * HALF + m * 16) * 512 + col0;
                float h[8];
#pragma unroll
                for (int n = 0; n < 2; ++n)
#pragma unroll
                    for (int j = 0; j < 4; ++j) { const float g = acc[ai][0][m][n][j], up = acc[ai][1][m][n][j]; h[n * 4 + j] = g / (1.f + __expf(-g)) * up; }
                u32x4 w; w.x = cvt_pk_bf16(h[0], h[1]); w.y = cvt_pk_bf16(h[2], h[3]); w.z = cvt_pk_bf16(h[4], h[5]); w.w = cvt_pk_bf16(h[6], h[7]);
                *(u32x4*)rowp = w; }
    }
};
struct MoeOrder {
    const int* blk_e; int ntile, G, c, shift;
    __device__ __forceinline__ bool next(int i, Unit& u) const {
        const int L = i * G + c; if (L >= ntile) return false;
        const int mb = L >> shift, nt = L & ((1 << shift) - 1);
        u.pm = mb; u.pn = (blk_e[mb] << shift) + nt; return true;
    }
    __device__ __forceinline__ void a_ready(const Unit&) const {}
    __device__ __forceinline__ void done(const Unit&) const {}
};
}

__device__ __forceinline__ void transpose_item(const float* __restrict__ W, int ldin, int n0, int K, u16* __restrict__ WT, int row0, int nbn, int item, float* scr, int lane, int ilv = -1) {
    const int kb = item / nbn, nb = item % nbn, k0 = 64 * kb, nn = 32 * nb;
    const int rb = ilv < 0 ? row0 + nn : row0 + (nn >> 7) * 256 + ilv * 128 + (nn & 127);
#pragma unroll 8
    for (int i = 0; i < 32; ++i) { const int kk = 2 * i + (lane >> 5); scr[kk * 33 + (lane & 31)] = W[(size_t)(k0 + kk) * ldin + n0 + nn + (lane & 31)]; }
    asm volatile("s_waitcnt lgkmcnt(0)" ::: "memory");
    const int c = lane & 7;
#pragma unroll
    for (int j = 0; j < 4; ++j) { const int n = (lane >> 3) + 8 * j; const float* s = scr + (8 * c) * 33 + n;
        uint4 o; o.x = pk2(s[0 * 33], s[1 * 33]); o.y = pk2(s[2 * 33], s[3 * 33]); o.z = pk2(s[4 * 33], s[5 * 33]); o.w = pk2(s[6 * 33], s[7 * 33]);
        *(uint4*)(WT + (size_t)(rb + n) * K + k0 + 8 * c) = o; }
    asm volatile("s_waitcnt lgkmcnt(0)" ::: "memory");
}
__device__ __forceinline__ void convert_moe_weights(const float* wg, const float* wu, const float* wd, u16* WguT, u16* WdT, int l, float* scr, int gw, int NGW, int lane) {
    constexpr int IPE = 512;
    for (int it = gw; it < 3 * NE * IPE; it += NGW) {
        const int which = it / (NE * IPE), r = it % (NE * IPE), e = r / IPE, item = r % IPE;
        const size_t eo = ((size_t)l * NE + e) * (size_t)D * DFF;
        if (which == 0)      transpose_item(wg + eo, DFF, 0, D, WguT + (size_t)e * 1024 * D, 0, DFF / 32, item, scr, lane, 0);
        else if (which == 1) transpose_item(wu + eo, DFF, 0, D, WguT + (size_t)e * 1024 * D, 0, DFF / 32, item, scr, lane, 1);
        else                 transpose_item(wd + eo, D, 0, DFF, WdT + (size_t)e * D * DFF, 0, D / 32, item, scr, lane);
    }
}


constexpr int ATT_RS = 144;
constexpr int ATT_VBYTES = 32 * ATT_RS;
typedef long long i64;
typedef unsigned u32x4v __attribute__((ext_vector_type(4)));
typedef unsigned u32x2v __attribute__((ext_vector_type(2)));
__device__ __forceinline__ float bperm(int srclane, float v) { return __int_as_float(__builtin_amdgcn_ds_bpermute(srclane << 2, __float_as_int(v))); }
__device__ __forceinline__ float softplus_fast(float z) { return fmaxf(z, 0.f) + __logf(1.f + __expf(-fabsf(z))); }
__device__ __forceinline__ void vt_frags(unsigned vaddr, int lane, bf16x8 (&vf)[4]) {
    const unsigned a = vaddr + (unsigned)((4 * (lane >> 4) + ((lane & 15) >> 2)) * ATT_RS + (lane & 3) * 8);
    i64 r0, r1, r2, r3, r4, r5, r6, r7;
    asm volatile("s_waitcnt lgkmcnt(0)\n\t"
                 "ds_read_b64_tr_b16 %0, %8\n\tds_read_b64_tr_b16 %1, %8 offset:2304\n\t"
                 "ds_read_b64_tr_b16 %2, %8 offset:32\n\tds_read_b64_tr_b16 %3, %8 offset:2336\n\t"
                 "ds_read_b64_tr_b16 %4, %8 offset:64\n\tds_read_b64_tr_b16 %5, %8 offset:2368\n\t"
                 "ds_read_b64_tr_b16 %6, %8 offset:96\n\tds_read_b64_tr_b16 %7, %8 offset:2400\n\t"
                 "s_waitcnt lgkmcnt(0)"
                 : "=&v"(r0), "=&v"(r1), "=&v"(r2), "=&v"(r3), "=&v"(r4), "=&v"(r5), "=&v"(r6), "=&v"(r7) : "v"(a) : "memory");
    typedef i64 i64x2 __attribute__((ext_vector_type(2)));
    i64x2 t; t.x = r0; t.y = r1; vf[0] = __builtin_bit_cast(bf16x8, t); t.x = r2; t.y = r3; vf[1] = __builtin_bit_cast(bf16x8, t);
    t.x = r4; t.y = r5; vf[2] = __builtin_bit_cast(bf16x8, t); t.x = r6; t.y = r7; vf[3] = __builtin_bit_cast(bf16x8, t);
}
__device__ __forceinline__ bf16x8 pack8(const float (&a)[4], const float (&b)[4]) {
    u32x4v w; w.x = pk2(a[0], a[1]); w.y = pk2(a[2], a[3]); w.z = pk2(b[0], b[1]); w.w = pk2(b[2], b[3]);
    return __builtin_bit_cast(bf16x8, w);
}
__device__ __forceinline__ void store_out_tile(const f32x4 (&o)[4], float scale, const float* __restrict__ gain, u16* __restrict__ dst  , int g) {
#pragma unroll
    for (int dt = 0; dt < 4; ++dt) { const float4 gg = *(const float4*)(gain + dt * 16 + 4 * g);
        *(uint2*)(dst + dt * 16 + 4 * g) = make_uint2(pk2(o[dt][0] * scale * gg.x, o[dt][1] * scale * gg.y), pk2(o[dt][2] * scale * gg.z, o[dt][3] * scale * gg.w)); }
}

__device__ __forceinline__ void sb_unit(const u16* __restrict__ PROJ, int b, int qb, int h, int lane, LAS char* vl, LAS float* red,
                                        const float* __restrict__ gout, u16* __restrict__ MIXED) {
    const int li = lane & 15, g = lane >> 4; const size_t tb = (size_t)b * SEQ; const int q0 = qb * 64;
    const u16* Qp = PROJ + C_SB + h * 64; const u16* Kp = Qp + 512; const u16* Vp = Qp + 1024;
    const unsigned vaddr = (unsigned)(size_t)vl;
    bf16x8 qf[4][2];
#pragma unroll
    for (int qt = 0; qt < 4; ++qt)
#pragma unroll
        for (int s = 0; s < 2; ++s) qf[qt][s] = *(const bf16x8*)(Qp + (tb + q0 + qt * 16 + li) * DP + 32 * s + 8 * g);
    f32x4 acc[4][4];
#pragma unroll
    for (int qt = 0; qt < 4; ++qt)
#pragma unroll
        for (int dt = 0; dt < 4; ++dt) acc[qt][dt] = (f32x4){0.f, 0.f, 0.f, 0.f};
    float carry[4] = {0.f, 0.f, 0.f, 0.f};
    for (int k0 = q0 + 32; k0 >= 0; k0 -= 32) {
        bf16x8 kf[2][2];
#pragma unroll
        for (int kt = 0; kt < 2; ++kt)
#pragma unroll
            for (int s = 0; s < 2; ++s) kf[kt][s] = *(const bf16x8*)(Kp + (tb + k0 + kt * 16 + li) * DP + 32 * s + 8 * g);
#pragma unroll
        for (int u = 0; u < 4; ++u) { const int c = lane + 64 * u, row = c >> 3, cc = c & 7;
            *(LAS u32x4v*)(vl + row * ATT_RS + cc * 16) = *(const u32x4v*)(Vp + (tb + k0 + row) * DP + cc * 8); }
        bf16x8 pf[4];
#pragma unroll
        for (int qt = 0; qt < 4; ++qt) {
            const int qpos = q0 + qt * 16 + li;
            float w[2][4];
#pragma unroll
            for (int kt = 1; kt >= 0; --kt) {
                f32x4 st = __builtin_amdgcn_mfma_f32_16x16x32_bf16(kf[kt][0], qf[qt][0], (f32x4){0.f, 0.f, 0.f, 0.f}, 0, 0, 0);
                st = __builtin_amdgcn_mfma_f32_16x16x32_bf16(kf[kt][1], qf[qt][1], st, 0, 0, 0);
                const int kb = k0 + kt * 16 + 4 * g;
                float sp[4];
#pragma unroll
                for (int r = 0; r < 4; ++r) sp[r] = (kb + r < qpos) ? softplus_fast(st[r]) : 0.f;
                const float G = (sp[0] + sp[1]) + (sp[2] + sp[3]);
                const float x1 = bperm(lane ^ 16, G), hs = G + x1, x2 = bperm(lane ^ 32, hs);
                float rs = carry[qt] + (g == 3 ? 0.f : g == 2 ? x1 : g == 1 ? x2 : x1 + x2);
#pragma unroll
                for (int r = 3; r >= 0; --r) { w[kt][r] = (kb + r < qpos) ? __expf(st[r] - sp[r] - rs) : 0.f; rs += sp[r]; }
                carry[qt] += hs + x2;
            }
            pf[qt] = pack8(w[0], w[1]);
        }
        bf16x8 vf[4]; vt_frags(vaddr, lane, vf);
#pragma unroll
        for (int qt = 0; qt < 4; ++qt)
#pragma unroll
            for (int dt = 0; dt < 4; ++dt) acc[qt][dt] = __builtin_amdgcn_mfma_f32_16x16x32_bf16(vf[dt], pf[qt], acc[qt][dt], 0, 0, 0);
        if (k0 + 32 <= q0 && __all(fminf(fminf(carry[0], carry[1]), fminf(carry[2], carry[3])) > 104.f)) break;
    }
    float ss[4];
#pragma unroll
    for (int qt = 0; qt < 4; ++qt) { float s = 0.f;
#pragma unroll
        for (int dt = 0; dt < 4; ++dt) s += (acc[qt][dt][0] * acc[qt][dt][0] + acc[qt][dt][1] * acc[qt][dt][1]) + (acc[qt][dt][2] * acc[qt][dt][2] + acc[qt][dt][3] * acc[qt][dt][3]);
        s += bperm(lane ^ 16, s); s += bperm(lane ^ 32, s); ss[qt] = s;
        if (g == 0) red[h * 64 + qt * 16 + li] = s; }
    __syncthreads();
#pragma unroll
    for (int qt = 0; qt < 4; ++qt) { float tot = 0.f;
#pragma unroll
        for (int hh = 0; hh < 8; ++hh) tot += red[hh * 64 + qt * 16 + li];
        const float sc = rsqrtf(tot / 512.f + EPS);
        store_out_tile(acc[qt], sc, gout + h * 64, MIXED + (tb + q0 + qt * 16 + li) * D + 512 + h * 64, g); }
}

__device__ __forceinline__ void dil_unit(const u16* __restrict__ PROJ, int b, int w, int r, int h, int lane, LAS char* vl, LAS float* red,
                                         const float* __restrict__ gout, u16* __restrict__ MIXED) {
    const int li = lane & 15, g = lane >> 4; const size_t tb = (size_t)b * SEQ; const int qpos = w * 256 + r + 16 * li;
    const u16* Qp = PROJ + C_DIL + h * 64; const u16* Kp = Qp + 512; const u16* Vp = Qp + 1024;
    const unsigned vaddr = (unsigned)(size_t)vl;
    bf16x8 qf[2];
#pragma unroll
    for (int s = 0; s < 2; ++s) qf[s] = *(const bf16x8*)(Qp + (tb + qpos) * DP + 32 * s + 8 * g);
    f32x4 acc[4];
#pragma unroll
    for (int dt = 0; dt < 4; ++dt) acc[dt] = (f32x4){0.f, 0.f, 0.f, 0.f};
    float mrun = -1e30f, lrun = 0.f;
#pragma unroll 1
    for (int br = 0; br < 3; ++br) {
        const int dsh = br == 0 ? 4 : br == 1 ? 2 : 0;
        const int nstep = br == 0 ? 5 : br == 1 ? 6 : 12;
        const int base = w * 256 + r - (128 << dsh);
        const int rat = li << (4 - dsh);
#pragma unroll 1
        for (int st_ = 0; st_ < nstep; ++st_) {
            const int m0 = st_ * 32;
            if (base + ((m0 + 31) << dsh) < 0) continue;
            bf16x8 kf[2][2];
#pragma unroll
            for (int kt = 0; kt < 2; ++kt) { int pos = base + ((m0 + kt * 16 + li) << dsh); pos = min(max(pos, 0), SEQ - 1);
#pragma unroll
                for (int s = 0; s < 2; ++s) kf[kt][s] = *(const bf16x8*)(Kp + (tb + pos) * DP + 32 * s + 8 * g); }
#pragma unroll
            for (int u = 0; u < 4; ++u) { const int c = lane + 64 * u, row = c >> 3, cc = c & 7; int pos = base + ((m0 + row) << dsh); pos = min(max(pos, 0), SEQ - 1);
                *(LAS u32x4v*)(vl + row * ATT_RS + cc * 16) = *(const u32x4v*)(Vp + (tb + pos) * DP + cc * 8); }
            float z[2][4]; bool ok[2][4]; float zmax = -1e30f;
#pragma unroll
            for (int kt = 0; kt < 2; ++kt) {
                f32x4 st = __builtin_amdgcn_mfma_f32_16x16x32_bf16(kf[kt][0], qf[0], (f32x4){0.f, 0.f, 0.f, 0.f}, 0, 0, 0);
                st = __builtin_amdgcn_mfma_f32_16x16x32_bf16(kf[kt][1], qf[1], st, 0, 0, 0);
#pragma unroll
                for (int rr = 0; rr < 4; ++rr) { const int m = m0 + kt * 16 + 4 * g + rr; const int dm = m - rat;
                    ok[kt][rr] = (dm >= 0) && (dm <= 128) && (base + (m << dsh) >= 0);
                    z[kt][rr] = st[rr]; if (ok[kt][rr]) zmax = fmaxf(zmax, st[rr]); }
            }
            zmax = fmaxf(zmax, bperm(lane ^ 16, zmax)); zmax = fmaxf(zmax, bperm(lane ^ 32, zmax));
            const float mn = fmaxf(mrun, zmax); const float al = __expf(mrun - mn); mrun = mn;
            float pw[2][4]; float ps = 0.f;
#pragma unroll
            for (int kt = 0; kt < 2; ++kt)
#pragma unroll
                for (int rr = 0; rr < 4; ++rr) { pw[kt][rr] = ok[kt][rr] ? __expf(z[kt][rr] - mn) : 0.f; ps += pw[kt][rr]; }
            lrun = lrun * al + ps;
#pragma unroll
            for (int dt = 0; dt < 4; ++dt) acc[dt] = acc[dt] * al;
            const bf16x8 pf = pack8(pw[0], pw[1]);
            bf16x8 vf[4]; vt_frags(vaddr, lane, vf);
#pragma unroll
            for (int dt = 0; dt < 4; ++dt) acc[dt] = __builtin_amdgcn_mfma_f32_16x16x32_bf16(vf[dt], pf, acc[dt], 0, 0, 0);
        }
    }
    lrun += bperm(lane ^ 16, lrun); lrun += bperm(lane ^ 32, lrun);
    const float inv = 1.f / lrun;
    float s = 0.f;
#pragma unroll
    for (int dt = 0; dt < 4; ++dt) { acc[dt] = acc[dt] * inv; s += (acc[dt][0] * acc[dt][0] + acc[dt][1] * acc[dt][1]) + (acc[dt][2] * acc[dt][2] + acc[dt][3] * acc[dt][3]); }
    s += bperm(lane ^ 16, s); s += bperm(lane ^ 32, s);
    if (g == 0) red[h * 64 + li] = s;
    __syncthreads();
    float tot = 0.f;
#pragma unroll
    for (int hh = 0; hh < 8; ++hh) tot += red[hh * 64 + li];
    const float sc = rsqrtf(tot / 512.f + EPS);
    store_out_tile(acc, sc, gout + h * 64, MIXED + (tb + qpos) * D + 1024 + h * 64, g);
}


template <int RS> __device__ __forceinline__ void tr_frags4(unsigned addr, int lane, bf16x8 (&f)[4]) {
    const unsigned a = addr + (unsigned)((4 * (lane >> 4) + ((lane & 15) >> 2)) * RS + (lane & 3) * 8);
    i64 r0, r1, r2, r3, r4, r5, r6, r7;
    asm volatile("s_waitcnt lgkmcnt(0)\n\t"
                 "ds_read_b64_tr_b16 %0, %8\n\tds_read_b64_tr_b16 %1, %8 offset:%9\n\t"
                 "ds_read_b64_tr_b16 %2, %8 offset:32\n\tds_read_b64_tr_b16 %3, %8 offset:%10\n\t"
                 "ds_read_b64_tr_b16 %4, %8 offset:64\n\tds_read_b64_tr_b16 %5, %8 offset:%11\n\t"
                 "ds_read_b64_tr_b16 %6, %8 offset:96\n\tds_read_b64_tr_b16 %7, %8 offset:%12\n\t"
                 "s_waitcnt lgkmcnt(0)"
                 : "=&v"(r0), "=&v"(r1), "=&v"(r2), "=&v"(r3), "=&v"(r4), "=&v"(r5), "=&v"(r6), "=&v"(r7)
                 : "v"(a), "i"(16 * RS), "i"(16 * RS + 32), "i"(16 * RS + 64), "i"(16 * RS + 96) : "memory");
    typedef i64 i64x2 __attribute__((ext_vector_type(2)));
    i64x2 t; t.x = r0; t.y = r1; f[0] = __builtin_bit_cast(bf16x8, t); t.x = r2; t.y = r3; f[1] = __builtin_bit_cast(bf16x8, t);
    t.x = r4; t.y = r5; f[2] = __builtin_bit_cast(bf16x8, t); t.x = r6; t.y = r7; f[3] = __builtin_bit_cast(bf16x8, t);
}
template <int RS> __device__ __forceinline__ bf16x8 tr_frag1(unsigned addr, int lane) {
    const unsigned a = addr + (unsigned)((4 * (lane >> 4) + ((lane & 15) >> 2)) * RS + (lane & 3) * 8);
    i64 r0, r1;
    asm volatile("s_waitcnt lgkmcnt(0)\n\tds_read_b64_tr_b16 %0, %2\n\tds_read_b64_tr_b16 %1, %2 offset:%3\n\ts_waitcnt lgkmcnt(0)"
                 : "=&v"(r0), "=&v"(r1) : "v"(a), "i"(16 * RS) : "memory");
    typedef i64 i64x2 __attribute__((ext_vector_type(2)));
    i64x2 t; t.x = r0; t.y = r1; return __builtin_bit_cast(bf16x8, t);
}
constexpr int SSD_RB = 272, SSD_RX = 144;
constexpr int SSD_OFF_B = 0, SSD_OFF_C = 128 * SSD_RB, SSD_OFF_X = 2 * 128 * SSD_RB, SSD_OFF_XW = SSD_OFF_X + 128 * SSD_RX, SSD_OFF_F = SSD_OFF_XW + 128 * SSD_RX;
__device__ __forceinline__ void ssd_chunk_unit(const u16* __restrict__ PROJ, const float* __restrict__ DTR, const float* __restrict__ cw, const float* __restrict__ cb,
                                               float dtbias, float aneg, float dskip, int b, int c, int h, int tid, LAS char* L,
                                               float* __restrict__ YD, float* __restrict__ SS, float* __restrict__ ATOT, float* __restrict__ ACS, u16* __restrict__ CG) {
    const int wave = tid >> 6, lane = tid & 63, li = lane & 15, g = lane >> 4, grp = h >> 2;
    const size_t t0 = (size_t)b * SEQ + (size_t)c * 128;
    LAS float* acs = (LAS float*)(L + SSD_OFF_F); LAS float* dts = acs + 128; LAS float* wls = acs + 256;
    __syncthreads();
    if (wave == 0) {
        const float d0 = softplusf(DTR[(t0 + 2 * lane) * 8 + h] + dtbias), d1 = softplusf(DTR[(t0 + 2 * lane + 1) * 8 + h] + dtbias);
        const float a0 = d0 * aneg, a1 = d1 * aneg;
        float v = a0 + a1;
#pragma unroll
        for (int o = 1; o < 64; o <<= 1) { const float t = bperm(lane - o, v); if (lane >= o) v += t; }
        acs[2 * lane] = v - a1; acs[2 * lane + 1] = v; dts[2 * lane] = d0; dts[2 * lane + 1] = d1;
    }
    __syncthreads();
    if (tid < 128) { const float a = acs[tid]; wls[tid] = dts[tid] * __expf(acs[127] - a); ACS[(t0 + tid) * 8 + h] = a; if (tid == 0) ATOT[((size_t)b * 32 + c) * 8 + h] = acs[127]; }
    __syncthreads();
    for (int it = tid; it < 128 * 40; it += NTHR) {
        const int tl = it / 40, cg = it % 40;
        const int ch = cg < 8 ? h * 64 + cg * 8 : cg < 24 ? 512 + grp * 128 + (cg - 8) * 8 : 768 + grp * 128 + (cg - 24) * 8;
        const int sl = c * 128 + tl;
        float a[8];
        { const float4 b0 = *(const float4*)(cb + ch), b1 = *(const float4*)(cb + ch + 4); a[0] = b0.x; a[1] = b0.y; a[2] = b0.z; a[3] = b0.w; a[4] = b1.x; a[5] = b1.y; a[6] = b1.z; a[7] = b1.w; }
#pragma unroll
        for (int k = 0; k < 4; ++k) if (sl - 3 + k >= 0) {
            const bf16x8 u = *(const bf16x8*)(PROJ + (t0 + tl - 3 + k) * DP + C_XBC + ch);
            const float4 w0 = *(const float4*)(cw + k * 1024 + ch), w1 = *(const float4*)(cw + k * 1024 + ch + 4);
            a[0] += w0.x * bf2f((u16)u[0]); a[1] += w0.y * bf2f((u16)u[1]); a[2] += w0.z * bf2f((u16)u[2]); a[3] += w0.w * bf2f((u16)u[3]);
            a[4] += w1.x * bf2f((u16)u[4]); a[5] += w1.y * bf2f((u16)u[5]); a[6] += w1.z * bf2f((u16)u[6]); a[7] += w1.w * bf2f((u16)u[7]);
        }
#pragma unroll
        for (int j = 0; j < 8; ++j) a[j] = siluf(a[j]);
        u32x4v o; o.x = pk2(a[0], a[1]); o.y = pk2(a[2], a[3]); o.z = pk2(a[4], a[5]); o.w = pk2(a[6], a[7]);
        if (cg < 8) {
            *(LAS u32x4v*)(L + SSD_OFF_X + tl * SSD_RX + cg * 16) = o;
            const float wl = wls[tl]; u32x4v ow; ow.x = pk2(a[0] * wl, a[1] * wl); ow.y = pk2(a[2] * wl, a[3] * wl); ow.z = pk2(a[4] * wl, a[5] * wl); ow.w = pk2(a[6] * wl, a[7] * wl);
            *(LAS u32x4v*)(L + SSD_OFF_XW + tl * SSD_RX + cg * 16) = ow;
        } else if (cg < 24) *(LAS u32x4v*)(L + SSD_OFF_B + tl * SSD_RB + (cg - 8) * 16) = o;
        else { *(LAS u32x4v*)(L + SSD_OFF_C + tl * SSD_RB + (cg - 24) * 16) = o;
               if ((h & 3) == 0) *(u32x4v*)(CG + (t0 + tl) * 256 + grp * 128 + (cg - 24) * 8) = o; }
    }
    __syncthreads();
    const unsigned Lb = (unsigned)(size_t)L;
    {
        const int lt = wave, lrow = lt * 16 + li; const float acl = acs[lrow];
        bf16x8 cf[4];
#pragma unroll
        for (int ks = 0; ks < 4; ++ks) cf[ks] = *(const LAS bf16x8*)(L + SSD_OFF_C + lrow * SSD_RB + ks * 64 + g * 16);
        f32x4 acc[4];
#pragma unroll
        for (int pt = 0; pt < 4; ++pt) acc[pt] = (f32x4){0.f, 0.f, 0.f, 0.f};
        for (int s0 = 0; s0 <= lt * 16; s0 += 32) {
            float w[2][4];
#pragma unroll
            for (int kt = 0; kt < 2; ++kt) {
                f32x4 st = (f32x4){0.f, 0.f, 0.f, 0.f};
#pragma unroll
                for (int ks = 0; ks < 4; ++ks) { const bf16x8 bfr = *(const LAS bf16x8*)(L + SSD_OFF_B + (s0 + kt * 16 + li) * SSD_RB + ks * 64 + g * 16);
                    st = __builtin_amdgcn_mfma_f32_16x16x32_bf16(bfr, cf[ks], st, 0, 0, 0); }
                const int sb = s0 + kt * 16 + 4 * g;
                const f32x4 as4 = *(const LAS f32x4*)(acs + sb), dt4 = *(const LAS f32x4*)(dts + sb);
#pragma unroll
                for (int r = 0; r < 4; ++r) w[kt][r] = (sb + r <= lrow) ? st[r] * __expf(acl - as4[r]) * dt4[r] : 0.f;
            }
            const bf16x8 pf = pack8(w[0], w[1]);
            bf16x8 xf[4]; tr_frags4<SSD_RX>(Lb + SSD_OFF_X + s0 * SSD_RX, lane, xf);
#pragma unroll
            for (int pt = 0; pt < 4; ++pt) acc[pt] = __builtin_amdgcn_mfma_f32_16x16x32_bf16(xf[pt], pf, acc[pt], 0, 0, 0);
        }
#pragma unroll
        for (int pt = 0; pt < 4; ++pt) {
            const u32x2v xr = *(const LAS u32x2v*)(L + SSD_OFF_X + lrow * SSD_RX + (pt * 16 + 4 * g) * 2);
            float4 o; o.x = acc[pt][0] + dskip * __uint_as_float(xr.x << 16); o.y = acc[pt][1] + dskip * __uint_as_float(xr.x & 0xffff0000u);
            o.z = acc[pt][2] + dskip * __uint_as_float(xr.y << 16); o.w = acc[pt][3] + dskip * __uint_as_float(xr.y & 0xffff0000u);
            *(float4*)(YD + (t0 + lrow) * 512 + h * 64 + pt * 16 + 4 * g) = o;
        }
    }
    {
        f32x4 acc[4];
#pragma unroll
        for (int pt = 0; pt < 4; ++pt) acc[pt] = (f32x4){0.f, 0.f, 0.f, 0.f};
#pragma unroll
        for (int ks = 0; ks < 4; ++ks) {
            const bf16x8 bt = tr_frag1<SSD_RB>(Lb + SSD_OFF_B + ks * 32 * SSD_RB + wave * 32, lane);
            bf16x8 xf[4]; tr_frags4<SSD_RX>(Lb + SSD_OFF_XW + ks * 32 * SSD_RX, lane, xf);
#pragma unroll
            for (int pt = 0; pt < 4; ++pt) acc[pt] = __builtin_amdgcn_mfma_f32_16x16x32_bf16(bt, xf[pt], acc[pt], 0, 0, 0);
        }
        float* so = SS + ((((size_t)b * 32 + c) * 8 + h) << 13);
#pragma unroll
        for (int pt = 0; pt < 4; ++pt) *(float4*)(so + (pt * 16 + li) * 128 + wave * 16 + 4 * g) = make_float4(acc[pt][0], acc[pt][1], acc[pt][2], acc[pt][3]);
    }
}
__device__ __forceinline__ void ssd_out_unit(const u16* __restrict__ PROJ, const u16* __restrict__ PREV, const u16* __restrict__ CG, const float* __restrict__ YD,
                                             const float* __restrict__ ACS, const float* __restrict__ ng, int b, int j, int h, int lane, LAS float* red, u16* __restrict__ MIXED) {
    const int li = lane & 15, g = lane >> 4, grp = h >> 2, c = j >> 2; const size_t t0 = (size_t)b * SEQ + (size_t)j * 32;
    const u16* pv = PREV + ((((size_t)b * 32 + c) * 8 + h) << 13);
    f32x4 acc[4][2];
#pragma unroll
    for (int pt = 0; pt < 4; ++pt) { acc[pt][0] = (f32x4){0.f, 0.f, 0.f, 0.f}; acc[pt][1] = (f32x4){0.f, 0.f, 0.f, 0.f}; }
#pragma unroll
    for (int ks = 0; ks < 4; ++ks) {
        bf16x8 cf[2];
#pragma unroll
        for (int lt = 0; lt < 2; ++lt) cf[lt] = *(const bf16x8*)(CG + (t0 + lt * 16 + li) * 256 + grp * 128 + ks * 32 + g * 8);
#pragma unroll
        for (int pt = 0; pt < 4; ++pt) { const bf16x8 pf = *(const bf16x8*)(pv + (pt * 16 + li) * 128 + ks * 32 + g * 8);
            acc[pt][0] = __builtin_amdgcn_mfma_f32_16x16x32_bf16(pf, cf[0], acc[pt][0], 0, 0, 0);
            acc[pt][1] = __builtin_amdgcn_mfma_f32_16x16x32_bf16(pf, cf[1], acc[pt][1], 0, 0, 0); }
    }
    float ssq[2];
#pragma unroll
    for (int lt = 0; lt < 2; ++lt) {
        const size_t t = t0 + lt * 16 + li; const float ea = __expf(ACS[t * 8 + h]); float s = 0.f;
#pragma unroll
        for (int pt = 0; pt < 4; ++pt) {
            const int col = h * 64 + pt * 16 + 4 * g;
            const float4 yd = *(const float4*)(YD + t * 512 + col); const uint2 zr = *(const uint2*)(PROJ + t * DP + C_Z + col);
            f32x4 y; y[0] = (yd.x + ea * acc[pt][lt][0]) * siluf(__uint_as_float(zr.x << 16)); y[1] = (yd.y + ea * acc[pt][lt][1]) * siluf(__uint_as_float(zr.x & 0xffff0000u));
            y[2] = (yd.z + ea * acc[pt][lt][2]) * siluf(__uint_as_float(zr.y << 16)); y[3] = (yd.w + ea * acc[pt][lt][3]) * siluf(__uint_as_float(zr.y & 0xffff0000u));
            acc[pt][lt] = y; s += (y[0] * y[0] + y[1] * y[1]) + (y[2] * y[2] + y[3] * y[3]);
        }
        s += bperm(lane ^ 16, s); s += bperm(lane ^ 32, s); ssq[lt] = s;
        if (g == 0) red[h * 64 + lt * 16 + li] = s;
    }
    __syncthreads();
#pragma unroll
    for (int lt = 0; lt < 2; ++lt) {
        float tot = 0.f;
#pragma unroll
        for (int hh = 0; hh < 8; ++hh) tot += red[hh * 64 + lt * 16 + li];
        const float sc = rsqrtf(tot / 512.f + EPS);
        f32x4 o[4];
#pragma unroll
        for (int pt = 0; pt < 4; ++pt) o[pt] = acc[pt][lt];
        store_out_tile(o, sc, ng + h * 64, MIXED + (t0 + lt * 16 + li) * D + h * 64, g);
    }
}

typedef const Params __attribute__((address_space(4)))* KP;
#define PARAMS KP kp_ = (KP)__builtin_amdgcn_kernarg_segment_ptr(); asm volatile("" : "+s"(kp_)); const __attribute__((address_space(4))) Params& p = *kp_;
__global__ void __launch_bounds__(NTHR, 2) mega(Params pk_unused) {
    extern __shared__ __attribute__((aligned(16))) char smem[];
    if (threadIdx.x == 0) *(uint4*)smem = make_uint4(0u, 0u, 0u, 0u);
    __syncthreads();
    XcdBarrier bar; { PARAMS bar = xcd_barrier_post(p.bar, (volatile LAS unsigned*)smem); }
    char* lds = smem + 16;
    LAS unsigned char* glds = (LAS unsigned char*)(smem + 16);
    const int G = gridDim.x, NGW = G * NWAVE;
    const long gsize = (long)G * NTHR;
#define IDS PARAMS int tid = threadIdx.x; asm volatile("" : "+v"(tid)); const int wave = tid >> 6, lane = tid & 63; const int gw = blockIdx.x * NWAVE + wave; const long gtid = (long)blockIdx.x * NTHR + tid; (void)wave; (void)lane; (void)gw; (void)gtid;

    { IDS
        const float4* s = (const float4*)p.x_in; float4* d = (float4*)p.X;
        for (long i = gtid; i < (long)T * D / 4; i += gsize) d[i] = s[i];
        float* scr = (float*)lds + wave * (64 * 33);
        constexpr int I_A = 32 * 48, I_B = 32 * 112, I_O = 32 * 64, I_L = I_A + I_B + I_O;
        for (int it = gw; it < 2 * I_L; it += NGW) {
            const int l = it / I_L; int r = it % I_L;
            const float* Wl = p.w_in + (size_t)l * D * DIN; u16* WTl = p.WinT + (size_t)l * DP * D;
            if (r < I_A) { transpose_item(Wl, DIN, 0, D, WTl, 0, 48, r, scr, lane); continue; } r -= I_A;
            if (r < I_B) { transpose_item(Wl, DIN, 1544, D, WTl, 1536, 112, r, scr, lane); continue; } r -= I_B;
            transpose_item(p.w_out + (size_t)l * D * D, D, 0, D, p.WoutT + (size_t)l * D * D, 0, 64, r, scr, lane);
        }
        convert_moe_weights(p.wg, p.wu, p.wd, p.WguT, p.WdT, 0, scr, gw, NGW, lane);
        for (long i = gtid; i < 2L * 80 * D; i += gsize) { const int l = (int)(i / (80 * D)), r = (int)(i % (80 * D)), c = r / D, k = r % D;
            const float w = (c < 8) ? p.rg_w[(size_t)l * D * 8 + k * 8 + c] : (c < 72) ? p.re_w[(size_t)l * D * 64 + k * 64 + (c - 8)] : 0.f;
            p.RT[i] = w * p.norm2_g[l * D + k]; }
        for (long i = gtid; i < 2L * 4 * 128 * 128; i += gsize) { const int e = (int)(i & 127), c = (int)((i >> 7) & 127); const long lg = i >> 14;
            p.WpT[(lg << 14) + e * 128 + c] = f2bf(p.pool_w[i]); }
        for (long i = gtid; i < 2L * 8 * D; i += gsize) { const int l = (int)(i / (8 * D)), r = (int)(i % (8 * D)), j = r / D, k = r % D;
            p.WDT[i] = p.w_in[(size_t)l * D * DIN + (size_t)k * DIN + 1536 + j]; }
    }
    xcd_barrier(bar);

#pragma unroll 1
    for (int l = 0; l < 2; ++l) {
        { IDS
            const float* g1 = p.norm1_g + l * D; const float* wdt = p.WDT + (size_t)l * 8 * D;
            for (int t = gw; t < T; t += NGW) {
                float4* xr = (float4*)(p.X + (size_t)t * D) + lane;
                float4 v[8]; float ss = 0.f;
#pragma unroll
                for (int j = 0; j < 8; ++j) v[j] = xr[64 * j];
                if (l > 0) {
                    const int r0 = p.tok_row[2 * t], r1 = p.tok_row[2 * t + 1]; const float g0 = p.tok_g[2 * t], gg1 = p.tok_g[2 * t + 1];
                    const float4* y0 = (const float4*)(p.Yb + (size_t)r0 * D) + lane; const float4* y1 = (const float4*)(p.Yb + (size_t)r1 * D) + lane;
#pragma unroll
                    for (int j = 0; j < 8; ++j) { const float4 a = y0[64 * j], b = y1[64 * j];
                        v[j].x += g0 * a.x + gg1 * b.x; v[j].y += g0 * a.y + gg1 * b.y; v[j].z += g0 * a.z + gg1 * b.z; v[j].w += g0 * a.w + gg1 * b.w; xr[64 * j] = v[j]; }
                }
#pragma unroll
                for (int j = 0; j < 8; ++j) ss += v[j].x * v[j].x + v[j].y * v[j].y + v[j].z * v[j].z + v[j].w * v[j].w;
                const float r = rsqrtf(wave_sum(ss) / D + EPS);
                uint2* hb = (uint2*)(p.HB + (size_t)t * D) + lane;
#pragma unroll
                for (int j = 0; j < 8; ++j) {
                    const float4 gg = ((const float4*)g1)[lane + 64 * j];
                    v[j].x *= r * gg.x; v[j].y *= r * gg.y; v[j].z *= r * gg.z; v[j].w *= r * gg.w;
                    hb[64 * j] = make_uint2(pk2(v[j].x, v[j].y), pk2(v[j].z, v[j].w));
                }
#pragma unroll 1
                for (int q = 0; q < 8; ++q) {
                    const float4* w = (const float4*)(wdt + q * D) + lane; float s = 0.f;
#pragma unroll
                    for (int j = 0; j < 8; ++j) { const float4 ww = w[64 * j]; s += v[j].x * ww.x + v[j].y * ww.y + v[j].z * ww.z + v[j].w * ww.w; }
                    s = wave_sum(s); if (lane == 0) p.DTR[t * 8 + q] = s;
                }
            }
            if (l == 1) { float* scr = (float*)lds + wave * (64 * 33); convert_moe_weights(p.wg, p.wu, p.wd, p.WguT, p.WdT, 1, scr, gw, NGW, lane); }
        }
        xcd_barrier(bar);
        {
            PARAMS
            pg8::Gemm g{p.HB, p.WinT + (size_t)l * DP * D, T, DP, D};
            pg8::StaticOrder so; so.init(T, DP, G, blockIdx.x);
            pg8::EpiStoreBf16 ep{p.PROJ, DP};
            pg8::gemm_phase(glds, g, so, ep, nullptr);
        }
        xcd_barrier(bar);
        { IDS
            for (int it = gw; it < T * 32; it += NGW) {
                const int t = it >> 5, r = it & 31, which = r >> 3, h = r & 7;
                const int col = (which == 0 ? C_SB : which == 1 ? C_SB + 512 : which == 2 ? C_DIL : C_DIL + 512) + h * 64 + lane;
                const float* g = (which == 0 ? p.sbq_g : which == 1 ? p.sbk_g : which == 2 ? p.dq_g : p.dk_g) + l * 64;
                u16* q = p.PROJ + (size_t)t * DP + col; const float v = bf2f(*q);
                const float ss = wave_sum(v * v);
                *q = f2bf(v * rsqrtf(ss / 64.f + EPS) * g[lane] * ((which & 1) ? 1.f : 0.125f));
            }
            for (int u = blockIdx.x; u < NB * 32 * 8; u += G) {
                const int b = u >> 8, c = (u >> 3) & 31, h = u & 7;
                ssd_chunk_unit(p.PROJ, p.DTR, p.conv_w + l * 4 * 1024, p.conv_b + l * 1024, p.dt_bias[l * 8 + h], -__expf(p.a_log[l * 8 + h]), p.ssd_d[l * 8 + h],
                               b, c, h, tid, (LAS char*)(smem + 16), p.YD, p.SS, p.ATOT, p.ACS, p.CG);
            }
            __syncthreads();
            {
                constexpr int PRS = 1040;
                LAS char* PL = (LAS char*)(smem + 16);
                const float* psc = p.pool_sc + l * 512; const u16* wpt = p.WpT + (size_t)l * 4 * 16384;
                for (int u = blockIdx.x; u < T / 32; u += G) {
                    const int tb0 = u * 32; __syncthreads();
                    { const int c = tid, gq = c >> 7, w = 2 << gq;
                      for (int tt = 0; tt < 32; ++tt) { const int t = tb0 + tt, s = t % SEQ; const int cn = min(w, s + 1);
                          float sum = 0.f; for (int i = 0; i < cn; ++i) sum += bf2f(p.PROJ[(size_t)(t - i) * DP + C_POOL + c]);
                          *(LAS u16*)(PL + tt * PRS + c * 2) = f2bf(sum / (float)cn - bf2f(p.PROJ[(size_t)t * DP + C_POOL + c])); } }
                    __syncthreads();
                    const int li = lane & 15, g4 = lane >> 4, gq = wave >> 1, eh = wave & 1;
                    f32x4 acc[4][2];
#pragma unroll
                    for (int et = 0; et < 4; ++et) { acc[et][0] = (f32x4){0.f, 0.f, 0.f, 0.f}; acc[et][1] = (f32x4){0.f, 0.f, 0.f, 0.f}; }
#pragma unroll
                    for (int ks = 0; ks < 4; ++ks) {
                        bf16x8 pf[2];
#pragma unroll
                        for (int tt = 0; tt < 2; ++tt) pf[tt] = *(const LAS bf16x8*)(PL + (tt * 16 + li) * PRS + (gq * 128 + ks * 32 + g4 * 8) * 2);
#pragma unroll
                        for (int et = 0; et < 4; ++et) { const bf16x8 wf = *(const bf16x8*)(wpt + gq * 16384 + (eh * 64 + et * 16 + li) * 128 + ks * 32 + g4 * 8);
                            acc[et][0] = __builtin_amdgcn_mfma_f32_16x16x32_bf16(wf, pf[0], acc[et][0], 0, 0, 0);
                            acc[et][1] = __builtin_amdgcn_mfma_f32_16x16x32_bf16(wf, pf[1], acc[et][1], 0, 0, 0); }
                    }
#pragma unroll
                    for (int tt = 0; tt < 2; ++tt)
#pragma unroll
                        for (int et = 0; et < 4; ++et) { const int col = gq * 128 + eh * 64 + et * 16 + 4 * g4; const float4 sc = *(const float4*)(psc + col);
                            *(uint2*)(p.MIXED + (size_t)(tb0 + tt * 16 + li) * D + 1536 + col) =
                                make_uint2(pk2(acc[et][tt][0] * sc.x, acc[et][tt][1] * sc.y), pk2(acc[et][tt][2] * sc.z, acc[et][tt][3] * sc.w)); }
                }
            }
        }
        xcd_barrier(bar);
        { IDS
        {
            for (int e = (int)gtid; e < NB * 8 * 8192; e += (int)gsize) {
                const int b = e >> 16, h = (e >> 13) & 7, pn = e & 8191; float st = 0.f;
#pragma unroll 8
                for (int c = 0; c < 32; ++c) { const size_t cu = ((size_t)b * 32 + c) * 8 + h; const size_t idx = (cu << 13) + pn;
                    p.PREV[idx] = f2bf(st); st = st * __expf(p.ATOT[cu]) + p.SS[idx]; }
            }
            LAS char* vl = (LAS char*)(smem + 16) + wave * ATT_VBYTES;
            LAS float* red = (LAS float*)((LAS char*)(smem + 16) + NWAVE * ATT_VBYTES);
            int par = 0;
            for (int u = blockIdx.x; u < 128 + 512; u += G, par ^= 1) {
                if (u < 128) sb_unit(p.PROJ, u >> 6, u & 63, wave, lane, vl, red + par * 512, p.sbo_g + l * 512, p.MIXED);
                else { const int v = u - 128; dil_unit(p.PROJ, v >> 8, (v >> 4) & 15, v & 15, wave, lane, vl, red + par * 512, p.do_g + l * 512, p.MIXED); }
            }
        }
        }
        xcd_barrier(bar);
        { IDS
            LAS float* red = (LAS float*)(smem + 16);
            int par = 0;
            for (int u = blockIdx.x; u < NB * 128; u += G, par ^= 1)
                ssd_out_unit(p.PROJ, p.PREV, p.CG, p.YD, p.ACS, p.ssd_ng + l * 512, u >> 7, u & 127, wave, lane, red + par * 512, p.MIXED);
        }
        xcd_barrier(bar);
        {
            PARAMS
            pg8::Gemm g{p.MIXED, p.WoutT + (size_t)l * D * D, T, D, D};
            pg8::StaticOrder so; so.init(T, D, G, blockIdx.x);
            pg8::EpiAddF32 ep{p.X, D};
            pg8::gemm_phase(glds, g, so, ep, nullptr);
        }
        xcd_barrier(bar);
        { IDS
            const float* g2 = p.norm2_g + l * D; const float* RTl = p.RT + (size_t)l * 80 * D; int* cnt = p.ctrl + l * 64;
            LAS float* part = (LAS float*)(smem + 16);
            LAS float* lg = part + 8 * 16 * 80;
            LAS float* rs = lg + 16 * 80;
            const int li = lane & 15, g4 = lane >> 4;
            for (int u = blockIdx.x; u < T / 16; u += G) {
                const int t0 = u * 16;
                __syncthreads();
#pragma unroll 1
                for (int tt = 0; tt < 2; ++tt) {
                    const int t = t0 + 2 * wave + tt;
                    const float4* xr = (const float4*)(p.X + (size_t)t * D) + lane;
                    float4 v[8]; float ss = 0.f;
#pragma unroll
                    for (int j = 0; j < 8; ++j) { v[j] = xr[64 * j]; ss += v[j].x * v[j].x + v[j].y * v[j].y + v[j].z * v[j].z + v[j].w * v[j].w; }
                    const float r = rsqrtf(wave_sum(ss) / D + EPS);
                    uint2* hb = (uint2*)(p.HB + (size_t)t * D) + lane;
#pragma unroll
                    for (int j = 0; j < 8; ++j) { const float4 gg = ((const float4*)g2)[lane + 64 * j];
                        hb[64 * j] = make_uint2(pk2(v[j].x * r * gg.x, v[j].y * r * gg.y), pk2(v[j].z * r * gg.z, v[j].w * r * gg.w)); }
                    if (lane == 0) rs[2 * wave + tt] = r;
                }
                f32x4 acc[5];
#pragma unroll
                for (int nt = 0; nt < 5; ++nt) acc[nt] = (f32x4){0.f, 0.f, 0.f, 0.f};
                const float* xa = p.X + (size_t)(t0 + li) * D + 256 * wave + 4 * g4; const float* rb = RTl + (size_t)li * D + 256 * wave + 4 * g4;
#pragma unroll 4
                for (int j = 0; j < 16; ++j) {
                    const float4 xv = *(const float4*)(xa + 16 * j);
#pragma unroll
                    for (int nt = 0; nt < 5; ++nt) { const float4 rv = *(const float4*)(rb + (size_t)nt * 16 * D + 16 * j);
                        acc[nt] = __builtin_amdgcn_mfma_f32_16x16x4f32(xv.x, rv.x, acc[nt], 0, 0, 0); acc[nt] = __builtin_amdgcn_mfma_f32_16x16x4f32(xv.y, rv.y, acc[nt], 0, 0, 0);
                        acc[nt] = __builtin_amdgcn_mfma_f32_16x16x4f32(xv.z, rv.z, acc[nt], 0, 0, 0); acc[nt] = __builtin_amdgcn_mfma_f32_16x16x4f32(xv.w, rv.w, acc[nt], 0, 0, 0); }
                }
#pragma unroll
                for (int nt = 0; nt < 5; ++nt)
#pragma unroll
                    for (int r = 0; r < 4; ++r) part[(wave * 16 + 4 * g4 + r) * 80 + nt * 16 + li] = acc[nt][r];
                __syncthreads();
                for (int i = tid; i < 16 * 72; i += NTHR) { const int tk = i / 72, c = i % 72; float s = 0.f;
#pragma unroll
                    for (int w = 0; w < 8; ++w) s += part[(w * 16 + tk) * 80 + c];
                    lg[tk * 80 + c] = s * rs[tk] + (c < 8 ? p.rg_b[l * 8 + c] : p.re_b[l * 64 + c - 8]); }
                __syncthreads();
                if (tid < 16) {
                    const LAS float* gl = lg + tid * 80; const int t = t0 + tid;
                    int gi = 0; float gm = gl[0];
                    for (int j = 1; j < 8; ++j) if (gl[j] > gm) { gm = gl[j]; gi = j; }
                    float gs = 0.f;
                    for (int j = 0; j < 8; ++j) gs += __expf(gl[j] - gm);
                    const float gp = 1.f / gs;
                    const LAS float* el = gl + 8 + gi * 8;
                    int i1 = 0; float m1 = el[0];
                    for (int j = 1; j < 8; ++j) if (el[j] > m1) { m1 = el[j]; i1 = j; }
                    int i2 = -1; float m2 = -1e30f;
                    for (int j = 0; j < 8; ++j) if (j != i1 && el[j] > m2) { m2 = el[j]; i2 = j; }
                    const float p2 = __expf(m2 - m1); const float ga = gp / (1.f + p2), gb = gp * p2 / (1.f + p2);
                    const int e1 = gi * 8 + i1, e2 = gi * 8 + i2;
                    p.tok_e[t * 2] = e1; p.tok_e[t * 2 + 1] = e2; p.tok_g[t * 2] = ga; p.tok_g[t * 2 + 1] = gb;
                    p.tok_pos[t * 2] = atomicAdd(&cnt[e1], 1); p.tok_pos[t * 2 + 1] = atomicAdd(&cnt[e2], 1);
                }
            }
        }
        xcd_barrier(bar);
        { IDS
            int* pstart = (int*)lds; int* cnt = p.ctrl + l * 64; int* nblk_p = p.ctrl + 128; int* blk_e = p.ctrl + 256;
            __syncthreads();
            if (tid == 0) {
                int off = 0;
                for (int e = 0; e < NE; ++e) { pstart[e] = off; const int nb = (cnt[e] + 255) >> 8;
                    if (blockIdx.x == 0) for (int i = 0; i < nb; ++i) blk_e[(off >> 8) + i] = e;
                    off += nb << 8; }
                if (blockIdx.x == 0) *nblk_p = off >> 8;
            }
            __syncthreads();
            for (int a = gw; a < 2 * T; a += NGW) {
                const int t = a >> 1; const int row = pstart[p.tok_e[a]] + p.tok_pos[a];
                if (lane == 0) p.tok_row[a] = row;
                const uint4* src = (const uint4*)(p.HB + (size_t)t * D) + lane; uint4* dst = (uint4*)(p.XG + (size_t)row * D) + lane;
#pragma unroll
                for (int j = 0; j < 4; ++j) dst[64 * j] = src[64 * j];
            }
            __syncthreads();
        }
        xcd_barrier(bar);
        {
            PARAMS
            pg8::Gemm g{p.XG, p.WguT, MAXBLK * 256, NE * 1024, D};
            pg8::MoeOrder mo{p.ctrl + 256, p.ctrl[128] * 4, G, (int)blockIdx.x, 2};
            pg8::EpiSwiglu ep{p.Hb};
            pg8::gemm_phase(glds, g, mo, ep, nullptr);
        }
        xcd_barrier(bar);
        {
            PARAMS
            pg8::Gemm g{p.Hb, p.WdT, MAXBLK * 256, NE * D, DFF};
            pg8::MoeOrder mo{p.ctrl + 256, p.ctrl[128] * 8, G, (int)blockIdx.x, 3};
            pg8::EpiDownF32 ep{p.Yb};
            pg8::gemm_phase(glds, g, mo, ep, nullptr);
        }
        xcd_barrier(bar);
    }
    { IDS
    for (int t = gw; t < T; t += NGW) {
        float4* xr = (float4*)(p.X + (size_t)t * D) + lane;
        const int r0 = p.tok_row[2 * t], r1 = p.tok_row[2 * t + 1]; const float g0 = p.tok_g[2 * t], g1 = p.tok_g[2 * t + 1];
        const float4* y0 = (const float4*)(p.Yb + (size_t)r0 * D) + lane; const float4* y1 = (const float4*)(p.Yb + (size_t)r1 * D) + lane;
#pragma unroll
        for (int j = 0; j < 8; ++j) { float4 v = xr[64 * j]; const float4 a = y0[64 * j], b = y1[64 * j];
            v.x += g0 * a.x + g1 * b.x; v.y += g0 * a.y + g1 * b.y; v.z += g0 * a.z + g1 * b.z; v.w += g0 * a.w + g1 * b.w; xr[64 * j] = v; }
    }
    }
}

extern "C" void kernel_launch(void* const* d_in, const int* in_sizes, int n_in, void* d_out, int out_size, void* d_ws, size_t ws_size, hipStream_t stream) {
    Params p{};
    const float** pin = (const float**)&p;
    for (int i = 0; i < 26; ++i) pin[i] = (const float*)d_in[i];
    p.X = (float*)d_out;
    char* ws = (char*)d_ws; size_t off = 0;
    auto alloc = [&](size_t bytes) { void* q = ws + off; off += (bytes + 255) & ~(size_t)255; return q; };
    constexpr size_t CTL_BYTES = (size_t)XCD_BAR_WORDS * 4 + CTRL_INTS * 4;
    p.bar = (unsigned*)alloc(CTL_BYTES); p.ctrl = (int*)(p.bar + XCD_BAR_WORDS);
    p.HB = (u16*)alloc((size_t)T * D * 2);
    p.MIXED = (u16*)alloc((size_t)T * D * 2);
    p.PROJ = (u16*)alloc((size_t)T * DP * 2);
    p.DTR = (float*)alloc((size_t)T * 8 * 4);
    p.YD = (float*)alloc((size_t)T * 512 * 4);
    p.SS = (float*)alloc((size_t)NB * 32 * 8 * 8192 * 4);
    p.PREV = (u16*)alloc((size_t)NB * 32 * 8 * 8192 * 2);
    p.ATOT = (float*)alloc((size_t)NB * 32 * 8 * 4);
    p.ACS = (float*)alloc((size_t)T * 8 * 4);
    p.CG = (u16*)alloc((size_t)T * 256 * 2);
    p.WinT = (u16*)alloc((size_t)2 * DP * D * 2);
    p.WoutT = (u16*)alloc((size_t)2 * D * D * 2);
    p.RT = (float*)alloc((size_t)2 * 80 * D * 4);
    p.WpT = (u16*)alloc((size_t)2 * 4 * 128 * 128 * 2);
    p.WDT = (float*)alloc((size_t)2 * 8 * D * 4);
    p.WguT = (u16*)alloc((size_t)NE * 2 * DFF * D * 2);
    p.WdT = (u16*)alloc((size_t)NE * D * DFF * 2);
    p.tok_e = (int*)alloc((size_t)T * 2 * 4); p.tok_pos = (int*)alloc((size_t)T * 2 * 4); p.tok_row = (int*)alloc((size_t)T * 2 * 4);
    p.tok_g = (float*)alloc((size_t)T * 2 * 4);
    p.XG = (u16*)alloc((size_t)MAXBLK * 256 * D * 2);
    p.Hb = (u16*)alloc((size_t)MAXBLK * 256 * DFF * 2);
    p.Yb = (float*)alloc((size_t)MAXBLK * 256 * D * 4);
    static int grid = 0;
    if (grid == 0) {
        if (off > ws_size || n_in != 26) { fprintf(stderr, "kernel_launch: workspace too small (%zu > %zu) or n_in %d\n", off, ws_size, n_in); grid = -1; return; }
        int dev = 0, cus = 0, per_cu = 0;
        if (hipGetDevice(&dev) != hipSuccess || hipDeviceGetAttribute(&cus, hipDeviceAttributeMultiprocessorCount, dev) != hipSuccess) { grid = -1; return; }
        if (hipFuncSetAttribute((const void*)mega, hipFuncAttributeMaxDynamicSharedMemorySize, LDS_BYTES) != hipSuccess) { fprintf(stderr, "hipFuncSetAttribute failed\n"); grid = -1; return; }
        if (hipOccupancyMaxActiveBlocksPerMultiprocessor(&per_cu, (const void*)mega, NTHR, LDS_BYTES) != hipSuccess || per_cu < 1)
            fprintf(stderr, "kernel_launch: occupancy query reports %d blocks per CU\n", per_cu);
        (void)hipGetLastError();
        grid = cus;
    }
    if (grid < 0) return;
    if (hipMemsetAsync(p.bar, 0, CTL_BYTES, stream) != hipSuccess) return;
    hipLaunchKernelGGL(mega, dim3(grid), dim3(NTHR), LDS_BYTES, stream, p);
}
```

```cpp
#include <hip/hip_runtime.h>
#include <hip/hip_bf16.h>
#include <stdint.h>
#include <stdio.h>

typedef unsigned short u16;
using bf16x8 = __attribute__((ext_vector_type(8))) short;
using f32x4  = __attribute__((ext_vector_type(4))) float;
#define LAS __attribute__((address_space(3)))

constexpr int NB = 2, SEQ = 4096, T = NB * SEQ, D = 2048, DIN = 5128, DP = 5120;
constexpr int NE = 64, DFF = 512;
constexpr int MAXBLK = 128;
constexpr float EPS = 1e-6f;
constexpr int C_Z = 0, C_XBC = 512, C_SB = 1536, C_DIL = 3072, C_POOL = 4608;
constexpr int NTHR = 512, NWAVE = 8;
constexpr int LDS_BYTES = 16 + 131072 + 4096;

__device__ __forceinline__ float bf2f(u16 h) { return __uint_as_float(((unsigned)h) << 16); }
__device__ __forceinline__ u16 f2bf(float f) { unsigned u = __float_as_uint(f); u += 0x7fffu + ((u >> 16) & 1u); return (u16)(u >> 16); }
__device__ __forceinline__ unsigned pk2(float lo, float hi) { return (unsigned)f2bf(lo) | ((unsigned)f2bf(hi) << 16); }
template <int O> __device__ __forceinline__ float swz_xor(float v) { return __int_as_float(__builtin_amdgcn_ds_swizzle(__float_as_int(v), (O << 10) | 0x1F)); }
__device__ __forceinline__ float rdlane(float v, int l) { return __int_as_float(__builtin_amdgcn_readlane(__float_as_int(v), l)); }
__device__ __forceinline__ float wave_sum(float v) {
    v += swz_xor<1>(v); v += swz_xor<2>(v); v += swz_xor<4>(v); v += swz_xor<8>(v); v += swz_xor<16>(v);
    return rdlane(v, 0) + rdlane(v, 32);
}
__device__ __forceinline__ float siluf(float x) { return x / (1.f + __expf(-x)); }
__device__ __forceinline__ float softplusf(float x) { return fmaxf(x, 0.f) + log1pf(__expf(-fabsf(x))); }

#define XB_TMO      128
#define XB_XCNT(j)  (256  + 64 * (j))
#define XB_XSUB(j)  (1280 + 64 * (j))
#define XB_XGEN(j)  (2304 + 64 * (j))
#define XB_TOP      3328
#define XB_TOPGEN   3392
#define XCD_BAR_WORDS 3456
#define XB_SPIN_CAP (1u << 18)
__device__ __forceinline__ unsigned xb_ld(unsigned* p)              { return __hip_atomic_load(p, __ATOMIC_RELAXED, __HIP_MEMORY_SCOPE_AGENT); }
__device__ __forceinline__ unsigned xb_add(unsigned* p, unsigned v) { return __hip_atomic_fetch_add(p, v, __ATOMIC_RELAXED, __HIP_MEMORY_SCOPE_AGENT); }
__device__ __forceinline__ unsigned xb_xcc_id() { return (unsigned)__builtin_amdgcn_s_getreg((3 << 11) | 20) & 0xFu; }
#define XB_SPIN(cond, bar) do { unsigned _sp = 0; while (cond) { __builtin_amdgcn_s_sleep(1); \
    if ((++_sp & 255u) == 0u) { if (xb_ld(&(bar)[XB_TMO])) break; if (_sp > XB_SPIN_CAP) { atomicAdd(&(bar)[XB_TMO], 1u); break; } } } } while (0)
struct XcdBarrier { unsigned* bar; unsigned x; volatile LAS unsigned* st; };
__device__ __forceinline__ XcdBarrier xcd_barrier_post(unsigned* bar, volatile LAS unsigned* st) {
    XcdBarrier b; b.bar = bar; b.x = xb_xcc_id(); b.st = st;
    if (threadIdx.x == 0) (void)xb_add(&bar[XB_XCNT(b.x)], 1u);
    return b;
}
__device__ __forceinline__ void xcd_barrier_complete(unsigned* bar, unsigned x, unsigned& nloc, unsigned& nx) {
    const unsigned G = gridDim.x * gridDim.y * gridDim.z;
    unsigned sum, cnt, mine, sp = 0u;
    for (;;) {
        sum = 0u; cnt = 0u; mine = 0u;
#pragma unroll
        for (unsigned j = 0; j < 16; ++j) { const unsigned c = xb_ld(&bar[XB_XCNT(j)]); sum += c; cnt += (c > 0u) ? 1u : 0u; mine = (j == x) ? c : mine; }
        if (sum == G) break;
        __builtin_amdgcn_s_sleep(1);
        if ((++sp & 255u) == 0u) { if (xb_ld(&bar[XB_TMO])) break; if (sp > XB_SPIN_CAP) { atomicAdd(&bar[XB_TMO], 1u); break; } }
    }
    nloc = mine > 0u ? mine : 1u; nx = cnt > 0u ? cnt : 1u;
}
__device__ __forceinline__ void xcd_barrier(const XcdBarrier& b) {
    asm volatile("s_waitcnt vmcnt(0)" ::: "memory");
    __syncthreads();
    if (threadIdx.x == 0) {
        unsigned* bar = b.bar; unsigned bx = b.x;
        asm volatile("" : "+s"(bar), "+s"(bx));
        __builtin_amdgcn_s_waitcnt(0);
        unsigned nloc = b.st[0], nx = b.st[1];
        if (nloc == 0u) { xcd_barrier_complete(bar, bx, nloc, nx); b.st[0] = nloc; b.st[1] = nx; }
        const unsigned old = xb_add(&bar[XB_XSUB(bx)], 1u);
        const unsigned gen = old / nloc;
        if (old + 1u == (gen + 1u) * nloc) {
            __builtin_amdgcn_fence(__ATOMIC_RELEASE, "agent");
            asm volatile("s_waitcnt vmcnt(0)" ::: "memory");
            const unsigned og = xb_add(&bar[XB_TOP], 1u);
            const unsigned tg = og / nx;
            if (og + 1u == (tg + 1u) * nx) xb_add(&bar[XB_TOPGEN], 1u);
            else XB_SPIN(xb_ld(&bar[XB_TOPGEN]) == tg, bar);
            __builtin_amdgcn_fence(__ATOMIC_ACQUIRE, "agent");
            xb_add(&bar[XB_XGEN(bx)], 1u);
            asm volatile("s_waitcnt vmcnt(0)" ::: "memory");
        } else {
            XB_SPIN(xb_ld(&bar[XB_XGEN(bx)]) == gen, bar);
            __builtin_amdgcn_fence(__ATOMIC_ACQUIRE, "agent");
            asm volatile("s_waitcnt vmcnt(0)" ::: "memory");
        }
    }
    __syncthreads();
}

struct Params {
    const float *x_in, *norm1_g, *w_in, *conv_w, *conv_b, *dt_bias, *a_log, *ssd_d, *ssd_ng, *sbq_g, *sbk_g, *sbo_g, *dq_g, *dk_g, *do_g,
                *pool_w, *pool_sc, *w_out, *norm2_g, *rg_w, *rg_b, *re_w, *re_b, *wg, *wu, *wd;
    float* X; unsigned* bar; int* ctrl;
    u16 *HB, *MIXED, *WinT, *WoutT, *Hb;
    u16 *PROJ, *PREV, *CG, *WpT; float *DTR, *YD, *SS, *ATOT, *ACS, *RT, *WDT, *tok_g, *Yb;
    int *tok_e, *tok_pos, *tlist;
};
constexpr int CTRL_INTS = 1024;

namespace pg8 {
#define PG8_LAS __attribute__((address_space(3)))
typedef unsigned short bf16_t;
typedef short bf16x8 __attribute__((ext_vector_type(8)));
typedef float f32x4 __attribute__((ext_vector_type(4)));
typedef unsigned u32x4 __attribute__((ext_vector_type(4)));
constexpr int BM = 256, BK = 64, HALF = 128, HTB = HALF * BK * 2  , STAGE_BYTES = 8 * HTB, NXCD = 8, WGM = 8;

__host__ __device__ __forceinline__ int lds_byte(int r, int c) { const int st = (r >> 4) * 2 + (c >> 5), rr = r & 15, cc = c & 31, ob = rr * 64 + cc * 2; return st * 1024 + (ob ^ (((ob >> 9) & 1) << 5)); }
__host__ __device__ __forceinline__ void stage_rc(int b, int& R, int& C) { const int st = b / 1024, sb = b % 1024, swz = sb ^ (((sb >> 9) & 1) << 5); R = (st >> 1) * 16 + swz / 64; C = (st & 1) * 32 + (swz % 64) / 2; }
__host__ __device__ __forceinline__ int perm32(int rho) { const int n = rho >> 4, i = rho & 15; return 8 * (i >> 2) + 4 * n + (i & 3); }

struct Unit { int pm, pn; };
struct Gemm { const bf16_t* A; const bf16_t* Bt; int M, N, K; };

struct StaticOrder {
    int nM, nN, nwg, G, c;
    __host__ __device__ void init(int M, int N, int G_, int c_) { nM = M / BM; nN = N / BM; nwg = nM * nN; G = G_; c = c_; }
    __host__ __device__ bool next(int i, Unit& u) const {
        const long L = (long)i * G + c; if (L >= nwg) return false;
        int wgid = (int)L; { const int q = nwg / NXCD, r = nwg % NXCD, xcd = wgid % NXCD, off = wgid / NXCD; wgid = (xcd < r ? xcd * (q + 1) : r * (q + 1) + (xcd - r) * q) + off; }
        const int nig = WGM * nN, gid = wgid / nig, fm = gid * WGM, gsz = (nM - fm) < WGM ? (nM - fm) : WGM;
        u.pm = fm + ((wgid % nig) % gsz); u.pn = (wgid % nig) / gsz; return true;
    }
    __device__ __forceinline__ void a_ready(const Unit&) const {}
    __device__ __forceinline__ void done(const Unit&) const {}
};
__device__ __forceinline__ unsigned cvt_pk_bf16(float lo, float hi) { unsigned r; asm volatile("v_cvt_pk_bf16_f32 %0, %1, %2" : "=v"(r) : "v"(lo), "v"(hi)); return r; }
typedef float f32x2 __attribute__((ext_vector_type(2)));
struct EpiF32 {
    static constexpr bool PERM = false, AFTER_DRAIN = false;
    float* C; int ldc; const float* bias;
    __device__ __forceinline__ void operator()(const f32x4 (&acc)[2][2][4][2], const Unit& u, int wr, int wc, int fr, int fq) const {
        const int row0 = u.pm * BM + wr * 64 + fr, col0 = u.pn * BM + wc * 32 + 4 * fq;
        f32x4 bv[2][2];
#pragma unroll
        for (int bj = 0; bj < 2; ++bj)
#pragma unroll
            for (int n = 0; n < 2; ++n) bv[bj][n] = bias ? *(const f32x4*)(bias + col0 + bj * HALF + n * 16) : (f32x4){0.f, 0.f, 0.f, 0.f};
#pragma unroll
        for (int ai = 0; ai < 2; ++ai)
#pragma unroll
            for (int m = 0; m < 4; ++m) { float* rowp = C + (size_t)(row0 + ai * HALF + m * 16) * ldc + col0;
#pragma unroll
                for (int bj = 0; bj < 2; ++bj)
#pragma unroll
                    for (int n = 0; n < 2; ++n) *(f32x4*)(rowp + bj * HALF + n * 16) = acc[ai][bj][m][n] + bv[bj][n]; }
    }
};
template <class Epi, class Sched, bool STAMP = false>
__device__ __forceinline__ void gemm_phase(PG8_LAS unsigned char* lds, const Gemm g, const Sched& S, const Epi& E, unsigned long long* stamps) {
    int tid = threadIdx.x; asm volatile("" : "+v"(tid));
    const int wid = __builtin_amdgcn_readfirstlane(tid >> 6), lane = tid & 63, wr = wid >> 2, wc = wid & 3, fr = lane & 15, fq = lane >> 4;
    const int K = g.K, nt = K / BK;
    int ts_lo = 0, ts_hi = 0, nts = 0; const unsigned long long rt_entry = STAMP ? (unsigned long long)wall_clock64() : 0ull;
#define PG8_STAMP() do { if (STAMP && wid == 0 && nts < 64) { const unsigned long long _c = (unsigned long long)clock64(); \
        ts_lo = (lane == nts) ? (int)(unsigned)_c : ts_lo; ts_hi = (lane == nts) ? (int)(unsigned)(_c >> 32) : ts_hi; ++nts; } } while (0)
    PG8_STAMP();
    unsigned voffA[2], voffB[2];
#pragma unroll
    for (int i = 0; i < 2; ++i) { int R, C; stage_rc(tid * 16 + i * 8192, R, C); const int Rb = Epi::PERM ? ((R & ~31) + perm32(R & 31)) : R;
        voffA[i] = (unsigned)(R * K + C) * 2u; voffB[i] = (unsigned)(Rb * K + C) * 2u; }
    const size_t kstep = (size_t)(BK * 2);
    const size_t hstep = (size_t)HALF * K * 2;
    const size_t tstep = 2 * hstep;
    const unsigned ldsw = (unsigned)wid * 1024u;
    const int aoff = lds_byte(wr * 64 + fr, fq * 8), boff = lds_byte(wc * 32 + fr, fq * 8);
#define PG8_SA(b, h) (((b) * 2 + (h)) * HTB)
#define PG8_SB(b, h) ((4 + (b) * 2 + (h)) * HTB)
#define PG8_STAGE(bufoff, gbase, voff) do { _Pragma("unroll") for (int _i = 0; _i < 2; ++_i) \
        __builtin_amdgcn_global_load_lds((const unsigned*)((const char*)(gbase) + (voff)[_i]), (PG8_LAS unsigned*)(lds + (bufoff) + ldsw + _i * 8192), 16, 0, 0); } while (0)
#define PG8_LDA(dst, b, h) do { _Pragma("unroll") for (int m = 0; m < 4; ++m) _Pragma("unroll") for (int k = 0; k < 2; ++k) dst[m][k] = *(const PG8_LAS bf16x8*)(lds + PG8_SA(b, h) + aoff + m * 2048 + k * 1024); } while (0)
#define PG8_LDB(dst, b, h) do { _Pragma("unroll") for (int n = 0; n < 2; ++n) _Pragma("unroll") for (int k = 0; k < 2; ++k) dst[n][k] = *(const PG8_LAS bf16x8*)(lds + PG8_SB(b, h) + boff + n * 2048 + k * 1024); } while (0)
#define PG8_MMA(ai, bj, At, Bt) do { __builtin_amdgcn_s_setprio(1); _Pragma("unroll") for (int m = 0; m < 4; ++m) _Pragma("unroll") for (int n = 0; n < 2; ++n) _Pragma("unroll") for (int k = 0; k < 2; ++k) \
        acc[ai][bj][m][n] = __builtin_amdgcn_mfma_f32_16x16x32_bf16(Bt[n][k], At[m][k], acc[ai][bj][m][n], 0, 0, 0); __builtin_amdgcn_s_setprio(0); } while (0)
#define PG8_WAIT_V(n) asm volatile("s_waitcnt vmcnt(" #n ")" ::: "memory")
#define PG8_WAIT_L(n) asm volatile("s_waitcnt lgkmcnt(" #n ")" ::: "memory")
#define PG8_BAR __builtin_amdgcn_s_barrier()
#define PG8_SCHED __builtin_amdgcn_sched_barrier(0)
    Unit cur, nxt; int ui = 0;
    if (!S.next(0, cur)) return;
    f32x4 acc[2][2][4][2];
#pragma unroll
    for (int a = 0; a < 2; ++a)
#pragma unroll
        for (int b = 0; b < 2; ++b)
#pragma unroll
            for (int m = 0; m < 4; ++m)
#pragma unroll
                for (int n = 0; n < 2; ++n) acc[a][b][m][n] = (f32x4){0.f, 0.f, 0.f, 0.f};
    bf16x8 At[4][2], B0[2][2], B1[2][2];
    const char* cA = (const char*)g.A + (size_t)cur.pm * tstep; const char* cB = (const char*)g.Bt + (size_t)cur.pn * tstep;
    S.a_ready(cur);
    PG8_STAGE(PG8_SB(0, 0), cB, voffB); PG8_STAGE(PG8_SA(0, 0), cA, voffA); PG8_STAGE(PG8_SB(0, 1), cB + hstep, voffB); PG8_STAGE(PG8_SA(0, 1), cA + hstep, voffA);
    if (wr == 1) PG8_BAR;
    PG8_WAIT_V(4); PG8_BAR;
    PG8_STAGE(PG8_SB(1, 0), cB + kstep, voffB); PG8_STAGE(PG8_SA(1, 0), cA + kstep, voffA); PG8_STAGE(PG8_SB(1, 1), cB + hstep + kstep, voffB);
    PG8_WAIT_V(6); PG8_BAR;
    PG8_STAMP();
    for (;;) {
        const bool has_next = S.next(ui + 1, nxt);
        const char* nA = has_next ? (const char*)g.A + (size_t)nxt.pm * tstep : cA; const char* nB = has_next ? (const char*)g.Bt + (size_t)nxt.pn * tstep : cB;
        for (int t = 0; t < nt; t += 2) {
            const bool last = (t == nt - 2);
            const char* a1 = cA + (size_t)(t + 1) * kstep;
            const char* a2 = last ? nA : cA + (size_t)(t + 2) * kstep; const char* b2 = last ? nB : cB + (size_t)(t + 2) * kstep;
            const char* a3 = a2 + kstep; const char* b3 = b2 + kstep;
            if (last && has_next) S.a_ready(nxt);
            PG8_LDB(B0, 0, 0); PG8_SCHED; PG8_LDA(At, 0, 0); PG8_STAGE(PG8_SA(1, 1), a1 + hstep, voffA);
            PG8_WAIT_L(8); PG8_BAR; PG8_WAIT_L(0); PG8_MMA(0, 0, At, B0); PG8_BAR; PG8_SCHED;
            PG8_LDB(B1, 0, 1); PG8_STAGE(PG8_SB(0, 0), b2, voffB);
            PG8_BAR; PG8_WAIT_L(0); PG8_MMA(0, 1, At, B1); PG8_BAR;
            PG8_LDA(At, 0, 1); PG8_STAGE(PG8_SA(0, 0), a2, voffA);
            PG8_BAR; PG8_WAIT_L(0); PG8_MMA(1, 0, At, B0); PG8_BAR; PG8_SCHED;
            PG8_STAGE(PG8_SB(0, 1), b2 + hstep, voffB);
            PG8_WAIT_V(6); PG8_BAR; PG8_MMA(1, 1, At, B1); PG8_BAR;
            PG8_LDB(B0, 1, 0); PG8_SCHED; PG8_LDA(At, 1, 0); PG8_STAGE(PG8_SA(0, 1), a2 + hstep, voffA);
            PG8_WAIT_L(8); PG8_BAR; PG8_WAIT_L(0); PG8_MMA(0, 0, At, B0); PG8_BAR; PG8_SCHED;
            PG8_LDB(B1, 1, 1); PG8_STAGE(PG8_SB(1, 0), b3, voffB);
            PG8_BAR; PG8_WAIT_L(0); PG8_MMA(0, 1, At, B1); PG8_BAR;
            PG8_LDA(At, 1, 1); PG8_STAGE(PG8_SA(1, 0), a3, voffA);
            PG8_BAR; PG8_WAIT_L(0); PG8_MMA(1, 0, At, B0); PG8_BAR; PG8_SCHED;
            PG8_STAGE(PG8_SB(1, 1), b3 + hstep, voffB);
            PG8_WAIT_V(6); PG8_BAR; PG8_MMA(1, 1, At, B1); PG8_BAR;
        }
        PG8_STAMP();
        if constexpr (!Epi::AFTER_DRAIN) { E(acc, cur, wr, wc, fr, fq); S.done(cur); }
        PG8_STAMP();
        if (!has_next) break;
#pragma unroll
        for (int a = 0; a < 2; ++a)
#pragma unroll
            for (int b = 0; b < 2; ++b)
#pragma unroll
                for (int m = 0; m < 4; ++m)
#pragma unroll
                    for (int n = 0; n < 2; ++n) acc[a][b][m][n] = (f32x4){0.f, 0.f, 0.f, 0.f};
        cur = nxt; cA = nA; cB = nB; ++ui;
    }
    PG8_WAIT_V(0);
    if (wr == 0) PG8_BAR;
    PG8_BAR;
    if constexpr (Epi::AFTER_DRAIN) { E.fused(acc, cur, wr, wc, fr, fq, lds, wid, lane); S.done(cur); }
    PG8_STAMP();
    if (STAMP && wid == 0) { stamps[lane] = lane < nts ? (((unsigned long long)(unsigned)ts_hi << 32) | (unsigned)ts_lo) : 0ull;
        if (lane == 62) stamps[62] = rt_entry; if (lane == 63) stamps[63] = (unsigned long long)wall_clock64(); }
#undef PG8_STAMP
#undef PG8_SA
#undef PG8_SB
#undef PG8_STAGE
#undef PG8_LDA
#undef PG8_LDB
#undef PG8_MMA
#undef PG8_WAIT_V
#undef PG8_WAIT_L
#undef PG8_BAR
#undef PG8_SCHED
}
}

namespace pg8 {
struct EpiStoreBf16 {
    static constexpr bool PERM = true, AFTER_DRAIN = false;
    bf16_t* O; int ldc;
    __device__ __forceinline__ void operator()(const f32x4 (&acc)[2][2][4][2], const Unit& u, int wr, int wc, int fr, int fq) const {
        const int row0 = u.pm * BM + wr * 64 + fr, col0 = u.pn * BM + wc * 32 + 8 * fq;
#pragma unroll
        for (int ai = 0; ai < 2; ++ai)
#pragma unroll
            for (int m = 0; m < 4; ++m) { bf16_t* rowp = O + (size_t)(row0 + ai * HALF + m * 16) * ldc + col0;
#pragma unroll
                for (int bj = 0; bj < 2; ++bj) { const f32x4 v0 = acc[ai][bj][m][0], v1 = acc[ai][bj][m][1];
                    u32x4 w; w.x = cvt_pk_bf16(v0[0], v0[1]); w.y = cvt_pk_bf16(v0[2], v0[3]); w.z = cvt_pk_bf16(v1[0], v1[1]); w.w = cvt_pk_bf16(v1[2], v1[3]);
                    *(u32x4*)(rowp + bj * HALF) = w; } }
    }
};
struct EpiAddF32 {
    static constexpr bool PERM = false, AFTER_DRAIN = false;
    float* C; int ldc;
    __device__ __forceinline__ void operator()(const f32x4 (&acc)[2][2][4][2], const Unit& u, int wr, int wc, int fr, int fq) const {
        const int row0 = u.pm * BM + wr * 64 + fr, col0 = u.pn * BM + wc * 32 + 4 * fq;
#pragma unroll
        for (int ai = 0; ai < 2; ++ai)
#pragma unroll
            for (int m = 0; m < 4; ++m) { float* rowp = C + (size_t)(row0 + ai * HALF + m * 16) * ldc + col0;
#pragma unroll
                for (int bj = 0; bj < 2; ++bj)
#pragma unroll
                    for (int n = 0; n < 2; ++n) { f32x4* q = (f32x4*)(rowp + bj * HALF + n * 16); *q = *q + acc[ai][bj][m][n]; } }
    }
};
struct EpiDownF32 {
    static constexpr bool PERM = false, AFTER_DRAIN = false;
    float* C;
    __device__ __forceinline__ void operator()(const f32x4 (&acc)[2][2][4][2], const Unit& u, int wr, int wc, int fr, int fq) const {
        const int row0 = u.pm * BM + wr * 64 + fr, col0 = (u.pn & 7) * BM + wc * 32 + 4 * fq;
#pragma unroll
        for (int ai = 0; ai < 2; ++ai)
#pragma unroll
            for (int m = 0; m < 4; ++m) { float* rowp = C + (size_t)(row0 + ai * HALF + m * 16) * 2048 + col0;
#pragma unroll
                for (int bj = 0; bj < 2; ++bj)
#pragma unroll
                    for (int n = 0; n < 2; ++n) *(f32x4*)(rowp + bj * HALF + n * 16) = acc[ai][bj][m][n]; }
    }
};
struct EpiSwiglu {
    static constexpr bool PERM = true, AFTER_DRAIN = false;
    bf16_t* H;
    __device__ __forceinline__ void operator()(const f32x4 (&acc)[2][2][4][2], const Unit& u, int wr, int wc, int fr, int fq) const {
        const int row0 = u.pm * BM + wr * 64 + fr, col0 = (u.pn & 3) * 128 + wc * 32 + 8 * fq;
#pragma unroll
        for (int ai = 0; ai < 2; ++ai)
#pragma unroll
            for (int m = 0; m < 4; ++m) { bf16_t* rowp = H + (size_t)(row0 + ai * HALF + m * 16) * 512 + col0;
                float h[8];
#pragma unroll
                for (int n = 0; n < 2; ++n)
#pragma unroll
                    for (int j = 0; j < 4; ++j) { const float g = acc[ai][0][m][n][j], up = acc[ai][1][m][n][j]; h[n * 4 + j] = g / (1.f + __expf(-g)) * up; }
                u32x4 w; w.x = cvt_pk_bf16(h[0], h[1]); w.y = cvt_pk_bf16(h[2], h[3]); w.z = cvt_pk_bf16(h[4], h[5]); w.w = cvt_pk_bf16(h[6], h[7]);
                *(u32x4*)rowp = w; }
    }
};
struct MoeOrder {
    const int* blk_e; int ntile, G, c, shift;
    __device__ __forceinline__ bool next(int i, Unit& u) const {
        const int L = i * G + c; if (L >= ntile) return false;
        const int mb = L >> shift, nt = L & ((1 << shift) - 1);
        u.pm = mb; u.pn = (blk_e[mb] << shift) + nt; return true;
    }
    __device__ __forceinline__ void a_ready(const Unit&) const {}
    __device__ __forceinline__ void done(const Unit&) const {}
};
}

__device__ __forceinline__ void transpose_item(const float* __restrict__ W, int ldin, int n0, int K, u16* __restrict__ WT, int row0, int nbn, int item, float* scr, int lane, int ilv = -1) {
    const int kb = item / nbn, nb = item % nbn, k0 = 64 * kb, nn = 32 * nb;
    const int rb = ilv < 0 ? row0 + nn : row0 + (nn >> 7) * 256 + ilv * 128 + (nn & 127);
#pragma unroll 8
    for (int i = 0; i < 32; ++i) { const int kk = 2 * i + (lane >> 5); scr[kk * 33 + (lane & 31)] = W[(size_t)(k0 + kk) * ldin + n0 + nn + (lane & 31)]; }
    asm volatile("s_waitcnt lgkmcnt(0)" ::: "memory");
    const int c = lane & 7;
#pragma unroll
    for (int j = 0; j < 4; ++j) { const int n = (lane >> 3) + 8 * j; const float* s = scr + (8 * c) * 33 + n;
        uint4 o; o.x = pk2(s[0 * 33], s[1 * 33]); o.y = pk2(s[2 * 33], s[3 * 33]); o.z = pk2(s[4 * 33], s[5 * 33]); o.w = pk2(s[6 * 33], s[7 * 33]);
        *(uint4*)(WT + (size_t)(rb + n) * K + k0 + 8 * c) = o; }
    asm volatile("s_waitcnt lgkmcnt(0)" ::: "memory");
}
__device__ __forceinline__ void convert_moe_weights(const float* wg, const float* wu, const float* wd, u16* WguT, u16* WdT, int l, float* scr, int gw, int NGW, int lane) {
    constexpr int IPE = 512;
    for (int it = gw; it < 3 * NE * IPE; it += NGW) {
        const int which = it / (NE * IPE), r = it % (NE * IPE), e = r / IPE, item = r % IPE;
        const size_t eo = ((size_t)l * NE + e) * (size_t)D * DFF;
        if (which == 0)      transpose_item(wg + eo, DFF, 0, D, WguT + (size_t)e * 1024 * D, 0, DFF / 32, item, scr, lane, 0);
        else if (which == 1) transpose_item(wu + eo, DFF, 0, D, WguT + (size_t)e * 1024 * D, 0, DFF / 32, item, scr, lane, 1);
        else                 transpose_item(wd + eo, D, 0, DFF, WdT + (size_t)e * D * DFF, 0, D / 32, item, scr, lane);
    }
}


constexpr int ATT_RS = 144;
constexpr int ATT_VBYTES = 32 * ATT_RS;
typedef long long i64;
typedef unsigned u32x4v __attribute__((ext_vector_type(4)));
typedef unsigned u32x2v __attribute__((ext_vector_type(2)));
__device__ __forceinline__ float bperm(int srclane, float v) { return __int_as_float(__builtin_amdgcn_ds_bpermute(srclane << 2, __float_as_int(v))); }
__device__ __forceinline__ float softplus_fast(float z) { return fmaxf(z, 0.f) + __logf(1.f + __expf(-fabsf(z))); }
__device__ __forceinline__ void vt_frags(unsigned vaddr, int lane, bf16x8 (&vf)[4]) {
    const unsigned a = vaddr + (unsigned)((4 * (lane >> 4) + ((lane & 15) >> 2)) * ATT_RS + (lane & 3) * 8);
    i64 r0, r1, r2, r3, r4, r5, r6, r7;
    asm volatile("s_waitcnt lgkmcnt(0)\n\t"
                 "ds_read_b64_tr_b16 %0, %8\n\tds_read_b64_tr_b16 %1, %8 offset:2304\n\t"
                 "ds_read_b64_tr_b16 %2, %8 offset:32\n\tds_read_b64_tr_b16 %3, %8 offset:2336\n\t"
                 "ds_read_b64_tr_b16 %4, %8 offset:64\n\tds_read_b64_tr_b16 %5, %8 offset:2368\n\t"
                 "ds_read_b64_tr_b16 %6, %8 offset:96\n\tds_read_b64_tr_b16 %7, %8 offset:2400\n\t"
                 "s_waitcnt lgkmcnt(0)"
                 : "=&v"(r0), "=&v"(r1), "=&v"(r2), "=&v"(r3), "=&v"(r4), "=&v"(r5), "=&v"(r6), "=&v"(r7) : "v"(a) : "memory");
    typedef i64 i64x2 __attribute__((ext_vector_type(2)));
    i64x2 t; t.x = r0; t.y = r1; vf[0] = __builtin_bit_cast(bf16x8, t); t.x = r2; t.y = r3; vf[1] = __builtin_bit_cast(bf16x8, t);
    t.x = r4; t.y = r5; vf[2] = __builtin_bit_cast(bf16x8, t); t.x = r6; t.y = r7; vf[3] = __builtin_bit_cast(bf16x8, t);
}
__device__ __forceinline__ bf16x8 pack8(const float (&a)[4], const float (&b)[4]) {
    u32x4v w; w.x = pk2(a[0], a[1]); w.y = pk2(a[2], a[3]); w.z = pk2(b[0], b[1]); w.w = pk2(b[2], b[3]);
    return __builtin_bit_cast(bf16x8, w);
}
__device__ __forceinline__ void store_out_tile(const f32x4 (&o)[4], float scale, const float* __restrict__ gain, u16* __restrict__ dst  , int g) {
#pragma unroll
    for (int dt = 0; dt < 4; ++dt) { const float4 gg = *(const float4*)(gain + dt * 16 + 4 * g);
        *(uint2*)(dst + dt * 16 + 4 * g) = make_uint2(pk2(o[dt][0] * scale * gg.x, o[dt][1] * scale * gg.y), pk2(o[dt][2] * scale * gg.z, o[dt][3] * scale * gg.w)); }
}

__device__ __forceinline__ void sb_unit(const u16* __restrict__ PROJ, int b, int qb, int h, int lane, LAS char* vl, LAS float* red,
                                        const float* __restrict__ gout, u16* __restrict__ MIXED) {
    const int li = lane & 15, g = lane >> 4; const size_t tb = (size_t)b * SEQ; const int q0 = qb * 64;
    const u16* Qp = PROJ + C_SB + h * 64; const u16* Kp = Qp + 512; const u16* Vp = Qp + 1024;
    const unsigned vaddr = (unsigned)(size_t)vl;
    bf16x8 qf[4][2];
#pragma unroll
    for (int qt = 0; qt < 4; ++qt)
#pragma unroll
        for (int s = 0; s < 2; ++s) qf[qt][s] = *(const bf16x8*)(Qp + (tb + q0 + qt * 16 + li) * DP + 32 * s + 8 * g);
    f32x4 acc[4][4];
#pragma unroll
    for (int qt = 0; qt < 4; ++qt)
#pragma unroll
        for (int dt = 0; dt < 4; ++dt) acc[qt][dt] = (f32x4){0.f, 0.f, 0.f, 0.f};
    float carry[4] = {0.f, 0.f, 0.f, 0.f};
    for (int k0 = q0 + 32; k0 >= 0; k0 -= 32) {
        bf16x8 kf[2][2];
#pragma unroll
        for (int kt = 0; kt < 2; ++kt)
#pragma unroll
            for (int s = 0; s < 2; ++s) kf[kt][s] = *(const bf16x8*)(Kp + (tb + k0 + kt * 16 + li) * DP + 32 * s + 8 * g);
#pragma unroll
        for (int u = 0; u < 4; ++u) { const int c = lane + 64 * u, row = c >> 3, cc = c & 7;
            *(LAS u32x4v*)(vl + row * ATT_RS + cc * 16) = *(const u32x4v*)(Vp + (tb + k0 + row) * DP + cc * 8); }
        bf16x8 pf[4];
#pragma unroll
        for (int qt = 0; qt < 4; ++qt) {
            const int qpos = q0 + qt * 16 + li;
            float w[2][4];
#pragma unroll
            for (int kt = 1; kt >= 0; --kt) {
                f32x4 st = __builtin_amdgcn_mfma_f32_16x16x32_bf16(kf[kt][0], qf[qt][0], (f32x4){0.f, 0.f, 0.f, 0.f}, 0, 0, 0);
                st = __builtin_amdgcn_mfma_f32_16x16x32_bf16(kf[kt][1], qf[qt][1], st, 0, 0, 0);
                const int kb = k0 + kt * 16 + 4 * g;
                float sp[4];
#pragma unroll
                for (int r = 0; r < 4; ++r) sp[r] = (kb + r < qpos) ? softplus_fast(st[r]) : 0.f;
                const float G = (sp[0] + sp[1]) + (sp[2] + sp[3]);
                const float x1 = bperm(lane ^ 16, G), hs = G + x1, x2 = bperm(lane ^ 32, hs);
                float rs = carry[qt] + (g == 3 ? 0.f : g == 2 ? x1 : g == 1 ? x2 : x1 + x2);
#pragma unroll
                for (int r = 3; r >= 0; --r) { w[kt][r] = (kb + r < qpos) ? __expf(st[r] - sp[r] - rs) : 0.f; rs += sp[r]; }
                carry[qt] += hs + x2;
            }
            pf[qt] = pack8(w[0], w[1]);
        }
        bf16x8 vf[4]; vt_frags(vaddr, lane, vf);
#pragma unroll
        for (int qt = 0; qt < 4; ++qt)
#pragma unroll
            for (int dt = 0; dt < 4; ++dt) acc[qt][dt] = __builtin_amdgcn_mfma_f32_16x16x32_bf16(vf[dt], pf[qt], acc[qt][dt], 0, 0, 0);
        if (k0 + 32 <= q0 && __all(fminf(fminf(carry[0], carry[1]), fminf(carry[2], carry[3])) > 104.f)) break;
    }
    float ss[4];
#pragma unroll
    for (int qt = 0; qt < 4; ++qt) { float s = 0.f;
#pragma unroll
        for (int dt = 0; dt < 4; ++dt) s += (acc[qt][dt][0] * acc[qt][dt][0] + acc[qt][dt][1] * acc[qt][dt][1]) + (acc[qt][dt][2] * acc[qt][dt][2] + acc[qt][dt][3] * acc[qt][dt][3]);
        s += bperm(lane ^ 16, s); s += bperm(lane ^ 32, s); ss[qt] = s;
        if (g == 0) red[h * 64 + qt * 16 + li] = s; }
    __syncthreads();
#pragma unroll
    for (int qt = 0; qt < 4; ++qt) { float tot = 0.f;
#pragma unroll
        for (int hh = 0; hh < 8; ++hh) tot += red[hh * 64 + qt * 16 + li];
        const float sc = rsqrtf(tot / 512.f + EPS);
        store_out_tile(acc[qt], sc, gout + h * 64, MIXED + (tb + q0 + qt * 16 + li) * D + 512 + h * 64, g); }
}

__device__ __forceinline__ void dil_unit(const u16* __restrict__ PROJ, int b, int w, int r, int h, int lane, LAS char* vl, LAS float* red,
                                         const float* __restrict__ gout, u16* __restrict__ MIXED) {
    const int li = lane & 15, g = lane >> 4; const size_t tb = (size_t)b * SEQ; const int qpos = w * 256 + r + 16 * li;
    const u16* Qp = PROJ + C_DIL + h * 64; const u16* Kp = Qp + 512; const u16* Vp = Qp + 1024;
    const unsigned vaddr = (unsigned)(size_t)vl;
    bf16x8 qf[2];
#pragma unroll
    for (int s = 0; s < 2; ++s) qf[s] = *(const bf16x8*)(Qp + (tb + qpos) * DP + 32 * s + 8 * g);
    f32x4 acc[4];
#pragma unroll
    for (int dt = 0; dt < 4; ++dt) acc[dt] = (f32x4){0.f, 0.f, 0.f, 0.f};
    float mrun = -1e30f, lrun = 0.f;
#pragma unroll 1
    for (int br = 0; br < 3; ++br) {
        const int dsh = br == 0 ? 4 : br == 1 ? 2 : 0;
        const int nstep = br == 0 ? 5 : br == 1 ? 6 : 12;
        const int base = w * 256 + r - (128 << dsh);
        const int rat = li << (4 - dsh);
#pragma unroll 1
        for (int st_ = 0; st_ < nstep; ++st_) {
            const int m0 = st_ * 32;
            if (base + ((m0 + 31) << dsh) < 0) continue;
            bf16x8 kf[2][2];
#pragma unroll
            for (int kt = 0; kt < 2; ++kt) { int pos = base + ((m0 + kt * 16 + li) << dsh); pos = min(max(pos, 0), SEQ - 1);
#pragma unroll
                for (int s = 0; s < 2; ++s) kf[kt][s] = *(const bf16x8*)(Kp + (tb + pos) * DP + 32 * s + 8 * g); }
#pragma unroll
            for (int u = 0; u < 4; ++u) { const int c = lane + 64 * u, row = c >> 3, cc = c & 7; int pos = base + ((m0 + row) << dsh); pos = min(max(pos, 0), SEQ - 1);
                *(LAS u32x4v*)(vl + row * ATT_RS + cc * 16) = *(const u32x4v*)(Vp + (tb + pos) * DP + cc * 8); }
            float z[2][4]; bool ok[2][4]; float zmax = -1e30f;
#pragma unroll
            for (int kt = 0; kt < 2; ++kt) {
                f32x4 st = __builtin_amdgcn_mfma_f32_16x16x32_bf16(kf[kt][0], qf[0], (f32x4){0.f, 0.f, 0.f, 0.f}, 0, 0, 0);
                st = __builtin_amdgcn_mfma_f32_16x16x32_bf16(kf[kt][1], qf[1], st, 0, 0, 0);
#pragma unroll
                for (int rr = 0; rr < 4; ++rr) { const int m = m0 + kt * 16 + 4 * g + rr; const int dm = m - rat;
                    ok[kt][rr] = (dm >= 0) && (dm <= 128) && (base + (m << dsh) >= 0);
                    z[kt][rr] = st[rr]; if (ok[kt][rr]) zmax = fmaxf(zmax, st[rr]); }
            }
            zmax = fmaxf(zmax, bperm(lane ^ 16, zmax)); zmax = fmaxf(zmax, bperm(lane ^ 32, zmax));
            const float mn = fmaxf(mrun, zmax); const float al = __expf(mrun - mn); mrun = mn;
            float pw[2][4]; float ps = 0.f;
#pragma unroll
            for (int kt = 0; kt < 2; ++kt)
#pragma unroll
                for (int rr = 0; rr < 4; ++rr) { pw[kt][rr] = ok[kt][rr] ? __expf(z[kt][rr] - mn) : 0.f; ps += pw[kt][rr]; }
            lrun = lrun * al + ps;
#pragma unroll
            for (int dt = 0; dt < 4; ++dt) acc[dt] = acc[dt] * al;
            const bf16x8 pf = pack8(pw[0], pw[1]);
            bf16x8 vf[4]; vt_frags(vaddr, lane, vf);
#pragma unroll
            for (int dt = 0; dt < 4; ++dt) acc[dt] = __builtin_amdgcn_mfma_f32_16x16x32_bf16(vf[dt], pf, acc[dt], 0, 0, 0);
        }
    }
    lrun += bperm(lane ^ 16, lrun); lrun += bperm(lane ^ 32, lrun);
    const float inv = 1.f / lrun;
    float s = 0.f;
#pragma unroll
    for (int dt = 0; dt < 4; ++dt) { acc[dt] = acc[dt] * inv; s += (acc[dt][0] * acc[dt][0] + acc[dt][1] * acc[dt][1]) + (acc[dt][2] * acc[dt][2] + acc[dt][3] * acc[dt][3]); }
    s += bperm(lane ^ 16, s); s += bperm(lane ^ 32, s);
    if (g == 0) red[h * 64 + li] = s;
    __syncthreads();
    float tot = 0.f;
#pragma unroll
    for (int hh = 0; hh < 8; ++hh) tot += red[hh * 64 + li];
    const float sc = rsqrtf(tot / 512.f + EPS);
    store_out_tile(acc, sc, gout + h * 64, MIXED + (tb + qpos) * D + 1024 + h * 64, g);
}


template <int RS> __device__ __forceinline__ void tr_frags4(unsigned addr, int lane, bf16x8 (&f)[4]) {
    const unsigned a = addr + (unsigned)((4 * (lane >> 4) + ((lane & 15) >> 2)) * RS + (lane & 3) * 8);
    i64 r0, r1, r2, r3, r4, r5, r6, r7;
    asm volatile("s_waitcnt lgkmcnt(0)\n\t"
                 "ds_read_b64_tr_b16 %0, %8\n\tds_read_b64_tr_b16 %1, %8 offset:%9\n\t"
                 "ds_read_b64_tr_b16 %2, %8 offset:32\n\tds_read_b64_tr_b16 %3, %8 offset:%10\n\t"
                 "ds_read_b64_tr_b16 %4, %8 offset:64\n\tds_read_b64_tr_b16 %5, %8 offset:%11\n\t"
                 "ds_read_b64_tr_b16 %6, %8 offset:96\n\tds_read_b64_tr_b16 %7, %8 offset:%12\n\t"
                 "s_waitcnt lgkmcnt(0)"
                 : "=&v"(r0), "=&v"(r1), "=&v"(r2), "=&v"(r3), "=&v"(r4), "=&v"(r5), "=&v"(r6), "=&v"(r7)
                 : "v"(a), "i"(16 * RS), "i"(16 * RS + 32), "i"(16 * RS + 64), "i"(16 * RS + 96) : "memory");
    typedef i64 i64x2 __attribute__((ext_vector_type(2)));
    i64x2 t; t.x = r0; t.y = r1; f[0] = __builtin_bit_cast(bf16x8, t); t.x = r2; t.y = r3; f[1] = __builtin_bit_cast(bf16x8, t);
    t.x = r4; t.y = r5; f[2] = __builtin_bit_cast(bf16x8, t); t.x = r6; t.y = r7; f[3] = __builtin_bit_cast(bf16x8, t);
}
template <int RS> __device__ __forceinline__ bf16x8 tr_frag1(unsigned addr, int lane) {
    const unsigned a = addr + (unsigned)((4 * (lane >> 4) + ((lane & 15) >> 2)) * RS + (lane & 3) * 8);
    i64 r0, r1;
    asm volatile("s_waitcnt lgkmcnt(0)\n\tds_read_b64_tr_b16 %0, %2\n\tds_read_b64_tr_b16 %1, %2 offset:%3\n\ts_waitcnt lgkmcnt(0)"
                 : "=&v"(r0), "=&v"(r1) : "v"(a), "i"(16 * RS) : "memory");
    typedef i64 i64x2 __attribute__((ext_vector_type(2)));
    i64x2 t; t.x = r0; t.y = r1; return __builtin_bit_cast(bf16x8, t);
}
constexpr int SSD_RB = 272, SSD_RX = 144;
constexpr int SSD_OFF_B = 0, SSD_OFF_C = 128 * SSD_RB, SSD_OFF_X = 2 * 128 * SSD_RB, SSD_OFF_XW = SSD_OFF_X + 128 * SSD_RX, SSD_OFF_F = SSD_OFF_XW + 128 * SSD_RX;
__device__ __forceinline__ void ssd_chunk_unit(const u16* __restrict__ PROJ, const float* __restrict__ DTR, const float* __restrict__ cw, const float* __restrict__ cb,
                                               float dtbias, float aneg, float dskip, int b, int c, int h, int tid, LAS char* L,
                                               float* __restrict__ YD, float* __restrict__ SS, float* __restrict__ ATOT, float* __restrict__ ACS, u16* __restrict__ CG) {
    const int wave = tid >> 6, lane = tid & 63, li = lane & 15, g = lane >> 4, grp = h >> 2;
    const size_t t0 = (size_t)b * SEQ + (size_t)c * 128;
    LAS float* acs = (LAS float*)(L + SSD_OFF_F); LAS float* dts = acs + 128; LAS float* wls = acs + 256;
    __syncthreads();
    if (wave == 0) {
        const float d0 = softplusf(DTR[(t0 + 2 * lane) * 8 + h] + dtbias), d1 = softplusf(DTR[(t0 + 2 * lane + 1) * 8 + h] + dtbias);
        const float a0 = d0 * aneg, a1 = d1 * aneg;
        float v = a0 + a1;
#pragma unroll
        for (int o = 1; o < 64; o <<= 1) { const float t = bperm(lane - o, v); if (lane >= o) v += t; }
        acs[2 * lane] = v - a1; acs[2 * lane + 1] = v; dts[2 * lane] = d0; dts[2 * lane + 1] = d1;
    }
    __syncthreads();
    if (tid < 128) { const float a = acs[tid]; wls[tid] = dts[tid] * __expf(acs[127] - a); ACS[(t0 + tid) * 8 + h] = a; if (tid == 0) ATOT[((size_t)b * 32 + c) * 8 + h] = acs[127]; }
    __syncthreads();
    for (int it = tid; it < 128 * 40; it += NTHR) {
        const int tl = it / 40, cg = it % 40;
        const int ch = cg < 8 ? h * 64 + cg * 8 : cg < 24 ? 512 + grp * 128 + (cg - 8) * 8 : 768 + grp * 128 + (cg - 24) * 8;
        const int sl = c * 128 + tl;
        float a[8];
        { const float4 b0 = *(const float4*)(cb + ch), b1 = *(const float4*)(cb + ch + 4); a[0] = b0.x; a[1] = b0.y; a[2] = b0.z; a[3] = b0.w; a[4] = b1.x; a[5] = b1.y; a[6] = b1.z; a[7] = b1.w; }
#pragma unroll
        for (int k = 0; k < 4; ++k) if (sl - 3 + k >= 0) {
            const bf16x8 u = *(const bf16x8*)(PROJ + (t0 + tl - 3 + k) * DP + C_XBC + ch);
            const float4 w0 = *(const float4*)(cw + k * 1024 + ch), w1 = *(const float4*)(cw + k * 1024 + ch + 4);
            a[0] += w0.x * bf2f((u16)u[0]); a[1] += w0.y * bf2f((u16)u[1]); a[2] += w0.z * bf2f((u16)u[2]); a[3] += w0.w * bf2f((u16)u[3]);
            a[4] += w1.x * bf2f((u16)u[4]); a[5] += w1.y * bf2f((u16)u[5]); a[6] += w1.z * bf2f((u16)u[6]); a[7] += w1.w * bf2f((u16)u[7]);
        }
#pragma unroll
        for (int j = 0; j < 8; ++j) a[j] = siluf(a[j]);
        u32x4v o; o.x = pk2(a[0], a[1]); o.y = pk2(a[2], a[3]); o.z = pk2(a[4], a[5]); o.w = pk2(a[6], a[7]);
        if (cg < 8) {
            *(LAS u32x4v*)(L + SSD_OFF_X + tl * SSD_RX + cg * 16) = o;
            const float wl = wls[tl]; u32x4v ow; ow.x = pk2(a[0] * wl, a[1] * wl); ow.y = pk2(a[2] * wl, a[3] * wl); ow.z = pk2(a[4] * wl, a[5] * wl); ow.w = pk2(a[6] * wl, a[7] * wl);
            *(LAS u32x4v*)(L + SSD_OFF_XW + tl * SSD_RX + cg * 16) = ow;
        } else if (cg < 24) *(LAS u32x4v*)(L + SSD_OFF_B + tl * SSD_RB + (cg - 8) * 16) = o;
        else { *(LAS u32x4v*)(L + SSD_OFF_C + tl * SSD_RB + (cg - 24) * 16) = o;
               if ((h & 3) == 0) *(u32x4v*)(CG + (t0 + tl) * 256 + grp * 128 + (cg - 24) * 8) = o; }
    }
    __syncthreads();
    const unsigned Lb = (unsigned)(size_t)L;
    {
        const int lt = wave, lrow = lt * 16 + li; const float acl = acs[lrow];
        bf16x8 cf[4];
#pragma unroll
        for (int ks = 0; ks < 4; ++ks) cf[ks] = *(const LAS bf16x8*)(L + SSD_OFF_C + lrow * SSD_RB + ks * 64 + g * 16);
        f32x4 acc[4];
#pragma unroll
        for (int pt = 0; pt < 4; ++pt) acc[pt] = (f32x4){0.f, 0.f, 0.f, 0.f};
        for (int s0 = 0; s0 <= lt * 16; s0 += 32) {
            float w[2][4];
#pragma unroll
            for (int kt = 0; kt < 2; ++kt) {
                f32x4 st = (f32x4){0.f, 0.f, 0.f, 0.f};
#pragma unroll
                for (int ks = 0; ks < 4; ++ks) { const bf16x8 bfr = *(const LAS bf16x8*)(L + SSD_OFF_B + (s0 + kt * 16 + li) * SSD_RB + ks * 64 + g * 16);
                    st = __builtin_amdgcn_mfma_f32_16x16x32_bf16(bfr, cf[ks], st, 0, 0, 0); }
                const int sb = s0 + kt * 16 + 4 * g;
                const f32x4 as4 = *(const LAS f32x4*)(acs + sb), dt4 = *(const LAS f32x4*)(dts + sb);
#pragma unroll
                for (int r = 0; r < 4; ++r) w[kt][r] = (sb + r <= lrow) ? st[r] * __expf(acl - as4[r]) * dt4[r] : 0.f;
            }
            const bf16x8 pf = pack8(w[0], w[1]);
            bf16x8 xf[4]; tr_frags4<SSD_RX>(Lb + SSD_OFF_X + s0 * SSD_RX, lane, xf);
#pragma unroll
            for (int pt = 0; pt < 4; ++pt) acc[pt] = __builtin_amdgcn_mfma_f32_16x16x32_bf16(xf[pt], pf, acc[pt], 0, 0, 0);
        }
#pragma unroll
        for (int pt = 0; pt < 4; ++pt) {
            const u32x2v xr = *(const LAS u32x2v*)(L + SSD_OFF_X + lrow * SSD_RX + (pt * 16 + 4 * g) * 2);
            float4 o; o.x = acc[pt][0] + dskip * __uint_as_float(xr.x << 16); o.y = acc[pt][1] + dskip * __uint_as_float(xr.x & 0xffff0000u);
            o.z = acc[pt][2] + dskip * __uint_as_float(xr.y << 16); o.w = acc[pt][3] + dskip * __uint_as_float(xr.y & 0xffff0000u);
            *(float4*)(YD + (t0 + lrow) * 512 + h * 64 + pt * 16 + 4 * g) = o;
        }
    }
    {
        f32x4 acc[4];
#pragma unroll
        for (int pt = 0; pt < 4; ++pt) acc[pt] = (f32x4){0.f, 0.f, 0.f, 0.f};
#pragma unroll
        for (int ks = 0; ks < 4; ++ks) {
            const bf16x8 bt = tr_frag1<SSD_RB>(Lb + SSD_OFF_B + ks * 32 * SSD_RB + wave * 32, lane);
            bf16x8 xf[4]; tr_frags4<SSD_RX>(Lb + SSD_OFF_XW + ks * 32 * SSD_RX, lane, xf);
#pragma unroll
            for (int pt = 0; pt < 4; ++pt) acc[pt] = __builtin_amdgcn_mfma_f32_16x16x32_bf16(bt, xf[pt], acc[pt], 0, 0, 0);
        }
        float* so = SS + ((((size_t)b * 32 + c) * 8 + h) << 13);
#pragma unroll
        for (int pt = 0; pt < 4; ++pt) *(float4*)(so + (pt * 16 + li) * 128 + wave * 16 + 4 * g) = make_float4(acc[pt][0], acc[pt][1], acc[pt][2], acc[pt][3]);
    }
}
__device__ __forceinline__ void ssd_out_unit(const u16* __restrict__ PROJ, const u16* __restrict__ PREV, const u16* __restrict__ CG, const float* __restrict__ YD,
                                             const float* __restrict__ ACS, const float* __restrict__ ng, int b, int j, int h, int lane, LAS float* red, u16* __restrict__ MIXED) {
    const int li = lane & 15, g = lane >> 4, grp = h >> 2, c = j >> 2; const size_t t0 = (size_t)b * SEQ + (size_t)j * 32;
    const u16* pv = PREV + ((((size_t)b * 32 + c) * 8 + h) << 13);
    f32x4 acc[4][2];
#pragma unroll
    for (int pt = 0; pt < 4; ++pt) { acc[pt][0] = (f32x4){0.f, 0.f, 0.f, 0.f}; acc[pt][1] = (f32x4){0.f, 0.f, 0.f, 0.f}; }
#pragma unroll
    for (int ks = 0; ks < 4; ++ks) {
        bf16x8 cf[2];
#pragma unroll
        for (int lt = 0; lt < 2; ++lt) cf[lt] = *(const bf16x8*)(CG + (t0 + lt * 16 + li) * 256 + grp * 128 + ks * 32 + g * 8);
#pragma unroll
        for (int pt = 0; pt < 4; ++pt) { const bf16x8 pf = *(const bf16x8*)(pv + (pt * 16 + li) * 128 + ks * 32 + g * 8);
            acc[pt][0] = __builtin_amdgcn_mfma_f32_16x16x32_bf16(pf, cf[0], acc[pt][0], 0, 0, 0);
            acc[pt][1] = __builtin_amdgcn_mfma_f32_16x16x32_bf16(pf, cf[1], acc[pt][1], 0, 0, 0); }
    }
    float ssq[2];
#pragma unroll
    for (int lt = 0; lt < 2; ++lt) {
        const size_t t = t0 + lt * 16 + li; const float ea = __expf(ACS[t * 8 + h]); float s = 0.f;
#pragma unroll
        for (int pt = 0; pt < 4; ++pt) {
            const int col = h * 64 + pt * 16 + 4 * g;
            const float4 yd = *(const float4*)(YD + t * 512 + col); const uint2 zr = *(const uint2*)(PROJ + t * DP + C_Z + col);
            f32x4 y; y[0] = (yd.x + ea * acc[pt][lt][0]) * siluf(__uint_as_float(zr.x << 16)); y[1] = (yd.y + ea * acc[pt][lt][1]) * siluf(__uint_as_float(zr.x & 0xffff0000u));
            y[2] = (yd.z + ea * acc[pt][lt][2]) * siluf(__uint_as_float(zr.y << 16)); y[3] = (yd.w + ea * acc[pt][lt][3]) * siluf(__uint_as_float(zr.y & 0xffff0000u));
            acc[pt][lt] = y; s += (y[0] * y[0] + y[1] * y[1]) + (y[2] * y[2] + y[3] * y[3]);
        }
        s += bperm(lane ^ 16, s); s += bperm(lane ^ 32, s); ssq[lt] = s;
        if (g == 0) red[h * 64 + lt * 16 + li] = s;
    }
    __syncthreads();
#pragma unroll
    for (int lt = 0; lt < 2; ++lt) {
        float tot = 0.f;
#pragma unroll
        for (int hh = 0; hh < 8; ++hh) tot += red[hh * 64 + lt * 16 + li];
        const float sc = rsqrtf(tot / 512.f + EPS);
        f32x4 o[4];
#pragma unroll
        for (int pt = 0; pt < 4; ++pt) o[pt] = acc[pt][lt];
        store_out_tile(o, sc, ng + h * 64, MIXED + (t0 + lt * 16 + li) * D + h * 64, g);
    }
}


constexpr int MOE_LDS_TAB = 131072;
template <bool GATEUP, int NK>
__device__ __forceinline__ void moe_unit(const u16* __restrict__ Abase, int lda, const float* __restrict__ W0, const float* __restrict__ W1, int ldw, int wcol0,
                                         int orow0, int ocol0, u16* __restrict__ Hout, float* __restrict__ Yout, LAS char* L, int tid) {
    const int wid = __builtin_amdgcn_readfirstlane(tid >> 6), lane = tid & 63, wr = wid >> 2, wc = wid & 3, li = lane & 15, g = lane >> 4;
    const LAS int* rowtab = (const LAS int*)(L + MOE_LDS_TAB);
    unsigned aoff[2][2];
#pragma unroll
    for (int i = 0; i < 2; ++i) { int R, C; pg8::stage_rc(tid * 16 + i * 8192, R, C);
#pragma unroll
        for (int hf = 0; hf < 2; ++hf) aoff[hf][i] = (unsigned)rowtab[hf * 128 + R] * (unsigned)lda + (unsigned)C; }
    const unsigned ldsw = (unsigned)wid * 1024u;
    const float* wp = GATEUP ? ((lane < 32 ? W0 : W1) + wcol0 + 4 * (lane & 31)) : (W0 + wcol0 + 4 * lane);
    wp += (size_t)(8 * wid) * ldw;
    unsigned bwr[4];
#pragma unroll
    for (int j = 0; j < 4; ++j) { const int hc = GATEUP ? 4 * (lane & 31) + j : 4 * lane + j;
        const int np = GATEUP ? ((hc >> 5) * 64 + (lane >> 5) * 32 + (hc & 31)) : hc;
        bwr[j] = (unsigned)((np >> 7) * 16384 + pg8::lds_byte(np & 127, 8 * wid)); }
    const int afr0 = wr * 16384 + pg8::lds_byte(li, g * 8), bfr0 = (wc >> 1) * 16384 + pg8::lds_byte((wc & 1) * 64 + li, g * 8);
    f32x4 acc[8][4];
#pragma unroll
    for (int m = 0; m < 8; ++m)
#pragma unroll
        for (int n = 0; n < 4; ++n) acc[m][n] = (f32x4){0.f, 0.f, 0.f, 0.f};
    float4 wreg[8];
#define MOE_LOADW(kt) do { _Pragma("unroll") for (int i = 0; i < 8; ++i) wreg[i] = *(const float4*)(wp + (size_t)((kt) * 64 + i) * ldw); } while (0)
#define MOE_STAGEA(buf, kt) do { _Pragma("unroll") for (int hf = 0; hf < 2; ++hf) _Pragma("unroll") for (int i = 0; i < 2; ++i) \
        __builtin_amdgcn_global_load_lds((const unsigned*)(Abase + aoff[hf][i] + (kt) * 64), (LAS unsigned*)(L + (buf) * 32768 + hf * 16384 + ldsw + i * 8192), 16, 0, 0); } while (0)
#define MOE_WRITEB(buf) do { _Pragma("unroll") for (int j = 0; j < 4; ++j) { u32x4v o; \
        o.x = pg8::cvt_pk_bf16(((const float*)&wreg[0])[j], ((const float*)&wreg[1])[j]); o.y = pg8::cvt_pk_bf16(((const float*)&wreg[2])[j], ((const float*)&wreg[3])[j]); \
        o.z = pg8::cvt_pk_bf16(((const float*)&wreg[4])[j], ((const float*)&wreg[5])[j]); o.w = pg8::cvt_pk_bf16(((const float*)&wreg[6])[j], ((const float*)&wreg[7])[j]); \
        *(LAS u32x4v*)(L + 65536 + (buf) * 32768 + bwr[j]) = o; } } while (0)
    MOE_LOADW(0); MOE_STAGEA(0, 0); MOE_WRITEB(0);
    asm volatile("s_waitcnt vmcnt(0) lgkmcnt(0)" ::: "memory"); __syncthreads();
#pragma unroll 1
    for (int kt = 0; kt < NK; ++kt) {
        const int cur = kt & 1, nxt = cur ^ 1;
        if (kt + 1 < NK) { MOE_LOADW(kt + 1); MOE_STAGEA(nxt, kt + 1); }
#pragma unroll
        for (int ks = 0; ks < 2; ++ks) {
            bf16x8 bf[4];
#pragma unroll
            for (int n = 0; n < 4; ++n) bf[n] = *(const LAS bf16x8*)(L + 65536 + cur * 32768 + bfr0 + n * 2048 + ks * 1024);
#pragma unroll
            for (int m = 0; m < 8; ++m) { const bf16x8 af = *(const LAS bf16x8*)(L + cur * 32768 + afr0 + m * 2048 + ks * 1024);
#pragma unroll
                for (int n = 0; n < 4; ++n) acc[m][n] = __builtin_amdgcn_mfma_f32_16x16x32_bf16(bf[n], af, acc[m][n], 0, 0, 0); }
        }
        if (kt + 1 < NK) MOE_WRITEB(nxt);
        asm volatile("s_waitcnt vmcnt(0) lgkmcnt(0)" ::: "memory"); __syncthreads();
    }
#undef MOE_LOADW
#undef MOE_STAGEA
#undef MOE_WRITEB
#pragma unroll
    for (int m = 0; m < 8; ++m) { const size_t row = (size_t)orow0 + wr * 128 + m * 16 + li;
        if (GATEUP) {
#pragma unroll
            for (int n = 0; n < 2; ++n) { float h[4];
#pragma unroll
                for (int r = 0; r < 4; ++r) { const float gt = acc[m][n][r], up = acc[m][n + 2][r]; h[r] = gt / (1.f + __expf(-gt)) * up; }
                *(uint2*)(Hout + row * DFF + ocol0 + wc * 32 + n * 16 + 4 * g) = make_uint2(pg8::cvt_pk_bf16(h[0], h[1]), pg8::cvt_pk_bf16(h[2], h[3])); }
        } else {
#pragma unroll
            for (int n = 0; n < 4; ++n) *(float4*)(Yout + row * D + ocol0 + wc * 64 + n * 16 + 4 * g) = make_float4(acc[m][n][0], acc[m][n][1], acc[m][n][2], acc[m][n][3]);
        }
    }
}
__device__ __forceinline__ int moe_tables(const int* __restrict__ cnt, LAS int* tab, int tid) {
    __syncthreads();
    if (tid == 0) { int off = 0;
        for (int e = 0; e < NE; ++e) { tab[e] = off << 8; const int nb = (cnt[e] + 255) >> 8; for (int i = 0; i < nb; ++i) tab[64 + off + i] = (e << 8) | i; off += nb; }
        tab[64 + 128] = off; }
    __syncthreads();
    return tab[64 + 128];
}

typedef const Params __attribute__((address_space(4)))* KP;
#define PARAMS KP kp_ = (KP)__builtin_amdgcn_kernarg_segment_ptr(); asm volatile("" : "+s"(kp_)); const __attribute__((address_space(4))) Params& p = *kp_;
__global__ void __launch_bounds__(NTHR, 2) mega(Params pk_unused) {
    extern __shared__ __attribute__((aligned(16))) char smem[];
    if (threadIdx.x == 0) *(uint4*)smem = make_uint4(0u, 0u, 0u, 0u);
    __syncthreads();
    XcdBarrier bar; { PARAMS bar = xcd_barrier_post(p.bar, (volatile LAS unsigned*)smem); }
    char* lds = smem + 16;
    LAS unsigned char* glds = (LAS unsigned char*)(smem + 16);
    const int G = gridDim.x, NGW = G * NWAVE;
    const long gsize = (long)G * NTHR;
#define IDS PARAMS int tid = threadIdx.x; asm volatile("" : "+v"(tid)); const int wave = tid >> 6, lane = tid & 63; const int gw = blockIdx.x * NWAVE + wave; const long gtid = (long)blockIdx.x * NTHR + tid; (void)wave; (void)lane; (void)gw; (void)gtid;

    { IDS
        const float4* s = (const float4*)p.x_in; float4* d = (float4*)p.X;
        for (long i = gtid; i < (long)T * D / 4; i += gsize) d[i] = s[i];
        float* scr = (float*)lds + wave * (64 * 33);
        constexpr int I_A = 32 * 48, I_B = 32 * 112, I_O = 32 * 64, I_L = I_A + I_B + I_O;
        for (int it = gw; it < 2 * I_L; it += NGW) {
            const int l = it / I_L; int r = it % I_L;
            const float* Wl = p.w_in + (size_t)l * D * DIN; u16* WTl = p.WinT + (size_t)l * DP * D;
            if (r < I_A) { transpose_item(Wl, DIN, 0, D, WTl, 0, 48, r, scr, lane); continue; } r -= I_A;
            if (r < I_B) { transpose_item(Wl, DIN, 1544, D, WTl, 1536, 112, r, scr, lane); continue; } r -= I_B;
            transpose_item(p.w_out + (size_t)l * D * D, D, 0, D, p.WoutT + (size_t)l * D * D, 0, 64, r, scr, lane);
        }
        for (long i = gtid; i < 2L * 80 * D; i += gsize) { const int l = (int)(i / (80 * D)), r = (int)(i % (80 * D)), c = r / D, k = r % D;
            const float w = (c < 8) ? p.rg_w[(size_t)l * D * 8 + k * 8 + c] : (c < 72) ? p.re_w[(size_t)l * D * 64 + k * 64 + (c - 8)] : 0.f;
            p.RT[i] = w * p.norm2_g[l * D + k]; }
        for (long i = gtid; i < 2L * 4 * 128 * 128; i += gsize) { const int e = (int)(i & 127), c = (int)((i >> 7) & 127); const long lg = i >> 14;
            p.WpT[(lg << 14) + e * 128 + c] = f2bf(p.pool_w[i]); }
        for (long i = gtid; i < 2L * 8 * D; i += gsize) { const int l = (int)(i / (8 * D)), r = (int)(i % (8 * D)), j = r / D, k = r % D;
            p.WDT[i] = p.w_in[(size_t)l * D * DIN + (size_t)k * DIN + 1536 + j]; }
    }
    xcd_barrier(bar);

#pragma unroll 1
    for (int l = 0; l < 2; ++l) {
        { IDS
            const float* g1 = p.norm1_g + l * D; const float* wdt = p.WDT + (size_t)l * 8 * D;
            LAS int* mtab = (LAS int*)(smem + 16);
            if (l > 0) moe_tables(p.ctrl + (l - 1) * 64, mtab, tid);
            for (int t = gw; t < T; t += NGW) {
                float4* xr = (float4*)(p.X + (size_t)t * D) + lane;
                float4 v[8]; float ss = 0.f;
#pragma unroll
                for (int j = 0; j < 8; ++j) v[j] = xr[64 * j];
                if (l > 0) {
                    const int r0 = mtab[p.tok_e[2 * t]] + p.tok_pos[2 * t], r1 = mtab[p.tok_e[2 * t + 1]] + p.tok_pos[2 * t + 1]; const float g0 = p.tok_g[2 * t], gg1 = p.tok_g[2 * t + 1];
                    const float4* y0 = (const float4*)(p.Yb + (size_t)r0 * D) + lane; const float4* y1 = (const float4*)(p.Yb + (size_t)r1 * D) + lane;
#pragma unroll
                    for (int j = 0; j < 8; ++j) { const float4 a = y0[64 * j], b = y1[64 * j];
                        v[j].x += g0 * a.x + gg1 * b.x; v[j].y += g0 * a.y + gg1 * b.y; v[j].z += g0 * a.z + gg1 * b.z; v[j].w += g0 * a.w + gg1 * b.w; xr[64 * j] = v[j]; }
                }
#pragma unroll
                for (int j = 0; j < 8; ++j) ss += v[j].x * v[j].x + v[j].y * v[j].y + v[j].z * v[j].z + v[j].w * v[j].w;
                const float r = rsqrtf(wave_sum(ss) / D + EPS);
                uint2* hb = (uint2*)(p.HB + (size_t)t * D) + lane;
#pragma unroll
                for (int j = 0; j < 8; ++j) {
                    const float4 gg = ((const float4*)g1)[lane + 64 * j];
                    v[j].x *= r * gg.x; v[j].y *= r * gg.y; v[j].z *= r * gg.z; v[j].w *= r * gg.w;
                    hb[64 * j] = make_uint2(pk2(v[j].x, v[j].y), pk2(v[j].z, v[j].w));
                }
#pragma unroll 1
                for (int q = 0; q < 8; ++q) {
                    const float4* w = (const float4*)(wdt + q * D) + lane; float s = 0.f;
#pragma unroll
                    for (int j = 0; j < 8; ++j) { const float4 ww = w[64 * j]; s += v[j].x * ww.x + v[j].y * ww.y + v[j].z * ww.z + v[j].w * ww.w; }
                    s = wave_sum(s); if (lane == 0) p.DTR[t * 8 + q] = s;
                }
            }
        }
        xcd_barrier(bar);
        {
            PARAMS
            pg8::Gemm g{p.HB, p.WinT + (size_t)l * DP * D, T, DP, D};
            pg8::StaticOrder so; so.init(T, DP, G, blockIdx.x);
            pg8::EpiStoreBf16 ep{p.PROJ, DP};
            pg8::gemm_phase(glds, g, so, ep, nullptr);
        }
        xcd_barrier(bar);
        { IDS
            for (int it = gw; it < T * 32; it += NGW) {
                const int t = it >> 5, r = it & 31, which = r >> 3, h = r & 7;
                const int col = (which == 0 ? C_SB : which == 1 ? C_SB + 512 : which == 2 ? C_DIL : C_DIL + 512) + h * 64 + lane;
                const float* g = (which == 0 ? p.sbq_g : which == 1 ? p.sbk_g : which == 2 ? p.dq_g : p.dk_g) + l * 64;
                u16* q = p.PROJ + (size_t)t * DP + col; const float v = bf2f(*q);
                const float ss = wave_sum(v * v);
                *q = f2bf(v * rsqrtf(ss / 64.f + EPS) * g[lane] * ((which & 1) ? 1.f : 0.125f));
            }
            for (int u = blockIdx.x; u < NB * 32 * 8; u += G) {
                const int b = u >> 8, c = (u >> 3) & 31, h = u & 7;
                ssd_chunk_unit(p.PROJ, p.DTR, p.conv_w + l * 4 * 1024, p.conv_b + l * 1024, p.dt_bias[l * 8 + h], -__expf(p.a_log[l * 8 + h]), p.ssd_d[l * 8 + h],
                               b, c, h, tid, (LAS char*)(smem + 16), p.YD, p.SS, p.ATOT, p.ACS, p.CG);
            }
            __syncthreads();
            {
                constexpr int PRS = 1040;
                LAS char* PL = (LAS char*)(smem + 16);
                const float* psc = p.pool_sc + l * 512; const u16* wpt = p.WpT + (size_t)l * 4 * 16384;
                for (int u = blockIdx.x; u < T / 32; u += G) {
                    const int tb0 = u * 32; __syncthreads();
                    { const int c = tid, gq = c >> 7, w = 2 << gq;
                      for (int tt = 0; tt < 32; ++tt) { const int t = tb0 + tt, s = t % SEQ; const int cn = min(w, s + 1);
                          float sum = 0.f; for (int i = 0; i < cn; ++i) sum += bf2f(p.PROJ[(size_t)(t - i) * DP + C_POOL + c]);
                          *(LAS u16*)(PL + tt * PRS + c * 2) = f2bf(sum / (float)cn - bf2f(p.PROJ[(size_t)t * DP + C_POOL + c])); } }
                    __syncthreads();
                    const int li = lane & 15, g4 = lane >> 4, gq = wave >> 1, eh = wave & 1;
                    f32x4 acc[4][2];
#pragma unroll
                    for (int et = 0; et < 4; ++et) { acc[et][0] = (f32x4){0.f, 0.f, 0.f, 0.f}; acc[et][1] = (f32x4){0.f, 0.f, 0.f, 0.f}; }
#pragma unroll
                    for (int ks = 0; ks < 4; ++ks) {
                        bf16x8 pf[2];
#pragma unroll
                        for (int tt = 0; tt < 2; ++tt) pf[tt] = *(const LAS bf16x8*)(PL + (tt * 16 + li) * PRS + (gq * 128 + ks * 32 + g4 * 8) * 2);
#pragma unroll
                        for (int et = 0; et < 4; ++et) { const bf16x8 wf = *(const bf16x8*)(wpt + gq * 16384 + (eh * 64 + et * 16 + li) * 128 + ks * 32 + g4 * 8);
                            acc[et][0] = __builtin_amdgcn_mfma_f32_16x16x32_bf16(wf, pf[0], acc[et][0], 0, 0, 0);
                            acc[et][1] = __builtin_amdgcn_mfma_f32_16x16x32_bf16(wf, pf[1], acc[et][1], 0, 0, 0); }
                    }
#pragma unroll
                    for (int tt = 0; tt < 2; ++tt)
#pragma unroll
                        for (int et = 0; et < 4; ++et) { const int col = gq * 128 + eh * 64 + et * 16 + 4 * g4; const float4 sc = *(const float4*)(psc + col);
                            *(uint2*)(p.MIXED + (size_t)(tb0 + tt * 16 + li) * D + 1536 + col) =
                                make_uint2(pk2(acc[et][tt][0] * sc.x, acc[et][tt][1] * sc.y), pk2(acc[et][tt][2] * sc.z, acc[et][tt][3] * sc.w)); }
                }
            }
        }
        xcd_barrier(bar);
        { IDS
        {
            for (int e = (int)gtid; e < NB * 8 * 8192; e += (int)gsize) {
                const int b = e >> 16, h = (e >> 13) & 7, pn = e & 8191; float st = 0.f;
#pragma unroll 8
                for (int c = 0; c < 32; ++c) { const size_t cu = ((size_t)b * 32 + c) * 8 + h; const size_t idx = (cu << 13) + pn;
                    p.PREV[idx] = f2bf(st); st = st * __expf(p.ATOT[cu]) + p.SS[idx]; }
            }
            LAS char* vl = (LAS char*)(smem + 16) + wave * ATT_VBYTES;
            LAS float* red = (LAS float*)((LAS char*)(smem + 16) + NWAVE * ATT_VBYTES);
            int par = 0;
            for (int u = blockIdx.x; u < 128 + 512; u += G, par ^= 1) {
                if (u < 128) sb_unit(p.PROJ, u >> 6, u & 63, wave, lane, vl, red + par * 512, p.sbo_g + l * 512, p.MIXED);
                else { const int v = u - 128; dil_unit(p.PROJ, v >> 8, (v >> 4) & 15, v & 15, wave, lane, vl, red + par * 512, p.do_g + l * 512, p.MIXED); }
            }
        }
        }
        xcd_barrier(bar);
        { IDS
            LAS float* red = (LAS float*)(smem + 16);
            int par = 0;
            for (int u = blockIdx.x; u < NB * 128; u += G, par ^= 1)
                ssd_out_unit(p.PROJ, p.PREV, p.CG, p.YD, p.ACS, p.ssd_ng + l * 512, u >> 7, u & 127, wave, lane, red + par * 512, p.MIXED);
        }
        xcd_barrier(bar);
        {
            PARAMS
            pg8::Gemm g{p.MIXED, p.WoutT + (size_t)l * D * D, T, D, D};
            pg8::StaticOrder so; so.init(T, D, G, blockIdx.x);
            pg8::EpiAddF32 ep{p.X, D};
            pg8::gemm_phase(glds, g, so, ep, nullptr);
        }
        xcd_barrier(bar);
        { IDS
            const float* g2 = p.norm2_g + l * D; const float* RTl = p.RT + (size_t)l * 80 * D; int* cnt = p.ctrl + l * 64;
            LAS float* part = (LAS float*)(smem + 16);
            LAS float* lg = part + 8 * 16 * 80;
            LAS float* rs = lg + 16 * 80;
            const int li = lane & 15, g4 = lane >> 4;
            for (int u = blockIdx.x; u < T / 16; u += G) {
                const int t0 = u * 16;
                __syncthreads();
#pragma unroll 1
                for (int tt = 0; tt < 2; ++tt) {
                    const int t = t0 + 2 * wave + tt;
                    const float4* xr = (const float4*)(p.X + (size_t)t * D) + lane;
                    float4 v[8]; float ss = 0.f;
#pragma unroll
                    for (int j = 0; j < 8; ++j) { v[j] = xr[64 * j]; ss += v[j].x * v[j].x + v[j].y * v[j].y + v[j].z * v[j].z + v[j].w * v[j].w; }
                    const float r = rsqrtf(wave_sum(ss) / D + EPS);
                    uint2* hb = (uint2*)(p.HB + (size_t)t * D) + lane;
#pragma unroll
                    for (int j = 0; j < 8; ++j) { const float4 gg = ((const float4*)g2)[lane + 64 * j];
                        hb[64 * j] = make_uint2(pk2(v[j].x * r * gg.x, v[j].y * r * gg.y), pk2(v[j].z * r * gg.z, v[j].w * r * gg.w)); }
                    if (lane == 0) rs[2 * wave + tt] = r;
                }
                f32x4 acc[5];
#pragma unroll
                for (int nt = 0; nt < 5; ++nt) acc[nt] = (f32x4){0.f, 0.f, 0.f, 0.f};
                const float* xa = p.X + (size_t)(t0 + li) * D + 256 * wave + 4 * g4; const float* rb = RTl + (size_t)li * D + 256 * wave + 4 * g4;
#pragma unroll 4
                for (int j = 0; j < 16; ++j) {
                    const float4 xv = *(const float4*)(xa + 16 * j);
#pragma unroll
                    for (int nt = 0; nt < 5; ++nt) { const float4 rv = *(const float4*)(rb + (size_t)nt * 16 * D + 16 * j);
                        acc[nt] = __builtin_amdgcn_mfma_f32_16x16x4f32(xv.x, rv.x, acc[nt], 0, 0, 0); acc[nt] = __builtin_amdgcn_mfma_f32_16x16x4f32(xv.y, rv.y, acc[nt], 0, 0, 0);
                        acc[nt] = __builtin_amdgcn_mfma_f32_16x16x4f32(xv.z, rv.z, acc[nt], 0, 0, 0); acc[nt] = __builtin_amdgcn_mfma_f32_16x16x4f32(xv.w, rv.w, acc[nt], 0, 0, 0); }
                }
#pragma unroll
                for (int nt = 0; nt < 5; ++nt)
#pragma unroll
                    for (int r = 0; r < 4; ++r) part[(wave * 16 + 4 * g4 + r) * 80 + nt * 16 + li] = acc[nt][r];
                __syncthreads();
                for (int i = tid; i < 16 * 72; i += NTHR) { const int tk = i / 72, c = i % 72; float s = 0.f;
#pragma unroll
                    for (int w = 0; w < 8; ++w) s += part[(w * 16 + tk) * 80 + c];
                    lg[tk * 80 + c] = s * rs[tk] + (c < 8 ? p.rg_b[l * 8 + c] : p.re_b[l * 64 + c - 8]); }
                __syncthreads();
                if (tid < 16) {
                    const LAS float* gl = lg + tid * 80; const int t = t0 + tid;
                    int gi = 0; float gm = gl[0];
                    for (int j = 1; j < 8; ++j) if (gl[j] > gm) { gm = gl[j]; gi = j; }
                    float gs = 0.f;
                    for (int j = 0; j < 8; ++j) gs += __expf(gl[j] - gm);
                    const float gp = 1.f / gs;
                    const LAS float* el = gl + 8 + gi * 8;
                    int i1 = 0; float m1 = el[0];
                    for (int j = 1; j < 8; ++j) if (el[j] > m1) { m1 = el[j]; i1 = j; }
                    int i2 = -1; float m2 = -1e30f;
                    for (int j = 0; j < 8; ++j) if (j != i1 && el[j] > m2) { m2 = el[j]; i2 = j; }
                    const float p2 = __expf(m2 - m1); const float ga = gp / (1.f + p2), gb = gp * p2 / (1.f + p2);
                    const int e1 = gi * 8 + i1, e2 = gi * 8 + i2;
                    p.tok_e[t * 2] = e1; p.tok_e[t * 2 + 1] = e2; p.tok_g[t * 2] = ga; p.tok_g[t * 2 + 1] = gb;
                    const int q1 = atomicAdd(&cnt[e1], 1), q2 = atomicAdd(&cnt[e2], 1);
                    p.tok_pos[t * 2] = q1; p.tok_pos[t * 2 + 1] = q2; p.tlist[e1 * T + q1] = t; p.tlist[e2 * T + q2] = t;
                }
            }
        }
        xcd_barrier(bar);
        { IDS
            LAS char* L = (LAS char*)(smem + 16); LAS int* tab = (LAS int*)(L + MOE_LDS_TAB + 1024); LAS int* rowtab = (LAS int*)(L + MOE_LDS_TAB);
            const int* cnt = p.ctrl + l * 64;
            const int nblk = moe_tables(cnt, tab, tid);
            for (int u = blockIdx.x; u < nblk * 4; u += G) {
                const int mb = u >> 2, nt = u & 3; const int em = tab[64 + mb], e = em >> 8, mt = em & 255; const int ce = cnt[e];
                __syncthreads();
                if (tid < 256) { const int i = mt * 256 + tid; rowtab[tid] = i < ce ? p.tlist[e * T + i] : 0; }
                __syncthreads();
                const size_t wo = ((size_t)l * NE + e) * (size_t)D * DFF;
                moe_unit<true, D / 64>(p.HB, D, p.wg + wo, p.wu + wo, DFF, nt * 128, tab[e] + mt * 256, nt * 128, p.Hb, nullptr, L, tid);
            }
        }
        xcd_barrier(bar);
        { IDS
            LAS char* L = (LAS char*)(smem + 16); LAS int* tab = (LAS int*)(L + MOE_LDS_TAB + 1024); LAS int* rowtab = (LAS int*)(L + MOE_LDS_TAB);
            const int nblk = moe_tables(p.ctrl + l * 64, tab, tid);
            for (int u = blockIdx.x; u < nblk * 8; u += G) {
                const int mb = u >> 3, nt = u & 7; const int em = tab[64 + mb], e = em >> 8, mt = em & 255; const int r0 = tab[e] + mt * 256;
                __syncthreads();
                if (tid < 256) rowtab[tid] = r0 + tid;
                __syncthreads();
                moe_unit<false, DFF / 64>(p.Hb, DFF, p.wd + ((size_t)l * NE + e) * (size_t)D * DFF, nullptr, D, nt * 256, r0, nt * 256, nullptr, p.Yb, L, tid);
            }
        }
        xcd_barrier(bar);
    }
    { IDS
    LAS int* mtab = (LAS int*)(smem + 16);
    moe_tables(p.ctrl + 64, mtab, tid);
    for (int t = gw; t < T; t += NGW) {
        float4* xr = (float4*)(p.X + (size_t)t * D) + lane;
        const int r0 = mtab[p.tok_e[2 * t]] + p.tok_pos[2 * t], r1 = mtab[p.tok_e[2 * t + 1]] + p.tok_pos[2 * t + 1]; const float g0 = p.tok_g[2 * t], g1 = p.tok_g[2 * t + 1];
        const float4* y0 = (const float4*)(p.Yb + (size_t)r0 * D) + lane; const float4* y1 = (const float4*)(p.Yb + (size_t)r1 * D) + lane;
#pragma unroll
        for (int j = 0; j < 8; ++j) { float4 v = xr[64 * j]; const float4 a = y0[64 * j], b = y1[64 * j];
            v.x += g0 * a.x + g1 * b.x; v.y += g0 * a.y + g1 * b.y; v.z += g0 * a.z + g1 * b.z; v.w += g0 * a.w + g1 * b.w; xr[64 * j] = v; }
    }
    }
}

extern "C" void kernel_launch(void* const* d_in, const int* in_sizes, int n_in, void* d_out, int out_size, void* d_ws, size_t ws_size, hipStream_t stream) {
    Params p{};
    const float** pin = (const float**)&p;
    for (int i = 0; i < 26; ++i) pin[i] = (const float*)d_in[i];
    p.X = (float*)d_out;
    char* ws = (char*)d_ws; size_t off = 0;
    auto alloc = [&](size_t bytes) { void* q = ws + off; off += (bytes + 255) & ~(size_t)255; return q; };
    constexpr size_t CTL_BYTES = (size_t)XCD_BAR_WORDS * 4 + CTRL_INTS * 4;
    p.bar = (unsigned*)alloc(CTL_BYTES); p.ctrl = (int*)(p.bar + XCD_BAR_WORDS);
    p.HB = (u16*)alloc((size_t)T * D * 2);
    p.MIXED = (u16*)alloc((size_t)T * D * 2);
    p.PROJ = (u16*)alloc((size_t)T * DP * 2);
    p.DTR = (float*)alloc((size_t)T * 8 * 4);
    p.YD = (float*)alloc((size_t)T * 512 * 4);
    p.SS = (float*)alloc((size_t)NB * 32 * 8 * 8192 * 4);
    p.PREV = (u16*)alloc((size_t)NB * 32 * 8 * 8192 * 2);
    p.ATOT = (float*)alloc((size_t)NB * 32 * 8 * 4);
    p.ACS = (float*)alloc((size_t)T * 8 * 4);
    p.CG = (u16*)alloc((size_t)T * 256 * 2);
    p.WinT = (u16*)alloc((size_t)2 * DP * D * 2);
    p.WoutT = (u16*)alloc((size_t)2 * D * D * 2);
    p.RT = (float*)alloc((size_t)2 * 80 * D * 4);
    p.WpT = (u16*)alloc((size_t)2 * 4 * 128 * 128 * 2);
    p.WDT = (float*)alloc((size_t)2 * 8 * D * 4);
    p.tok_e = (int*)alloc((size_t)T * 2 * 4); p.tok_pos = (int*)alloc((size_t)T * 2 * 4); p.tlist = (int*)alloc((size_t)NE * T * 4);
    p.tok_g = (float*)alloc((size_t)T * 2 * 4);
    p.Hb = (u16*)alloc((size_t)MAXBLK * 256 * DFF * 2);
    p.Yb = (float*)alloc((size_t)MAXBLK * 256 * D * 4);
    static int grid = 0;
    if (grid == 0) {
        if (off > ws_size || n_in != 26) { fprintf(stderr, "kernel_launch: workspace too small (%zu > %zu) or n_in %d\n", off, ws_size, n_in); grid = -1; return; }
        int dev = 0, cus = 0, per_cu = 0;
        if (hipGetDevice(&dev) != hipSuccess || hipDeviceGetAttribute(&cus, hipDeviceAttributeMultiprocessorCount, dev) != hipSuccess) { grid = -1; return; }
        if (hipFuncSetAttribute((const void*)mega, hipFuncAttributeMaxDynamicSharedMemorySize, LDS_BYTES) != hipSuccess) { fprintf(stderr, "hipFuncSetAttribute failed\n"); grid = -1; return; }
        if (hipOccupancyMaxActiveBlocksPerMultiprocessor(&per_cu, (const void*)mega, NTHR, LDS_BYTES) != hipSuccess || per_cu < 1)
            fprintf(stderr, "kernel_launch: occupancy query reports %d blocks per CU\n", per_cu);
        (void)hipGetLastError();
        grid = cus;
    }
    if (grid < 0) return;
    if (hipMemsetAsync(p.bar, 0, CTL_BYTES, stream) != hipSuccess) return;
    hipLaunchKernelGGL(mega, dim3(grid), dim3(NTHR), LDS_BYTES, stream, p);
}
```

```cpp
#include <hip/hip_runtime.h>
#include <hip/hip_bf16.h>
#include <stdint.h>
#include <stdio.h>

typedef unsigned short u16;
using bf16x8 = __attribute__((ext_vector_type(8))) short;
using f32x4  = __attribute__((ext_vector_type(4))) float;
#define LAS __attribute__((address_space(3)))

constexpr int NB = 2, SEQ = 4096, T = NB * SEQ, D = 2048, DIN = 5128, DP = 5120;
constexpr int NE = 64, DFF = 512;
constexpr int MAXBLK = 128;
constexpr float EPS = 1e-6f;
constexpr int C_Z = 0, C_XBC = 512, C_SB = 1536, C_DIL = 3072, C_POOL = 4608;
constexpr int NTHR = 512, NWAVE = 8;
constexpr int LDS_BYTES = 16 + 131072 + 4096;

__device__ __forceinline__ float bf2f(u16 h) { return __uint_as_float(((unsigned)h) << 16); }
__device__ __forceinline__ u16 f2bf(float f) { unsigned u = __float_as_uint(f); u += 0x7fffu + ((u >> 16) & 1u); return (u16)(u >> 16); }
__device__ __forceinline__ unsigned pk2(float lo, float hi) { return (unsigned)f2bf(lo) | ((unsigned)f2bf(hi) << 16); }
template <int O> __device__ __forceinline__ float swz_xor(float v) { return __int_as_float(__builtin_amdgcn_ds_swizzle(__float_as_int(v), (O << 10) | 0x1F)); }
__device__ __forceinline__ float rdlane(float v, int l) { return __int_as_float(__builtin_amdgcn_readlane(__float_as_int(v), l)); }
__device__ __forceinline__ float wave_sum(float v) {
    v += swz_xor<1>(v); v += swz_xor<2>(v); v += swz_xor<4>(v); v += swz_xor<8>(v); v += swz_xor<16>(v);
    return rdlane(v, 0) + rdlane(v, 32);
}
__device__ __forceinline__ float siluf(float x) { return x / (1.f + __expf(-x)); }
__device__ __forceinline__ float softplusf(float x) { return fmaxf(x, 0.f) + log1pf(__expf(-fabsf(x))); }

#define XB_TMO      128
#define XB_XCNT(j)  (256  + 64 * (j))
#define XB_XSUB(j)  (1280 + 64 * (j))
#define XB_XGEN(j)  (2304 + 64 * (j))
#define XB_TOP      3328
#define XB_TOPGEN   3392
#define XCD_BAR_WORDS 3456
#define XB_SPIN_CAP (1u << 18)
__device__ __forceinline__ unsigned xb_ld(unsigned* p)              { return __hip_atomic_load(p, __ATOMIC_RELAXED, __HIP_MEMORY_SCOPE_AGENT); }
__device__ __forceinline__ unsigned xb_add(unsigned* p, unsigned v) { return __hip_atomic_fetch_add(p, v, __ATOMIC_RELAXED, __HIP_MEMORY_SCOPE_AGENT); }
__device__ __forceinline__ unsigned xb_xcc_id() { return (unsigned)__builtin_amdgcn_s_getreg((3 << 11) | 20) & 0xFu; }
#define XB_SPIN(cond, bar) do { unsigned _sp = 0; while (cond) { __builtin_amdgcn_s_sleep(1); \
    if ((++_sp & 255u) == 0u) { if (xb_ld(&(bar)[XB_TMO])) break; if (_sp > XB_SPIN_CAP) { atomicAdd(&(bar)[XB_TMO], 1u); break; } } } } while (0)
struct XcdBarrier { unsigned* bar; unsigned x; volatile LAS unsigned* st; };
__device__ __forceinline__ XcdBarrier xcd_barrier_post(unsigned* bar, volatile LAS unsigned* st) {
    XcdBarrier b; b.bar = bar; b.x = xb_xcc_id(); b.st = st;
    if (threadIdx.x == 0) (void)xb_add(&bar[XB_XCNT(b.x)], 1u);
    return b;
}
__device__ __forceinline__ void xcd_barrier_complete(unsigned* bar, unsigned x, unsigned& nloc, unsigned& nx) {
    const unsigned G = gridDim.x * gridDim.y * gridDim.z;
    unsigned sum, cnt, mine, sp = 0u;
    for (;;) {
        sum = 0u; cnt = 0u; mine = 0u;
#pragma unroll
        for (unsigned j = 0; j < 16; ++j) { const unsigned c = xb_ld(&bar[XB_XCNT(j)]); sum += c; cnt += (c > 0u) ? 1u : 0u; mine = (j == x) ? c : mine; }
        if (sum == G) break;
        __builtin_amdgcn_s_sleep(1);
        if ((++sp & 255u) == 0u) { if (xb_ld(&bar[XB_TMO])) break; if (sp > XB_SPIN_CAP) { atomicAdd(&bar[XB_TMO], 1u); break; } }
    }
    nloc = mine > 0u ? mine : 1u; nx = cnt > 0u ? cnt : 1u;
}
__device__ __forceinline__ void xcd_barrier(const XcdBarrier& b) {
    asm volatile("s_waitcnt vmcnt(0)" ::: "memory");
    __syncthreads();
    if (threadIdx.x == 0) {
        unsigned* bar = b.bar; unsigned bx = b.x;
        asm volatile("" : "+s"(bar), "+s"(bx));
        __builtin_amdgcn_s_waitcnt(0);
        unsigned nloc = b.st[0], nx = b.st[1];
        if (nloc == 0u) { xcd_barrier_complete(bar, bx, nloc, nx); b.st[0] = nloc; b.st[1] = nx; }
        const unsigned old = xb_add(&bar[XB_XSUB(bx)], 1u);
        const unsigned gen = old / nloc;
        if (old + 1u == (gen + 1u) * nloc) {
            __builtin_amdgcn_fence(__ATOMIC_RELEASE, "agent");
            asm volatile("s_waitcnt vmcnt(0)" ::: "memory");
            const unsigned og = xb_add(&bar[XB_TOP], 1u);
            const unsigned tg = og / nx;
            if (og + 1u == (tg + 1u) * nx) xb_add(&bar[XB_TOPGEN], 1u);
            else XB_SPIN(xb_ld(&bar[XB_TOPGEN]) == tg, bar);
            __builtin_amdgcn_fence(__ATOMIC_ACQUIRE, "agent");
            xb_add(&bar[XB_XGEN(bx)], 1u);
            asm volatile("s_waitcnt vmcnt(0)" ::: "memory");
        } else {
            XB_SPIN(xb_ld(&bar[XB_XGEN(bx)]) == gen, bar);
            __builtin_amdgcn_fence(__ATOMIC_ACQUIRE, "agent");
            asm volatile("s_waitcnt vmcnt(0)" ::: "memory");
        }
    }
    __syncthreads();
}

struct Params {
    const float *x_in, *norm1_g, *w_in, *conv_w, *conv_b, *dt_bias, *a_log, *ssd_d, *ssd_ng, *sbq_g, *sbk_g, *sbo_g, *dq_g, *dk_g, *do_g,
                *pool_w, *pool_sc, *w_out, *norm2_g, *rg_w, *rg_b, *re_w, *re_b, *wg, *wu, *wd;
    float* X; unsigned* bar; int* ctrl;
    u16 *HB, *MIXED, *WinT, *WoutT, *Hb;
    u16 *PROJ, *PREV, *CG, *WpT; float *DTR, *YD, *SS, *ATOT, *ACS, *RT, *WDT, *tok_g, *Yb;
    int *tok_e, *tok_pos, *tlist;
};
constexpr int CTRL_INTS = 1024;

namespace pg8 {
#define PG8_LAS __attribute__((address_space(3)))
typedef unsigned short bf16_t;
typedef short bf16x8 __attribute__((ext_vector_type(8)));
typedef float f32x4 __attribute__((ext_vector_type(4)));
typedef unsigned u32x4 __attribute__((ext_vector_type(4)));
constexpr int BM = 256, BK = 64, HALF = 128, HTB = HALF * BK * 2  , STAGE_BYTES = 8 * HTB, NXCD = 8, WGM = 8;

__host__ __device__ __forceinline__ int lds_byte(int r, int c) { const int st = (r >> 4) * 2 + (c >> 5), rr = r & 15, cc = c & 31, ob = rr * 64 + cc * 2; return st * 1024 + (ob ^ (((ob >> 9) & 1) << 5)); }
__host__ __device__ __forceinline__ void stage_rc(int b, int& R, int& C) { const int st = b / 1024, sb = b % 1024, swz = sb ^ (((sb >> 9) & 1) << 5); R = (st >> 1) * 16 + swz / 64; C = (st & 1) * 32 + (swz % 64) / 2; }
__host__ __device__ __forceinline__ int perm32(int rho) { const int n = rho >> 4, i = rho & 15; return 8 * (i >> 2) + 4 * n + (i & 3); }

struct Unit { int pm, pn; };
struct Gemm { const bf16_t* A; const bf16_t* Bt; int M, N, K; };

struct StaticOrder {
    int nM, nN, nwg, G, c;
    __host__ __device__ void init(int M, int N, int G_, int c_) { nM = M / BM; nN = N / BM; nwg = nM * nN; G = G_; c = c_; }
    __host__ __device__ bool next(int i, Unit& u) const {
        const long L = (long)i * G + c; if (L >= nwg) return false;
        int wgid = (int)L; { const int q = nwg / NXCD, r = nwg % NXCD, xcd = wgid % NXCD, off = wgid / NXCD; wgid = (xcd < r ? xcd * (q + 1) : r * (q + 1) + (xcd - r) * q) + off; }
        const int nig = WGM * nN, gid = wgid / nig, fm = gid * WGM, gsz = (nM - fm) < WGM ? (nM - fm) : WGM;
        u.pm = fm + ((wgid % nig) % gsz); u.pn = (wgid % nig) / gsz; return true;
    }
    __device__ __forceinline__ void a_ready(const Unit&) const {}
    __device__ __forceinline__ void done(const Unit&) const {}
};
__device__ __forceinline__ unsigned cvt_pk_bf16(float lo, float hi) { unsigned r; asm volatile("v_cvt_pk_bf16_f32 %0, %1, %2" : "=v"(r) : "v"(lo), "v"(hi)); return r; }
typedef float f32x2 __attribute__((ext_vector_type(2)));
struct EpiF32 {
    static constexpr bool PERM = false, AFTER_DRAIN = false;
    float* C; int ldc; const float* bias;
    __device__ __forceinline__ void operator()(const f32x4 (&acc)[2][2][4][2], const Unit& u, int wr, int wc, int fr, int fq) const {
        const int row0 = u.pm * BM + wr * 64 + fr, col0 = u.pn * BM + wc * 32 + 4 * fq;
        f32x4 bv[2][2];
#pragma unroll
        for (int bj = 0; bj < 2; ++bj)
#pragma unroll
            for (int n = 0; n < 2; ++n) bv[bj][n] = bias ? *(const f32x4*)(bias + col0 + bj * HALF + n * 16) : (f32x4){0.f, 0.f, 0.f, 0.f};
#pragma unroll
        for (int ai = 0; ai < 2; ++ai)
#pragma unroll
            for (int m = 0; m < 4; ++m) { float* rowp = C + (size_t)(row0 + ai * HALF + m * 16) * ldc + col0;
#pragma unroll
                for (int bj = 0; bj < 2; ++bj)
#pragma unroll
                    for (int n = 0; n < 2; ++n) *(f32x4*)(rowp + bj * HALF + n * 16) = acc[ai][bj][m][n] + bv[bj][n]; }
    }
};
template <class Epi, class Sched, bool STAMP = false>
__device__ __forceinline__ void gemm_phase(PG8_LAS unsigned char* lds, const Gemm g, const Sched& S, const Epi& E, unsigned long long* stamps) {
    int tid = threadIdx.x; asm volatile("" : "+v"(tid));
    const int wid = __builtin_amdgcn_readfirstlane(tid >> 6), lane = tid & 63, wr = wid >> 2, wc = wid & 3, fr = lane & 15, fq = lane >> 4;
    const int K = g.K, nt = K / BK;
    int ts_lo = 0, ts_hi = 0, nts = 0; const unsigned long long rt_entry = STAMP ? (unsigned long long)wall_clock64() : 0ull;
#define PG8_STAMP() do { if (STAMP && wid == 0 && nts < 64) { const unsigned long long _c = (unsigned long long)clock64(); \
        ts_lo = (lane == nts) ? (int)(unsigned)_c : ts_lo; ts_hi = (lane == nts) ? (int)(unsigned)(_c >> 32) : ts_hi; ++nts; } } while (0)
    PG8_STAMP();
    unsigned voffA[2], voffB[2];
#pragma unroll
    for (int i = 0; i < 2; ++i) { int R, C; stage_rc(tid * 16 + i * 8192, R, C); const int Rb = Epi::PERM ? ((R & ~31) + perm32(R & 31)) : R;
        voffA[i] = (unsigned)(R * K + C) * 2u; voffB[i] = (unsigned)(Rb * K + C) * 2u; }
    const size_t kstep = (size_t)(BK * 2);
    const size_t hstep = (size_t)HALF * K * 2;
    const size_t tstep = 2 * hstep;
    const unsigned ldsw = (unsigned)wid * 1024u;
    const int aoff = lds_byte(wr * 64 + fr, fq * 8), boff = lds_byte(wc * 32 + fr, fq * 8);
#define PG8_SA(b, h) (((b) * 2 + (h)) * HTB)
#define PG8_SB(b, h) ((4 + (b) * 2 + (h)) * HTB)
#define PG8_STAGE(bufoff, gbase, voff) do { _Pragma("unroll") for (int _i = 0; _i < 2; ++_i) \
        __builtin_amdgcn_global_load_lds((const unsigned*)((const char*)(gbase) + (voff)[_i]), (PG8_LAS unsigned*)(lds + (bufoff) + ldsw + _i * 8192), 16, 0, 0); } while (0)
#define PG8_LDA(dst, b, h) do { _Pragma("unroll") for (int m = 0; m < 4; ++m) _Pragma("unroll") for (int k = 0; k < 2; ++k) dst[m][k] = *(const PG8_LAS bf16x8*)(lds + PG8_SA(b, h) + aoff + m * 2048 + k * 1024); } while (0)
#define PG8_LDB(dst, b, h) do { _Pragma("unroll") for (int n = 0; n < 2; ++n) _Pragma("unroll") for (int k = 0; k < 2; ++k) dst[n][k] = *(const PG8_LAS bf16x8*)(lds + PG8_SB(b, h) + boff + n * 2048 + k * 1024); } while (0)
#define PG8_MMA(ai, bj, At, Bt) do { __builtin_amdgcn_s_setprio(1); _Pragma("unroll") for (int m = 0; m < 4; ++m) _Pragma("unroll") for (int n = 0; n < 2; ++n) _Pragma("unroll") for (int k = 0; k < 2; ++k) \
        acc[ai][bj][m][n] = __builtin_amdgcn_mfma_f32_16x16x32_bf16(Bt[n][k], At[m][k], acc[ai][bj][m][n], 0, 0, 0); __builtin_amdgcn_s_setprio(0); } while (0)
#define PG8_WAIT_V(n) asm volatile("s_waitcnt vmcnt(" #n ")" ::: "memory")
#define PG8_WAIT_L(n) asm volatile("s_waitcnt lgkmcnt(" #n ")" ::: "memory")
#define PG8_BAR __builtin_amdgcn_s_barrier()
#define PG8_SCHED __builtin_amdgcn_sched_barrier(0)
    Unit cur, nxt; int ui = 0;
    if (!S.next(0, cur)) return;
    f32x4 acc[2][2][4][2];
#pragma unroll
    for (int a = 0; a < 2; ++a)
#pragma unroll
        for (int b = 0; b < 2; ++b)
#pragma unroll
            for (int m = 0; m < 4; ++m)
#pragma unroll
                for (int n = 0; n < 2; ++n) acc[a][b][m][n] = (f32x4){0.f, 0.f, 0.f, 0.f};
    bf16x8 At[4][2], B0[2][2], B1[2][2];
    const char* cA = (const char*)g.A + (size_t)cur.pm * tstep; const char* cB = (const char*)g.Bt + (size_t)cur.pn * tstep;
    S.a_ready(cur);
    PG8_STAGE(PG8_SB(0, 0), cB, voffB); PG8_STAGE(PG8_SA(0, 0), cA, voffA); PG8_STAGE(PG8_SB(0, 1), cB + hstep, voffB); PG8_STAGE(PG8_SA(0, 1), cA + hstep, voffA);
    if (wr == 1) PG8_BAR;
    PG8_WAIT_V(4); PG8_BAR;
    PG8_STAGE(PG8_SB(1, 0), cB + kstep, voffB); PG8_STAGE(PG8_SA(1, 0), cA + kstep, voffA); PG8_STAGE(PG8_SB(1, 1), cB + hstep + kstep, voffB);
    PG8_WAIT_V(6); PG8_BAR;
    PG8_STAMP();
    for (;;) {
        const bool has_next = S.next(ui + 1, nxt);
        const char* nA = has_next ? (const char*)g.A + (size_t)nxt.pm * tstep : cA; const char* nB = has_next ? (const char*)g.Bt + (size_t)nxt.pn * tstep : cB;
        for (int t = 0; t < nt; t += 2) {
            const bool last = (t == nt - 2);
            const char* a1 = cA + (size_t)(t + 1) * kstep;
            const char* a2 = last ? nA : cA + (size_t)(t + 2) * kstep; const char* b2 = last ? nB : cB + (size_t)(t + 2) * kstep;
            const char* a3 = a2 + kstep; const char* b3 = b2 + kstep;
            if (last && has_next) S.a_ready(nxt);
            PG8_LDB(B0, 0, 0); PG8_SCHED; PG8_LDA(At, 0, 0); PG8_STAGE(PG8_SA(1, 1), a1 + hstep, voffA);
            PG8_WAIT_L(8); PG8_BAR; PG8_WAIT_L(0); PG8_MMA(0, 0, At, B0); PG8_BAR; PG8_SCHED;
            PG8_LDB(B1, 0, 1); PG8_STAGE(PG8_SB(0, 0), b2, voffB);
            PG8_BAR; PG8_WAIT_L(0); PG8_MMA(0, 1, At, B1); PG8_BAR;
            PG8_LDA(At, 0, 1); PG8_STAGE(PG8_SA(0, 0), a2, voffA);
            PG8_BAR; PG8_WAIT_L(0); PG8_MMA(1, 0, At, B0); PG8_BAR; PG8_SCHED;
            PG8_STAGE(PG8_SB(0, 1), b2 + hstep, voffB);
            PG8_WAIT_V(6); PG8_BAR; PG8_MMA(1, 1, At, B1); PG8_BAR;
            PG8_LDB(B0, 1, 0); PG8_SCHED; PG8_LDA(At, 1, 0); PG8_STAGE(PG8_SA(0, 1), a2 + hstep, voffA);
            PG8_WAIT_L(8); PG8_BAR; PG8_WAIT_L(0); PG8_MMA(0, 0, At, B0); PG8_BAR; PG8_SCHED;
            PG8_LDB(B1, 1, 1); PG8_STAGE(PG8_SB(1, 0), b3, voffB);
            PG8_BAR; PG8_WAIT_L(0); PG8_MMA(0, 1, At, B1); PG8_BAR;
            PG8_LDA(At, 1, 1); PG8_STAGE(PG8_SA(1, 0), a3, voffA);
            PG8_BAR; PG8_WAIT_L(0); PG8_MMA(1, 0, At, B0); PG8_BAR; PG8_SCHED;
            PG8_STAGE(PG8_SB(1, 1), b3 + hstep, voffB);
            PG8_WAIT_V(6); PG8_BAR; PG8_MMA(1, 1, At, B1); PG8_BAR;
        }
        PG8_STAMP();
        if constexpr (!Epi::AFTER_DRAIN) { E(acc, cur, wr, wc, fr, fq); S.done(cur); }
        PG8_STAMP();
        if (!has_next) break;
#pragma unroll
        for (int a = 0; a < 2; ++a)
#pragma unroll
            for (int b = 0; b < 2; ++b)
#pragma unroll
                for (int m = 0; m < 4; ++m)
#pragma unroll
                    for (int n = 0; n < 2; ++n) acc[a][b][m][n] = (f32x4){0.f, 0.f, 0.f, 0.f};
        cur = nxt; cA = nA; cB = nB; ++ui;
    }
    PG8_WAIT_V(0);
    if (wr == 0) PG8_BAR;
    PG8_BAR;
    if constexpr (Epi::AFTER_DRAIN) { E.fused(acc, cur, wr, wc, fr, fq, lds, wid, lane); S.done(cur); }
    PG8_STAMP();
    if (STAMP && wid == 0) { stamps[lane] = lane < nts ? (((unsigned long long)(unsigned)ts_hi << 32) | (unsigned)ts_lo) : 0ull;
        if (lane == 62) stamps[62] = rt_entry; if (lane == 63) stamps[63] = (unsigned long long)wall_clock64(); }
#undef PG8_STAMP
#undef PG8_SA
#undef PG8_SB
#undef PG8_STAGE
#undef PG8_LDA
#undef PG8_LDB
#undef PG8_MMA
#undef PG8_WAIT_V
#undef PG8_WAIT_L
#undef PG8_BAR
#undef PG8_SCHED
}
}

namespace pg8 {
struct EpiStoreBf16 {
    static constexpr bool PERM = true, AFTER_DRAIN = false;
    bf16_t* O; int ldc;
    __device__ __forceinline__ void operator()(const f32x4 (&acc)[2][2][4][2], const Unit& u, int wr, int wc, int fr, int fq) const {
        const int row0 = u.pm * BM + wr * 64 + fr, col0 = u.pn * BM + wc * 32 + 8 * fq;
#pragma unroll
        for (int ai = 0; ai < 2; ++ai)
#pragma unroll
            for (int m = 0; m < 4; ++m) { bf16_t* rowp = O + (size_t)(row0 + ai * HALF + m * 16) * ldc + col0;
#pragma unroll
                for (int bj = 0; bj < 2; ++bj) { const f32x4 v0 = acc[ai][bj][m][0], v1 = acc[ai][bj][m][1];
                    u32x4 w; w.x = cvt_pk_bf16(v0[0], v0[1]); w.y = cvt_pk_bf16(v0[2], v0[3]); w.z = cvt_pk_bf16(v1[0], v1[1]); w.w = cvt_pk_bf16(v1[2], v1[3]);
                    *(u32x4*)(rowp + bj * HALF) = w; } }
    }
};
struct EpiAddF32 {
    static constexpr bool PERM = false, AFTER_DRAIN = false;
    float* C; int ldc;
    __device__ __forceinline__ void operator()(const f32x4 (&acc)[2][2][4][2], const Unit& u, int wr, int wc, int fr, int fq) const {
        const int row0 = u.pm * BM + wr * 64 + fr, col0 = u.pn * BM + wc * 32 + 4 * fq;
#pragma unroll
        for (int ai = 0; ai < 2; ++ai)
#pragma unroll
            for (int m = 0; m < 4; ++m) { float* rowp = C + (size_t)(row0 + ai * HALF + m * 16) * ldc + col0;
#pragma unroll
                for (int bj = 0; bj < 2; ++bj)
#pragma unroll
                    for (int n = 0; n < 2; ++n) { f32x4* q = (f32x4*)(rowp + bj * HALF + n * 16); *q = *q + acc[ai][bj][m][n]; } }
    }
};
struct EpiDownF32 {
    static constexpr bool PERM = false, AFTER_DRAIN = false;
    float* C;
    __device__ __forceinline__ void operator()(const f32x4 (&acc)[2][2][4][2], const Unit& u, int wr, int wc, int fr, int fq) const {
        const int row0 = u.pm * BM + wr * 64 + fr, col0 = (u.pn & 7) * BM + wc * 32 + 4 * fq;
#pragma unroll
        for (int ai = 0; ai < 2; ++ai)
#pragma unroll
            for (int m = 0; m < 4; ++m) { float* rowp = C + (size_t)(row0 + ai * HALF + m * 16) * 2048 + col0;
#pragma unroll
                for (int bj = 0; bj < 2; ++bj)
#pragma unroll
                    for (int n = 0; n < 2; ++n) *(f32x4*)(rowp + bj * HALF + n * 16) = acc[ai][bj][m][n]; }
    }
};
struct EpiSwiglu {
    static constexpr bool PERM = true, AFTER_DRAIN = false;
    bf16_t* H;
    __device__ __forceinline__ void operator()(const f32x4 (&acc)[2][2][4][2], const Unit& u, int wr, int wc, int fr, int fq) const {
        const int row0 = u.pm * BM + wr * 64 + fr, col0 = (u.pn & 3) * 128 + wc * 32 + 8 * fq;
#pragma unroll
        for (int ai = 0; ai < 2; ++ai)
#pragma unroll
            for (int m = 0; m < 4; ++m) { bf16_t* rowp = H + (size_t)(row0 + ai * HALF + m * 16) * 512 + col0;
                float h[8];
#pragma unroll
                for (int n = 0; n < 2; ++n)
#pragma unroll
                    for (int j = 0; j < 4; ++j) { const float g = acc[ai][0][m][n][j], up = acc[ai][1][m][n][j]; h[n * 4 + j] = g / (1.f + __expf(-g)) * up; }
                u32x4 w; w.x = cvt_pk_bf16(h[0], h[1]); w.y = cvt_pk_bf16(h[2], h[3]); w.z = cvt_pk_bf16(h[4], h[5]); w.w = cvt_pk_bf16(h[6], h[7]);
                *(u32x4*)rowp = w; }
    }
};
struct MoeOrder {
    const int* blk_e; int ntile, G, c, shift;
    __device__ __forceinline__ bool next(int i, Unit& u) const {
        const int L = i * G + c; if (L >= ntile) return false;
        const int mb = L >> shift, nt = L & ((1 << shift) - 1);
        u.pm = mb; u.pn = (blk_e[mb] << shift) + nt; return true;
    }
    __device__ __forceinline__ void a_ready(const Unit&) const {}
    __device__ __forceinline__ void done(const Unit&) const {}
};
}

__device__ __forceinline__ void transpose_item(const float* __restrict__ W, int ldin, int n0, int K, u16* __restrict__ WT, int row0, int nbn, int item, float* scr, int lane, int ilv = -1) {
    const int kb = item / nbn, nb = item % nbn, k0 = 64 * kb, nn = 32 * nb;
    const int rb = ilv < 0 ? row0 + nn : row0 + (nn >> 7) * 256 + ilv * 128 + (nn & 127);
#pragma unroll 8
    for (int i = 0; i < 32; ++i) { const int kk = 2 * i + (lane >> 5); scr[kk * 33 + (lane & 31)] = W[(size_t)(k0 + kk) * ldin + n0 + nn + (lane & 31)]; }
    asm volatile("s_waitcnt lgkmcnt(0)" ::: "memory");
    const int c = lane & 7;
#pragma unroll
    for (int j = 0; j < 4; ++j) { const int n = (lane >> 3) + 8 * j; const float* s = scr + (8 * c) * 33 + n;
        uint4 o; o.x = pk2(s[0 * 33], s[1 * 33]); o.y = pk2(s[2 * 33], s[3 * 33]); o.z = pk2(s[4 * 33], s[5 * 33]); o.w = pk2(s[6 * 33], s[7 * 33]);
        *(uint4*)(WT + (size_t)(rb + n) * K + k0 + 8 * c) = o; }
    asm volatile("s_waitcnt lgkmcnt(0)" ::: "memory");
}
__device__ __forceinline__ void convert_moe_weights(const float* wg, const float* wu, const float* wd, u16* WguT, u16* WdT, int l, float* scr, int gw, int NGW, int lane) {
    constexpr int IPE = 512;
    for (int it = gw; it < 3 * NE * IPE; it += NGW) {
        const int which = it / (NE * IPE), r = it % (NE * IPE), e = r / IPE, item = r % IPE;
        const size_t eo = ((size_t)l * NE + e) * (size_t)D * DFF;
        if (which == 0)      transpose_item(wg + eo, DFF, 0, D, WguT + (size_t)e * 1024 * D, 0, DFF / 32, item, scr, lane, 0);
        else if (which == 1) transpose_item(wu + eo, DFF, 0, D, WguT + (size_t)e * 1024 * D, 0, DFF / 32, item, scr, lane, 1);
        else                 transpose_item(wd + eo, D, 0, DFF, WdT + (size_t)e * D * DFF, 0, D / 32, item, scr, lane);
    }
}


constexpr int ATT_RS = 144;
constexpr int ATT_VBYTES = 32 * ATT_RS;
typedef long long i64;
typedef unsigned u32x4v __attribute__((ext_vector_type(4)));
typedef unsigned u32x2v __attribute__((ext_vector_type(2)));
__device__ __forceinline__ float bperm(int srclane, float v) { return __int_as_float(__builtin_amdgcn_ds_bpermute(srclane << 2, __float_as_int(v))); }
__device__ __forceinline__ float softplus_fast(float z) { return fmaxf(z, 0.f) + __logf(1.f + __expf(-fabsf(z))); }
__device__ __forceinline__ void vt_frags(unsigned vaddr, int lane, bf16x8 (&vf)[4]) {
    const unsigned a = vaddr + (unsigned)((4 * (lane >> 4) + ((lane & 15) >> 2)) * ATT_RS + (lane & 3) * 8);
    i64 r0, r1, r2, r3, r4, r5, r6, r7;
    asm volatile("s_waitcnt lgkmcnt(0)\n\t"
                 "ds_read_b64_tr_b16 %0, %8\n\tds_read_b64_tr_b16 %1, %8 offset:2304\n\t"
                 "ds_read_b64_tr_b16 %2, %8 offset:32\n\tds_read_b64_tr_b16 %3, %8 offset:2336\n\t"
                 "ds_read_b64_tr_b16 %4, %8 offset:64\n\tds_read_b64_tr_b16 %5, %8 offset:2368\n\t"
                 "ds_read_b64_tr_b16 %6, %8 offset:96\n\tds_read_b64_tr_b16 %7, %8 offset:2400\n\t"
                 "s_waitcnt lgkmcnt(0)"
                 : "=&v"(r0), "=&v"(r1), "=&v"(r2), "=&v"(r3), "=&v"(r4), "=&v"(r5), "=&v"(r6), "=&v"(r7) : "v"(a) : "memory");
    typedef i64 i64x2 __attribute__((ext_vector_type(2)));
    i64x2 t; t.x = r0; t.y = r1; vf[0] = __builtin_bit_cast(bf16x8, t); t.x = r2; t.y = r3; vf[1] = __builtin_bit_cast(bf16x8, t);
    t.x = r4; t.y = r5; vf[2] = __builtin_bit_cast(bf16x8, t); t.x = r6; t.y = r7; vf[3] = __builtin_bit_cast(bf16x8, t);
}
__device__ __forceinline__ bf16x8 pack8(const float (&a)[4], const float (&b)[4]) {
    u32x4v w; w.x = pk2(a[0], a[1]); w.y = pk2(a[2], a[3]); w.z = pk2(b[0], b[1]); w.w = pk2(b[2], b[3]);
    return __builtin_bit_cast(bf16x8, w);
}
__device__ __forceinline__ void store_out_tile(const f32x4 (&o)[4], float scale, const float* __restrict__ gain, u16* __restrict__ dst  , int g) {
#pragma unroll
    for (int dt = 0; dt < 4; ++dt) { const float4 gg = *(const float4*)(gain + dt * 16 + 4 * g);
        *(uint2*)(dst + dt * 16 + 4 * g) = make_uint2(pk2(o[dt][0] * scale * gg.x, o[dt][1] * scale * gg.y), pk2(o[dt][2] * scale * gg.z, o[dt][3] * scale * gg.w)); }
}

__device__ __forceinline__ void sb_unit(const u16* __restrict__ PROJ, int b, int qb, int h, int lane, LAS char* vl, LAS float* red,
                                        const float* __restrict__ gout, u16* __restrict__ MIXED) {
    const int li = lane & 15, g = lane >> 4; const size_t tb = (size_t)b * SEQ; const int q0 = qb * 64;
    const u16* Qp = PROJ + C_SB + h * 64; const u16* Kp = Qp + 512; const u16* Vp = Qp + 1024;
    const unsigned vaddr = (unsigned)(size_t)vl;
    bf16x8 qf[4][2];
#pragma unroll
    for (int qt = 0; qt < 4; ++qt)
#pragma unroll
        for (int s = 0; s < 2; ++s) qf[qt][s] = *(const bf16x8*)(Qp + (tb + q0 + qt * 16 + li) * DP + 32 * s + 8 * g);
    f32x4 acc[4][4];
#pragma unroll
    for (int qt = 0; qt < 4; ++qt)
#pragma unroll
        for (int dt = 0; dt < 4; ++dt) acc[qt][dt] = (f32x4){0.f, 0.f, 0.f, 0.f};
    float carry[4] = {0.f, 0.f, 0.f, 0.f};
    for (int k0 = q0 + 32; k0 >= 0; k0 -= 32) {
        bf16x8 kf[2][2];
#pragma unroll
        for (int kt = 0; kt < 2; ++kt)
#pragma unroll
            for (int s = 0; s < 2; ++s) kf[kt][s] = *(const bf16x8*)(Kp + (tb + k0 + kt * 16 + li) * DP + 32 * s + 8 * g);
#pragma unroll
        for (int u = 0; u < 4; ++u) { const int c = lane + 64 * u, row = c >> 3, cc = c & 7;
            *(LAS u32x4v*)(vl + row * ATT_RS + cc * 16) = *(const u32x4v*)(Vp + (tb + k0 + row) * DP + cc * 8); }
        bf16x8 pf[4];
#pragma unroll
        for (int qt = 0; qt < 4; ++qt) {
            const int qpos = q0 + qt * 16 + li;
            float w[2][4];
#pragma unroll
            for (int kt = 1; kt >= 0; --kt) {
                f32x4 st = __builtin_amdgcn_mfma_f32_16x16x32_bf16(kf[kt][0], qf[qt][0], (f32x4){0.f, 0.f, 0.f, 0.f}, 0, 0, 0);
                st = __builtin_amdgcn_mfma_f32_16x16x32_bf16(kf[kt][1], qf[qt][1], st, 0, 0, 0);
                const int kb = k0 + kt * 16 + 4 * g;
                float sp[4];
#pragma unroll
                for (int r = 0; r < 4; ++r) sp[r] = (kb + r < qpos) ? softplus_fast(st[r]) : 0.f;
                const float G = (sp[0] + sp[1]) + (sp[2] + sp[3]);
                const float x1 = bperm(lane ^ 16, G), hs = G + x1, x2 = bperm(lane ^ 32, hs);
                float rs = carry[qt] + (g == 3 ? 0.f : g == 2 ? x1 : g == 1 ? x2 : x1 + x2);
#pragma unroll
                for (int r = 3; r >= 0; --r) { w[kt][r] = (kb + r < qpos) ? __expf(st[r] - sp[r] - rs) : 0.f; rs += sp[r]; }
                carry[qt] += hs + x2;
            }
            pf[qt] = pack8(w[0], w[1]);
        }
        bf16x8 vf[4]; vt_frags(vaddr, lane, vf);
#pragma unroll
        for (int qt = 0; qt < 4; ++qt)
#pragma unroll
            for (int dt = 0; dt < 4; ++dt) acc[qt][dt] = __builtin_amdgcn_mfma_f32_16x16x32_bf16(vf[dt], pf[qt], acc[qt][dt], 0, 0, 0);
        if (k0 + 32 <= q0 && __all(fminf(fminf(carry[0], carry[1]), fminf(carry[2], carry[3])) > 104.f)) break;
    }
    float ss[4];
#pragma unroll
    for (int qt = 0; qt < 4; ++qt) { float s = 0.f;
#pragma unroll
        for (int dt = 0; dt < 4; ++dt) s += (acc[qt][dt][0] * acc[qt][dt][0] + acc[qt][dt][1] * acc[qt][dt][1]) + (acc[qt][dt][2] * acc[qt][dt][2] + acc[qt][dt][3] * acc[qt][dt][3]);
        s += bperm(lane ^ 16, s); s += bperm(lane ^ 32, s); ss[qt] = s;
        if (g == 0) red[h * 64 + qt * 16 + li] = s; }
    __syncthreads();
#pragma unroll
    for (int qt = 0; qt < 4; ++qt) { float tot = 0.f;
#pragma unroll
        for (int hh = 0; hh < 8; ++hh) tot += red[hh * 64 + qt * 16 + li];
        const float sc = rsqrtf(tot / 512.f + EPS);
        store_out_tile(acc[qt], sc, gout + h * 64, MIXED + (tb + q0 + qt * 16 + li) * D + 512 + h * 64, g); }
}

__device__ __forceinline__ void dil_unit(const u16* __restrict__ PROJ, int b, int w, int r, int h, int lane, LAS char* vl, LAS float* red,
                                         const float* __restrict__ gout, u16* __restrict__ MIXED) {
    const int li = lane & 15, g = lane >> 4; const size_t tb = (size_t)b * SEQ; const int qpos = w * 256 + r + 16 * li;
    const u16* Qp = PROJ + C_DIL + h * 64; const u16* Kp = Qp + 512; const u16* Vp = Qp + 1024;
    const unsigned vaddr = (unsigned)(size_t)vl;
    bf16x8 qf[2];
#pragma unroll
    for (int s = 0; s < 2; ++s) qf[s] = *(const bf16x8*)(Qp + (tb + qpos) * DP + 32 * s + 8 * g);
    f32x4 acc[4];
#pragma unroll
    for (int dt = 0; dt < 4; ++dt) acc[dt] = (f32x4){0.f, 0.f, 0.f, 0.f};
    float mrun = -1e30f, lrun = 0.f;
#pragma unroll 1
    for (int br = 0; br < 3; ++br) {
        const int dsh = br == 0 ? 4 : br == 1 ? 2 : 0;
        const int nstep = br == 0 ? 5 : br == 1 ? 6 : 12;
        const int base = w * 256 + r - (128 << dsh);
        const int rat = li << (4 - dsh);
#pragma unroll 1
        for (int st_ = 0; st_ < nstep; ++st_) {
            const int m0 = st_ * 32;
            if (base + ((m0 + 31) << dsh) < 0) continue;
            bf16x8 kf[2][2];
#pragma unroll
            for (int kt = 0; kt < 2; ++kt) { int pos = base + ((m0 + kt * 16 + li) << dsh); pos = min(max(pos, 0), SEQ - 1);
#pragma unroll
                for (int s = 0; s < 2; ++s) kf[kt][s] = *(const bf16x8*)(Kp + (tb + pos) * DP + 32 * s + 8 * g); }
#pragma unroll
            for (int u = 0; u < 4; ++u) { const int c = lane + 64 * u, row = c >> 3, cc = c & 7; int pos = base + ((m0 + row) << dsh); pos = min(max(pos, 0), SEQ - 1);
                *(LAS u32x4v*)(vl + row * ATT_RS + cc * 16) = *(const u32x4v*)(Vp + (tb + pos) * DP + cc * 8); }
            float z[2][4]; bool ok[2][4]; float zmax = -1e30f;
#pragma unroll
            for (int kt = 0; kt < 2; ++kt) {
                f32x4 st = __builtin_amdgcn_mfma_f32_16x16x32_bf16(kf[kt][0], qf[0], (f32x4){0.f, 0.f, 0.f, 0.f}, 0, 0, 0);
                st = __builtin_amdgcn_mfma_f32_16x16x32_bf16(kf[kt][1], qf[1], st, 0, 0, 0);
#pragma unroll
                for (int rr = 0; rr < 4; ++rr) { const int m = m0 + kt * 16 + 4 * g + rr; const int dm = m - rat;
                    ok[kt][rr] = (dm >= 0) && (dm <= 128) && (base + (m << dsh) >= 0);
                    z[kt][rr] = st[rr]; if (ok[kt][rr]) zmax = fmaxf(zmax, st[rr]); }
            }
            zmax = fmaxf(zmax, bperm(lane ^ 16, zmax)); zmax = fmaxf(zmax, bperm(lane ^ 32, zmax));
            const float mn = fmaxf(mrun, zmax); const float al = __expf(mrun - mn); mrun = mn;
            float pw[2][4]; float ps = 0.f;
#pragma unroll
            for (int kt = 0; kt < 2; ++kt)
#pragma unroll
                for (int rr = 0; rr < 4; ++rr) { pw[kt][rr] = ok[kt][rr] ? __expf(z[kt][rr] - mn) : 0.f; ps += pw[kt][rr]; }
            lrun = lrun * al + ps;
#pragma unroll
            for (int dt = 0; dt < 4; ++dt) acc[dt] = acc[dt] * al;
            const bf16x8 pf = pack8(pw[0], pw[1]);
            bf16x8 vf[4]; vt_frags(vaddr, lane, vf);
#pragma unroll
            for (int dt = 0; dt < 4; ++dt) acc[dt] = __builtin_amdgcn_mfma_f32_16x16x32_bf16(vf[dt], pf, acc[dt], 0, 0, 0);
        }
    }
    lrun += bperm(lane ^ 16, lrun); lrun += bperm(lane ^ 32, lrun);
    const float inv = 1.f / lrun;
    float s = 0.f;
#pragma unroll
    for (int dt = 0; dt < 4; ++dt) { acc[dt] = acc[dt] * inv; s += (acc[dt][0] * acc[dt][0] + acc[dt][1] * acc[dt][1]) + (acc[dt][2] * acc[dt][2] + acc[dt][3] * acc[dt][3]); }
    s += bperm(lane ^ 16, s); s += bperm(lane ^ 32, s);
    if (g == 0) red[h * 64 + li] = s;
    __syncthreads();
    float tot = 0.f;
#pragma unroll
    for (int hh = 0; hh < 8; ++hh) tot += red[hh * 64 + li];
    const float sc = rsqrtf(tot / 512.f + EPS);
    store_out_tile(acc, sc, gout + h * 64, MIXED + (tb + qpos) * D + 1024 + h * 64, g);
}


template <int RS> __device__ __forceinline__ void tr_frags4(unsigned addr, int lane, bf16x8 (&f)[4]) {
    const unsigned a = addr + (unsigned)((4 * (lane >> 4) + ((lane & 15) >> 2)) * RS + (lane & 3) * 8);
    i64 r0, r1, r2, r3, r4, r5, r6, r7;
    asm volatile("s_waitcnt lgkmcnt(0)\n\t"
                 "ds_read_b64_tr_b16 %0, %8\n\tds_read_b64_tr_b16 %1, %8 offset:%9\n\t"
                 "ds_read_b64_tr_b16 %2, %8 offset:32\n\tds_read_b64_tr_b16 %3, %8 offset:%10\n\t"
                 "ds_read_b64_tr_b16 %4, %8 offset:64\n\tds_read_b64_tr_b16 %5, %8 offset:%11\n\t"
                 "ds_read_b64_tr_b16 %6, %8 offset:96\n\tds_read_b64_tr_b16 %7, %8 offset:%12\n\t"
                 "s_waitcnt lgkmcnt(0)"
                 : "=&v"(r0), "=&v"(r1), "=&v"(r2), "=&v"(r3), "=&v"(r4), "=&v"(r5), "=&v"(r6), "=&v"(r7)
                 : "v"(a), "i"(16 * RS), "i"(16 * RS + 32), "i"(16 * RS + 64), "i"(16 * RS + 96) : "memory");
    typedef i64 i64x2 __attribute__((ext_vector_type(2)));
    i64x2 t; t.x = r0; t.y = r1; f[0] = __builtin_bit_cast(bf16x8, t); t.x = r2; t.y = r3; f[1] = __builtin_bit_cast(bf16x8, t);
    t.x = r4; t.y = r5; f[2] = __builtin_bit_cast(bf16x8, t); t.x = r6; t.y = r7; f[3] = __builtin_bit_cast(bf16x8, t);
}
template <int RS> __device__ __forceinline__ bf16x8 tr_frag1(unsigned addr, int lane) {
    const unsigned a = addr + (unsigned)((4 * (lane >> 4) + ((lane & 15) >> 2)) * RS + (lane & 3) * 8);
    i64 r0, r1;
    asm volatile("s_waitcnt lgkmcnt(0)\n\tds_read_b64_tr_b16 %0, %2\n\tds_read_b64_tr_b16 %1, %2 offset:%3\n\ts_waitcnt lgkmcnt(0)"
                 : "=&v"(r0), "=&v"(r1) : "v"(a), "i"(16 * RS) : "memory");
    typedef i64 i64x2 __attribute__((ext_vector_type(2)));
    i64x2 t; t.x = r0; t.y = r1; return __builtin_bit_cast(bf16x8, t);
}
constexpr int SSD_RB = 272, SSD_RX = 144;
constexpr int SSD_OFF_B = 0, SSD_OFF_C = 128 * SSD_RB, SSD_OFF_X = 2 * 128 * SSD_RB, SSD_OFF_XW = SSD_OFF_X + 128 * SSD_RX, SSD_OFF_F = SSD_OFF_XW + 128 * SSD_RX;
__device__ __forceinline__ void ssd_chunk_unit(const u16* __restrict__ PROJ, const float* __restrict__ DTR, const float* __restrict__ cw, const float* __restrict__ cb,
                                               float dtbias, float aneg, float dskip, int b, int c, int h, int tid, LAS char* L,
                                               float* __restrict__ YD, float* __restrict__ SS, float* __restrict__ ATOT, float* __restrict__ ACS, u16* __restrict__ CG) {
    const int wave = tid >> 6, lane = tid & 63, li = lane & 15, g = lane >> 4, grp = h >> 2;
    const size_t t0 = (size_t)b * SEQ + (size_t)c * 128;
    LAS float* acs = (LAS float*)(L + SSD_OFF_F); LAS float* dts = acs + 128; LAS float* wls = acs + 256;
    __syncthreads();
    if (wave == 0) {
        const float d0 = softplusf(DTR[(t0 + 2 * lane) * 8 + h] + dtbias), d1 = softplusf(DTR[(t0 + 2 * lane + 1) * 8 + h] + dtbias);
        const float a0 = d0 * aneg, a1 = d1 * aneg;
        float v = a0 + a1;
#pragma unroll
        for (int o = 1; o < 64; o <<= 1) { const float t = bperm(lane - o, v); if (lane >= o) v += t; }
        acs[2 * lane] = v - a1; acs[2 * lane + 1] = v; dts[2 * lane] = d0; dts[2 * lane + 1] = d1;
    }
    __syncthreads();
    if (tid < 128) { const float a = acs[tid]; wls[tid] = dts[tid] * __expf(acs[127] - a); ACS[(t0 + tid) * 8 + h] = a; if (tid == 0) ATOT[((size_t)b * 32 + c) * 8 + h] = acs[127]; }
    __syncthreads();
    for (int it = tid; it < 128 * 40; it += NTHR) {
        const int tl = it / 40, cg = it % 40;
        const int ch = cg < 8 ? h * 64 + cg * 8 : cg < 24 ? 512 + grp * 128 + (cg - 8) * 8 : 768 + grp * 128 + (cg - 24) * 8;
        const int sl = c * 128 + tl;
        float a[8];
        { const float4 b0 = *(const float4*)(cb + ch), b1 = *(const float4*)(cb + ch + 4); a[0] = b0.x; a[1] = b0.y; a[2] = b0.z; a[3] = b0.w; a[4] = b1.x; a[5] = b1.y; a[6] = b1.z; a[7] = b1.w; }
#pragma unroll
        for (int k = 0; k < 4; ++k) if (sl - 3 + k >= 0) {
            const bf16x8 u = *(const bf16x8*)(PROJ + (t0 + tl - 3 + k) * DP + C_XBC + ch);
            const float4 w0 = *(const float4*)(cw + k * 1024 + ch), w1 = *(const float4*)(cw + k * 1024 + ch + 4);
            a[0] += w0.x * bf2f((u16)u[0]); a[1] += w0.y * bf2f((u16)u[1]); a[2] += w0.z * bf2f((u16)u[2]); a[3] += w0.w * bf2f((u16)u[3]);
            a[4] += w1.x * bf2f((u16)u[4]); a[5] += w1.y * bf2f((u16)u[5]); a[6] += w1.z * bf2f((u16)u[6]); a[7] += w1.w * bf2f((u16)u[7]);
        }
#pragma unroll
        for (int j = 0; j < 8; ++j) a[j] = siluf(a[j]);
        u32x4v o; o.x = pk2(a[0], a[1]); o.y = pk2(a[2], a[3]); o.z = pk2(a[4], a[5]); o.w = pk2(a[6], a[7]);
        if (cg < 8) {
            *(LAS u32x4v*)(L + SSD_OFF_X + tl * SSD_RX + cg * 16) = o;
            const float wl = wls[tl]; u32x4v ow; ow.x = pk2(a[0] * wl, a[1] * wl); ow.y = pk2(a[2] * wl, a[3] * wl); ow.z = pk2(a[4] * wl, a[5] * wl); ow.w = pk2(a[6] * wl, a[7] * wl);
            *(LAS u32x4v*)(L + SSD_OFF_XW + tl * SSD_RX + cg * 16) = ow;
        } else if (cg < 24) *(LAS u32x4v*)(L + SSD_OFF_B + tl * SSD_RB + (cg - 8) * 16) = o;
        else { *(LAS u32x4v*)(L + SSD_OFF_C + tl * SSD_RB + (cg - 24) * 16) = o;
               if ((h & 3) == 0) *(u32x4v*)(CG + (t0 + tl) * 256 + grp * 128 + (cg - 24) * 8) = o; }
    }
    __syncthreads();
    const unsigned Lb = (unsigned)(size_t)L;
    {
        const int lt = wave, lrow = lt * 16 + li; const float acl = acs[lrow];
        bf16x8 cf[4];
#pragma unroll
        for (int ks = 0; ks < 4; ++ks) cf[ks] = *(const LAS bf16x8*)(L + SSD_OFF_C + lrow * SSD_RB + ks * 64 + g * 16);
        f32x4 acc[4];
#pragma unroll
        for (int pt = 0; pt < 4; ++pt) acc[pt] = (f32x4){0.f, 0.f, 0.f, 0.f};
        for (int s0 = 0; s0 <= lt * 16; s0 += 32) {
            float w[2][4];
#pragma unroll
            for (int kt = 0; kt < 2; ++kt) {
                f32x4 st = (f32x4){0.f, 0.f, 0.f, 0.f};
#pragma unroll
                for (int ks = 0; ks < 4; ++ks) { const bf16x8 bfr = *(const LAS bf16x8*)(L + SSD_OFF_B + (s0 + kt * 16 + li) * SSD_RB + ks * 64 + g * 16);
                    st = __builtin_amdgcn_mfma_f32_16x16x32_bf16(bfr, cf[ks], st, 0, 0, 0); }
                const int sb = s0 + kt * 16 + 4 * g;
                const f32x4 as4 = *(const LAS f32x4*)(acs + sb), dt4 = *(const LAS f32x4*)(dts + sb);
#pragma unroll
                for (int r = 0; r < 4; ++r) w[kt][r] = (sb + r <= lrow) ? st[r] * __expf(acl - as4[r]) * dt4[r] : 0.f;
            }
            const bf16x8 pf = pack8(w[0], w[1]);
            bf16x8 xf[4]; tr_frags4<SSD_RX>(Lb + SSD_OFF_X + s0 * SSD_RX, lane, xf);
#pragma unroll
            for (int pt = 0; pt < 4; ++pt) acc[pt] = __builtin_amdgcn_mfma_f32_16x16x32_bf16(xf[pt], pf, acc[pt], 0, 0, 0);
        }
#pragma unroll
        for (int pt = 0; pt < 4; ++pt) {
            const u32x2v xr = *(const LAS u32x2v*)(L + SSD_OFF_X + lrow * SSD_RX + (pt * 16 + 4 * g) * 2);
            float4 o; o.x = acc[pt][0] + dskip * __uint_as_float(xr.x << 16); o.y = acc[pt][1] + dskip * __uint_as_float(xr.x & 0xffff0000u);
            o.z = acc[pt][2] + dskip * __uint_as_float(xr.y << 16); o.w = acc[pt][3] + dskip * __uint_as_float(xr.y & 0xffff0000u);
            *(float4*)(YD + (t0 + lrow) * 512 + h * 64 + pt * 16 + 4 * g) = o;
        }
    }
    {
        f32x4 acc[4];
#pragma unroll
        for (int pt = 0; pt < 4; ++pt) acc[pt] = (f32x4){0.f, 0.f, 0.f, 0.f};
#pragma unroll
        for (int ks = 0; ks < 4; ++ks) {
            const bf16x8 bt = tr_frag1<SSD_RB>(Lb + SSD_OFF_B + ks * 32 * SSD_RB + wave * 32, lane);
            bf16x8 xf[4]; tr_frags4<SSD_RX>(Lb + SSD_OFF_XW + ks * 32 * SSD_RX, lane, xf);
#pragma unroll
            for (int pt = 0; pt < 4; ++pt) acc[pt] = __builtin_amdgcn_mfma_f32_16x16x32_bf16(bt, xf[pt], acc[pt], 0, 0, 0);
        }
        float* so = SS + ((((size_t)b * 32 + c) * 8 + h) << 13);
#pragma unroll
        for (int pt = 0; pt < 4; ++pt) *(float4*)(so + (pt * 16 + li) * 128 + wave * 16 + 4 * g) = make_float4(acc[pt][0], acc[pt][1], acc[pt][2], acc[pt][3]);
    }
}
__device__ __forceinline__ void ssd_out_unit(const u16* __restrict__ PROJ, const u16* __restrict__ PREV, const u16* __restrict__ CG, const float* __restrict__ YD,
                                             const float* __restrict__ ACS, const float* __restrict__ ng, int b, int j, int h, int lane, LAS float* red, u16* __restrict__ MIXED) {
    const int li = lane & 15, g = lane >> 4, grp = h >> 2, c = j >> 2; const size_t t0 = (size_t)b * SEQ + (size_t)j * 32;
    const u16* pv = PREV + ((((size_t)b * 32 + c) * 8 + h) << 13);
    f32x4 acc[4][2];
#pragma unroll
    for (int pt = 0; pt < 4; ++pt) { acc[pt][0] = (f32x4){0.f, 0.f, 0.f, 0.f}; acc[pt][1] = (f32x4){0.f, 0.f, 0.f, 0.f}; }
#pragma unroll
    for (int ks = 0; ks < 4; ++ks) {
        bf16x8 cf[2];
#pragma unroll
        for (int lt = 0; lt < 2; ++lt) cf[lt] = *(const bf16x8*)(CG + (t0 + lt * 16 + li) * 256 + grp * 128 + ks * 32 + g * 8);
#pragma unroll
        for (int pt = 0; pt < 4; ++pt) { const bf16x8 pf = *(const bf16x8*)(pv + (pt * 16 + li) * 128 + ks * 32 + g * 8);
            acc[pt][0] = __builtin_amdgcn_mfma_f32_16x16x32_bf16(pf, cf[0], acc[pt][0], 0, 0, 0);
            acc[pt][1] = __builtin_amdgcn_mfma_f32_16x16x32_bf16(pf, cf[1], acc[pt][1], 0, 0, 0); }
    }
    float ssq[2];
#pragma unroll
    for (int lt = 0; lt < 2; ++lt) {
        const size_t t = t0 + lt * 16 + li; const float ea = __expf(ACS[t * 8 + h]); float s = 0.f;
#pragma unroll
        for (int pt = 0; pt < 4; ++pt) {
            const int col = h * 64 + pt * 16 + 4 * g;
            const float4 yd = *(const float4*)(YD + t * 512 + col); const uint2 zr = *(const uint2*)(PROJ + t * DP + C_Z + col);
            f32x4 y; y[0] = (yd.x + ea * acc[pt][lt][0]) * siluf(__uint_as_float(zr.x << 16)); y[1] = (yd.y + ea * acc[pt][lt][1]) * siluf(__uint_as_float(zr.x & 0xffff0000u));
            y[2] = (yd.z + ea * acc[pt][lt][2]) * siluf(__uint_as_float(zr.y << 16)); y[3] = (yd.w + ea * acc[pt][lt][3]) * siluf(__uint_as_float(zr.y & 0xffff0000u));
            acc[pt][lt] = y; s += (y[0] * y[0] + y[1] * y[1]) + (y[2] * y[2] + y[3] * y[3]);
        }
        s += bperm(lane ^ 16, s); s += bperm(lane ^ 32, s); ssq[lt] = s;
        if (g == 0) red[h * 64 + lt * 16 + li] = s;
    }
    __syncthreads();
#pragma unroll
    for (int lt = 0; lt < 2; ++lt) {
        float tot = 0.f;
#pragma unroll
        for (int hh = 0; hh < 8; ++hh) tot += red[hh * 64 + lt * 16 + li];
        const float sc = rsqrtf(tot / 512.f + EPS);
        f32x4 o[4];
#pragma unroll
        for (int pt = 0; pt < 4; ++pt) o[pt] = acc[pt][lt];
        store_out_tile(o, sc, ng + h * 64, MIXED + (t0 + lt * 16 + li) * D + h * 64, g);
    }
}


constexpr int MOE_LDS_TAB = 131072;
constexpr int MOE_RS = 80, MOE_ABUF = 256 * MOE_RS, MOE_BBUF = 128 * MOE_RS, MOE_BOFF = 2 * MOE_ABUF;
template <bool GATEUP, int NK>
__device__ __forceinline__ void moe_unit(const u16* __restrict__ Abase, int lda, const float* __restrict__ W0, const float* __restrict__ W1, int ldw, int wcol0,
                                         int orow0, int ocol0, u16* __restrict__ Hout, float* __restrict__ Yout, LAS char* L, int tid) {
    static_assert(NK % 4 == 0 && NK >= 4, "K-steps in groups of four (register ring)");
    const int wid = __builtin_amdgcn_readfirstlane(tid >> 6), lane = tid & 63, wr = wid >> 2, wc = wid & 3, li = lane & 15, g = lane >> 4;
    const LAS int* rowtab = (const LAS int*)(L + MOE_LDS_TAB);
    const u16* ap[2]; unsigned awr[2];
#pragma unroll
    for (int i = 0; i < 2; ++i) { const int row = (tid >> 2) + 128 * i; ap[i] = Abase + (size_t)rowtab[row] * lda + (tid & 3) * 8; awr[i] = (unsigned)(row * MOE_RS + (tid & 3) * 16); }
    const int cg = tid & 31, kq = tid >> 5;
    const float* wp = (GATEUP ? ((cg < 16 ? W0 : W1) + wcol0 + 4 * (cg & 15)) : (W0 + wcol0 + 4 * cg)) + (size_t)(2 * kq) * ldw;
    unsigned bwr[4];
#pragma unroll
    for (int j = 0; j < 4; ++j) { const int hc = GATEUP ? 4 * (cg & 15) + j : 4 * cg + j; const int np = GATEUP ? ((hc >> 4) * 32 + (cg >> 4) * 16 + (hc & 15)) : hc;
        bwr[j] = (unsigned)(MOE_BOFF + np * MOE_RS + kq * 4); }
    const unsigned afr0 = (unsigned)((wr * 128 + li) * MOE_RS + g * 16), bfr0 = (unsigned)(MOE_BOFF + (wc * 32 + li) * MOE_RS + g * 16);
    f32x4 acc[8][2];
#pragma unroll
    for (int m = 0; m < 8; ++m) { acc[m][0] = (f32x4){0.f, 0.f, 0.f, 0.f}; acc[m][1] = (f32x4){0.f, 0.f, 0.f, 0.f}; }
    float4 wq[4][2]; bf16x8 aq[4][2];
#define MOE_LOAD(s, kt) do { _Pragma("unroll") for (int i = 0; i < 2; ++i) { aq[s][i] = *(const bf16x8*)(ap[i] + (kt) * 32); wq[s][i] = *(const float4*)(wp + (size_t)((kt) * 32 + i) * ldw); } } while (0)
#define MOE_WRITE(s, buf) do { _Pragma("unroll") for (int i = 0; i < 2; ++i) *(LAS bf16x8*)(L + (buf) * MOE_ABUF + awr[i]) = aq[s][i]; \
        *(LAS unsigned*)(L + (buf) * MOE_BBUF + bwr[0]) = pg8::cvt_pk_bf16(wq[s][0].x, wq[s][1].x); *(LAS unsigned*)(L + (buf) * MOE_BBUF + bwr[1]) = pg8::cvt_pk_bf16(wq[s][0].y, wq[s][1].y); \
        *(LAS unsigned*)(L + (buf) * MOE_BBUF + bwr[2]) = pg8::cvt_pk_bf16(wq[s][0].z, wq[s][1].z); *(LAS unsigned*)(L + (buf) * MOE_BBUF + bwr[3]) = pg8::cvt_pk_bf16(wq[s][0].w, wq[s][1].w); } while (0)
#define MOE_COMPUTE(buf) do { const bf16x8 b0 = *(const LAS bf16x8*)(L + (buf) * MOE_BBUF + bfr0), b1 = *(const LAS bf16x8*)(L + (buf) * MOE_BBUF + bfr0 + 16 * MOE_RS); bf16x8 af[8]; \
        _Pragma("unroll") for (int m = 0; m < 8; ++m) af[m] = *(const LAS bf16x8*)(L + (buf) * MOE_ABUF + afr0 + m * 16 * MOE_RS); \
        asm volatile("s_waitcnt lgkmcnt(0)" ::: "memory"); __builtin_amdgcn_sched_barrier(0); \
        _Pragma("unroll") for (int m = 0; m < 8; ++m) { \
            acc[m][0] = __builtin_amdgcn_mfma_f32_16x16x32_bf16(b0, af[m], acc[m][0], 0, 0, 0); acc[m][1] = __builtin_amdgcn_mfma_f32_16x16x32_bf16(b1, af[m], acc[m][1], 0, 0, 0); } } while (0)
#define MOE_STEP(s, kt) do { { const int kl_ = (kt) + 3 < NK ? (kt) + 3 : NK - 1; MOE_LOAD(((s) + 3) & 3, kl_); } MOE_COMPUTE((s) & 1); MOE_WRITE(((s) + 1) & 3, ((s) + 1) & 1); __syncthreads(); } while (0)
    MOE_LOAD(0, 0); MOE_LOAD(1, 1); MOE_LOAD(2, 2);
    MOE_WRITE(0, 0);
    __syncthreads();
#pragma unroll 1
    for (int k4 = 0; k4 < NK; k4 += 4) { MOE_STEP(0, k4); MOE_STEP(1, k4 + 1); MOE_STEP(2, k4 + 2); MOE_STEP(3, k4 + 3); }
#undef MOE_LOAD
#undef MOE_WRITE
#undef MOE_COMPUTE
#undef MOE_STEP
#pragma unroll
    for (int m = 0; m < 8; ++m) { const size_t row = (size_t)orow0 + wr * 128 + m * 16 + li;
        if (GATEUP) { float h[4];
#pragma unroll
            for (int r = 0; r < 4; ++r) { const float gt = acc[m][0][r], up = acc[m][1][r]; h[r] = gt / (1.f + __expf(-gt)) * up; }
            *(uint2*)(Hout + row * DFF + ocol0 + wc * 16 + 4 * g) = make_uint2(pg8::cvt_pk_bf16(h[0], h[1]), pg8::cvt_pk_bf16(h[2], h[3]));
        } else {
#pragma unroll
            for (int n = 0; n < 2; ++n) *(float4*)(Yout + row * D + ocol0 + wc * 32 + n * 16 + 4 * g) = make_float4(acc[m][n][0], acc[m][n][1], acc[m][n][2], acc[m][n][3]);
        }
    }
}
__device__ __forceinline__ int moe_tables(const int* __restrict__ cnt, LAS int* tab, int tid) {
    __syncthreads();
    if (tid == 0) { int off = 0;
        for (int e = 0; e < NE; ++e) { tab[e] = off << 8; const int nb = (cnt[e] + 255) >> 8; for (int i = 0; i < nb; ++i) tab[64 + off + i] = (e << 8) | i; off += nb; }
        tab[64 + 128] = off; }
    __syncthreads();
    return tab[64 + 128];
}


template <int NTL, bool COMBINE>
__device__ __forceinline__ float norm_proj_unit(float* __restrict__ X, int t0, const float* __restrict__ gain, const float* __restrict__ Wt, u16* __restrict__ HB,
                                                LAS float* part, LAS float* ssp, int wave, int lane,
                                                const LAS int* mtab, const int* __restrict__ tok_e, const int* __restrict__ tok_pos, const float* __restrict__ tok_g, const float* __restrict__ Yb) {
    const int li = lane & 15, g4 = lane >> 4, t = t0 + li; const int kb = 256 * wave + 4 * g4;
    float* xp = X + (size_t)t * D + kb;
    float4 xv[16];
#pragma unroll
    for (int j = 0; j < 16; ++j) xv[j] = *(const float4*)(xp + 16 * j);
    if (COMBINE) {
        const float* y0 = Yb + (size_t)(mtab[tok_e[2 * t]] + tok_pos[2 * t]) * D + kb; const float* y1 = Yb + (size_t)(mtab[tok_e[2 * t + 1]] + tok_pos[2 * t + 1]) * D + kb;
        const float g0 = tok_g[2 * t], g1 = tok_g[2 * t + 1];
#pragma unroll
        for (int j = 0; j < 16; ++j) { const float4 a = *(const float4*)(y0 + 16 * j), b = *(const float4*)(y1 + 16 * j);
            xv[j].x += g0 * a.x + g1 * b.x; xv[j].y += g0 * a.y + g1 * b.y; xv[j].z += g0 * a.z + g1 * b.z; xv[j].w += g0 * a.w + g1 * b.w;
            *(float4*)(xp + 16 * j) = xv[j]; }
    }
    float ss = 0.f;
#pragma unroll
    for (int j = 0; j < 16; ++j) ss += (xv[j].x * xv[j].x + xv[j].y * xv[j].y) + (xv[j].z * xv[j].z + xv[j].w * xv[j].w);
    ss += bperm(lane ^ 16, ss); ss += bperm(lane ^ 32, ss);
    if (g4 == 0) ssp[wave * 16 + li] = ss;
    f32x4 acc[NTL];
#pragma unroll
    for (int nt = 0; nt < NTL; ++nt) acc[nt] = (f32x4){0.f, 0.f, 0.f, 0.f};
    const float* rb = Wt + (size_t)li * D + kb;
#pragma unroll
    for (int j = 0; j < 16; ++j) {
#pragma unroll
        for (int nt = 0; nt < NTL; ++nt) { const float4 rv = *(const float4*)(rb + (size_t)nt * 16 * D + 16 * j);
            acc[nt] = __builtin_amdgcn_mfma_f32_16x16x4f32(xv[j].x, rv.x, acc[nt], 0, 0, 0); acc[nt] = __builtin_amdgcn_mfma_f32_16x16x4f32(xv[j].y, rv.y, acc[nt], 0, 0, 0);
            acc[nt] = __builtin_amdgcn_mfma_f32_16x16x4f32(xv[j].z, rv.z, acc[nt], 0, 0, 0); acc[nt] = __builtin_amdgcn_mfma_f32_16x16x4f32(xv[j].w, rv.w, acc[nt], 0, 0, 0); }
    }
#pragma unroll
    for (int nt = 0; nt < NTL; ++nt)
#pragma unroll
        for (int r = 0; r < 4; ++r) part[(wave * 16 + 4 * g4 + r) * (NTL * 16) + nt * 16 + li] = acc[nt][r];
    __syncthreads();
    float tot = 0.f;
#pragma unroll
    for (int w = 0; w < 8; ++w) tot += ssp[w * 16 + li];
    const float rs = rsqrtf(tot / D + EPS);
    u16* hp = HB + (size_t)t * D + kb; const float* gq = gain + kb;
#pragma unroll
    for (int j = 0; j < 16; ++j) { const float4 gg = *(const float4*)(gq + 16 * j);
        *(uint2*)(hp + 16 * j) = make_uint2(pk2(xv[j].x * rs * gg.x, xv[j].y * rs * gg.y), pk2(xv[j].z * rs * gg.z, xv[j].w * rs * gg.w)); }
    return rs;
}

typedef const Params __attribute__((address_space(4)))* KP;
#define PARAMS KP kp_ = (KP)__builtin_amdgcn_kernarg_segment_ptr(); asm volatile("" : "+s"(kp_)); const __attribute__((address_space(4))) Params& p = *kp_;
__global__ void __launch_bounds__(NTHR, 2) mega(Params pk_unused) {
    extern __shared__ __attribute__((aligned(16))) char smem[];
    if (threadIdx.x == 0) *(uint4*)smem = make_uint4(0u, 0u, 0u, 0u);
    __syncthreads();
    XcdBarrier bar; { PARAMS bar = xcd_barrier_post(p.bar, (volatile LAS unsigned*)smem); }
    char* lds = smem + 16;
    LAS unsigned char* glds = (LAS unsigned char*)(smem + 16);
    const int G = gridDim.x, NGW = G * NWAVE;
    const long gsize = (long)G * NTHR;
#define IDS PARAMS int tid = threadIdx.x; asm volatile("" : "+v"(tid)); const int wave = tid >> 6, lane = tid & 63; const int gw = blockIdx.x * NWAVE + wave; const long gtid = (long)blockIdx.x * NTHR + tid; (void)wave; (void)lane; (void)gw; (void)gtid;

    { IDS
        const float4* s = (const float4*)p.x_in; float4* d = (float4*)p.X;
        for (long i = gtid; i < (long)T * D / 4; i += gsize) d[i] = s[i];
        float* scr = (float*)lds + wave * (64 * 33);
        constexpr int I_A = 32 * 48, I_B = 32 * 112, I_O = 32 * 64, I_L = I_A + I_B + I_O;
        for (int it = gw; it < 2 * I_L; it += NGW) {
            const int l = it / I_L; int r = it % I_L;
            const float* Wl = p.w_in + (size_t)l * D * DIN; u16* WTl = p.WinT + (size_t)l * DP * D;
            if (r < I_A) { transpose_item(Wl, DIN, 0, D, WTl, 0, 48, r, scr, lane); continue; } r -= I_A;
            if (r < I_B) { transpose_item(Wl, DIN, 1544, D, WTl, 1536, 112, r, scr, lane); continue; } r -= I_B;
            transpose_item(p.w_out + (size_t)l * D * D, D, 0, D, p.WoutT + (size_t)l * D * D, 0, 64, r, scr, lane);
        }
        for (long i = gtid; i < 2L * 80 * D; i += gsize) { const int l = (int)(i / (80 * D)), r = (int)(i % (80 * D)), c = r / D, k = r % D;
            const float w = (c < 8) ? p.rg_w[(size_t)l * D * 8 + k * 8 + c] : (c < 72) ? p.re_w[(size_t)l * D * 64 + k * 64 + (c - 8)] : 0.f;
            p.RT[i] = w * p.norm2_g[l * D + k]; }
        for (long i = gtid; i < 2L * 4 * 128 * 128; i += gsize) { const int e = (int)(i & 127), c = (int)((i >> 7) & 127); const long lg = i >> 14;
            p.WpT[(lg << 14) + e * 128 + c] = f2bf(p.pool_w[i]); }
        for (long i = gtid; i < 2L * 16 * D; i += gsize) { const int l = (int)(i / (16 * D)), r = (int)(i % (16 * D)), j = r / D, k = r % D;
            p.WDT[i] = j < 8 ? p.w_in[(size_t)l * D * DIN + (size_t)k * DIN + 1536 + j] * p.norm1_g[l * D + k] : 0.f; }
    }
    xcd_barrier(bar);

#pragma unroll 1
    for (int l = 0; l < 2; ++l) {
        { IDS
            LAS float* part = (LAS float*)(smem + 16); LAS float* ssp = part + 8 * 16 * 16; LAS int* mtab = (LAS int*)(ssp + 128);
            if (l > 0) moe_tables(p.ctrl + (l - 1) * 64, mtab, tid);
            const float* g1 = p.norm1_g + l * D; const float* wdt = p.WDT + (size_t)l * 16 * D;
            for (int u = blockIdx.x; u < T / 16; u += G) {
                __syncthreads();
                float rs;
                if (l > 0) rs = norm_proj_unit<1, true>(p.X, u * 16, g1, wdt, p.HB, part, ssp, wave, lane, mtab, p.tok_e, p.tok_pos, p.tok_g, p.Yb);
                else       rs = norm_proj_unit<1, false>(p.X, u * 16, g1, wdt, p.HB, part, ssp, wave, lane, mtab, p.tok_e, p.tok_pos, p.tok_g, p.Yb);
                (void)rs;
                if (tid < 128) { const int tk = tid >> 3, q = tid & 7; float s = 0.f, tot = 0.f;
#pragma unroll
                    for (int w = 0; w < 8; ++w) { s += part[(w * 16 + tk) * 16 + q]; tot += ssp[w * 16 + tk]; }
                    p.DTR[(size_t)(u * 16 + tk) * 8 + q] = s * rsqrtf(tot / D + EPS); }
            }
        }
        xcd_barrier(bar);
        {
            PARAMS
            pg8::Gemm g{p.HB, p.WinT + (size_t)l * DP * D, T, DP, D};
            pg8::StaticOrder so; so.init(T, DP, G, blockIdx.x);
            pg8::EpiStoreBf16 ep{p.PROJ, DP};
            pg8::gemm_phase(glds, g, so, ep, nullptr);
        }
        xcd_barrier(bar);
        { IDS
            for (int it = gw; it < T * 2; it += NGW) {
                const int t = it >> 1, mix = it & 1;
                u16* base = p.PROJ + (size_t)t * DP + (mix ? C_DIL : C_SB) + lane * 16;
                const float* gp = (mix ? (lane < 32 ? p.dq_g : p.dk_g) : (lane < 32 ? p.sbq_g : p.sbk_g)) + l * 64 + (lane & 3) * 16;
                const bf16x8 a = *(const bf16x8*)base, b = *(const bf16x8*)(base + 8);
                float v[16]; float ss = 0.f;
#pragma unroll
                for (int j = 0; j < 8; ++j) { v[j] = bf2f((u16)a[j]); v[8 + j] = bf2f((u16)b[j]); }
#pragma unroll
                for (int j = 0; j < 16; ++j) ss += v[j] * v[j];
                ss += swz_xor<1>(ss); ss += swz_xor<2>(ss);
                const float r = rsqrtf(ss / 64.f + EPS) * (lane < 32 ? 0.125f : 1.f);
                u32x4v o0, o1;
                { const float4 g0 = *(const float4*)gp, g1 = *(const float4*)(gp + 4), g2 = *(const float4*)(gp + 8), g3 = *(const float4*)(gp + 12);
                  o0.x = pk2(v[0] * r * g0.x, v[1] * r * g0.y); o0.y = pk2(v[2] * r * g0.z, v[3] * r * g0.w); o0.z = pk2(v[4] * r * g1.x, v[5] * r * g1.y); o0.w = pk2(v[6] * r * g1.z, v[7] * r * g1.w);
                  o1.x = pk2(v[8] * r * g2.x, v[9] * r * g2.y); o1.y = pk2(v[10] * r * g2.z, v[11] * r * g2.w); o1.z = pk2(v[12] * r * g3.x, v[13] * r * g3.y); o1.w = pk2(v[14] * r * g3.z, v[15] * r * g3.w); }
                *(u32x4v*)base = o0; *(u32x4v*)(base + 8) = o1;
            }
            for (int u = blockIdx.x; u < NB * 32 * 8; u += G) {
                const int b = u >> 8, c = (u >> 3) & 31, h = u & 7;
                ssd_chunk_unit(p.PROJ, p.DTR, p.conv_w + l * 4 * 1024, p.conv_b + l * 1024, p.dt_bias[l * 8 + h], -__expf(p.a_log[l * 8 + h]), p.ssd_d[l * 8 + h],
                               b, c, h, tid, (LAS char*)(smem + 16), p.YD, p.SS, p.ATOT, p.ACS, p.CG);
            }
            __syncthreads();
            {
                constexpr int PRS = 1040;
                LAS char* PL = (LAS char*)(smem + 16);
                const float* psc = p.pool_sc + l * 512; const u16* wpt = p.WpT + (size_t)l * 4 * 16384;
                for (int u = blockIdx.x; u < T / 32; u += G) {
                    const int tb0 = u * 32; __syncthreads();
                    { const int c = tid, gq = c >> 7, w = 2 << gq;
                      for (int tt = 0; tt < 32; ++tt) { const int t = tb0 + tt, s = t % SEQ; const int cn = min(w, s + 1);
                          float sum = 0.f; for (int i = 0; i < cn; ++i) sum += bf2f(p.PROJ[(size_t)(t - i) * DP + C_POOL + c]);
                          *(LAS u16*)(PL + tt * PRS + c * 2) = f2bf(sum / (float)cn - bf2f(p.PROJ[(size_t)t * DP + C_POOL + c])); } }
                    __syncthreads();
                    const int li = lane & 15, g4 = lane >> 4, gq = wave >> 1, eh = wave & 1;
                    f32x4 acc[4][2];
#pragma unroll
                    for (int et = 0; et < 4; ++et) { acc[et][0] = (f32x4){0.f, 0.f, 0.f, 0.f}; acc[et][1] = (f32x4){0.f, 0.f, 0.f, 0.f}; }
#pragma unroll
                    for (int ks = 0; ks < 4; ++ks) {
                        bf16x8 pf[2];
#pragma unroll
                        for (int tt = 0; tt < 2; ++tt) pf[tt] = *(const LAS bf16x8*)(PL + (tt * 16 + li) * PRS + (gq * 128 + ks * 32 + g4 * 8) * 2);
#pragma unroll
                        for (int et = 0; et < 4; ++et) { const bf16x8 wf = *(const bf16x8*)(wpt + gq * 16384 + (eh * 64 + et * 16 + li) * 128 + ks * 32 + g4 * 8);
                            acc[et][0] = __builtin_amdgcn_mfma_f32_16x16x32_bf16(wf, pf[0], acc[et][0], 0, 0, 0);
                            acc[et][1] = __builtin_amdgcn_mfma_f32_16x16x32_bf16(wf, pf[1], acc[et][1], 0, 0, 0); }
                    }
#pragma unroll
                    for (int tt = 0; tt < 2; ++tt)
#pragma unroll
                        for (int et = 0; et < 4; ++et) { const int col = gq * 128 + eh * 64 + et * 16 + 4 * g4; const float4 sc = *(const float4*)(psc + col);
                            *(uint2*)(p.MIXED + (size_t)(tb0 + tt * 16 + li) * D + 1536 + col) =
                                make_uint2(pk2(acc[et][tt][0] * sc.x, acc[et][tt][1] * sc.y), pk2(acc[et][tt][2] * sc.z, acc[et][tt][3] * sc.w)); }
                }
            }
        }
        xcd_barrier(bar);
        { IDS
        {
            for (int e = (int)gtid; e < NB * 8 * 8192; e += (int)gsize) {
                const int b = e >> 16, h = (e >> 13) & 7, pn = e & 8191; float st = 0.f;
#pragma unroll 8
                for (int c = 0; c < 32; ++c) { const size_t cu = ((size_t)b * 32 + c) * 8 + h; const size_t idx = (cu << 13) + pn;
                    p.PREV[idx] = f2bf(st); st = st * __expf(p.ATOT[cu]) + p.SS[idx]; }
            }
            LAS char* vl = (LAS char*)(smem + 16) + wave * ATT_VBYTES;
            LAS float* red = (LAS float*)((LAS char*)(smem + 16) + NWAVE * ATT_VBYTES);
            int par = 0;
            for (int u = blockIdx.x; u < 128 + 512; u += G, par ^= 1) {
                if (u < 128) sb_unit(p.PROJ, u >> 6, u & 63, wave, lane, vl, red + par * 512, p.sbo_g + l * 512, p.MIXED);
                else { const int v = u - 128; dil_unit(p.PROJ, v >> 8, (v >> 4) & 15, v & 15, wave, lane, vl, red + par * 512, p.do_g + l * 512, p.MIXED); }
            }
        }
        }
        xcd_barrier(bar);
        { IDS
            LAS float* red = (LAS float*)(smem + 16);
            int par = 0;
            for (int u = blockIdx.x; u < NB * 128; u += G, par ^= 1)
                ssd_out_unit(p.PROJ, p.PREV, p.CG, p.YD, p.ACS, p.ssd_ng + l * 512, u >> 7, u & 127, wave, lane, red + par * 512, p.MIXED);
        }
        xcd_barrier(bar);
        {
            PARAMS
            pg8::Gemm g{p.MIXED, p.WoutT + (size_t)l * D * D, T, D, D};
            pg8::StaticOrder so; so.init(T, D, G, blockIdx.x);
            pg8::EpiAddF32 ep{p.X, D};
            pg8::gemm_phase(glds, g, so, ep, nullptr);
        }
        xcd_barrier(bar);
        { IDS
            const float* g2 = p.norm2_g + l * D; const float* RTl = p.RT + (size_t)l * 80 * D; int* cnt = p.ctrl + l * 64;
            LAS float* part = (LAS float*)(smem + 16);
            LAS float* ssp = part + 8 * 16 * 80;
            LAS float* lg = ssp + 128;
            for (int u = blockIdx.x; u < T / 16; u += G) {
                const int t0 = u * 16;
                __syncthreads();
                norm_proj_unit<5, false>(p.X, t0, g2, RTl, p.HB, part, ssp, wave, lane, nullptr, nullptr, nullptr, nullptr, nullptr);
                for (int i = tid; i < 16 * 72; i += NTHR) { const int tk = i / 72, c = i % 72; float s = 0.f, tot = 0.f;
#pragma unroll
                    for (int w = 0; w < 8; ++w) { s += part[(w * 16 + tk) * 80 + c]; tot += ssp[w * 16 + tk]; }
                    lg[tk * 80 + c] = s * rsqrtf(tot / D + EPS) + (c < 8 ? p.rg_b[l * 8 + c] : p.re_b[l * 64 + c - 8]); }
                __syncthreads();
                if (tid < 16) {
                    const LAS float* gl = lg + tid * 80; const int t = t0 + tid;
                    int gi = 0; float gm = gl[0];
                    for (int j = 1; j < 8; ++j) if (gl[j] > gm) { gm = gl[j]; gi = j; }
                    float gs = 0.f;
                    for (int j = 0; j < 8; ++j) gs += __expf(gl[j] - gm);
                    const float gp = 1.f / gs;
                    const LAS float* el = gl + 8 + gi * 8;
                    int i1 = 0; float m1 = el[0];
                    for (int j = 1; j < 8; ++j) if (el[j] > m1) { m1 = el[j]; i1 = j; }
                    int i2 = -1; float m2 = -1e30f;
                    for (int j = 0; j < 8; ++j) if (j != i1 && el[j] > m2) { m2 = el[j]; i2 = j; }
                    const float p2 = __expf(m2 - m1); const float ga = gp / (1.f + p2), gb = gp * p2 / (1.f + p2);
                    const int e1 = gi * 8 + i1, e2 = gi * 8 + i2;
                    p.tok_e[t * 2] = e1; p.tok_e[t * 2 + 1] = e2; p.tok_g[t * 2] = ga; p.tok_g[t * 2 + 1] = gb;
                    const int q1 = atomicAdd(&cnt[e1], 1), q2 = atomicAdd(&cnt[e2], 1);
                    p.tok_pos[t * 2] = q1; p.tok_pos[t * 2 + 1] = q2; p.tlist[e1 * T + q1] = t; p.tlist[e2 * T + q2] = t;
                }
            }
        }
        xcd_barrier(bar);
        { IDS
            LAS char* L = (LAS char*)(smem + 16); LAS int* tab = (LAS int*)(L + MOE_LDS_TAB + 1024); LAS int* rowtab = (LAS int*)(L + MOE_LDS_TAB);
            const int* cnt = p.ctrl + l * 64;
            const int nblk = moe_tables(cnt, tab, tid);
            for (int u = blockIdx.x; u < nblk * 8; u += G) {
                const int mb = u >> 3, nt = u & 7; const int em = tab[64 + mb], e = em >> 8, mt = em & 255; const int ce = cnt[e];
                __syncthreads();
                if (tid < 256) { const int i = mt * 256 + tid; rowtab[tid] = i < ce ? p.tlist[e * T + i] : 0; }
                __syncthreads();
                const size_t wo = ((size_t)l * NE + e) * (size_t)D * DFF;
                moe_unit<true, D / 32>(p.HB, D, p.wg + wo, p.wu + wo, DFF, nt * 64, tab[e] + mt * 256, nt * 64, p.Hb, nullptr, L, tid);
            }
        }
        xcd_barrier(bar);
        { IDS
            LAS char* L = (LAS char*)(smem + 16); LAS int* tab = (LAS int*)(L + MOE_LDS_TAB + 1024); LAS int* rowtab = (LAS int*)(L + MOE_LDS_TAB);
            const int nblk = moe_tables(p.ctrl + l * 64, tab, tid);
            for (int u = blockIdx.x; u < nblk * 16; u += G) {
                const int mb = u >> 4, nt = u & 15; const int em = tab[64 + mb], e = em >> 8, mt = em & 255; const int r0 = tab[e] + mt * 256;
                __syncthreads();
                if (tid < 256) rowtab[tid] = r0 + tid;
                __syncthreads();
                moe_unit<false, DFF / 32>(p.Hb, DFF, p.wd + ((size_t)l * NE + e) * (size_t)D * DFF, nullptr, D, nt * 128, r0, nt * 128, nullptr, p.Yb, L, tid);
            }
        }
        xcd_barrier(bar);
    }
    { IDS
    LAS int* mtab = (LAS int*)(smem + 16);
    moe_tables(p.ctrl + 64, mtab, tid);
    for (int t = gw; t < T; t += NGW) {
        float4* xr = (float4*)(p.X + (size_t)t * D) + lane;
        const int r0 = mtab[p.tok_e[2 * t]] + p.tok_pos[2 * t], r1 = mtab[p.tok_e[2 * t + 1]] + p.tok_pos[2 * t + 1]; const float g0 = p.tok_g[2 * t], g1 = p.tok_g[2 * t + 1];
        const float4* y0 = (const float4*)(p.Yb + (size_t)r0 * D) + lane; const float4* y1 = (const float4*)(p.Yb + (size_t)r1 * D) + lane;
#pragma unroll
        for (int j = 0; j < 8; ++j) { float4 v = xr[64 * j]; const float4 a = y0[64 * j], b = y1[64 * j];
            v.x += g0 * a.x + g1 * b.x; v.y += g0 * a.y + g1 * b.y; v.z += g0 * a.z + g1 * b.z; v.w += g0 * a.w + g1 * b.w; xr[64 * j] = v; }
    }
    }
}

extern "C" void kernel_launch(void* const* d_in, const int* in_sizes, int n_in, void* d_out, int out_size, void* d_ws, size_t ws_size, hipStream_t stream) {
    Params p{};
    const float** pin = (const float**)&p;
    for (int i = 0; i < 26; ++i) pin[i] = (const float*)d_in[i];
    p.X = (float*)d_out;
    char* ws = (char*)d_ws; size_t off = 0;
    auto alloc = [&](size_t bytes) { void* q = ws + off; off += (bytes + 255) & ~(size_t)255; return q; };
    constexpr size_t CTL_BYTES = (size_t)XCD_BAR_WORDS * 4 + CTRL_INTS * 4;
    p.bar = (unsigned*)alloc(CTL_BYTES); p.ctrl = (int*)(p.bar + XCD_BAR_WORDS);
    p.HB = (u16*)alloc((size_t)T * D * 2);
    p.MIXED = (u16*)alloc((size_t)T * D * 2);
    p.PROJ = (u16*)alloc((size_t)T * DP * 2);
    p.DTR = (float*)alloc((size_t)T * 8 * 4);
    p.YD = (float*)alloc((size_t)T * 512 * 4);
    p.SS = (float*)alloc((size_t)NB * 32 * 8 * 8192 * 4);
    p.PREV = (u16*)alloc((size_t)NB * 32 * 8 * 8192 * 2);
    p.ATOT = (float*)alloc((size_t)NB * 32 * 8 * 4);
    p.ACS = (float*)alloc((size_t)T * 8 * 4);
    p.CG = (u16*)alloc((size_t)T * 256 * 2);
    p.WinT = (u16*)alloc((size_t)2 * DP * D * 2);
    p.WoutT = (u16*)alloc((size_t)2 * D * D * 2);
    p.RT = (float*)alloc((size_t)2 * 80 * D * 4);
    p.WpT = (u16*)alloc((size_t)2 * 4 * 128 * 128 * 2);
    p.WDT = (float*)alloc((size_t)2 * 16 * D * 4);
    p.tok_e = (int*)alloc((size_t)T * 2 * 4); p.tok_pos = (int*)alloc((size_t)T * 2 * 4); p.tlist = (int*)alloc((size_t)NE * T * 4);
    p.tok_g = (float*)alloc((size_t)T * 2 * 4);
    p.Hb = (u16*)alloc((size_t)MAXBLK * 256 * DFF * 2);
    p.Yb = (float*)alloc((size_t)MAXBLK * 256 * D * 4);
    static int grid = 0;
    if (grid == 0) {
        if (off > ws_size || n_in != 26) { fprintf(stderr, "kernel_launch: workspace too small (%zu > %zu) or n_in %d\n", off, ws_size, n_in); grid = -1; return; }
        int dev = 0, cus = 0, per_cu = 0;
        if (hipGetDevice(&dev) != hipSuccess || hipDeviceGetAttribute(&cus, hipDeviceAttributeMultiprocessorCount, dev) != hipSuccess) { grid = -1; return; }
        if (hipFuncSetAttribute((const void*)mega, hipFuncAttributeMaxDynamicSharedMemorySize, LDS_BYTES) != hipSuccess) { fprintf(stderr, "hipFuncSetAttribute failed\n"); grid = -1; return; }
        if (hipOccupancyMaxActiveBlocksPerMultiprocessor(&per_cu, (const void*)mega, NTHR, LDS_BYTES) != hipSuccess || per_cu < 1)
            fprintf(stderr, "kernel_launch: occupancy query reports %d blocks per CU\n", per_cu);
        (void)hipGetLastError();
        grid = cus;
    }
    if (grid < 0) return;
    if (hipMemsetAsync(p.bar, 0, CTL_BYTES, stream) != hipSuccess) return;
    hipLaunchKernelGGL(mega, dim3(grid), dim3(NTHR), LDS_BYTES, stream, p);
}
```

```cpp
#include <hip/hip_runtime.h>
#include <hip/hip_bf16.h>
#include <stdint.h>
#include <stdio.h>

typedef unsigned short u16;
using bf16x8 = __attribute__((ext_vector_type(8))) short;
using f32x4  = __attribute__((ext_vector_type(4))) float;
#define LAS __attribute__((address_space(3)))

constexpr int NB = 2, SEQ = 4096, T = NB * SEQ, D = 2048, DIN = 5128, DP = 5120;
constexpr int NE = 64, DFF = 512;
constexpr int MAXBLK = 128;
constexpr float EPS = 1e-6f;
constexpr int C_Z = 0, C_XBC = 512, C_SB = 1536, C_DIL = 3072, C_POOL = 4608;
constexpr int NTHR = 512, NWAVE = 8;
constexpr int LDS_BYTES = 16 + 131072 + 4096;

__device__ __forceinline__ float bf2f(u16 h) { return __uint_as_float(((unsigned)h) << 16); }
__device__ __forceinline__ u16 f2bf(float f) { unsigned u = __float_as_uint(f); u += 0x7fffu + ((u >> 16) & 1u); return (u16)(u >> 16); }
__device__ __forceinline__ unsigned pk2(float lo, float hi) { return (unsigned)f2bf(lo) | ((unsigned)f2bf(hi) << 16); }
template <int O> __device__ __forceinline__ float swz_xor(float v) { return __int_as_float(__builtin_amdgcn_ds_swizzle(__float_as_int(v), (O << 10) | 0x1F)); }
__device__ __forceinline__ float rdlane(float v, int l) { return __int_as_float(__builtin_amdgcn_readlane(__float_as_int(v), l)); }
__device__ __forceinline__ float wave_sum(float v) {
    v += swz_xor<1>(v); v += swz_xor<2>(v); v += swz_xor<4>(v); v += swz_xor<8>(v); v += swz_xor<16>(v);
    return rdlane(v, 0) + rdlane(v, 32);
}
__device__ __forceinline__ float siluf(float x) { return x / (1.f + __expf(-x)); }
__device__ __forceinline__ float softplusf(float x) { return fmaxf(x, 0.f) + log1pf(__expf(-fabsf(x))); }

#define XB_TMO      128
#define XB_XCNT(j)  (256  + 64 * (j))
#define XB_XSUB(j)  (1280 + 64 * (j))
#define XB_XGEN(j)  (2304 + 64 * (j))
#define XB_TOP      3328
#define XB_TOPGEN   3392
#define XCD_BAR_WORDS 3456
#define XB_SPIN_CAP (1u << 18)
__device__ __forceinline__ unsigned xb_ld(unsigned* p)              { return __hip_atomic_load(p, __ATOMIC_RELAXED, __HIP_MEMORY_SCOPE_AGENT); }
__device__ __forceinline__ unsigned xb_add(unsigned* p, unsigned v) { return __hip_atomic_fetch_add(p, v, __ATOMIC_RELAXED, __HIP_MEMORY_SCOPE_AGENT); }
__device__ __forceinline__ unsigned xb_xcc_id() { return (unsigned)__builtin_amdgcn_s_getreg((3 << 11) | 20) & 0xFu; }
#define XB_SPIN(cond, bar) do { unsigned _sp = 0; while (cond) { __builtin_amdgcn_s_sleep(1); \
    if ((++_sp & 255u) == 0u) { if (xb_ld(&(bar)[XB_TMO])) break; if (_sp > XB_SPIN_CAP) { atomicAdd(&(bar)[XB_TMO], 1u); break; } } } } while (0)
struct XcdBarrier { unsigned* bar; unsigned x; volatile LAS unsigned* st; };
__device__ __forceinline__ XcdBarrier xcd_barrier_post(unsigned* bar, volatile LAS unsigned* st) {
    XcdBarrier b; b.bar = bar; b.x = xb_xcc_id(); b.st = st;
    if (threadIdx.x == 0) (void)xb_add(&bar[XB_XCNT(b.x)], 1u);
    return b;
}
__device__ __forceinline__ void xcd_barrier_complete(unsigned* bar, unsigned x, unsigned& nloc, unsigned& nx) {
    const unsigned G = gridDim.x * gridDim.y * gridDim.z;
    unsigned sum, cnt, mine, sp = 0u;
    for (;;) {
        sum = 0u; cnt = 0u; mine = 0u;
#pragma unroll
        for (unsigned j = 0; j < 16; ++j) { const unsigned c = xb_ld(&bar[XB_XCNT(j)]); sum += c; cnt += (c > 0u) ? 1u : 0u; mine = (j == x) ? c : mine; }
        if (sum == G) break;
        __builtin_amdgcn_s_sleep(1);
        if ((++sp & 255u) == 0u) { if (xb_ld(&bar[XB_TMO])) break; if (sp > XB_SPIN_CAP) { atomicAdd(&bar[XB_TMO], 1u); break; } }
    }
    nloc = mine > 0u ? mine : 1u; nx = cnt > 0u ? cnt : 1u;
}
__device__ __forceinline__ void xcd_barrier(const XcdBarrier& b) {
    asm volatile("s_waitcnt vmcnt(0)" ::: "memory");
    __syncthreads();
    if (threadIdx.x == 0) {
        unsigned* bar = b.bar; unsigned bx = b.x;
        asm volatile("" : "+s"(bar), "+s"(bx));
        __builtin_amdgcn_s_waitcnt(0);
        unsigned nloc = b.st[0], nx = b.st[1];
        if (nloc == 0u) { xcd_barrier_complete(bar, bx, nloc, nx); b.st[0] = nloc; b.st[1] = nx; }
        const unsigned old = xb_add(&bar[XB_XSUB(bx)], 1u);
        const unsigned gen = old / nloc;
        if (old + 1u == (gen + 1u) * nloc) {
            __builtin_amdgcn_fence(__ATOMIC_RELEASE, "agent");
            asm volatile("s_waitcnt vmcnt(0)" ::: "memory");
            const unsigned og = xb_add(&bar[XB_TOP], 1u);
            const unsigned tg = og / nx;
            if (og + 1u == (tg + 1u) * nx) xb_add(&bar[XB_TOPGEN], 1u);
            else XB_SPIN(xb_ld(&bar[XB_TOPGEN]) == tg, bar);
            __builtin_amdgcn_fence(__ATOMIC_ACQUIRE, "agent");
            xb_add(&bar[XB_XGEN(bx)], 1u);
            asm volatile("s_waitcnt vmcnt(0)" ::: "memory");
        } else {
            XB_SPIN(xb_ld(&bar[XB_XGEN(bx)]) == gen, bar);
            __builtin_amdgcn_fence(__ATOMIC_ACQUIRE, "agent");
            asm volatile("s_waitcnt vmcnt(0)" ::: "memory");
        }
    }
    __syncthreads();
}

struct Params {
    const float *x_in, *norm1_g, *w_in, *conv_w, *conv_b, *dt_bias, *a_log, *ssd_d, *ssd_ng, *sbq_g, *sbk_g, *sbo_g, *dq_g, *dk_g, *do_g,
                *pool_w, *pool_sc, *w_out, *norm2_g, *rg_w, *rg_b, *re_w, *re_b, *wg, *wu, *wd;
    float* X; unsigned* bar; int* ctrl;
    u16 *HB, *MIXED, *WinT, *WoutT, *Hb;
    u16 *PROJ, *PREV, *CG, *WpT; float *DTR, *YD, *SS, *ATOT, *ACS, *RT, *WDT, *tok_g, *Yb;
    int *tok_e, *tok_pos, *tlist;
};
constexpr int CTRL_INTS = 1024;

namespace pg8 {
#define PG8_LAS __attribute__((address_space(3)))
typedef unsigned short bf16_t;
typedef short bf16x8 __attribute__((ext_vector_type(8)));
typedef float f32x4 __attribute__((ext_vector_type(4)));
typedef unsigned u32x4 __attribute__((ext_vector_type(4)));
constexpr int BM = 256, BK = 64, HALF = 128, HTB = HALF * BK * 2  , STAGE_BYTES = 8 * HTB, NXCD = 8, WGM = 8;

__host__ __device__ __forceinline__ int lds_byte(int r, int c) { const int st = (r >> 4) * 2 + (c >> 5), rr = r & 15, cc = c & 31, ob = rr * 64 + cc * 2; return st * 1024 + (ob ^ (((ob >> 9) & 1) << 5)); }
__host__ __device__ __forceinline__ void stage_rc(int b, int& R, int& C) { const int st = b / 1024, sb = b % 1024, swz = sb ^ (((sb >> 9) & 1) << 5); R = (st >> 1) * 16 + swz / 64; C = (st & 1) * 32 + (swz % 64) / 2; }
__host__ __device__ __forceinline__ int perm32(int rho) { const int n = rho >> 4, i = rho & 15; return 8 * (i >> 2) + 4 * n + (i & 3); }

struct Unit { int pm, pn; };
struct Gemm { const bf16_t* A; const bf16_t* Bt; int M, N, K; };

struct StaticOrder {
    int nM, nN, nwg, G, c;
    __host__ __device__ void init(int M, int N, int G_, int c_) { nM = M / BM; nN = N / BM; nwg = nM * nN; G = G_; c = c_; }
    __host__ __device__ bool next(int i, Unit& u) const {
        const long L = (long)i * G + c; if (L >= nwg) return false;
        int wgid = (int)L; { const int q = nwg / NXCD, r = nwg % NXCD, xcd = wgid % NXCD, off = wgid / NXCD; wgid = (xcd < r ? xcd * (q + 1) : r * (q + 1) + (xcd - r) * q) + off; }
        const int nig = WGM * nN, gid = wgid / nig, fm = gid * WGM, gsz = (nM - fm) < WGM ? (nM - fm) : WGM;
        u.pm = fm + ((wgid % nig) % gsz); u.pn = (wgid % nig) / gsz; return true;
    }
    __device__ __forceinline__ void a_ready(const Unit&) const {}
    __device__ __forceinline__ void done(const Unit&) const {}
};
__device__ __forceinline__ unsigned cvt_pk_bf16(float lo, float hi) { unsigned r; asm volatile("v_cvt_pk_bf16_f32 %0, %1, %2" : "=v"(r) : "v"(lo), "v"(hi)); return r; }
typedef float f32x2 __attribute__((ext_vector_type(2)));
struct EpiF32 {
    static constexpr bool PERM = false, AFTER_DRAIN = false;
    float* C; int ldc; const float* bias;
    __device__ __forceinline__ void operator()(const f32x4 (&acc)[2][2][4][2], const Unit& u, int wr, int wc, int fr, int fq) const {
        const int row0 = u.pm * BM + wr * 64 + fr, col0 = u.pn * BM + wc * 32 + 4 * fq;
        f32x4 bv[2][2];
#pragma unroll
        for (int bj = 0; bj < 2; ++bj)
#pragma unroll
            for (int n = 0; n < 2; ++n) bv[bj][n] = bias ? *(const f32x4*)(bias + col0 + bj * HALF + n * 16) : (f32x4){0.f, 0.f, 0.f, 0.f};
#pragma unroll
        for (int ai = 0; ai < 2; ++ai)
#pragma unroll
            for (int m = 0; m < 4; ++m) { float* rowp = C + (size_t)(row0 + ai * HALF + m * 16) * ldc + col0;
#pragma unroll
                for (int bj = 0; bj < 2; ++bj)
#pragma unroll
                    for (int n = 0; n < 2; ++n) *(f32x4*)(rowp + bj * HALF + n * 16) = acc[ai][bj][m][n] + bv[bj][n]; }
    }
};
template <class Epi, class Sched, bool STAMP = false>
__device__ __forceinline__ void gemm_phase(PG8_LAS unsigned char* lds, const Gemm g, const Sched& S, const Epi& E, unsigned long long* stamps) {
    int tid = threadIdx.x; asm volatile("" : "+v"(tid));
    const int wid = __builtin_amdgcn_readfirstlane(tid >> 6), lane = tid & 63, wr = wid >> 2, wc = wid & 3, fr = lane & 15, fq = lane >> 4;
    const int K = g.K, nt = K / BK;
    int ts_lo = 0, ts_hi = 0, nts = 0; const unsigned long long rt_entry = STAMP ? (unsigned long long)wall_clock64() : 0ull;
#define PG8_STAMP() do { if (STAMP && wid == 0 && nts < 64) { const unsigned long long _c = (unsigned long long)clock64(); \
        ts_lo = (lane == nts) ? (int)(unsigned)_c : ts_lo; ts_hi = (lane == nts) ? (int)(unsigned)(_c >> 32) : ts_hi; ++nts; } } while (0)
    PG8_STAMP();
    unsigned voffA[2], voffB[2];
#pragma unroll
    for (int i = 0; i < 2; ++i) { int R, C; stage_rc(tid * 16 + i * 8192, R, C); const int Rb = Epi::PERM ? ((R & ~31) + perm32(R & 31)) : R;
        voffA[i] = (unsigned)(R * K + C) * 2u; voffB[i] = (unsigned)(Rb * K + C) * 2u; }
    const size_t kstep = (size_t)(BK * 2);
    const size_t hstep = (size_t)HALF * K * 2;
    const size_t tstep = 2 * hstep;
    const unsigned ldsw = (unsigned)wid * 1024u;
    const int aoff = lds_byte(wr * 64 + fr, fq * 8), boff = lds_byte(wc * 32 + fr, fq * 8);
#define PG8_SA(b, h) (((b) * 2 + (h)) * HTB)
#define PG8_SB(b, h) ((4 + (b) * 2 + (h)) * HTB)
#define PG8_STAGE(bufoff, gbase, voff) do { _Pragma("unroll") for (int _i = 0; _i < 2; ++_i) \
        __builtin_amdgcn_global_load_lds((const unsigned*)((const char*)(gbase) + (voff)[_i]), (PG8_LAS unsigned*)(lds + (bufoff) + ldsw + _i * 8192), 16, 0, 0); } while (0)
#define PG8_LDA(dst, b, h) do { _Pragma("unroll") for (int m = 0; m < 4; ++m) _Pragma("unroll") for (int k = 0; k < 2; ++k) dst[m][k] = *(const PG8_LAS bf16x8*)(lds + PG8_SA(b, h) + aoff + m * 2048 + k * 1024); } while (0)
#define PG8_LDB(dst, b, h) do { _Pragma("unroll") for (int n = 0; n < 2; ++n) _Pragma("unroll") for (int k = 0; k < 2; ++k) dst[n][k] = *(const PG8_LAS bf16x8*)(lds + PG8_SB(b, h) + boff + n * 2048 + k * 1024); } while (0)
#define PG8_MMA(ai, bj, At, Bt) do { __builtin_amdgcn_s_setprio(1); _Pragma("unroll") for (int m = 0; m < 4; ++m) _Pragma("unroll") for (int n = 0; n < 2; ++n) _Pragma("unroll") for (int k = 0; k < 2; ++k) \
        acc[ai][bj][m][n] = __builtin_amdgcn_mfma_f32_16x16x32_bf16(Bt[n][k], At[m][k], acc[ai][bj][m][n], 0, 0, 0); __builtin_amdgcn_s_setprio(0); } while (0)
#define PG8_WAIT_V(n) asm volatile("s_waitcnt vmcnt(" #n ")" ::: "memory")
#define PG8_WAIT_L(n) asm volatile("s_waitcnt lgkmcnt(" #n ")" ::: "memory")
#define PG8_BAR __builtin_amdgcn_s_barrier()
#define PG8_SCHED __builtin_amdgcn_sched_barrier(0)
    Unit cur, nxt; int ui = 0;
    if (!S.next(0, cur)) return;
    f32x4 acc[2][2][4][2];
#pragma unroll
    for (int a = 0; a < 2; ++a)
#pragma unroll
        for (int b = 0; b < 2; ++b)
#pragma unroll
            for (int m = 0; m < 4; ++m)
#pragma unroll
                for (int n = 0; n < 2; ++n) acc[a][b][m][n] = (f32x4){0.f, 0.f, 0.f, 0.f};
    bf16x8 At[4][2], B0[2][2], B1[2][2];
    const char* cA = (const char*)g.A + (size_t)cur.pm * tstep; const char* cB = (const char*)g.Bt + (size_t)cur.pn * tstep;
    S.a_ready(cur);
    PG8_STAGE(PG8_SB(0, 0), cB, voffB); PG8_STAGE(PG8_SA(0, 0), cA, voffA); PG8_STAGE(PG8_SB(0, 1), cB + hstep, voffB); PG8_STAGE(PG8_SA(0, 1), cA + hstep, voffA);
    if (wr == 1) PG8_BAR;
    PG8_WAIT_V(4); PG8_BAR;
    PG8_STAGE(PG8_SB(1, 0), cB + kstep, voffB); PG8_STAGE(PG8_SA(1, 0), cA + kstep, voffA); PG8_STAGE(PG8_SB(1, 1), cB + hstep + kstep, voffB);
    PG8_WAIT_V(6); PG8_BAR;
    PG8_STAMP();
    for (;;) {
        const bool has_next = S.next(ui + 1, nxt);
        const char* nA = has_next ? (const char*)g.A + (size_t)nxt.pm * tstep : cA; const char* nB = has_next ? (const char*)g.Bt + (size_t)nxt.pn * tstep : cB;
        for (int t = 0; t < nt; t += 2) {
            const bool last = (t == nt - 2);
            const char* a1 = cA + (size_t)(t + 1) * kstep;
            const char* a2 = last ? nA : cA + (size_t)(t + 2) * kstep; const char* b2 = last ? nB : cB + (size_t)(t + 2) * kstep;
            const char* a3 = a2 + kstep; const char* b3 = b2 + kstep;
            if (last && has_next) S.a_ready(nxt);
            PG8_LDB(B0, 0, 0); PG8_SCHED; PG8_LDA(At, 0, 0); PG8_STAGE(PG8_SA(1, 1), a1 + hstep, voffA);
            PG8_WAIT_L(8); PG8_BAR; PG8_WAIT_L(0); PG8_MMA(0, 0, At, B0); PG8_BAR; PG8_SCHED;
            PG8_LDB(B1, 0, 1); PG8_STAGE(PG8_SB(0, 0), b2, voffB);
            PG8_BAR; PG8_WAIT_L(0); PG8_MMA(0, 1, At, B1); PG8_BAR;
            PG8_LDA(At, 0, 1); PG8_STAGE(PG8_SA(0, 0), a2, voffA);
            PG8_BAR; PG8_WAIT_L(0); PG8_MMA(1, 0, At, B0); PG8_BAR; PG8_SCHED;
            PG8_STAGE(PG8_SB(0, 1), b2 + hstep, voffB);
            PG8_WAIT_V(6); PG8_BAR; PG8_MMA(1, 1, At, B1); PG8_BAR;
            PG8_LDB(B0, 1, 0); PG8_SCHED; PG8_LDA(At, 1, 0); PG8_STAGE(PG8_SA(0, 1), a2 + hstep, voffA);
            PG8_WAIT_L(8); PG8_BAR; PG8_WAIT_L(0); PG8_MMA(0, 0, At, B0); PG8_BAR; PG8_SCHED;
            PG8_LDB(B1, 1, 1); PG8_STAGE(PG8_SB(1, 0), b3, voffB);
            PG8_BAR; PG8_WAIT_L(0); PG8_MMA(0, 1, At, B1); PG8_BAR;
            PG8_LDA(At, 1, 1); PG8_STAGE(PG8_SA(1, 0), a3, voffA);
            PG8_BAR; PG8_WAIT_L(0); PG8_MMA(1, 0, At, B0); PG8_BAR; PG8_SCHED;
            PG8_STAGE(PG8_SB(1, 1), b3 + hstep, voffB);
            PG8_WAIT_V(6); PG8_BAR; PG8_MMA(1, 1, At, B1); PG8_BAR;
        }
        PG8_STAMP();
        if constexpr (!Epi::AFTER_DRAIN) { E(acc, cur, wr, wc, fr, fq); S.done(cur); }
        PG8_STAMP();
        if (!has_next) break;
#pragma unroll
        for (int a = 0; a < 2; ++a)
#pragma unroll
            for (int b = 0; b < 2; ++b)
#pragma unroll
                for (int m = 0; m < 4; ++m)
#pragma unroll
                    for (int n = 0; n < 2; ++n) acc[a][b][m][n] = (f32x4){0.f, 0.f, 0.f, 0.f};
        cur = nxt; cA = nA; cB = nB; ++ui;
    }
    PG8_WAIT_V(0);
    if (wr == 0) PG8_BAR;
    PG8_BAR;
    if constexpr (Epi::AFTER_DRAIN) { E.fused(acc, cur, wr, wc, fr, fq, lds, wid, lane); S.done(cur); }
    PG8_STAMP();
    if (STAMP && wid == 0) { stamps[lane] = lane < nts ? (((unsigned long long)(unsigned)ts_hi << 32) | (unsigned)ts_lo) : 0ull;
        if (lane == 62) stamps[62] = rt_entry; if (lane == 63) stamps[63] = (unsigned long long)wall_clock64(); }
#undef PG8_STAMP
#undef PG8_SA
#undef PG8_SB
#undef PG8_STAGE
#undef PG8_LDA
#undef PG8_LDB
#undef PG8_MMA
#undef PG8_WAIT_V
#undef PG8_WAIT_L
#undef PG8_BAR
#undef PG8_SCHED
}
}

namespace pg8 {
struct EpiStoreBf16 {
    static constexpr bool PERM = true, AFTER_DRAIN = false;
    bf16_t* O; int ldc;
    __device__ __forceinline__ void operator()(const f32x4 (&acc)[2][2][4][2], const Unit& u, int wr, int wc, int fr, int fq) const {
        const int row0 = u.pm * BM + wr * 64 + fr, col0 = u.pn * BM + wc * 32 + 8 * fq;
#pragma unroll
        for (int ai = 0; ai < 2; ++ai)
#pragma unroll
            for (int m = 0; m < 4; ++m) { bf16_t* rowp = O + (size_t)(row0 + ai * HALF + m * 16) * ldc + col0;
#pragma unroll
                for (int bj = 0; bj < 2; ++bj) { const f32x4 v0 = acc[ai][bj][m][0], v1 = acc[ai][bj][m][1];
                    u32x4 w; w.x = cvt_pk_bf16(v0[0], v0[1]); w.y = cvt_pk_bf16(v0[2], v0[3]); w.z = cvt_pk_bf16(v1[0], v1[1]); w.w = cvt_pk_bf16(v1[2], v1[3]);
                    *(u32x4*)(rowp + bj * HALF) = w; } }
    }
};
struct EpiAddF32 {
    static constexpr bool PERM = false, AFTER_DRAIN = false;
    float* C; int ldc;
    __device__ __forceinline__ void operator()(const f32x4 (&acc)[2][2][4][2], const Unit& u, int wr, int wc, int fr, int fq) const {
        const int row0 = u.pm * BM + wr * 64 + fr, col0 = u.pn * BM + wc * 32 + 4 * fq;
#pragma unroll
        for (int ai = 0; ai < 2; ++ai)
#pragma unroll
            for (int m = 0; m < 4; ++m) { float* rowp = C + (size_t)(row0 + ai * HALF + m * 16) * ldc + col0;
#pragma unroll
                for (int bj = 0; bj < 2; ++bj)
#pragma unroll
                    for (int n = 0; n < 2; ++n) { f32x4* q = (f32x4*)(rowp + bj * HALF + n * 16); *q = *q + acc[ai][bj][m][n]; } }
    }
};
struct EpiDownF32 {
    static constexpr bool PERM = false, AFTER_DRAIN = false;
    float* C;
    __device__ __forceinline__ void operator()(const f32x4 (&acc)[2][2][4][2], const Unit& u, int wr, int wc, int fr, int fq) const {
        const int row0 = u.pm * BM + wr * 64 + fr, col0 = (u.pn & 7) * BM + wc * 32 + 4 * fq;
#pragma unroll
        for (int ai = 0; ai < 2; ++ai)
#pragma unroll
            for (int m = 0; m < 4; ++m) { float* rowp = C + (size_t)(row0 + ai * HALF + m * 16) * 2048 + col0;
#pragma unroll
                for (int bj = 0; bj < 2; ++bj)
#pragma unroll
                    for (int n = 0; n < 2; ++n) *(f32x4*)(rowp + bj * HALF + n * 16) = acc[ai][bj][m][n]; }
    }
};
struct EpiSwiglu {
    static constexpr bool PERM = true, AFTER_DRAIN = false;
    bf16_t* H;
    __device__ __forceinline__ void operator()(const f32x4 (&acc)[2][2][4][2], const Unit& u, int wr, int wc, int fr, int fq) const {
        const int row0 = u.pm * BM + wr * 64 + fr, col0 = (u.pn & 3) * 128 + wc * 32 + 8 * fq;
#pragma unroll
        for (int ai = 0; ai < 2; ++ai)
#pragma unroll
            for (int m = 0; m < 4; ++m) { bf16_t* rowp = H + (size_t)(row0 + ai * HALF + m * 16) * 512 + col0;
                float h[8];
#pragma unroll
                for (int n = 0; n < 2; ++n)
#pragma unroll
                    for (int j = 0; j < 4; ++j) { const float g = acc[ai][0][m][n][j], up = acc[ai][1][m][n][j]; h[n * 4 + j] = g / (1.f + __expf(-g)) * up; }
                u32x4 w; w.x = cvt_pk_bf16(h[0], h[1]); w.y = cvt_pk_bf16(h[2], h[3]); w.z = cvt_pk_bf16(h[4], h[5]); w.w = cvt_pk_bf16(h[6], h[7]);
                *(u32x4*)rowp = w; }
    }
};
struct MoeOrder {
    const int* blk_e; int ntile, G, c, shift;
    __device__ __forceinline__ bool next(int i, Unit& u) const {
        const int L = i * G + c; if (L >= ntile) return false;
        const int mb = L >> shift, nt = L & ((1 << shift) - 1);
        u.pm = mb; u.pn = (blk_e[mb] << shift) + nt; return true;
    }
    __device__ __forceinline__ void a_ready(const Unit&) const {}
    __device__ __forceinline__ void done(const Unit&) const {}
};
}

__device__ __forceinline__ void transpose_item(const float* __restrict__ W, int ldin, int n0, int K, u16* __restrict__ WT, int row0, int nbn, int item, float* scr, int lane, int ilv = -1) {
    const int kb = item / nbn, nb = item % nbn, k0 = 64 * kb, nn = 32 * nb;
    const int rb = ilv < 0 ? row0 + nn : row0 + (nn >> 7) * 256 + ilv * 128 + (nn & 127);
#pragma unroll 8
    for (int i = 0; i < 32; ++i) { const int kk = 2 * i + (lane >> 5); scr[kk * 33 + (lane & 31)] = W[(size_t)(k0 + kk) * ldin + n0 + nn + (lane & 31)]; }
    asm volatile("s_waitcnt lgkmcnt(0)" ::: "memory");
    const int c = lane & 7;
#pragma unroll
    for (int j = 0; j < 4; ++j) { const int n = (lane >> 3) + 8 * j; const float* s = scr + (8 * c) * 33 + n;
        uint4 o; o.x = pk2(s[0 * 33], s[1 * 33]); o.y = pk2(s[2 * 33], s[3 * 33]); o.z = pk2(s[4 * 33], s[5 * 33]); o.w = pk2(s[6 * 33], s[7 * 33]);
        *(uint4*)(WT + (size_t)(rb + n) * K + k0 + 8 * c) = o; }
    asm volatile("s_waitcnt lgkmcnt(0)" ::: "memory");
}
__device__ __forceinline__ void convert_moe_weights(const float* wg, const float* wu, const float* wd, u16* WguT, u16* WdT, int l, float* scr, int gw, int NGW, int lane) {
    constexpr int IPE = 512;
    for (int it = gw; it < 3 * NE * IPE; it += NGW) {
        const int which = it / (NE * IPE), r = it % (NE * IPE), e = r / IPE, item = r % IPE;
        const size_t eo = ((size_t)l * NE + e) * (size_t)D * DFF;
        if (which == 0)      transpose_item(wg + eo, DFF, 0, D, WguT + (size_t)e * 1024 * D, 0, DFF / 32, item, scr, lane, 0);
        else if (which == 1) transpose_item(wu + eo, DFF, 0, D, WguT + (size_t)e * 1024 * D, 0, DFF / 32, item, scr, lane, 1);
        else                 transpose_item(wd + eo, D, 0, DFF, WdT + (size_t)e * D * DFF, 0, D / 32, item, scr, lane);
    }
}


constexpr int ATT_RS = 144;
constexpr int ATT_VBYTES = 32 * ATT_RS;
typedef long long i64;
typedef unsigned u32x4v __attribute__((ext_vector_type(4)));
typedef unsigned u32x2v __attribute__((ext_vector_type(2)));
__device__ __forceinline__ float bperm(int srclane, float v) { return __int_as_float(__builtin_amdgcn_ds_bpermute(srclane << 2, __float_as_int(v))); }
__device__ __forceinline__ float softplus_fast(float z) { return fmaxf(z, 0.f) + __logf(1.f + __expf(-fabsf(z))); }
__device__ __forceinline__ void vt_frags(unsigned vaddr, int lane, bf16x8 (&vf)[4]) {
    const unsigned a = vaddr + (unsigned)((4 * (lane >> 4) + ((lane & 15) >> 2)) * ATT_RS + (lane & 3) * 8);
    i64 r0, r1, r2, r3, r4, r5, r6, r7;
    asm volatile("s_waitcnt lgkmcnt(0)\n\t"
                 "ds_read_b64_tr_b16 %0, %8\n\tds_read_b64_tr_b16 %1, %8 offset:2304\n\t"
                 "ds_read_b64_tr_b16 %2, %8 offset:32\n\tds_read_b64_tr_b16 %3, %8 offset:2336\n\t"
                 "ds_read_b64_tr_b16 %4, %8 offset:64\n\tds_read_b64_tr_b16 %5, %8 offset:2368\n\t"
                 "ds_read_b64_tr_b16 %6, %8 offset:96\n\tds_read_b64_tr_b16 %7, %8 offset:2400\n\t"
                 "s_waitcnt lgkmcnt(0)"
                 : "=&v"(r0), "=&v"(r1), "=&v"(r2), "=&v"(r3), "=&v"(r4), "=&v"(r5), "=&v"(r6), "=&v"(r7) : "v"(a) : "memory");
    typedef i64 i64x2 __attribute__((ext_vector_type(2)));
    i64x2 t; t.x = r0; t.y = r1; vf[0] = __builtin_bit_cast(bf16x8, t); t.x = r2; t.y = r3; vf[1] = __builtin_bit_cast(bf16x8, t);
    t.x = r4; t.y = r5; vf[2] = __builtin_bit_cast(bf16x8, t); t.x = r6; t.y = r7; vf[3] = __builtin_bit_cast(bf16x8, t);
}
__device__ __forceinline__ bf16x8 pack8(const float (&a)[4], const float (&b)[4]) {
    u32x4v w; w.x = pk2(a[0], a[1]); w.y = pk2(a[2], a[3]); w.z = pk2(b[0], b[1]); w.w = pk2(b[2], b[3]);
    return __builtin_bit_cast(bf16x8, w);
}
__device__ __forceinline__ void store_out_tile(const f32x4 (&o)[4], float scale, const float* __restrict__ gain, u16* __restrict__ dst  , int g) {
#pragma unroll
    for (int dt = 0; dt < 4; ++dt) { const float4 gg = *(const float4*)(gain + dt * 16 + 4 * g);
        *(uint2*)(dst + dt * 16 + 4 * g) = make_uint2(pk2(o[dt][0] * scale * gg.x, o[dt][1] * scale * gg.y), pk2(o[dt][2] * scale * gg.z, o[dt][3] * scale * gg.w)); }
}

__device__ __forceinline__ void sb_unit(const u16* __restrict__ PROJ, int b, int qb, int h, int lane, LAS char* vl, LAS float* red,
                                        const float* __restrict__ gout, u16* __restrict__ MIXED) {
    const int li = lane & 15, g = lane >> 4; const size_t tb = (size_t)b * SEQ; const int q0 = qb * 32;
    const u16* Qp = PROJ + C_SB + h * 64; const u16* Kp = Qp + 512; const u16* Vp = Qp + 1024;
    const unsigned vaddr = (unsigned)(size_t)vl;
    bf16x8 qf[2][2];
#pragma unroll
    for (int qt = 0; qt < 2; ++qt)
#pragma unroll
        for (int s = 0; s < 2; ++s) qf[qt][s] = *(const bf16x8*)(Qp + (tb + q0 + qt * 16 + li) * DP + 32 * s + 8 * g);
    f32x4 acc[2][4];
#pragma unroll
    for (int qt = 0; qt < 2; ++qt)
#pragma unroll
        for (int dt = 0; dt < 4; ++dt) acc[qt][dt] = (f32x4){0.f, 0.f, 0.f, 0.f};
    float carry[2] = {0.f, 0.f};
    bf16x8 kn[2][2]; u32x4v vn[4];
#define SB_LOAD(kk) do { _Pragma("unroll") for (int kt = 0; kt < 2; ++kt) _Pragma("unroll") for (int s = 0; s < 2; ++s) kn[kt][s] = *(const bf16x8*)(Kp + (tb + (kk) + kt * 16 + li) * DP + 32 * s + 8 * g); \
        _Pragma("unroll") for (int u = 0; u < 4; ++u) { const int c = lane + 64 * u; vn[u] = *(const u32x4v*)(Vp + (tb + (kk) + (c >> 3)) * DP + (c & 7) * 8); } } while (0)
    SB_LOAD(q0);
    for (int k0 = q0; k0 >= 0; k0 -= 32) {
        bf16x8 kf[2][2];
#pragma unroll
        for (int kt = 0; kt < 2; ++kt)
#pragma unroll
            for (int s = 0; s < 2; ++s) kf[kt][s] = kn[kt][s];
#pragma unroll
        for (int u = 0; u < 4; ++u) { const int c = lane + 64 * u; *(LAS u32x4v*)(vl + (c >> 3) * ATT_RS + (c & 7) * 16) = vn[u]; }
        if (k0 >= 32) SB_LOAD(k0 - 32);
        bf16x8 pf[2];
#pragma unroll
        for (int qt = 0; qt < 2; ++qt) {
            const int qpos = q0 + qt * 16 + li;
            float w[2][4];
#pragma unroll
            for (int kt = 1; kt >= 0; --kt) {
                f32x4 st = __builtin_amdgcn_mfma_f32_16x16x32_bf16(kf[kt][0], qf[qt][0], (f32x4){0.f, 0.f, 0.f, 0.f}, 0, 0, 0);
                st = __builtin_amdgcn_mfma_f32_16x16x32_bf16(kf[kt][1], qf[qt][1], st, 0, 0, 0);
                const int kb = k0 + kt * 16 + 4 * g;
                float sp[4];
#pragma unroll
                for (int r = 0; r < 4; ++r) sp[r] = (kb + r < qpos) ? softplus_fast(st[r]) : 0.f;
                const float G = (sp[0] + sp[1]) + (sp[2] + sp[3]);
                const float x1 = bperm(lane ^ 16, G), hs = G + x1, x2 = bperm(lane ^ 32, hs);
                float rs = carry[qt] + (g == 3 ? 0.f : g == 2 ? x1 : g == 1 ? x2 : x1 + x2);
#pragma unroll
                for (int r = 3; r >= 0; --r) { w[kt][r] = (kb + r < qpos) ? __expf(st[r] - sp[r] - rs) : 0.f; rs += sp[r]; }
                carry[qt] += hs + x2;
            }
            pf[qt] = pack8(w[0], w[1]);
        }
        bf16x8 vf[4]; vt_frags(vaddr, lane, vf);
#pragma unroll
        for (int qt = 0; qt < 2; ++qt)
#pragma unroll
            for (int dt = 0; dt < 4; ++dt) acc[qt][dt] = __builtin_amdgcn_mfma_f32_16x16x32_bf16(vf[dt], pf[qt], acc[qt][dt], 0, 0, 0);
        if (k0 + 32 <= q0 && __all(fminf(carry[0], carry[1]) > 104.f)) break;
    }
#undef SB_LOAD
    float ss[2];
#pragma unroll
    for (int qt = 0; qt < 2; ++qt) { float s = 0.f;
#pragma unroll
        for (int dt = 0; dt < 4; ++dt) s += (acc[qt][dt][0] * acc[qt][dt][0] + acc[qt][dt][1] * acc[qt][dt][1]) + (acc[qt][dt][2] * acc[qt][dt][2] + acc[qt][dt][3] * acc[qt][dt][3]);
        s += bperm(lane ^ 16, s); s += bperm(lane ^ 32, s); ss[qt] = s;
        if (g == 0) red[h * 64 + qt * 16 + li] = s; }
    __syncthreads();
#pragma unroll
    for (int qt = 0; qt < 2; ++qt) { float tot = 0.f;
#pragma unroll
        for (int hh = 0; hh < 8; ++hh) tot += red[hh * 64 + qt * 16 + li];
        const float sc = rsqrtf(tot / 512.f + EPS);
        store_out_tile(acc[qt], sc, gout + h * 64, MIXED + (tb + q0 + qt * 16 + li) * D + 512 + h * 64, g); }
}

__device__ __forceinline__ void dil_unit(const u16* __restrict__ PROJ, int b, int w, int r, int h, int lane, LAS char* vl, LAS float* red,
                                         const float* __restrict__ gout, u16* __restrict__ MIXED) {
    const int li = lane & 15, g = lane >> 4; const size_t tb = (size_t)b * SEQ; const int qpos = w * 256 + r + 16 * li;
    const u16* Qp = PROJ + C_DIL + h * 64; const u16* Kp = Qp + 512; const u16* Vp = Qp + 1024;
    const unsigned vaddr = (unsigned)(size_t)vl;
    bf16x8 qf[2];
#pragma unroll
    for (int s = 0; s < 2; ++s) qf[s] = *(const bf16x8*)(Qp + (tb + qpos) * DP + 32 * s + 8 * g);
    f32x4 acc[4];
#pragma unroll
    for (int dt = 0; dt < 4; ++dt) acc[dt] = (f32x4){0.f, 0.f, 0.f, 0.f};
    float mrun = -1e30f, lrun = 0.f;
#pragma unroll 1
    for (int br = 0; br < 3; ++br) {
        const int dsh = br == 0 ? 4 : br == 1 ? 2 : 0;
        const int nstep = br == 0 ? 5 : br == 1 ? 6 : 12;
        const int base = w * 256 + r - (128 << dsh);
        const int rat = li << (4 - dsh);
        const int nbf = base < 0 ? ((-base + (1 << dsh) - 1) >> dsh) : 0;
        const int sbeg = nbf >> 5;
        bf16x8 kn[2][2]; u32x4v vn[4];
#define DIL_LOAD(mm) do { _Pragma("unroll") for (int kt = 0; kt < 2; ++kt) { int pos = base + (((mm) + kt * 16 + li) << dsh); pos = min(max(pos, 0), SEQ - 1); \
            _Pragma("unroll") for (int s = 0; s < 2; ++s) kn[kt][s] = *(const bf16x8*)(Kp + (tb + pos) * DP + 32 * s + 8 * g); } \
        _Pragma("unroll") for (int u = 0; u < 4; ++u) { const int c = lane + 64 * u; int pos = base + (((mm) + (c >> 3)) << dsh); pos = min(max(pos, 0), SEQ - 1); \
            vn[u] = *(const u32x4v*)(Vp + (tb + pos) * DP + (c & 7) * 8); } } while (0)
        DIL_LOAD(sbeg * 32);
#pragma unroll 1
        for (int st_ = sbeg; st_ < nstep; ++st_) {
            const int m0 = st_ * 32;
            bf16x8 kf[2][2];
#pragma unroll
            for (int kt = 0; kt < 2; ++kt)
#pragma unroll
                for (int s = 0; s < 2; ++s) kf[kt][s] = kn[kt][s];
#pragma unroll
            for (int u = 0; u < 4; ++u) { const int c = lane + 64 * u; *(LAS u32x4v*)(vl + (c >> 3) * ATT_RS + (c & 7) * 16) = vn[u]; }
            if (st_ + 1 < nstep) DIL_LOAD(m0 + 32);
            float z[2][4]; bool ok[2][4]; float zmax = -1e30f;
#pragma unroll
            for (int kt = 0; kt < 2; ++kt) {
                f32x4 st = __builtin_amdgcn_mfma_f32_16x16x32_bf16(kf[kt][0], qf[0], (f32x4){0.f, 0.f, 0.f, 0.f}, 0, 0, 0);
                st = __builtin_amdgcn_mfma_f32_16x16x32_bf16(kf[kt][1], qf[1], st, 0, 0, 0);
#pragma unroll
                for (int rr = 0; rr < 4; ++rr) { const int m = m0 + kt * 16 + 4 * g + rr; const int dm = m - rat;
                    ok[kt][rr] = (dm >= 0) && (dm <= 128) && (base + (m << dsh) >= 0);
                    z[kt][rr] = st[rr]; if (ok[kt][rr]) zmax = fmaxf(zmax, st[rr]); }
            }
            zmax = fmaxf(zmax, bperm(lane ^ 16, zmax)); zmax = fmaxf(zmax, bperm(lane ^ 32, zmax));
            const float mn = fmaxf(mrun, zmax); const float al = __expf(mrun - mn); mrun = mn;
            float pw[2][4]; float ps = 0.f;
#pragma unroll
            for (int kt = 0; kt < 2; ++kt)
#pragma unroll
                for (int rr = 0; rr < 4; ++rr) { pw[kt][rr] = ok[kt][rr] ? __expf(z[kt][rr] - mn) : 0.f; ps += pw[kt][rr]; }
            lrun = lrun * al + ps;
#pragma unroll
            for (int dt = 0; dt < 4; ++dt) acc[dt] = acc[dt] * al;
            const bf16x8 pf = pack8(pw[0], pw[1]);
            bf16x8 vf[4]; vt_frags(vaddr, lane, vf);
#pragma unroll
            for (int dt = 0; dt < 4; ++dt) acc[dt] = __builtin_amdgcn_mfma_f32_16x16x32_bf16(vf[dt], pf, acc[dt], 0, 0, 0);
        }
    }
#undef DIL_LOAD
    lrun += bperm(lane ^ 16, lrun); lrun += bperm(lane ^ 32, lrun);
    const float inv = 1.f / lrun;
    float s = 0.f;
#pragma unroll
    for (int dt = 0; dt < 4; ++dt) { acc[dt] = acc[dt] * inv; s += (acc[dt][0] * acc[dt][0] + acc[dt][1] * acc[dt][1]) + (acc[dt][2] * acc[dt][2] + acc[dt][3] * acc[dt][3]); }
    s += bperm(lane ^ 16, s); s += bperm(lane ^ 32, s);
    if (g == 0) red[h * 64 + li] = s;
    __syncthreads();
    float tot = 0.f;
#pragma unroll
    for (int hh = 0; hh < 8; ++hh) tot += red[hh * 64 + li];
    const float sc = rsqrtf(tot / 512.f + EPS);
    store_out_tile(acc, sc, gout + h * 64, MIXED + (tb + qpos) * D + 1024 + h * 64, g);
}


template <int RS> __device__ __forceinline__ void tr_frags4(unsigned addr, int lane, bf16x8 (&f)[4]) {
    const unsigned a = addr + (unsigned)((4 * (lane >> 4) + ((lane & 15) >> 2)) * RS + (lane & 3) * 8);
    i64 r0, r1, r2, r3, r4, r5, r6, r7;
    asm volatile("s_waitcnt lgkmcnt(0)\n\t"
                 "ds_read_b64_tr_b16 %0, %8\n\tds_read_b64_tr_b16 %1, %8 offset:%9\n\t"
                 "ds_read_b64_tr_b16 %2, %8 offset:32\n\tds_read_b64_tr_b16 %3, %8 offset:%10\n\t"
                 "ds_read_b64_tr_b16 %4, %8 offset:64\n\tds_read_b64_tr_b16 %5, %8 offset:%11\n\t"
                 "ds_read_b64_tr_b16 %6, %8 offset:96\n\tds_read_b64_tr_b16 %7, %8 offset:%12\n\t"
                 "s_waitcnt lgkmcnt(0)"
                 : "=&v"(r0), "=&v"(r1), "=&v"(r2), "=&v"(r3), "=&v"(r4), "=&v"(r5), "=&v"(r6), "=&v"(r7)
                 : "v"(a), "i"(16 * RS), "i"(16 * RS + 32), "i"(16 * RS + 64), "i"(16 * RS + 96) : "memory");
    typedef i64 i64x2 __attribute__((ext_vector_type(2)));
    i64x2 t; t.x = r0; t.y = r1; f[0] = __builtin_bit_cast(bf16x8, t); t.x = r2; t.y = r3; f[1] = __builtin_bit_cast(bf16x8, t);
    t.x = r4; t.y = r5; f[2] = __builtin_bit_cast(bf16x8, t); t.x = r6; t.y = r7; f[3] = __builtin_bit_cast(bf16x8, t);
}
template <int RS> __device__ __forceinline__ bf16x8 tr_frag1(unsigned addr, int lane) {
    const unsigned a = addr + (unsigned)((4 * (lane >> 4) + ((lane & 15) >> 2)) * RS + (lane & 3) * 8);
    i64 r0, r1;
    asm volatile("s_waitcnt lgkmcnt(0)\n\tds_read_b64_tr_b16 %0, %2\n\tds_read_b64_tr_b16 %1, %2 offset:%3\n\ts_waitcnt lgkmcnt(0)"
                 : "=&v"(r0), "=&v"(r1) : "v"(a), "i"(16 * RS) : "memory");
    typedef i64 i64x2 __attribute__((ext_vector_type(2)));
    i64x2 t; t.x = r0; t.y = r1; return __builtin_bit_cast(bf16x8, t);
}
constexpr int SSD_RB = 272, SSD_RX = 144;
constexpr int SSD_OFF_B = 0, SSD_OFF_C = 128 * SSD_RB, SSD_OFF_X = 2 * 128 * SSD_RB, SSD_OFF_XW = SSD_OFF_X + 128 * SSD_RX, SSD_OFF_F = SSD_OFF_XW + 128 * SSD_RX;
__device__ __forceinline__ void ssd_chunk_unit(const u16* __restrict__ PROJ, const float* __restrict__ DTR, const float* __restrict__ cw, const float* __restrict__ cb,
                                               float dtbias, float aneg, float dskip, int b, int c, int h, int tid, LAS char* L,
                                               float* __restrict__ YD, float* __restrict__ SS, float* __restrict__ ATOT, float* __restrict__ ACS, u16* __restrict__ CG) {
    const int wave = tid >> 6, lane = tid & 63, li = lane & 15, g = lane >> 4, grp = h >> 2;
    const size_t t0 = (size_t)b * SEQ + (size_t)c * 128;
    LAS float* acs = (LAS float*)(L + SSD_OFF_F); LAS float* dts = acs + 128; LAS float* wls = acs + 256;
    __syncthreads();
    if (wave == 0) {
        const float d0 = softplusf(DTR[(t0 + 2 * lane) * 8 + h] + dtbias), d1 = softplusf(DTR[(t0 + 2 * lane + 1) * 8 + h] + dtbias);
        const float a0 = d0 * aneg, a1 = d1 * aneg;
        float v = a0 + a1;
#pragma unroll
        for (int o = 1; o < 64; o <<= 1) { const float t = bperm(lane - o, v); if (lane >= o) v += t; }
        acs[2 * lane] = v - a1; acs[2 * lane + 1] = v; dts[2 * lane] = d0; dts[2 * lane + 1] = d1;
    }
    __syncthreads();
    if (tid < 128) { const float a = acs[tid]; wls[tid] = dts[tid] * __expf(acs[127] - a); ACS[(t0 + tid) * 8 + h] = a; if (tid == 0) ATOT[((size_t)b * 32 + c) * 8 + h] = acs[127]; }
    __syncthreads();
    for (int it = tid; it < 128 * 40; it += NTHR) {
        const int tl = it / 40, cg = it % 40;
        const int ch = cg < 8 ? h * 64 + cg * 8 : cg < 24 ? 512 + grp * 128 + (cg - 8) * 8 : 768 + grp * 128 + (cg - 24) * 8;
        const int sl = c * 128 + tl;
        float a[8];
        { const float4 b0 = *(const float4*)(cb + ch), b1 = *(const float4*)(cb + ch + 4); a[0] = b0.x; a[1] = b0.y; a[2] = b0.z; a[3] = b0.w; a[4] = b1.x; a[5] = b1.y; a[6] = b1.z; a[7] = b1.w; }
#pragma unroll
        for (int k = 0; k < 4; ++k) if (sl - 3 + k >= 0) {
            const bf16x8 u = *(const bf16x8*)(PROJ + (t0 + tl - 3 + k) * DP + C_XBC + ch);
            const float4 w0 = *(const float4*)(cw + k * 1024 + ch), w1 = *(const float4*)(cw + k * 1024 + ch + 4);
            a[0] += w0.x * bf2f((u16)u[0]); a[1] += w0.y * bf2f((u16)u[1]); a[2] += w0.z * bf2f((u16)u[2]); a[3] += w0.w * bf2f((u16)u[3]);
            a[4] += w1.x * bf2f((u16)u[4]); a[5] += w1.y * bf2f((u16)u[5]); a[6] += w1.z * bf2f((u16)u[6]); a[7] += w1.w * bf2f((u16)u[7]);
        }
#pragma unroll
        for (int j = 0; j < 8; ++j) a[j] = siluf(a[j]);
        u32x4v o; o.x = pk2(a[0], a[1]); o.y = pk2(a[2], a[3]); o.z = pk2(a[4], a[5]); o.w = pk2(a[6], a[7]);
        if (cg < 8) {
            *(LAS u32x4v*)(L + SSD_OFF_X + tl * SSD_RX + cg * 16) = o;
            const float wl = wls[tl]; u32x4v ow; ow.x = pk2(a[0] * wl, a[1] * wl); ow.y = pk2(a[2] * wl, a[3] * wl); ow.z = pk2(a[4] * wl, a[5] * wl); ow.w = pk2(a[6] * wl, a[7] * wl);
            *(LAS u32x4v*)(L + SSD_OFF_XW + tl * SSD_RX + cg * 16) = ow;
        } else if (cg < 24) *(LAS u32x4v*)(L + SSD_OFF_B + tl * SSD_RB + (cg - 8) * 16) = o;
        else { *(LAS u32x4v*)(L + SSD_OFF_C + tl * SSD_RB + (cg - 24) * 16) = o;
               if ((h & 3) == 0) *(u32x4v*)(CG + (t0 + tl) * 256 + grp * 128 + (cg - 24) * 8) = o; }
    }
    __syncthreads();
    const unsigned Lb = (unsigned)(size_t)L;
    {
        const int lt = wave, lrow = lt * 16 + li; const float acl = acs[lrow];
        bf16x8 cf[4];
#pragma unroll
        for (int ks = 0; ks < 4; ++ks) cf[ks] = *(const LAS bf16x8*)(L + SSD_OFF_C + lrow * SSD_RB + ks * 64 + g * 16);
        f32x4 acc[4];
#pragma unroll
        for (int pt = 0; pt < 4; ++pt) acc[pt] = (f32x4){0.f, 0.f, 0.f, 0.f};
        for (int s0 = 0; s0 <= lt * 16; s0 += 32) {
            float w[2][4];
#pragma unroll
            for (int kt = 0; kt < 2; ++kt) {
                f32x4 st = (f32x4){0.f, 0.f, 0.f, 0.f};
#pragma unroll
                for (int ks = 0; ks < 4; ++ks) { const bf16x8 bfr = *(const LAS bf16x8*)(L + SSD_OFF_B + (s0 + kt * 16 + li) * SSD_RB + ks * 64 + g * 16);
                    st = __builtin_amdgcn_mfma_f32_16x16x32_bf16(bfr, cf[ks], st, 0, 0, 0); }
                const int sb = s0 + kt * 16 + 4 * g;
                const f32x4 as4 = *(const LAS f32x4*)(acs + sb), dt4 = *(const LAS f32x4*)(dts + sb);
#pragma unroll
                for (int r = 0; r < 4; ++r) w[kt][r] = (sb + r <= lrow) ? st[r] * __expf(acl - as4[r]) * dt4[r] : 0.f;
            }
            const bf16x8 pf = pack8(w[0], w[1]);
            bf16x8 xf[4]; tr_frags4<SSD_RX>(Lb + SSD_OFF_X + s0 * SSD_RX, lane, xf);
#pragma unroll
            for (int pt = 0; pt < 4; ++pt) acc[pt] = __builtin_amdgcn_mfma_f32_16x16x32_bf16(xf[pt], pf, acc[pt], 0, 0, 0);
        }
#pragma unroll
        for (int pt = 0; pt < 4; ++pt) {
            const u32x2v xr = *(const LAS u32x2v*)(L + SSD_OFF_X + lrow * SSD_RX + (pt * 16 + 4 * g) * 2);
            float4 o; o.x = acc[pt][0] + dskip * __uint_as_float(xr.x << 16); o.y = acc[pt][1] + dskip * __uint_as_float(xr.x & 0xffff0000u);
            o.z = acc[pt][2] + dskip * __uint_as_float(xr.y << 16); o.w = acc[pt][3] + dskip * __uint_as_float(xr.y & 0xffff0000u);
            *(float4*)(YD + (t0 + lrow) * 512 + h * 64 + pt * 16 + 4 * g) = o;
        }
    }
    {
        f32x4 acc[4];
#pragma unroll
        for (int pt = 0; pt < 4; ++pt) acc[pt] = (f32x4){0.f, 0.f, 0.f, 0.f};
#pragma unroll
        for (int ks = 0; ks < 4; ++ks) {
            const bf16x8 bt = tr_frag1<SSD_RB>(Lb + SSD_OFF_B + ks * 32 * SSD_RB + wave * 32, lane);
            bf16x8 xf[4]; tr_frags4<SSD_RX>(Lb + SSD_OFF_XW + ks * 32 * SSD_RX, lane, xf);
#pragma unroll
            for (int pt = 0; pt < 4; ++pt) acc[pt] = __builtin_amdgcn_mfma_f32_16x16x32_bf16(bt, xf[pt], acc[pt], 0, 0, 0);
        }
        float* so = SS + ((((size_t)b * 32 + c) * 8 + h) << 13);
#pragma unroll
        for (int pt = 0; pt < 4; ++pt) *(float4*)(so + (pt * 16 + li) * 128 + wave * 16 + 4 * g) = make_float4(acc[pt][0], acc[pt][1], acc[pt][2], acc[pt][3]);
    }
}
__device__ __forceinline__ void ssd_out_unit(const u16* __restrict__ PROJ, const u16* __restrict__ PREV, const u16* __restrict__ CG, const float* __restrict__ YD,
                                             const float* __restrict__ ACS, const float* __restrict__ ng, int b, int j, int h, int lane, LAS float* red, u16* __restrict__ MIXED) {
    const int li = lane & 15, g = lane >> 4, grp = h >> 2, c = j >> 2; const size_t t0 = (size_t)b * SEQ + (size_t)j * 32;
    const u16* pv = PREV + ((((size_t)b * 32 + c) * 8 + h) << 13);
    f32x4 acc[4][2];
#pragma unroll
    for (int pt = 0; pt < 4; ++pt) { acc[pt][0] = (f32x4){0.f, 0.f, 0.f, 0.f}; acc[pt][1] = (f32x4){0.f, 0.f, 0.f, 0.f}; }
#pragma unroll
    for (int ks = 0; ks < 4; ++ks) {
        bf16x8 cf[2];
#pragma unroll
        for (int lt = 0; lt < 2; ++lt) cf[lt] = *(const bf16x8*)(CG + (t0 + lt * 16 + li) * 256 + grp * 128 + ks * 32 + g * 8);
#pragma unroll
        for (int pt = 0; pt < 4; ++pt) { const bf16x8 pf = *(const bf16x8*)(pv + (pt * 16 + li) * 128 + ks * 32 + g * 8);
            acc[pt][0] = __builtin_amdgcn_mfma_f32_16x16x32_bf16(pf, cf[0], acc[pt][0], 0, 0, 0);
            acc[pt][1] = __builtin_amdgcn_mfma_f32_16x16x32_bf16(pf, cf[1], acc[pt][1], 0, 0, 0); }
    }
    float ssq[2];
#pragma unroll
    for (int lt = 0; lt < 2; ++lt) {
        const size_t t = t0 + lt * 16 + li; const float ea = __expf(ACS[t * 8 + h]); float s = 0.f;
#pragma unroll
        for (int pt = 0; pt < 4; ++pt) {
            const int col = h * 64 + pt * 16 + 4 * g;
            const float4 yd = *(const float4*)(YD + t * 512 + col); const uint2 zr = *(const uint2*)(PROJ + t * DP + C_Z + col);
            f32x4 y; y[0] = (yd.x + ea * acc[pt][lt][0]) * siluf(__uint_as_float(zr.x << 16)); y[1] = (yd.y + ea * acc[pt][lt][1]) * siluf(__uint_as_float(zr.x & 0xffff0000u));
            y[2] = (yd.z + ea * acc[pt][lt][2]) * siluf(__uint_as_float(zr.y << 16)); y[3] = (yd.w + ea * acc[pt][lt][3]) * siluf(__uint_as_float(zr.y & 0xffff0000u));
            acc[pt][lt] = y; s += (y[0] * y[0] + y[1] * y[1]) + (y[2] * y[2] + y[3] * y[3]);
        }
        s += bperm(lane ^ 16, s); s += bperm(lane ^ 32, s); ssq[lt] = s;
        if (g == 0) red[h * 64 + lt * 16 + li] = s;
    }
    __syncthreads();
#pragma unroll
    for (int lt = 0; lt < 2; ++lt) {
        float tot = 0.f;
#pragma unroll
        for (int hh = 0; hh < 8; ++hh) tot += red[hh * 64 + lt * 16 + li];
        const float sc = rsqrtf(tot / 512.f + EPS);
        f32x4 o[4];
#pragma unroll
        for (int pt = 0; pt < 4; ++pt) o[pt] = acc[pt][lt];
        store_out_tile(o, sc, ng + h * 64, MIXED + (t0 + lt * 16 + li) * D + h * 64, g);
    }
}


constexpr int MOE_LDS_TAB = 131072;
constexpr int MOE_RS = 80, MOE_ABUF = 256 * MOE_RS, MOE_BBUF = 128 * MOE_RS, MOE_BOFF = 2 * MOE_ABUF;
template <bool GATEUP, int NK>
__device__ __forceinline__ void moe_unit(const u16* __restrict__ Abase, int lda, const float* __restrict__ W0, const float* __restrict__ W1, int ldw, int wcol0,
                                         int orow0, int ocol0, u16* __restrict__ Hout, float* __restrict__ Yout, LAS char* L, int tid) {
    static_assert(NK % 4 == 0 && NK >= 4, "K-steps in groups of four (register ring)");
    const int wid = __builtin_amdgcn_readfirstlane(tid >> 6), lane = tid & 63, wr = wid >> 2, wc = wid & 3, li = lane & 15, g = lane >> 4;
    const LAS int* rowtab = (const LAS int*)(L + MOE_LDS_TAB);
    const u16* ap[2]; unsigned awr[2];
#pragma unroll
    for (int i = 0; i < 2; ++i) { const int row = (tid >> 2) + 128 * i; ap[i] = Abase + (size_t)rowtab[row] * lda + (tid & 3) * 8; awr[i] = (unsigned)(row * MOE_RS + (tid & 3) * 16); }
    const int cg = tid & 31, kq = tid >> 5;
    const float* wp = (GATEUP ? ((cg < 16 ? W0 : W1) + wcol0 + 4 * (cg & 15)) : (W0 + wcol0 + 4 * cg)) + (size_t)(2 * kq) * ldw;
    unsigned bwr[4];
#pragma unroll
    for (int j = 0; j < 4; ++j) { const int hc = GATEUP ? 4 * (cg & 15) + j : 4 * cg + j; const int np = GATEUP ? ((hc >> 4) * 32 + (cg >> 4) * 16 + (hc & 15)) : hc;
        bwr[j] = (unsigned)(MOE_BOFF + np * MOE_RS + kq * 4); }
    const unsigned afr0 = (unsigned)((wr * 128 + li) * MOE_RS + g * 16), bfr0 = (unsigned)(MOE_BOFF + (wc * 32 + li) * MOE_RS + g * 16);
    f32x4 acc[8][2];
#pragma unroll
    for (int m = 0; m < 8; ++m) { acc[m][0] = (f32x4){0.f, 0.f, 0.f, 0.f}; acc[m][1] = (f32x4){0.f, 0.f, 0.f, 0.f}; }
    float4 wq[4][2]; bf16x8 aq[4][2];
#define MOE_LOAD(s, kt) do { _Pragma("unroll") for (int i = 0; i < 2; ++i) { aq[s][i] = *(const bf16x8*)(ap[i] + (kt) * 32); wq[s][i] = *(const float4*)(wp + (size_t)((kt) * 32 + i) * ldw); } } while (0)
#define MOE_WRITE(s, buf) do { _Pragma("unroll") for (int i = 0; i < 2; ++i) *(LAS bf16x8*)(L + (buf) * MOE_ABUF + awr[i]) = aq[s][i]; \
        *(LAS unsigned*)(L + (buf) * MOE_BBUF + bwr[0]) = pg8::cvt_pk_bf16(wq[s][0].x, wq[s][1].x); *(LAS unsigned*)(L + (buf) * MOE_BBUF + bwr[1]) = pg8::cvt_pk_bf16(wq[s][0].y, wq[s][1].y); \
        *(LAS unsigned*)(L + (buf) * MOE_BBUF + bwr[2]) = pg8::cvt_pk_bf16(wq[s][0].z, wq[s][1].z); *(LAS unsigned*)(L + (buf) * MOE_BBUF + bwr[3]) = pg8::cvt_pk_bf16(wq[s][0].w, wq[s][1].w); } while (0)
#define MOE_COMPUTE(buf) do { const bf16x8 b0 = *(const LAS bf16x8*)(L + (buf) * MOE_BBUF + bfr0), b1 = *(const LAS bf16x8*)(L + (buf) * MOE_BBUF + bfr0 + 16 * MOE_RS); bf16x8 af[8]; \
        _Pragma("unroll") for (int m = 0; m < 8; ++m) af[m] = *(const LAS bf16x8*)(L + (buf) * MOE_ABUF + afr0 + m * 16 * MOE_RS); \
        asm volatile("s_waitcnt lgkmcnt(0)" ::: "memory"); __builtin_amdgcn_sched_barrier(0); \
        _Pragma("unroll") for (int m = 0; m < 8; ++m) { \
            acc[m][0] = __builtin_amdgcn_mfma_f32_16x16x32_bf16(b0, af[m], acc[m][0], 0, 0, 0); acc[m][1] = __builtin_amdgcn_mfma_f32_16x16x32_bf16(b1, af[m], acc[m][1], 0, 0, 0); } } while (0)
#define MOE_STEP(s, kt) do { { const int kl_ = (kt) + 3 < NK ? (kt) + 3 : NK - 1; MOE_LOAD(((s) + 3) & 3, kl_); } MOE_COMPUTE((s) & 1); MOE_WRITE(((s) + 1) & 3, ((s) + 1) & 1); __syncthreads(); } while (0)
    MOE_LOAD(0, 0); MOE_LOAD(1, 1); MOE_LOAD(2, 2);
    MOE_WRITE(0, 0);
    __syncthreads();
#pragma unroll 1
    for (int k4 = 0; k4 < NK; k4 += 4) { MOE_STEP(0, k4); MOE_STEP(1, k4 + 1); MOE_STEP(2, k4 + 2); MOE_STEP(3, k4 + 3); }
#undef MOE_LOAD
#undef MOE_WRITE
#undef MOE_COMPUTE
#undef MOE_STEP
#pragma unroll
    for (int m = 0; m < 8; ++m) { const size_t row = (size_t)orow0 + wr * 128 + m * 16 + li;
        if (GATEUP) { float h[4];
#pragma unroll
            for (int r = 0; r < 4; ++r) { const float gt = acc[m][0][r], up = acc[m][1][r]; h[r] = gt / (1.f + __expf(-gt)) * up; }
            *(uint2*)(Hout + row * DFF + ocol0 + wc * 16 + 4 * g) = make_uint2(pg8::cvt_pk_bf16(h[0], h[1]), pg8::cvt_pk_bf16(h[2], h[3]));
        } else {
#pragma unroll
            for (int n = 0; n < 2; ++n) *(float4*)(Yout + row * D + ocol0 + wc * 32 + n * 16 + 4 * g) = make_float4(acc[m][n][0], acc[m][n][1], acc[m][n][2], acc[m][n][3]);
        }
    }
}
__device__ __forceinline__ int moe_tables(const int* __restrict__ cnt, LAS int* tab, int tid) {
    __syncthreads();
    if (tid == 0) { int off = 0;
        for (int e = 0; e < NE; ++e) { tab[e] = off << 8; const int nb = (cnt[e] + 255) >> 8; for (int i = 0; i < nb; ++i) tab[64 + off + i] = (e << 8) | i; off += nb; }
        tab[64 + 128] = off; }
    __syncthreads();
    return tab[64 + 128];
}


template <int NTL, bool COMBINE>
__device__ __forceinline__ float norm_proj_unit(float* __restrict__ X, int t0, const float* __restrict__ gain, const float* __restrict__ Wt, u16* __restrict__ HB,
                                                LAS float* part, LAS float* ssp, int wave, int lane,
                                                const LAS int* mtab, const int* __restrict__ tok_e, const int* __restrict__ tok_pos, const float* __restrict__ tok_g, const float* __restrict__ Yb) {
    const int li = lane & 15, g4 = lane >> 4, t = t0 + li; const int kb = 256 * wave + 4 * g4;
    float* xp = X + (size_t)t * D + kb;
    float4 xv[16];
#pragma unroll
    for (int j = 0; j < 16; ++j) xv[j] = *(const float4*)(xp + 16 * j);
    if (COMBINE) {
        const float* y0 = Yb + (size_t)(mtab[tok_e[2 * t]] + tok_pos[2 * t]) * D + kb; const float* y1 = Yb + (size_t)(mtab[tok_e[2 * t + 1]] + tok_pos[2 * t + 1]) * D + kb;
        const float g0 = tok_g[2 * t], g1 = tok_g[2 * t + 1];
#pragma unroll
        for (int j = 0; j < 16; ++j) { const float4 a = *(const float4*)(y0 + 16 * j), b = *(const float4*)(y1 + 16 * j);
            xv[j].x += g0 * a.x + g1 * b.x; xv[j].y += g0 * a.y + g1 * b.y; xv[j].z += g0 * a.z + g1 * b.z; xv[j].w += g0 * a.w + g1 * b.w;
            *(float4*)(xp + 16 * j) = xv[j]; }
    }
    float ss = 0.f;
#pragma unroll
    for (int j = 0; j < 16; ++j) ss += (xv[j].x * xv[j].x + xv[j].y * xv[j].y) + (xv[j].z * xv[j].z + xv[j].w * xv[j].w);
    ss += bperm(lane ^ 16, ss); ss += bperm(lane ^ 32, ss);
    if (g4 == 0) ssp[wave * 16 + li] = ss;
    f32x4 acc[NTL];
#pragma unroll
    for (int nt = 0; nt < NTL; ++nt) acc[nt] = (f32x4){0.f, 0.f, 0.f, 0.f};
    const float* rb = Wt + (size_t)li * D + kb;
#pragma unroll
    for (int j = 0; j < 16; ++j) {
#pragma unroll
        for (int nt = 0; nt < NTL; ++nt) { const float4 rv = *(const float4*)(rb + (size_t)nt * 16 * D + 16 * j);
            acc[nt] = __builtin_amdgcn_mfma_f32_16x16x4f32(xv[j].x, rv.x, acc[nt], 0, 0, 0); acc[nt] = __builtin_amdgcn_mfma_f32_16x16x4f32(xv[j].y, rv.y, acc[nt], 0, 0, 0);
            acc[nt] = __builtin_amdgcn_mfma_f32_16x16x4f32(xv[j].z, rv.z, acc[nt], 0, 0, 0); acc[nt] = __builtin_amdgcn_mfma_f32_16x16x4f32(xv[j].w, rv.w, acc[nt], 0, 0, 0); }
    }
#pragma unroll
    for (int nt = 0; nt < NTL; ++nt)
#pragma unroll
        for (int r = 0; r < 4; ++r) part[(wave * 16 + 4 * g4 + r) * (NTL * 16) + nt * 16 + li] = acc[nt][r];
    __syncthreads();
    float tot = 0.f;
#pragma unroll
    for (int w = 0; w < 8; ++w) tot += ssp[w * 16 + li];
    const float rs = rsqrtf(tot / D + EPS);
    u16* hp = HB + (size_t)t * D + kb; const float* gq = gain + kb;
#pragma unroll
    for (int j = 0; j < 16; ++j) { const float4 gg = *(const float4*)(gq + 16 * j);
        *(uint2*)(hp + 16 * j) = make_uint2(pk2(xv[j].x * rs * gg.x, xv[j].y * rs * gg.y), pk2(xv[j].z * rs * gg.z, xv[j].w * rs * gg.w)); }
    return rs;
}

typedef const Params __attribute__((address_space(4)))* KP;
#define PARAMS KP kp_ = (KP)__builtin_amdgcn_kernarg_segment_ptr(); asm volatile("" : "+s"(kp_)); const __attribute__((address_space(4))) Params& p = *kp_;
__global__ void __launch_bounds__(NTHR, 2) mega(Params pk_unused) {
    extern __shared__ __attribute__((aligned(16))) char smem[];
    if (threadIdx.x == 0) *(uint4*)smem = make_uint4(0u, 0u, 0u, 0u);
    __syncthreads();
    XcdBarrier bar; { PARAMS bar = xcd_barrier_post(p.bar, (volatile LAS unsigned*)smem); }
    char* lds = smem + 16;
    LAS unsigned char* glds = (LAS unsigned char*)(smem + 16);
    const int G = gridDim.x, NGW = G * NWAVE;
    const long gsize = (long)G * NTHR;
#define IDS PARAMS int tid = threadIdx.x; asm volatile("" : "+v"(tid)); const int wave = tid >> 6, lane = tid & 63; const int gw = blockIdx.x * NWAVE + wave; const long gtid = (long)blockIdx.x * NTHR + tid; (void)wave; (void)lane; (void)gw; (void)gtid;

    { IDS
        const float4* s = (const float4*)p.x_in; float4* d = (float4*)p.X;
        for (long i = gtid; i < (long)T * D / 4; i += gsize) d[i] = s[i];
        float* scr = (float*)lds + wave * (64 * 33);
        constexpr int I_A = 32 * 48, I_B = 32 * 112, I_O = 32 * 64, I_L = I_A + I_B + I_O;
        for (int it = gw; it < 2 * I_L; it += NGW) {
            const int l = it / I_L; int r = it % I_L;
            const float* Wl = p.w_in + (size_t)l * D * DIN; u16* WTl = p.WinT + (size_t)l * DP * D;
            if (r < I_A) { transpose_item(Wl, DIN, 0, D, WTl, 0, 48, r, scr, lane); continue; } r -= I_A;
            if (r < I_B) { transpose_item(Wl, DIN, 1544, D, WTl, 1536, 112, r, scr, lane); continue; } r -= I_B;
            transpose_item(p.w_out + (size_t)l * D * D, D, 0, D, p.WoutT + (size_t)l * D * D, 0, 64, r, scr, lane);
        }
        for (long i = gtid; i < 2L * 80 * D; i += gsize) { const int l = (int)(i / (80 * D)), r = (int)(i % (80 * D)), c = r / D, k = r % D;
            const float w = (c < 8) ? p.rg_w[(size_t)l * D * 8 + k * 8 + c] : (c < 72) ? p.re_w[(size_t)l * D * 64 + k * 64 + (c - 8)] : 0.f;
            p.RT[i] = w * p.norm2_g[l * D + k]; }
        for (long i = gtid; i < 2L * 4 * 128 * 128; i += gsize) { const int e = (int)(i & 127), c = (int)((i >> 7) & 127); const long lg = i >> 14;
            p.WpT[(lg << 14) + e * 128 + c] = f2bf(p.pool_w[i]); }
        for (long i = gtid; i < 2L * 16 * D; i += gsize) { const int l = (int)(i / (16 * D)), r = (int)(i % (16 * D)), j = r / D, k = r % D;
            p.WDT[i] = j < 8 ? p.w_in[(size_t)l * D * DIN + (size_t)k * DIN + 1536 + j] * p.norm1_g[l * D + k] : 0.f; }
    }
    xcd_barrier(bar);

#pragma unroll 1
    for (int l = 0; l < 2; ++l) {
        { IDS
            LAS float* part = (LAS float*)(smem + 16); LAS float* ssp = part + 8 * 16 * 16; LAS int* mtab = (LAS int*)(ssp + 128);
            if (l > 0) moe_tables(p.ctrl + (l - 1) * 64, mtab, tid);
            const float* g1 = p.norm1_g + l * D; const float* wdt = p.WDT + (size_t)l * 16 * D;
            for (int u = blockIdx.x; u < T / 16; u += G) {
                __syncthreads();
                float rs;
                if (l > 0) rs = norm_proj_unit<1, true>(p.X, u * 16, g1, wdt, p.HB, part, ssp, wave, lane, mtab, p.tok_e, p.tok_pos, p.tok_g, p.Yb);
                else       rs = norm_proj_unit<1, false>(p.X, u * 16, g1, wdt, p.HB, part, ssp, wave, lane, mtab, p.tok_e, p.tok_pos, p.tok_g, p.Yb);
                (void)rs;
                if (tid < 128) { const int tk = tid >> 3, q = tid & 7; float s = 0.f, tot = 0.f;
#pragma unroll
                    for (int w = 0; w < 8; ++w) { s += part[(w * 16 + tk) * 16 + q]; tot += ssp[w * 16 + tk]; }
                    p.DTR[(size_t)(u * 16 + tk) * 8 + q] = s * rsqrtf(tot / D + EPS); }
            }
        }
        xcd_barrier(bar);
        {
            PARAMS
            pg8::Gemm g{p.HB, p.WinT + (size_t)l * DP * D, T, DP, D};
            pg8::StaticOrder so; so.init(T, DP, G, blockIdx.x);
            pg8::EpiStoreBf16 ep{p.PROJ, DP};
            pg8::gemm_phase(glds, g, so, ep, nullptr);
        }
        xcd_barrier(bar);
        { IDS
            for (int it = gw; it < T * 2; it += NGW) {
                const int t = it >> 1, mix = it & 1;
                u16* base = p.PROJ + (size_t)t * DP + (mix ? C_DIL : C_SB) + lane * 16;
                const float* gp = (mix ? (lane < 32 ? p.dq_g : p.dk_g) : (lane < 32 ? p.sbq_g : p.sbk_g)) + l * 64 + (lane & 3) * 16;
                const bf16x8 a = *(const bf16x8*)base, b = *(const bf16x8*)(base + 8);
                float v[16]; float ss = 0.f;
#pragma unroll
                for (int j = 0; j < 8; ++j) { v[j] = bf2f((u16)a[j]); v[8 + j] = bf2f((u16)b[j]); }
#pragma unroll
                for (int j = 0; j < 16; ++j) ss += v[j] * v[j];
                ss += swz_xor<1>(ss); ss += swz_xor<2>(ss);
                const float r = rsqrtf(ss / 64.f + EPS) * (lane < 32 ? 0.125f : 1.f);
                u32x4v o0, o1;
                { const float4 g0 = *(const float4*)gp, g1 = *(const float4*)(gp + 4), g2 = *(const float4*)(gp + 8), g3 = *(const float4*)(gp + 12);
                  o0.x = pk2(v[0] * r * g0.x, v[1] * r * g0.y); o0.y = pk2(v[2] * r * g0.z, v[3] * r * g0.w); o0.z = pk2(v[4] * r * g1.x, v[5] * r * g1.y); o0.w = pk2(v[6] * r * g1.z, v[7] * r * g1.w);
                  o1.x = pk2(v[8] * r * g2.x, v[9] * r * g2.y); o1.y = pk2(v[10] * r * g2.z, v[11] * r * g2.w); o1.z = pk2(v[12] * r * g3.x, v[13] * r * g3.y); o1.w = pk2(v[14] * r * g3.z, v[15] * r * g3.w); }
                *(u32x4v*)base = o0; *(u32x4v*)(base + 8) = o1;
            }
            for (int u = blockIdx.x; u < NB * 32 * 8; u += G) {
                const int b = u >> 8, c = (u >> 3) & 31, h = u & 7;
                ssd_chunk_unit(p.PROJ, p.DTR, p.conv_w + l * 4 * 1024, p.conv_b + l * 1024, p.dt_bias[l * 8 + h], -__expf(p.a_log[l * 8 + h]), p.ssd_d[l * 8 + h],
                               b, c, h, tid, (LAS char*)(smem + 16), p.YD, p.SS, p.ATOT, p.ACS, p.CG);
            }
            __syncthreads();
            {
                constexpr int PRS = 1040;
                LAS char* PL = (LAS char*)(smem + 16);
                const float* psc = p.pool_sc + l * 512; const u16* wpt = p.WpT + (size_t)l * 4 * 16384;
                for (int u = blockIdx.x; u < T / 32; u += G) {
                    const int tb0 = u * 32; __syncthreads();
                    { const int c = tid, gq = c >> 7, w = 2 << gq;
                      for (int tt = 0; tt < 32; ++tt) { const int t = tb0 + tt, s = t % SEQ; const int cn = min(w, s + 1);
                          float sum = 0.f; for (int i = 0; i < cn; ++i) sum += bf2f(p.PROJ[(size_t)(t - i) * DP + C_POOL + c]);
                          *(LAS u16*)(PL + tt * PRS + c * 2) = f2bf(sum / (float)cn - bf2f(p.PROJ[(size_t)t * DP + C_POOL + c])); } }
                    __syncthreads();
                    const int li = lane & 15, g4 = lane >> 4, gq = wave >> 1, eh = wave & 1;
                    f32x4 acc[4][2];
#pragma unroll
                    for (int et = 0; et < 4; ++et) { acc[et][0] = (f32x4){0.f, 0.f, 0.f, 0.f}; acc[et][1] = (f32x4){0.f, 0.f, 0.f, 0.f}; }
#pragma unroll
                    for (int ks = 0; ks < 4; ++ks) {
                        bf16x8 pf[2];
#pragma unroll
                        for (int tt = 0; tt < 2; ++tt) pf[tt] = *(const LAS bf16x8*)(PL + (tt * 16 + li) * PRS + (gq * 128 + ks * 32 + g4 * 8) * 2);
#pragma unroll
                        for (int et = 0; et < 4; ++et) { const bf16x8 wf = *(const bf16x8*)(wpt + gq * 16384 + (eh * 64 + et * 16 + li) * 128 + ks * 32 + g4 * 8);
                            acc[et][0] = __builtin_amdgcn_mfma_f32_16x16x32_bf16(wf, pf[0], acc[et][0], 0, 0, 0);
                            acc[et][1] = __builtin_amdgcn_mfma_f32_16x16x32_bf16(wf, pf[1], acc[et][1], 0, 0, 0); }
                    }
#pragma unroll
                    for (int tt = 0; tt < 2; ++tt)
#pragma unroll
                        for (int et = 0; et < 4; ++et) { const int col = gq * 128 + eh * 64 + et * 16 + 4 * g4; const float4 sc = *(const float4*)(psc + col);
                            *(uint2*)(p.MIXED + (size_t)(tb0 + tt * 16 + li) * D + 1536 + col) =
                                make_uint2(pk2(acc[et][tt][0] * sc.x, acc[et][tt][1] * sc.y), pk2(acc[et][tt][2] * sc.z, acc[et][tt][3] * sc.w)); }
                }
            }
        }
        xcd_barrier(bar);
        { IDS
        {
            for (int e = (int)gtid; e < NB * 8 * 8192; e += (int)gsize) {
                const int b = e >> 16, h = (e >> 13) & 7, pn = e & 8191; float st = 0.f;
#pragma unroll 8
                for (int c = 0; c < 32; ++c) { const size_t cu = ((size_t)b * 32 + c) * 8 + h; const size_t idx = (cu << 13) + pn;
                    p.PREV[idx] = f2bf(st); st = st * __expf(p.ATOT[cu]) + p.SS[idx]; }
            }
            LAS char* vl = (LAS char*)(smem + 16) + wave * ATT_VBYTES;
            LAS float* red = (LAS float*)((LAS char*)(smem + 16) + NWAVE * ATT_VBYTES);
            int par = 0;
            for (int u = blockIdx.x; u < 256 + 512; u += G, par ^= 1) {
                if (u < 256) sb_unit(p.PROJ, u >> 7, u & 127, wave, lane, vl, red + par * 512, p.sbo_g + l * 512, p.MIXED);
                else { const int v = u - 256; dil_unit(p.PROJ, v >> 8, (v >> 4) & 15, v & 15, wave, lane, vl, red + par * 512, p.do_g + l * 512, p.MIXED); }
            }
        }
        }
        xcd_barrier(bar);
        { IDS
            LAS float* red = (LAS float*)(smem + 16);
            int par = 0;
            for (int u = blockIdx.x; u < NB * 128; u += G, par ^= 1)
                ssd_out_unit(p.PROJ, p.PREV, p.CG, p.YD, p.ACS, p.ssd_ng + l * 512, u >> 7, u & 127, wave, lane, red + par * 512, p.MIXED);
        }
        xcd_barrier(bar);
        {
            PARAMS
            pg8::Gemm g{p.MIXED, p.WoutT + (size_t)l * D * D, T, D, D};
            pg8::StaticOrder so; so.init(T, D, G, blockIdx.x);
            pg8::EpiAddF32 ep{p.X, D};
            pg8::gemm_phase(glds, g, so, ep, nullptr);
        }
        xcd_barrier(bar);
        { IDS
            const float* g2 = p.norm2_g + l * D; const float* RTl = p.RT + (size_t)l * 80 * D; int* cnt = p.ctrl + l * 64;
            LAS float* part = (LAS float*)(smem + 16);
            LAS float* ssp = part + 8 * 16 * 80;
            LAS float* lg = ssp + 128;
            for (int u = blockIdx.x; u < T / 16; u += G) {
                const int t0 = u * 16;
                __syncthreads();
                norm_proj_unit<5, false>(p.X, t0, g2, RTl, p.HB, part, ssp, wave, lane, nullptr, nullptr, nullptr, nullptr, nullptr);
                for (int i = tid; i < 16 * 72; i += NTHR) { const int tk = i / 72, c = i % 72; float s = 0.f, tot = 0.f;
#pragma unroll
                    for (int w = 0; w < 8; ++w) { s += part[(w * 16 + tk) * 80 + c]; tot += ssp[w * 16 + tk]; }
                    lg[tk * 80 + c] = s * rsqrtf(tot / D + EPS) + (c < 8 ? p.rg_b[l * 8 + c] : p.re_b[l * 64 + c - 8]); }
                __syncthreads();
                if (tid < 16) {
                    const LAS float* gl = lg + tid * 80; const int t = t0 + tid;
                    int gi = 0; float gm = gl[0];
                    for (int j = 1; j < 8; ++j) if (gl[j] > gm) { gm = gl[j]; gi = j; }
                    float gs = 0.f;
                    for (int j = 0; j < 8; ++j) gs += __expf(gl[j] - gm);
                    const float gp = 1.f / gs;
                    const LAS float* el = gl + 8 + gi * 8;
                    int i1 = 0; float m1 = el[0];
                    for (int j = 1; j < 8; ++j) if (el[j] > m1) { m1 = el[j]; i1 = j; }
                    int i2 = -1; float m2 = -1e30f;
                    for (int j = 0; j < 8; ++j) if (j != i1 && el[j] > m2) { m2 = el[j]; i2 = j; }
                    const float p2 = __expf(m2 - m1); const float ga = gp / (1.f + p2), gb = gp * p2 / (1.f + p2);
                    const int e1 = gi * 8 + i1, e2 = gi * 8 + i2;
                    p.tok_e[t * 2] = e1; p.tok_e[t * 2 + 1] = e2; p.tok_g[t * 2] = ga; p.tok_g[t * 2 + 1] = gb;
                    const int q1 = atomicAdd(&cnt[e1], 1), q2 = atomicAdd(&cnt[e2], 1);
                    p.tok_pos[t * 2] = q1; p.tok_pos[t * 2 + 1] = q2; p.tlist[e1 * T + q1] = t; p.tlist[e2 * T + q2] = t;
                }
            }
        }
        xcd_barrier(bar);
        { IDS
            LAS char* L = (LAS char*)(smem + 16); LAS int* tab = (LAS int*)(L + MOE_LDS_TAB + 1024); LAS int* rowtab = (LAS int*)(L + MOE_LDS_TAB);
            const int* cnt = p.ctrl + l * 64;
            const int nblk = moe_tables(cnt, tab, tid);
            for (int u = blockIdx.x; u < nblk * 8; u += G) {
                const int mb = u >> 3, nt = u & 7; const int em = tab[64 + mb], e = em >> 8, mt = em & 255; const int ce = cnt[e];
                __syncthreads();
                if (tid < 256) { const int i = mt * 256 + tid; rowtab[tid] = i < ce ? p.tlist[e * T + i] : 0; }
                __syncthreads();
                const size_t wo = ((size_t)l * NE + e) * (size_t)D * DFF;
                moe_unit<true, D / 32>(p.HB, D, p.wg + wo, p.wu + wo, DFF, nt * 64, tab[e] + mt * 256, nt * 64, p.Hb, nullptr, L, tid);
            }
        }
        xcd_barrier(bar);
        { IDS
            LAS char* L = (LAS char*)(smem + 16); LAS int* tab = (LAS int*)(L + MOE_LDS_TAB + 1024); LAS int* rowtab = (LAS int*)(L + MOE_LDS_TAB);
            const int nblk = moe_tables(p.ctrl + l * 64, tab, tid);
            for (int u = blockIdx.x; u < nblk * 16; u += G) {
                const int mb = u >> 4, nt = u & 15; const int em = tab[64 + mb], e = em >> 8, mt = em & 255; const int r0 = tab[e] + mt * 256;
                __syncthreads();
                if (tid < 256) rowtab[tid] = r0 + tid;
                __syncthreads();
                moe_unit<false, DFF / 32>(p.Hb, DFF, p.wd + ((size_t)l * NE + e) * (size_t)D * DFF, nullptr, D, nt * 128, r0, nt * 128, nullptr, p.Yb, L, tid);
            }
        }
        xcd_barrier(bar);
    }
    { IDS
    LAS int* mtab = (LAS int*)(smem + 16);
    moe_tables(p.ctrl + 64, mtab, tid);
    for (int t = gw; t < T; t += NGW) {
        float4* xr = (float4*)(p.X + (size_t)t * D) + lane;
        const int r0 = mtab[p.tok_e[2 * t]] + p.tok_pos[2 * t], r1 = mtab[p.tok_e[2 * t + 1]] + p.tok_pos[2 * t + 1]; const float g0 = p.tok_g[2 * t], g1 = p.tok_g[2 * t + 1];
        const float4* y0 = (const float4*)(p.Yb + (size_t)r0 * D) + lane; const float4* y1 = (const float4*)(p.Yb + (size_t)r1 * D) + lane;
#pragma unroll
        for (int j = 0; j < 8; ++j) { float4 v = xr[64 * j]; const float4 a = y0[64 * j], b = y1[64 * j];
            v.x += g0 * a.x + g1 * b.x; v.y += g0 * a.y + g1 * b.y; v.z += g0 * a.z + g1 * b.z; v.w += g0 * a.w + g1 * b.w; xr[64 * j] = v; }
    }
    }
}

extern "C" void kernel_launch(void* const* d_in, const int* in_sizes, int n_in, void* d_out, int out_size, void* d_ws, size_t ws_size, hipStream_t stream) {
    Params p{};
    const float** pin = (const float**)&p;
    for (int i = 0; i < 26; ++i) pin[i] = (const float*)d_in[i];
    p.X = (float*)d_out;
    char* ws = (char*)d_ws; size_t off = 0;
    auto alloc = [&](size_t bytes) { void* q = ws + off; off += (bytes + 255) & ~(size_t)255; return q; };
    constexpr size_t CTL_BYTES = (size_t)XCD_BAR_WORDS * 4 + CTRL_INTS * 4;
    p.bar = (unsigned*)alloc(CTL_BYTES); p.ctrl = (int*)(p.bar + XCD_BAR_WORDS);
    p.HB = (u16*)alloc((size_t)T * D * 2);
    p.MIXED = (u16*)alloc((size_t)T * D * 2);
    p.PROJ = (u16*)alloc((size_t)T * DP * 2);
    p.DTR = (float*)alloc((size_t)T * 8 * 4);
    p.YD = (float*)alloc((size_t)T * 512 * 4);
    p.SS = (float*)alloc((size_t)NB * 32 * 8 * 8192 * 4);
    p.PREV = (u16*)alloc((size_t)NB * 32 * 8 * 8192 * 2);
    p.ATOT = (float*)alloc((size_t)NB * 32 * 8 * 4);
    p.ACS = (float*)alloc((size_t)T * 8 * 4);
    p.CG = (u16*)alloc((size_t)T * 256 * 2);
    p.WinT = (u16*)alloc((size_t)2 * DP * D * 2);
    p.WoutT = (u16*)alloc((size_t)2 * D * D * 2);
    p.RT = (float*)alloc((size_t)2 * 80 * D * 4);
    p.WpT = (u16*)alloc((size_t)2 * 4 * 128 * 128 * 2);
    p.WDT = (float*)alloc((size_t)2 * 16 * D * 4);
    p.tok_e = (int*)alloc((size_t)T * 2 * 4); p.tok_pos = (int*)alloc((size_t)T * 2 * 4); p.tlist = (int*)alloc((size_t)NE * T * 4);
    p.tok_g = (float*)alloc((size_t)T * 2 * 4);
    p.Hb = (u16*)alloc((size_t)MAXBLK * 256 * DFF * 2);
    p.Yb = (float*)alloc((size_t)MAXBLK * 256 * D * 4);
    static int grid = 0;
    if (grid == 0) {
        if (off > ws_size || n_in != 26) { fprintf(stderr, "kernel_launch: workspace too small (%zu > %zu) or n_in %d\n", off, ws_size, n_in); grid = -1; return; }
        int dev = 0, cus = 0, per_cu = 0;
        if (hipGetDevice(&dev) != hipSuccess || hipDeviceGetAttribute(&cus, hipDeviceAttributeMultiprocessorCount, dev) != hipSuccess) { grid = -1; return; }
        if (hipFuncSetAttribute((const void*)mega, hipFuncAttributeMaxDynamicSharedMemorySize, LDS_BYTES) != hipSuccess) { fprintf(stderr, "hipFuncSetAttribute failed\n"); grid = -1; return; }
        if (hipOccupancyMaxActiveBlocksPerMultiprocessor(&per_cu, (const void*)mega, NTHR, LDS_BYTES) != hipSuccess || per_cu < 1)
            fprintf(stderr, "kernel_launch: occupancy query reports %d blocks per CU\n", per_cu);
        (void)hipGetLastError();
        grid = cus;
    }
    if (grid < 0) return;
    if (hipMemsetAsync(p.bar, 0, CTL_BYTES, stream) != hipSuccess) return;
    hipLaunchKernelGGL(mega, dim3(grid), dim3(NTHR), LDS_BYTES, stream, p);
}
```

```cpp
#include <hip/hip_runtime.h>
#include <hip/hip_bf16.h>
#include <stdint.h>
#include <stdio.h>

typedef unsigned short u16;
using bf16x8 = __attribute__((ext_vector_type(8))) short;
using f32x4  = __attribute__((ext_vector_type(4))) float;
#define LAS __attribute__((address_space(3)))

constexpr int NB = 2, SEQ = 4096, T = NB * SEQ, D = 2048, DIN = 5128, DP = 5120;
constexpr int NE = 64, DFF = 512;
constexpr int MAXBLK = 128;
constexpr float EPS = 1e-6f;
constexpr int C_Z = 0, C_XBC = 512, C_SB = 1536, C_DIL = 3072, C_POOL = 4608;
constexpr int NTHR = 512, NWAVE = 8;
constexpr int LDS_BYTES = 16 + 155648;

__device__ __forceinline__ float bf2f(u16 h) { return __uint_as_float(((unsigned)h) << 16); }
__device__ __forceinline__ u16 f2bf(float f) { unsigned u = __float_as_uint(f); u += 0x7fffu + ((u >> 16) & 1u); return (u16)(u >> 16); }
__device__ __forceinline__ unsigned pk2(float lo, float hi) { return (unsigned)f2bf(lo) | ((unsigned)f2bf(hi) << 16); }
template <int O> __device__ __forceinline__ float swz_xor(float v) { return __int_as_float(__builtin_amdgcn_ds_swizzle(__float_as_int(v), (O << 10) | 0x1F)); }
__device__ __forceinline__ float rdlane(float v, int l) { return __int_as_float(__builtin_amdgcn_readlane(__float_as_int(v), l)); }
__device__ __forceinline__ float wave_sum(float v) {
    v += swz_xor<1>(v); v += swz_xor<2>(v); v += swz_xor<4>(v); v += swz_xor<8>(v); v += swz_xor<16>(v);
    return rdlane(v, 0) + rdlane(v, 32);
}
__device__ __forceinline__ float siluf(float x) { return x / (1.f + __expf(-x)); }
__device__ __forceinline__ float softplusf(float x) { return fmaxf(x, 0.f) + log1pf(__expf(-fabsf(x))); }

#define XB_TMO      128
#define XB_XCNT(j)  (256  + 64 * (j))
#define XB_XSUB(j)  (1280 + 64 * (j))
#define XB_XGEN(j)  (2304 + 64 * (j))
#define XB_TOP      3328
#define XB_TOPGEN   3392
#define XCD_BAR_WORDS 3456
#define XB_SPIN_CAP (1u << 18)
__device__ __forceinline__ unsigned xb_ld(unsigned* p)              { return __hip_atomic_load(p, __ATOMIC_RELAXED, __HIP_MEMORY_SCOPE_AGENT); }
__device__ __forceinline__ unsigned xb_add(unsigned* p, unsigned v) { return __hip_atomic_fetch_add(p, v, __ATOMIC_RELAXED, __HIP_MEMORY_SCOPE_AGENT); }
__device__ __forceinline__ unsigned xb_xcc_id() { return (unsigned)__builtin_amdgcn_s_getreg((3 << 11) | 20) & 0xFu; }
#define XB_SPIN(cond, bar) do { unsigned _sp = 0; while (cond) { __builtin_amdgcn_s_sleep(1); \
    if ((++_sp & 255u) == 0u) { if (xb_ld(&(bar)[XB_TMO])) break; if (_sp > XB_SPIN_CAP) { atomicAdd(&(bar)[XB_TMO], 1u); break; } } } } while (0)
struct XcdBarrier { unsigned* bar; unsigned x; volatile LAS unsigned* st; };
__device__ __forceinline__ XcdBarrier xcd_barrier_post(unsigned* bar, volatile LAS unsigned* st) {
    XcdBarrier b; b.bar = bar; b.x = xb_xcc_id(); b.st = st;
    if (threadIdx.x == 0) (void)xb_add(&bar[XB_XCNT(b.x)], 1u);
    return b;
}
__device__ __forceinline__ void xcd_barrier_complete(unsigned* bar, unsigned x, unsigned& nloc, unsigned& nx) {
    const unsigned G = gridDim.x * gridDim.y * gridDim.z;
    unsigned sum, cnt, mine, sp = 0u;
    for (;;) {
        sum = 0u; cnt = 0u; mine = 0u;
#pragma unroll
        for (unsigned j = 0; j < 16; ++j) { const unsigned c = xb_ld(&bar[XB_XCNT(j)]); sum += c; cnt += (c > 0u) ? 1u : 0u; mine = (j == x) ? c : mine; }
        if (sum == G) break;
        __builtin_amdgcn_s_sleep(1);
        if ((++sp & 255u) == 0u) { if (xb_ld(&bar[XB_TMO])) break; if (sp > XB_SPIN_CAP) { atomicAdd(&bar[XB_TMO], 1u); break; } }
    }
    nloc = mine > 0u ? mine : 1u; nx = cnt > 0u ? cnt : 1u;
}
__device__ __forceinline__ void xcd_barrier(const XcdBarrier& b) {
    asm volatile("s_waitcnt vmcnt(0)" ::: "memory");
    __syncthreads();
    if (threadIdx.x == 0) {
        unsigned* bar = b.bar; unsigned bx = b.x;
        asm volatile("" : "+s"(bar), "+s"(bx));
        __builtin_amdgcn_s_waitcnt(0);
        unsigned nloc = b.st[0], nx = b.st[1];
        if (nloc == 0u) { xcd_barrier_complete(bar, bx, nloc, nx); b.st[0] = nloc; b.st[1] = nx; }
        const unsigned old = xb_add(&bar[XB_XSUB(bx)], 1u);
        const unsigned gen = old / nloc;
        if (old + 1u == (gen + 1u) * nloc) {
            __builtin_amdgcn_fence(__ATOMIC_RELEASE, "agent");
            asm volatile("s_waitcnt vmcnt(0)" ::: "memory");
            const unsigned og = xb_add(&bar[XB_TOP], 1u);
            const unsigned tg = og / nx;
            if (og + 1u == (tg + 1u) * nx) xb_add(&bar[XB_TOPGEN], 1u);
            else XB_SPIN(xb_ld(&bar[XB_TOPGEN]) == tg, bar);
            __builtin_amdgcn_fence(__ATOMIC_ACQUIRE, "agent");
            xb_add(&bar[XB_XGEN(bx)], 1u);
            asm volatile("s_waitcnt vmcnt(0)" ::: "memory");
        } else {
            XB_SPIN(xb_ld(&bar[XB_XGEN(bx)]) == gen, bar);
            __builtin_amdgcn_fence(__ATOMIC_ACQUIRE, "agent");
            asm volatile("s_waitcnt vmcnt(0)" ::: "memory");
        }
    }
    __syncthreads();
}

struct Params {
    const float *x_in, *norm1_g, *w_in, *conv_w, *conv_b, *dt_bias, *a_log, *ssd_d, *ssd_ng, *sbq_g, *sbk_g, *sbo_g, *dq_g, *dk_g, *do_g,
                *pool_w, *pool_sc, *w_out, *norm2_g, *rg_w, *rg_b, *re_w, *re_b, *wg, *wu, *wd;
    float* X; unsigned* bar; int* ctrl;
    u16 *HB, *MIXED, *WinT, *WoutT, *Hb;
    u16 *PROJ, *PREV, *CG, *WpT; float *DTR, *YD, *SS, *ATOT, *ACS, *RT, *WDT, *tok_g; u16* Yb;
    int *tok_e, *tok_pos, *tlist;
};
constexpr int CTRL_INTS = 1024;

namespace pg8 {
#define PG8_LAS __attribute__((address_space(3)))
typedef unsigned short bf16_t;
typedef short bf16x8 __attribute__((ext_vector_type(8)));
typedef float f32x4 __attribute__((ext_vector_type(4)));
typedef unsigned u32x4 __attribute__((ext_vector_type(4)));
constexpr int BM = 256, BK = 64, HALF = 128, HTB = HALF * BK * 2  , STAGE_BYTES = 8 * HTB, NXCD = 8, WGM = 8;

__host__ __device__ __forceinline__ int lds_byte(int r, int c) { const int st = (r >> 4) * 2 + (c >> 5), rr = r & 15, cc = c & 31, ob = rr * 64 + cc * 2; return st * 1024 + (ob ^ (((ob >> 9) & 1) << 5)); }
__host__ __device__ __forceinline__ void stage_rc(int b, int& R, int& C) { const int st = b / 1024, sb = b % 1024, swz = sb ^ (((sb >> 9) & 1) << 5); R = (st >> 1) * 16 + swz / 64; C = (st & 1) * 32 + (swz % 64) / 2; }
__host__ __device__ __forceinline__ int perm32(int rho) { const int n = rho >> 4, i = rho & 15; return 8 * (i >> 2) + 4 * n + (i & 3); }

struct Unit { int pm, pn; };
struct Gemm { const bf16_t* A; const bf16_t* Bt; int M, N, K; };

struct StaticOrder {
    int nM, nN, nwg, G, c;
    __host__ __device__ void init(int M, int N, int G_, int c_) { nM = M / BM; nN = N / BM; nwg = nM * nN; G = G_; c = c_; }
    __host__ __device__ bool next(int i, Unit& u) const {
        const long L = (long)i * G + c; if (L >= nwg) return false;
        int wgid = (int)L; { const int q = nwg / NXCD, r = nwg % NXCD, xcd = wgid % NXCD, off = wgid / NXCD; wgid = (xcd < r ? xcd * (q + 1) : r * (q + 1) + (xcd - r) * q) + off; }
        const int nig = WGM * nN, gid = wgid / nig, fm = gid * WGM, gsz = (nM - fm) < WGM ? (nM - fm) : WGM;
        u.pm = fm + ((wgid % nig) % gsz); u.pn = (wgid % nig) / gsz; return true;
    }
    __device__ __forceinline__ void a_ready(const Unit&) const {}
    __device__ __forceinline__ void done(const Unit&) const {}
};
__device__ __forceinline__ unsigned cvt_pk_bf16(float lo, float hi) { unsigned r; asm volatile("v_cvt_pk_bf16_f32 %0, %1, %2" : "=v"(r) : "v"(lo), "v"(hi)); return r; }
typedef float f32x2 __attribute__((ext_vector_type(2)));
struct EpiF32 {
    static constexpr bool PERM = false, AFTER_DRAIN = false;
    float* C; int ldc; const float* bias;
    __device__ __forceinline__ void operator()(const f32x4 (&acc)[2][2][4][2], const Unit& u, int wr, int wc, int fr, int fq) const {
        const int row0 = u.pm * BM + wr * 64 + fr, col0 = u.pn * BM + wc * 32 + 4 * fq;
        f32x4 bv[2][2];
#pragma unroll
        for (int bj = 0; bj < 2; ++bj)
#pragma unroll
            for (int n = 0; n < 2; ++n) bv[bj][n] = bias ? *(const f32x4*)(bias + col0 + bj * HALF + n * 16) : (f32x4){0.f, 0.f, 0.f, 0.f};
#pragma unroll
        for (int ai = 0; ai < 2; ++ai)
#pragma unroll
            for (int m = 0; m < 4; ++m) { float* rowp = C + (size_t)(row0 + ai * HALF + m * 16) * ldc + col0;
#pragma unroll
                for (int bj = 0; bj < 2; ++bj)
#pragma unroll
                    for (int n = 0; n < 2; ++n) *(f32x4*)(rowp + bj * HALF + n * 16) = acc[ai][bj][m][n] + bv[bj][n]; }
    }
};
template <class Epi, class Sched, bool STAMP = false>
__device__ __forceinline__ void gemm_phase(PG8_LAS unsigned char* lds, const Gemm g, const Sched& S, const Epi& E, unsigned long long* stamps) {
    int tid = threadIdx.x; asm volatile("" : "+v"(tid));
    const int wid = __builtin_amdgcn_readfirstlane(tid >> 6), lane = tid & 63, wr = wid >> 2, wc = wid & 3, fr = lane & 15, fq = lane >> 4;
    const int K = g.K, nt = K / BK;
    int ts_lo = 0, ts_hi = 0, nts = 0; const unsigned long long rt_entry = STAMP ? (unsigned long long)wall_clock64() : 0ull;
#define PG8_STAMP() do { if (STAMP && wid == 0 && nts < 64) { const unsigned long long _c = (unsigned long long)clock64(); \
        ts_lo = (lane == nts) ? (int)(unsigned)_c : ts_lo; ts_hi = (lane == nts) ? (int)(unsigned)(_c >> 32) : ts_hi; ++nts; } } while (0)
    PG8_STAMP();
    unsigned voffA[2], voffB[2];
#pragma unroll
    for (int i = 0; i < 2; ++i) { int R, C; stage_rc(tid * 16 + i * 8192, R, C); const int Rb = Epi::PERM ? ((R & ~31) + perm32(R & 31)) : R;
        voffA[i] = (unsigned)(R * K + C) * 2u; voffB[i] = (unsigned)(Rb * K + C) * 2u; }
    const size_t kstep = (size_t)(BK * 2);
    const size_t hstep = (size_t)HALF * K * 2;
    const size_t tstep = 2 * hstep;
    const unsigned ldsw = (unsigned)wid * 1024u;
    const int aoff = lds_byte(wr * 64 + fr, fq * 8), boff = lds_byte(wc * 32 + fr, fq * 8);
#define PG8_SA(b, h) (((b) * 2 + (h)) * HTB)
#define PG8_SB(b, h) ((4 + (b) * 2 + (h)) * HTB)
#define PG8_STAGE(bufoff, gbase, voff) do { _Pragma("unroll") for (int _i = 0; _i < 2; ++_i) \
        __builtin_amdgcn_global_load_lds((const unsigned*)((const char*)(gbase) + (voff)[_i]), (PG8_LAS unsigned*)(lds + (bufoff) + ldsw + _i * 8192), 16, 0, 0); } while (0)
#define PG8_LDA(dst, b, h) do { _Pragma("unroll") for (int m = 0; m < 4; ++m) _Pragma("unroll") for (int k = 0; k < 2; ++k) dst[m][k] = *(const PG8_LAS bf16x8*)(lds + PG8_SA(b, h) + aoff + m * 2048 + k * 1024); } while (0)
#define PG8_LDB(dst, b, h) do { _Pragma("unroll") for (int n = 0; n < 2; ++n) _Pragma("unroll") for (int k = 0; k < 2; ++k) dst[n][k] = *(const PG8_LAS bf16x8*)(lds + PG8_SB(b, h) + boff + n * 2048 + k * 1024); } while (0)
#define PG8_MMA(ai, bj, At, Bt) do { __builtin_amdgcn_s_setprio(1); _Pragma("unroll") for (int m = 0; m < 4; ++m) _Pragma("unroll") for (int n = 0; n < 2; ++n) _Pragma("unroll") for (int k = 0; k < 2; ++k) \
        acc[ai][bj][m][n] = __builtin_amdgcn_mfma_f32_16x16x32_bf16(Bt[n][k], At[m][k], acc[ai][bj][m][n], 0, 0, 0); __builtin_amdgcn_s_setprio(0); } while (0)
#define PG8_WAIT_V(n) asm volatile("s_waitcnt vmcnt(" #n ")" ::: "memory")
#define PG8_WAIT_L(n) asm volatile("s_waitcnt lgkmcnt(" #n ")" ::: "memory")
#define PG8_BAR __builtin_amdgcn_s_barrier()
#define PG8_SCHED __builtin_amdgcn_sched_barrier(0)
    Unit cur, nxt; int ui = 0;
    if (!S.next(0, cur)) return;
    f32x4 acc[2][2][4][2];
#pragma unroll
    for (int a = 0; a < 2; ++a)
#pragma unroll
        for (int b = 0; b < 2; ++b)
#pragma unroll
            for (int m = 0; m < 4; ++m)
#pragma unroll
                for (int n = 0; n < 2; ++n) acc[a][b][m][n] = (f32x4){0.f, 0.f, 0.f, 0.f};
    bf16x8 At[4][2], B0[2][2], B1[2][2];
    const char* cA = (const char*)g.A + (size_t)cur.pm * tstep; const char* cB = (const char*)g.Bt + (size_t)cur.pn * tstep;
    S.a_ready(cur);
    PG8_STAGE(PG8_SB(0, 0), cB, voffB); PG8_STAGE(PG8_SA(0, 0), cA, voffA); PG8_STAGE(PG8_SB(0, 1), cB + hstep, voffB); PG8_STAGE(PG8_SA(0, 1), cA + hstep, voffA);
    if (wr == 1) PG8_BAR;
    PG8_WAIT_V(4); PG8_BAR;
    PG8_STAGE(PG8_SB(1, 0), cB + kstep, voffB); PG8_STAGE(PG8_SA(1, 0), cA + kstep, voffA); PG8_STAGE(PG8_SB(1, 1), cB + hstep + kstep, voffB);
    PG8_WAIT_V(6); PG8_BAR;
    PG8_STAMP();
    for (;;) {
        const bool has_next = S.next(ui + 1, nxt);
        const char* nA = has_next ? (const char*)g.A + (size_t)nxt.pm * tstep : cA; const char* nB = has_next ? (const char*)g.Bt + (size_t)nxt.pn * tstep : cB;
        for (int t = 0; t < nt; t += 2) {
            const bool last = (t == nt - 2);
            const char* a1 = cA + (size_t)(t + 1) * kstep;
            const char* a2 = last ? nA : cA + (size_t)(t + 2) * kstep; const char* b2 = last ? nB : cB + (size_t)(t + 2) * kstep;
            const char* a3 = a2 + kstep; const char* b3 = b2 + kstep;
            if (last && has_next) S.a_ready(nxt);
            PG8_LDB(B0, 0, 0); PG8_SCHED; PG8_LDA(At, 0, 0); PG8_STAGE(PG8_SA(1, 1), a1 + hstep, voffA);
            PG8_WAIT_L(8); PG8_BAR; PG8_WAIT_L(0); PG8_MMA(0, 0, At, B0); PG8_BAR; PG8_SCHED;
            PG8_LDB(B1, 0, 1); PG8_STAGE(PG8_SB(0, 0), b2, voffB);
            PG8_BAR; PG8_WAIT_L(0); PG8_MMA(0, 1, At, B1); PG8_BAR;
            PG8_LDA(At, 0, 1); PG8_STAGE(PG8_SA(0, 0), a2, voffA);
            PG8_BAR; PG8_WAIT_L(0); PG8_MMA(1, 0, At, B0); PG8_BAR; PG8_SCHED;
            PG8_STAGE(PG8_SB(0, 1), b2 + hstep, voffB);
            PG8_WAIT_V(6); PG8_BAR; PG8_MMA(1, 1, At, B1); PG8_BAR;
            PG8_LDB(B0, 1, 0); PG8_SCHED; PG8_LDA(At, 1, 0); PG8_STAGE(PG8_SA(0, 1), a2 + hstep, voffA);
            PG8_WAIT_L(8); PG8_BAR; PG8_WAIT_L(0); PG8_MMA(0, 0, At, B0); PG8_BAR; PG8_SCHED;
            PG8_LDB(B1, 1, 1); PG8_STAGE(PG8_SB(1, 0), b3, voffB);
            PG8_BAR; PG8_WAIT_L(0); PG8_MMA(0, 1, At, B1); PG8_BAR;
            PG8_LDA(At, 1, 1); PG8_STAGE(PG8_SA(1, 0), a3, voffA);
            PG8_BAR; PG8_WAIT_L(0); PG8_MMA(1, 0, At, B0); PG8_BAR; PG8_SCHED;
            PG8_STAGE(PG8_SB(1, 1), b3 + hstep, voffB);
            PG8_WAIT_V(6); PG8_BAR; PG8_MMA(1, 1, At, B1); PG8_BAR;
        }
        PG8_STAMP();
        if constexpr (!Epi::AFTER_DRAIN) { E(acc, cur, wr, wc, fr, fq); S.done(cur); }
        PG8_STAMP();
        if (!has_next) break;
#pragma unroll
        for (int a = 0; a < 2; ++a)
#pragma unroll
            for (int b = 0; b < 2; ++b)
#pragma unroll
                for (int m = 0; m < 4; ++m)
#pragma unroll
                    for (int n = 0; n < 2; ++n) acc[a][b][m][n] = (f32x4){0.f, 0.f, 0.f, 0.f};
        cur = nxt; cA = nA; cB = nB; ++ui;
    }
    PG8_WAIT_V(0);
    if (wr == 0) PG8_BAR;
    PG8_BAR;
    if constexpr (Epi::AFTER_DRAIN) { E.fused(acc, cur, wr, wc, fr, fq, lds, wid, lane); S.done(cur); }
    PG8_STAMP();
    if (STAMP && wid == 0) { stamps[lane] = lane < nts ? (((unsigned long long)(unsigned)ts_hi << 32) | (unsigned)ts_lo) : 0ull;
        if (lane == 62) stamps[62] = rt_entry; if (lane == 63) stamps[63] = (unsigned long long)wall_clock64(); }
#undef PG8_STAMP
#undef PG8_SA
#undef PG8_SB
#undef PG8_STAGE
#undef PG8_LDA
#undef PG8_LDB
#undef PG8_MMA
#undef PG8_WAIT_V
#undef PG8_WAIT_L
#undef PG8_BAR
#undef PG8_SCHED
}
}

namespace pg8 {
struct EpiStoreBf16 {
    static constexpr bool PERM = true, AFTER_DRAIN = false;
    bf16_t* O; int ldc;
    __device__ __forceinline__ void operator()(const f32x4 (&acc)[2][2][4][2], const Unit& u, int wr, int wc, int fr, int fq) const {
        const int row0 = u.pm * BM + wr * 64 + fr, col0 = u.pn * BM + wc * 32 + 8 * fq;
#pragma unroll
        for (int ai = 0; ai < 2; ++ai)
#pragma unroll
            for (int m = 0; m < 4; ++m) { bf16_t* rowp = O + (size_t)(row0 + ai * HALF + m * 16) * ldc + col0;
#pragma unroll
                for (int bj = 0; bj < 2; ++bj) { const f32x4 v0 = acc[ai][bj][m][0], v1 = acc[ai][bj][m][1];
                    u32x4 w; w.x = cvt_pk_bf16(v0[0], v0[1]); w.y = cvt_pk_bf16(v0[2], v0[3]); w.z = cvt_pk_bf16(v1[0], v1[1]); w.w = cvt_pk_bf16(v1[2], v1[3]);
                    *(u32x4*)(rowp + bj * HALF) = w; } }
    }
};
struct EpiAddF32 {
    static constexpr bool PERM = false, AFTER_DRAIN = false;
    float* C; int ldc;
    __device__ __forceinline__ void operator()(const f32x4 (&acc)[2][2][4][2], const Unit& u, int wr, int wc, int fr, int fq) const {
        const int row0 = u.pm * BM + wr * 64 + fr, col0 = u.pn * BM + wc * 32 + 4 * fq;
#pragma unroll
        for (int ai = 0; ai < 2; ++ai)
#pragma unroll
            for (int m = 0; m < 4; ++m) { float* rowp = C + (size_t)(row0 + ai * HALF + m * 16) * ldc + col0;
#pragma unroll
                for (int bj = 0; bj < 2; ++bj)
#pragma unroll
                    for (int n = 0; n < 2; ++n) { f32x4* q = (f32x4*)(rowp + bj * HALF + n * 16); *q = *q + acc[ai][bj][m][n]; } }
    }
};
struct EpiDownF32 {
    static constexpr bool PERM = false, AFTER_DRAIN = false;
    float* C;
    __device__ __forceinline__ void operator()(const f32x4 (&acc)[2][2][4][2], const Unit& u, int wr, int wc, int fr, int fq) const {
        const int row0 = u.pm * BM + wr * 64 + fr, col0 = (u.pn & 7) * BM + wc * 32 + 4 * fq;
#pragma unroll
        for (int ai = 0; ai < 2; ++ai)
#pragma unroll
            for (int m = 0; m < 4; ++m) { float* rowp = C + (size_t)(row0 + ai * HALF + m * 16) * 2048 + col0;
#pragma unroll
                for (int bj = 0; bj < 2; ++bj)
#pragma unroll
                    for (int n = 0; n < 2; ++n) *(f32x4*)(rowp + bj * HALF + n * 16) = acc[ai][bj][m][n]; }
    }
};
struct EpiSwiglu {
    static constexpr bool PERM = true, AFTER_DRAIN = false;
    bf16_t* H;
    __device__ __forceinline__ void operator()(const f32x4 (&acc)[2][2][4][2], const Unit& u, int wr, int wc, int fr, int fq) const {
        const int row0 = u.pm * BM + wr * 64 + fr, col0 = (u.pn & 3) * 128 + wc * 32 + 8 * fq;
#pragma unroll
        for (int ai = 0; ai < 2; ++ai)
#pragma unroll
            for (int m = 0; m < 4; ++m) { bf16_t* rowp = H + (size_t)(row0 + ai * HALF + m * 16) * 512 + col0;
                float h[8];
#pragma unroll
                for (int n = 0; n < 2; ++n)
#pragma unroll
                    for (int j = 0; j < 4; ++j) { const float g = acc[ai][0][m][n][j], up = acc[ai][1][m][n][j]; h[n * 4 + j] = g / (1.f + __expf(-g)) * up; }
                u32x4 w; w.x = cvt_pk_bf16(h[0], h[1]); w.y = cvt_pk_bf16(h[2], h[3]); w.z = cvt_pk_bf16(h[4], h[5]); w.w = cvt_pk_bf16(h[6], h[7]);
                *(u32x4*)rowp = w; }
    }
};
struct MoeOrder {
    const int* blk_e; int ntile, G, c, shift;
    __device__ __forceinline__ bool next(int i, Unit& u) const {
        const int L = i * G + c; if (L >= ntile) return false;
        const int mb = L >> shift, nt = L & ((1 << shift) - 1);
        u.pm = mb; u.pn = (blk_e[mb] << shift) + nt; return true;
    }
    __device__ __forceinline__ void a_ready(const Unit&) const {}
    __device__ __forceinline__ void done(const Unit&) const {}
};
}

__device__ __forceinline__ void transpose_item(const float* __restrict__ W, int ldin, int n0, int K, u16* __restrict__ WT, int row0, int nbn, int item, float* scr, int lane, int ilv = -1) {
    const int kb = item / nbn, nb = item % nbn, k0 = 64 * kb, nn = 32 * nb;
    const int rb = ilv < 0 ? row0 + nn : row0 + (nn >> 7) * 256 + ilv * 128 + (nn & 127);
#pragma unroll 8
    for (int i = 0; i < 32; ++i) { const int kk = 2 * i + (lane >> 5); scr[kk * 33 + (lane & 31)] = W[(size_t)(k0 + kk) * ldin + n0 + nn + (lane & 31)]; }
    asm volatile("s_waitcnt lgkmcnt(0)" ::: "memory");
    const int c = lane & 7;
#pragma unroll
    for (int j = 0; j < 4; ++j) { const int n = (lane >> 3) + 8 * j; const float* s = scr + (8 * c) * 33 + n;
        uint4 o; o.x = pk2(s[0 * 33], s[1 * 33]); o.y = pk2(s[2 * 33], s[3 * 33]); o.z = pk2(s[4 * 33], s[5 * 33]); o.w = pk2(s[6 * 33], s[7 * 33]);
        *(uint4*)(WT + (size_t)(rb + n) * K + k0 + 8 * c) = o; }
    asm volatile("s_waitcnt lgkmcnt(0)" ::: "memory");
}
__device__ __forceinline__ void convert_moe_weights(const float* wg, const float* wu, const float* wd, u16* WguT, u16* WdT, int l, float* scr, int gw, int NGW, int lane) {
    constexpr int IPE = 512;
    for (int it = gw; it < 3 * NE * IPE; it += NGW) {
        const int which = it / (NE * IPE), r = it % (NE * IPE), e = r / IPE, item = r % IPE;
        const size_t eo = ((size_t)l * NE + e) * (size_t)D * DFF;
        if (which == 0)      transpose_item(wg + eo, DFF, 0, D, WguT + (size_t)e * 1024 * D, 0, DFF / 32, item, scr, lane, 0);
        else if (which == 1) transpose_item(wu + eo, DFF, 0, D, WguT + (size_t)e * 1024 * D, 0, DFF / 32, item, scr, lane, 1);
        else                 transpose_item(wd + eo, D, 0, DFF, WdT + (size_t)e * D * DFF, 0, D / 32, item, scr, lane);
    }
}


constexpr int ATT_RS = 144;
constexpr int ATT_VBYTES = 32 * ATT_RS;
typedef long long i64;
typedef unsigned u32x4v __attribute__((ext_vector_type(4)));
typedef unsigned u32x2v __attribute__((ext_vector_type(2)));
__device__ __forceinline__ float bperm(int srclane, float v) { return __int_as_float(__builtin_amdgcn_ds_bpermute(srclane << 2, __float_as_int(v))); }
__device__ __forceinline__ float softplus_fast(float z) { return fmaxf(z, 0.f) + __logf(1.f + __expf(-fabsf(z))); }
__device__ __forceinline__ void vt_frags(unsigned vaddr, int lane, bf16x8 (&vf)[4]) {
    const unsigned a = vaddr + (unsigned)((4 * (lane >> 4) + ((lane & 15) >> 2)) * ATT_RS + (lane & 3) * 8);
    i64 r0, r1, r2, r3, r4, r5, r6, r7;
    asm volatile("s_waitcnt lgkmcnt(0)\n\t"
                 "ds_read_b64_tr_b16 %0, %8\n\tds_read_b64_tr_b16 %1, %8 offset:2304\n\t"
                 "ds_read_b64_tr_b16 %2, %8 offset:32\n\tds_read_b64_tr_b16 %3, %8 offset:2336\n\t"
                 "ds_read_b64_tr_b16 %4, %8 offset:64\n\tds_read_b64_tr_b16 %5, %8 offset:2368\n\t"
                 "ds_read_b64_tr_b16 %6, %8 offset:96\n\tds_read_b64_tr_b16 %7, %8 offset:2400\n\t"
                 "s_waitcnt lgkmcnt(0)"
                 : "=&v"(r0), "=&v"(r1), "=&v"(r2), "=&v"(r3), "=&v"(r4), "=&v"(r5), "=&v"(r6), "=&v"(r7) : "v"(a) : "memory");
    typedef i64 i64x2 __attribute__((ext_vector_type(2)));
    i64x2 t; t.x = r0; t.y = r1; vf[0] = __builtin_bit_cast(bf16x8, t); t.x = r2; t.y = r3; vf[1] = __builtin_bit_cast(bf16x8, t);
    t.x = r4; t.y = r5; vf[2] = __builtin_bit_cast(bf16x8, t); t.x = r6; t.y = r7; vf[3] = __builtin_bit_cast(bf16x8, t);
}
__device__ __forceinline__ bf16x8 pack8(const float (&a)[4], const float (&b)[4]) {
    u32x4v w; w.x = pk2(a[0], a[1]); w.y = pk2(a[2], a[3]); w.z = pk2(b[0], b[1]); w.w = pk2(b[2], b[3]);
    return __builtin_bit_cast(bf16x8, w);
}
__device__ __forceinline__ void store_out_tile(const f32x4 (&o)[4], float scale, const float* __restrict__ gain, u16* __restrict__ dst  , int g) {
#pragma unroll
    for (int dt = 0; dt < 4; ++dt) { const float4 gg = *(const float4*)(gain + dt * 16 + 4 * g);
        *(uint2*)(dst + dt * 16 + 4 * g) = make_uint2(pk2(o[dt][0] * scale * gg.x, o[dt][1] * scale * gg.y), pk2(o[dt][2] * scale * gg.z, o[dt][3] * scale * gg.w)); }
}

__device__ __forceinline__ void sb_unit(const u16* __restrict__ PROJ, int b, int qb, int h, int lane, LAS char* vl, LAS float* red,
                                        const float* __restrict__ gout, u16* __restrict__ MIXED) {
    const int li = lane & 15, g = lane >> 4; const size_t tb = (size_t)b * SEQ; const int q0 = qb * 32;
    const u16* Qp = PROJ + C_SB + h * 64; const u16* Kp = Qp + 512; const u16* Vp = Qp + 1024;
    const unsigned vaddr = (unsigned)(size_t)vl;
    bf16x8 qf[2][2];
#pragma unroll
    for (int qt = 0; qt < 2; ++qt)
#pragma unroll
        for (int s = 0; s < 2; ++s) qf[qt][s] = *(const bf16x8*)(Qp + (tb + q0 + qt * 16 + li) * DP + 32 * s + 8 * g);
    f32x4 acc[2][4];
#pragma unroll
    for (int qt = 0; qt < 2; ++qt)
#pragma unroll
        for (int dt = 0; dt < 4; ++dt) acc[qt][dt] = (f32x4){0.f, 0.f, 0.f, 0.f};
    float carry[2] = {0.f, 0.f};
    bf16x8 kn[2][2]; u32x4v vn[4];
#define SB_LOAD(kk) do { _Pragma("unroll") for (int kt = 0; kt < 2; ++kt) _Pragma("unroll") for (int s = 0; s < 2; ++s) kn[kt][s] = *(const bf16x8*)(Kp + (tb + (kk) + kt * 16 + li) * DP + 32 * s + 8 * g); \
        _Pragma("unroll") for (int u = 0; u < 4; ++u) { const int c = lane + 64 * u; vn[u] = *(const u32x4v*)(Vp + (tb + (kk) + (c >> 3)) * DP + (c & 7) * 8); } } while (0)
    SB_LOAD(q0);
    for (int k0 = q0; k0 >= 0; k0 -= 32) {
        bf16x8 kf[2][2];
#pragma unroll
        for (int kt = 0; kt < 2; ++kt)
#pragma unroll
            for (int s = 0; s < 2; ++s) kf[kt][s] = kn[kt][s];
#pragma unroll
        for (int u = 0; u < 4; ++u) { const int c = lane + 64 * u; *(LAS u32x4v*)(vl + (c >> 3) * ATT_RS + (c & 7) * 16) = vn[u]; }
        if (k0 >= 32) SB_LOAD(k0 - 32);
        bf16x8 pf[2];
#pragma unroll
        for (int qt = 0; qt < 2; ++qt) {
            const int qpos = q0 + qt * 16 + li;
            float w[2][4];
#pragma unroll
            for (int kt = 1; kt >= 0; --kt) {
                f32x4 st = __builtin_amdgcn_mfma_f32_16x16x32_bf16(kf[kt][0], qf[qt][0], (f32x4){0.f, 0.f, 0.f, 0.f}, 0, 0, 0);
                st = __builtin_amdgcn_mfma_f32_16x16x32_bf16(kf[kt][1], qf[qt][1], st, 0, 0, 0);
                const int kb = k0 + kt * 16 + 4 * g;
                float sp[4];
#pragma unroll
                for (int r = 0; r < 4; ++r) sp[r] = (kb + r < qpos) ? softplus_fast(st[r]) : 0.f;
                const float G = (sp[0] + sp[1]) + (sp[2] + sp[3]);
                const float x1 = bperm(lane ^ 16, G), hs = G + x1, x2 = bperm(lane ^ 32, hs);
                float rs = carry[qt] + (g == 3 ? 0.f : g == 2 ? x1 : g == 1 ? x2 : x1 + x2);
#pragma unroll
                for (int r = 3; r >= 0; --r) { w[kt][r] = (kb + r < qpos) ? __expf(st[r] - sp[r] - rs) : 0.f; rs += sp[r]; }
                carry[qt] += hs + x2;
            }
            pf[qt] = pack8(w[0], w[1]);
        }
        bf16x8 vf[4]; vt_frags(vaddr, lane, vf);
#pragma unroll
        for (int qt = 0; qt < 2; ++qt)
#pragma unroll
            for (int dt = 0; dt < 4; ++dt) acc[qt][dt] = __builtin_amdgcn_mfma_f32_16x16x32_bf16(vf[dt], pf[qt], acc[qt][dt], 0, 0, 0);
        if (k0 + 32 <= q0 && __all(fminf(carry[0], carry[1]) > 104.f)) break;
    }
#undef SB_LOAD
    float ss[2];
#pragma unroll
    for (int qt = 0; qt < 2; ++qt) { float s = 0.f;
#pragma unroll
        for (int dt = 0; dt < 4; ++dt) s += (acc[qt][dt][0] * acc[qt][dt][0] + acc[qt][dt][1] * acc[qt][dt][1]) + (acc[qt][dt][2] * acc[qt][dt][2] + acc[qt][dt][3] * acc[qt][dt][3]);
        s += bperm(lane ^ 16, s); s += bperm(lane ^ 32, s); ss[qt] = s;
        if (g == 0) red[h * 64 + qt * 16 + li] = s; }
    __syncthreads();
#pragma unroll
    for (int qt = 0; qt < 2; ++qt) { float tot = 0.f;
#pragma unroll
        for (int hh = 0; hh < 8; ++hh) tot += red[hh * 64 + qt * 16 + li];
        const float sc = rsqrtf(tot / 512.f + EPS);
        store_out_tile(acc[qt], sc, gout + h * 64, MIXED + (tb + q0 + qt * 16 + li) * D + 512 + h * 64, g); }
}

__device__ __forceinline__ void dil_unit(const u16* __restrict__ PROJ, int b, int w, int r, int h, int lane, LAS char* vl, LAS float* red,
                                         const float* __restrict__ gout, u16* __restrict__ MIXED) {
    const int li = lane & 15, g = lane >> 4; const size_t tb = (size_t)b * SEQ; const int qpos = w * 256 + r + 16 * li;
    const u16* Qp = PROJ + C_DIL + h * 64; const u16* Kp = Qp + 512; const u16* Vp = Qp + 1024;
    const unsigned vaddr = (unsigned)(size_t)vl;
    bf16x8 qf[2];
#pragma unroll
    for (int s = 0; s < 2; ++s) qf[s] = *(const bf16x8*)(Qp + (tb + qpos) * DP + 32 * s + 8 * g);
    f32x4 acc[4];
#pragma unroll
    for (int dt = 0; dt < 4; ++dt) acc[dt] = (f32x4){0.f, 0.f, 0.f, 0.f};
    float mrun = -1e30f, lrun = 0.f;
#pragma unroll 1
    for (int br = 0; br < 3; ++br) {
        const int dsh = br == 0 ? 4 : br == 1 ? 2 : 0;
        const int nstep = br == 0 ? 5 : br == 1 ? 6 : 12;
        const int base = w * 256 + r - (128 << dsh);
        const int rat = li << (4 - dsh);
        const int nbf = base < 0 ? ((-base + (1 << dsh) - 1) >> dsh) : 0;
        const int sbeg = nbf >> 5;
        bf16x8 kn[2][2]; u32x4v vn[4];
#define DIL_LOAD(mm) do { _Pragma("unroll") for (int kt = 0; kt < 2; ++kt) { int pos = base + (((mm) + kt * 16 + li) << dsh); pos = min(max(pos, 0), SEQ - 1); \
            _Pragma("unroll") for (int s = 0; s < 2; ++s) kn[kt][s] = *(const bf16x8*)(Kp + (tb + pos) * DP + 32 * s + 8 * g); } \
        _Pragma("unroll") for (int u = 0; u < 4; ++u) { const int c = lane + 64 * u; int pos = base + (((mm) + (c >> 3)) << dsh); pos = min(max(pos, 0), SEQ - 1); \
            vn[u] = *(const u32x4v*)(Vp + (tb + pos) * DP + (c & 7) * 8); } } while (0)
        DIL_LOAD(sbeg * 32);
#pragma unroll 1
        for (int st_ = sbeg; st_ < nstep; ++st_) {
            const int m0 = st_ * 32;
            bf16x8 kf[2][2];
#pragma unroll
            for (int kt = 0; kt < 2; ++kt)
#pragma unroll
                for (int s = 0; s < 2; ++s) kf[kt][s] = kn[kt][s];
#pragma unroll
            for (int u = 0; u < 4; ++u) { const int c = lane + 64 * u; *(LAS u32x4v*)(vl + (c >> 3) * ATT_RS + (c & 7) * 16) = vn[u]; }
            if (st_ + 1 < nstep) DIL_LOAD(m0 + 32);
            float z[2][4]; bool ok[2][4]; float zmax = -1e30f;
#pragma unroll
            for (int kt = 0; kt < 2; ++kt) {
                f32x4 st = __builtin_amdgcn_mfma_f32_16x16x32_bf16(kf[kt][0], qf[0], (f32x4){0.f, 0.f, 0.f, 0.f}, 0, 0, 0);
                st = __builtin_amdgcn_mfma_f32_16x16x32_bf16(kf[kt][1], qf[1], st, 0, 0, 0);
#pragma unroll
                for (int rr = 0; rr < 4; ++rr) { const int m = m0 + kt * 16 + 4 * g + rr; const int dm = m - rat;
                    ok[kt][rr] = (dm >= 0) && (dm <= 128) && (base + (m << dsh) >= 0);
                    z[kt][rr] = st[rr]; if (ok[kt][rr]) zmax = fmaxf(zmax, st[rr]); }
            }
            zmax = fmaxf(zmax, bperm(lane ^ 16, zmax)); zmax = fmaxf(zmax, bperm(lane ^ 32, zmax));
            const float mn = fmaxf(mrun, zmax); const float al = __expf(mrun - mn); mrun = mn;
            float pw[2][4]; float ps = 0.f;
#pragma unroll
            for (int kt = 0; kt < 2; ++kt)
#pragma unroll
                for (int rr = 0; rr < 4; ++rr) { pw[kt][rr] = ok[kt][rr] ? __expf(z[kt][rr] - mn) : 0.f; ps += pw[kt][rr]; }
            lrun = lrun * al + ps;
#pragma unroll
            for (int dt = 0; dt < 4; ++dt) acc[dt] = acc[dt] * al;
            const bf16x8 pf = pack8(pw[0], pw[1]);
            bf16x8 vf[4]; vt_frags(vaddr, lane, vf);
#pragma unroll
            for (int dt = 0; dt < 4; ++dt) acc[dt] = __builtin_amdgcn_mfma_f32_16x16x32_bf16(vf[dt], pf, acc[dt], 0, 0, 0);
        }
    }
#undef DIL_LOAD
    lrun += bperm(lane ^ 16, lrun); lrun += bperm(lane ^ 32, lrun);
    const float inv = 1.f / lrun;
    float s = 0.f;
#pragma unroll
    for (int dt = 0; dt < 4; ++dt) { acc[dt] = acc[dt] * inv; s += (acc[dt][0] * acc[dt][0] + acc[dt][1] * acc[dt][1]) + (acc[dt][2] * acc[dt][2] + acc[dt][3] * acc[dt][3]); }
    s += bperm(lane ^ 16, s); s += bperm(lane ^ 32, s);
    if (g == 0) red[h * 64 + li] = s;
    __syncthreads();
    float tot = 0.f;
#pragma unroll
    for (int hh = 0; hh < 8; ++hh) tot += red[hh * 64 + li];
    const float sc = rsqrtf(tot / 512.f + EPS);
    store_out_tile(acc, sc, gout + h * 64, MIXED + (tb + qpos) * D + 1024 + h * 64, g);
}


template <int RS> __device__ __forceinline__ void tr_frags4(unsigned addr, int lane, bf16x8 (&f)[4]) {
    const unsigned a = addr + (unsigned)((4 * (lane >> 4) + ((lane & 15) >> 2)) * RS + (lane & 3) * 8);
    i64 r0, r1, r2, r3, r4, r5, r6, r7;
    asm volatile("s_waitcnt lgkmcnt(0)\n\t"
                 "ds_read_b64_tr_b16 %0, %8\n\tds_read_b64_tr_b16 %1, %8 offset:%9\n\t"
                 "ds_read_b64_tr_b16 %2, %8 offset:32\n\tds_read_b64_tr_b16 %3, %8 offset:%10\n\t"
                 "ds_read_b64_tr_b16 %4, %8 offset:64\n\tds_read_b64_tr_b16 %5, %8 offset:%11\n\t"
                 "ds_read_b64_tr_b16 %6, %8 offset:96\n\tds_read_b64_tr_b16 %7, %8 offset:%12\n\t"
                 "s_waitcnt lgkmcnt(0)"
                 : "=&v"(r0), "=&v"(r1), "=&v"(r2), "=&v"(r3), "=&v"(r4), "=&v"(r5), "=&v"(r6), "=&v"(r7)
                 : "v"(a), "i"(16 * RS), "i"(16 * RS + 32), "i"(16 * RS + 64), "i"(16 * RS + 96) : "memory");
    typedef i64 i64x2 __attribute__((ext_vector_type(2)));
    i64x2 t; t.x = r0; t.y = r1; f[0] = __builtin_bit_cast(bf16x8, t); t.x = r2; t.y = r3; f[1] = __builtin_bit_cast(bf16x8, t);
    t.x = r4; t.y = r5; f[2] = __builtin_bit_cast(bf16x8, t); t.x = r6; t.y = r7; f[3] = __builtin_bit_cast(bf16x8, t);
}
template <int RS> __device__ __forceinline__ bf16x8 tr_frag1(unsigned addr, int lane) {
    const unsigned a = addr + (unsigned)((4 * (lane >> 4) + ((lane & 15) >> 2)) * RS + (lane & 3) * 8);
    i64 r0, r1;
    asm volatile("s_waitcnt lgkmcnt(0)\n\tds_read_b64_tr_b16 %0, %2\n\tds_read_b64_tr_b16 %1, %2 offset:%3\n\ts_waitcnt lgkmcnt(0)"
                 : "=&v"(r0), "=&v"(r1) : "v"(a), "i"(16 * RS) : "memory");
    typedef i64 i64x2 __attribute__((ext_vector_type(2)));
    i64x2 t; t.x = r0; t.y = r1; return __builtin_bit_cast(bf16x8, t);
}
constexpr int SSD_RB = 272, SSD_RX = 144;
constexpr int SSD_OFF_B = 0, SSD_OFF_C = 128 * SSD_RB, SSD_OFF_X = 2 * 128 * SSD_RB, SSD_OFF_XW = SSD_OFF_X + 128 * SSD_RX, SSD_OFF_F = SSD_OFF_XW + 128 * SSD_RX;
__device__ __forceinline__ void ssd_chunk_unit(const u16* __restrict__ PROJ, const float* __restrict__ DTR, const float* __restrict__ cw, const float* __restrict__ cb,
                                               float dtbias, float aneg, float dskip, int b, int c, int h, int tid, LAS char* L,
                                               float* __restrict__ YD, float* __restrict__ SS, float* __restrict__ ATOT, float* __restrict__ ACS, u16* __restrict__ CG) {
    const int wave = tid >> 6, lane = tid & 63, li = lane & 15, g = lane >> 4, grp = h >> 2;
    const size_t t0 = (size_t)b * SEQ + (size_t)c * 128;
    LAS float* acs = (LAS float*)(L + SSD_OFF_F); LAS float* dts = acs + 128; LAS float* wls = acs + 256;
    __syncthreads();
    if (wave == 0) {
        const float d0 = softplusf(DTR[(t0 + 2 * lane) * 8 + h] + dtbias), d1 = softplusf(DTR[(t0 + 2 * lane + 1) * 8 + h] + dtbias);
        const float a0 = d0 * aneg, a1 = d1 * aneg;
        float v = a0 + a1;
#pragma unroll
        for (int o = 1; o < 64; o <<= 1) { const float t = bperm(lane - o, v); if (lane >= o) v += t; }
        acs[2 * lane] = v - a1; acs[2 * lane + 1] = v; dts[2 * lane] = d0; dts[2 * lane + 1] = d1;
    }
    __syncthreads();
    if (tid < 128) { const float a = acs[tid]; wls[tid] = dts[tid] * __expf(acs[127] - a); ACS[(t0 + tid) * 8 + h] = a; if (tid == 0) ATOT[((size_t)b * 32 + c) * 8 + h] = acs[127]; }
    __syncthreads();
    for (int it = tid; it < 128 * 40; it += NTHR) {
        const int tl = it / 40, cg = it % 40;
        const int ch = cg < 8 ? h * 64 + cg * 8 : cg < 24 ? 512 + grp * 128 + (cg - 8) * 8 : 768 + grp * 128 + (cg - 24) * 8;
        const int sl = c * 128 + tl;
        float a[8];
        { const float4 b0 = *(const float4*)(cb + ch), b1 = *(const float4*)(cb + ch + 4); a[0] = b0.x; a[1] = b0.y; a[2] = b0.z; a[3] = b0.w; a[4] = b1.x; a[5] = b1.y; a[6] = b1.z; a[7] = b1.w; }
#pragma unroll
        for (int k = 0; k < 4; ++k) if (sl - 3 + k >= 0) {
            const bf16x8 u = *(const bf16x8*)(PROJ + (t0 + tl - 3 + k) * DP + C_XBC + ch);
            const float4 w0 = *(const float4*)(cw + k * 1024 + ch), w1 = *(const float4*)(cw + k * 1024 + ch + 4);
            a[0] += w0.x * bf2f((u16)u[0]); a[1] += w0.y * bf2f((u16)u[1]); a[2] += w0.z * bf2f((u16)u[2]); a[3] += w0.w * bf2f((u16)u[3]);
            a[4] += w1.x * bf2f((u16)u[4]); a[5] += w1.y * bf2f((u16)u[5]); a[6] += w1.z * bf2f((u16)u[6]); a[7] += w1.w * bf2f((u16)u[7]);
        }
#pragma unroll
        for (int j = 0; j < 8; ++j) a[j] = siluf(a[j]);
        u32x4v o; o.x = pk2(a[0], a[1]); o.y = pk2(a[2], a[3]); o.z = pk2(a[4], a[5]); o.w = pk2(a[6], a[7]);
        if (cg < 8) {
            *(LAS u32x4v*)(L + SSD_OFF_X + tl * SSD_RX + cg * 16) = o;
            const float wl = wls[tl]; u32x4v ow; ow.x = pk2(a[0] * wl, a[1] * wl); ow.y = pk2(a[2] * wl, a[3] * wl); ow.z = pk2(a[4] * wl, a[5] * wl); ow.w = pk2(a[6] * wl, a[7] * wl);
            *(LAS u32x4v*)(L + SSD_OFF_XW + tl * SSD_RX + cg * 16) = ow;
        } else if (cg < 24) *(LAS u32x4v*)(L + SSD_OFF_B + tl * SSD_RB + (cg - 8) * 16) = o;
        else { *(LAS u32x4v*)(L + SSD_OFF_C + tl * SSD_RB + (cg - 24) * 16) = o;
               if ((h & 3) == 0) *(u32x4v*)(CG + (t0 + tl) * 256 + grp * 128 + (cg - 24) * 8) = o; }
    }
    __syncthreads();
    const unsigned Lb = (unsigned)(size_t)L;
    {
        const int lt = wave, lrow = lt * 16 + li; const float acl = acs[lrow];
        bf16x8 cf[4];
#pragma unroll
        for (int ks = 0; ks < 4; ++ks) cf[ks] = *(const LAS bf16x8*)(L + SSD_OFF_C + lrow * SSD_RB + ks * 64 + g * 16);
        f32x4 acc[4];
#pragma unroll
        for (int pt = 0; pt < 4; ++pt) acc[pt] = (f32x4){0.f, 0.f, 0.f, 0.f};
        for (int s0 = 0; s0 <= lt * 16; s0 += 32) {
            float w[2][4];
#pragma unroll
            for (int kt = 0; kt < 2; ++kt) {
                f32x4 st = (f32x4){0.f, 0.f, 0.f, 0.f};
#pragma unroll
                for (int ks = 0; ks < 4; ++ks) { const bf16x8 bfr = *(const LAS bf16x8*)(L + SSD_OFF_B + (s0 + kt * 16 + li) * SSD_RB + ks * 64 + g * 16);
                    st = __builtin_amdgcn_mfma_f32_16x16x32_bf16(bfr, cf[ks], st, 0, 0, 0); }
                const int sb = s0 + kt * 16 + 4 * g;
                const f32x4 as4 = *(const LAS f32x4*)(acs + sb), dt4 = *(const LAS f32x4*)(dts + sb);
#pragma unroll
                for (int r = 0; r < 4; ++r) w[kt][r] = (sb + r <= lrow) ? st[r] * __expf(acl - as4[r]) * dt4[r] : 0.f;
            }
            const bf16x8 pf = pack8(w[0], w[1]);
            bf16x8 xf[4]; tr_frags4<SSD_RX>(Lb + SSD_OFF_X + s0 * SSD_RX, lane, xf);
#pragma unroll
            for (int pt = 0; pt < 4; ++pt) acc[pt] = __builtin_amdgcn_mfma_f32_16x16x32_bf16(xf[pt], pf, acc[pt], 0, 0, 0);
        }
#pragma unroll
        for (int pt = 0; pt < 4; ++pt) {
            const u32x2v xr = *(const LAS u32x2v*)(L + SSD_OFF_X + lrow * SSD_RX + (pt * 16 + 4 * g) * 2);
            float4 o; o.x = acc[pt][0] + dskip * __uint_as_float(xr.x << 16); o.y = acc[pt][1] + dskip * __uint_as_float(xr.x & 0xffff0000u);
            o.z = acc[pt][2] + dskip * __uint_as_float(xr.y << 16); o.w = acc[pt][3] + dskip * __uint_as_float(xr.y & 0xffff0000u);
            *(float4*)(YD + (t0 + lrow) * 512 + h * 64 + pt * 16 + 4 * g) = o;
        }
    }
    {
        f32x4 acc[4];
#pragma unroll
        for (int pt = 0; pt < 4; ++pt) acc[pt] = (f32x4){0.f, 0.f, 0.f, 0.f};
#pragma unroll
        for (int ks = 0; ks < 4; ++ks) {
            const bf16x8 bt = tr_frag1<SSD_RB>(Lb + SSD_OFF_B + ks * 32 * SSD_RB + wave * 32, lane);
            bf16x8 xf[4]; tr_frags4<SSD_RX>(Lb + SSD_OFF_XW + ks * 32 * SSD_RX, lane, xf);
#pragma unroll
            for (int pt = 0; pt < 4; ++pt) acc[pt] = __builtin_amdgcn_mfma_f32_16x16x32_bf16(bt, xf[pt], acc[pt], 0, 0, 0);
        }
        float* so = SS + ((((size_t)b * 32 + c) * 8 + h) << 13);
#pragma unroll
        for (int pt = 0; pt < 4; ++pt) *(float4*)(so + (pt * 16 + li) * 128 + wave * 16 + 4 * g) = make_float4(acc[pt][0], acc[pt][1], acc[pt][2], acc[pt][3]);
    }
}
__device__ __forceinline__ void ssd_out_unit(const u16* __restrict__ PROJ, const u16* __restrict__ PREV, const u16* __restrict__ CG, const float* __restrict__ YD,
                                             const float* __restrict__ ACS, const float* __restrict__ ng, int b, int j, int h, int lane, LAS float* red, u16* __restrict__ MIXED) {
    const int li = lane & 15, g = lane >> 4, grp = h >> 2, c = j >> 2; const size_t t0 = (size_t)b * SEQ + (size_t)j * 32;
    const u16* pv = PREV + ((((size_t)b * 32 + c) * 8 + h) << 13);
    f32x4 acc[4][2];
#pragma unroll
    for (int pt = 0; pt < 4; ++pt) { acc[pt][0] = (f32x4){0.f, 0.f, 0.f, 0.f}; acc[pt][1] = (f32x4){0.f, 0.f, 0.f, 0.f}; }
#pragma unroll
    for (int ks = 0; ks < 4; ++ks) {
        bf16x8 cf[2];
#pragma unroll
        for (int lt = 0; lt < 2; ++lt) cf[lt] = *(const bf16x8*)(CG + (t0 + lt * 16 + li) * 256 + grp * 128 + ks * 32 + g * 8);
#pragma unroll
        for (int pt = 0; pt < 4; ++pt) { const bf16x8 pf = *(const bf16x8*)(pv + (pt * 16 + li) * 128 + ks * 32 + g * 8);
            acc[pt][0] = __builtin_amdgcn_mfma_f32_16x16x32_bf16(pf, cf[0], acc[pt][0], 0, 0, 0);
            acc[pt][1] = __builtin_amdgcn_mfma_f32_16x16x32_bf16(pf, cf[1], acc[pt][1], 0, 0, 0); }
    }
    float ssq[2];
#pragma unroll
    for (int lt = 0; lt < 2; ++lt) {
        const size_t t = t0 + lt * 16 + li; const float ea = __expf(ACS[t * 8 + h]); float s = 0.f;
#pragma unroll
        for (int pt = 0; pt < 4; ++pt) {
            const int col = h * 64 + pt * 16 + 4 * g;
            const float4 yd = *(const float4*)(YD + t * 512 + col); const uint2 zr = *(const uint2*)(PROJ + t * DP + C_Z + col);
            f32x4 y; y[0] = (yd.x + ea * acc[pt][lt][0]) * siluf(__uint_as_float(zr.x << 16)); y[1] = (yd.y + ea * acc[pt][lt][1]) * siluf(__uint_as_float(zr.x & 0xffff0000u));
            y[2] = (yd.z + ea * acc[pt][lt][2]) * siluf(__uint_as_float(zr.y << 16)); y[3] = (yd.w + ea * acc[pt][lt][3]) * siluf(__uint_as_float(zr.y & 0xffff0000u));
            acc[pt][lt] = y; s += (y[0] * y[0] + y[1] * y[1]) + (y[2] * y[2] + y[3] * y[3]);
        }
        s += bperm(lane ^ 16, s); s += bperm(lane ^ 32, s); ssq[lt] = s;
        if (g == 0) red[h * 64 + lt * 16 + li] = s;
    }
    __syncthreads();
#pragma unroll
    for (int lt = 0; lt < 2; ++lt) {
        float tot = 0.f;
#pragma unroll
        for (int hh = 0; hh < 8; ++hh) tot += red[hh * 64 + lt * 16 + li];
        const float sc = rsqrtf(tot / 512.f + EPS);
        f32x4 o[4];
#pragma unroll
        for (int pt = 0; pt < 4; ++pt) o[pt] = acc[pt][lt];
        store_out_tile(o, sc, ng + h * 64, MIXED + (t0 + lt * 16 + li) * D + h * 64, g);
    }
}


constexpr int MOE_RS = 80, MOE_ABUF = 32768, MOE_WOFF = 2 * MOE_ABUF, MOE_WBUF = 16384, MOE_BOFF = MOE_WOFF + 4 * MOE_WBUF, MOE_BBUF = 128 * MOE_RS;
constexpr int MOE_LDS_TAB = MOE_BOFF + 2 * MOE_BBUF;
__device__ __forceinline__ void glds16(const void* gsrc, unsigned lds_dst) {
    unsigned keep;
    asm volatile("s_mov_b32 %0, m0\n\ts_mov_b32 m0, %2\n\ts_nop 0\n\tglobal_load_lds_dwordx4 %1, off\n\ts_mov_b32 m0, %0" : "=&s"(keep) : "v"(gsrc), "s"(lds_dst) : "memory");
}
template <bool GATEUP, int NK>
__device__ __forceinline__ void moe_unit(const u16* __restrict__ Abase, int lda, const float* __restrict__ W0, const float* __restrict__ W1, int ldw, int wcol0, int valid,
                                         int orow0, int ocol0, u16* __restrict__ Hout, u16* __restrict__ Yout, LAS char* L, int tid) {
    static_assert(NK >= 4, "at least four K-steps");
    const int wid = __builtin_amdgcn_readfirstlane(tid >> 6), lane = tid & 63, wr = wid >> 2, wc = wid & 3, li = lane & 15, g = lane >> 4;
    const LAS int* rowtab = (const LAS int*)(L + MOE_LDS_TAB);
    const unsigned Lb = (unsigned)(size_t)L;
    const u16* ap[4];
#pragma unroll
    for (int j = 0; j < 4; ++j) ap[j] = Abase + (size_t)rowtab[(wid * 4 + j) * 16 + (lane >> 2)] * lda + ((lane & 3) ^ ((lane >> 4) & 3)) * 8;
    const unsigned adst = Lb + (unsigned)(wid * 4) * 1024u;
    const int cpc = lane & 31;
    const float* wp = (GATEUP ? ((cpc < 16 ? W0 : W1) + wcol0 + 4 * (cpc & 15)) : (W0 + wcol0 + 4 * cpc)) + (size_t)(4 * wid + (lane >> 5)) * ldw;
    const unsigned wdst = Lb + MOE_WOFF + (unsigned)(wid * 2) * 1024u;
    const int ccol = tid & 127, ckb = tid >> 7;
    const int chc = GATEUP ? (ccol & 63) : ccol; const int cnp = GATEUP ? ((chc >> 4) * 32 + (ccol >> 6) * 16 + (chc & 15)) : chc;
    const unsigned cvr = (unsigned)(MOE_WOFF + (8 * ckb) * 512 + ccol * 4), cvw = (unsigned)(MOE_BOFF + cnp * MOE_RS + ckb * 16);
    const unsigned afr0 = (unsigned)((wr * 16 + li) * 64 + ((g ^ ((li >> 2) & 3)) * 16)), bfr0 = (unsigned)(MOE_BOFF + (wc * 32 + li) * MOE_RS + g * 16);
    const int mrows = valid - wr * 16;
    f32x4 acc[16][2];
#pragma unroll
    for (int m = 0; m < 16; ++m) { acc[m][0] = (f32x4){0.f, 0.f, 0.f, 0.f}; acc[m][1] = (f32x4){0.f, 0.f, 0.f, 0.f}; }
#define MOE_DMAA(slot, kt) do { _Pragma("unroll") for (int j = 0; j < 4; ++j) if ((wid * 4 + j) * 16 < valid) glds16(ap[j] + (kt) * 32, adst + (unsigned)(slot) * MOE_ABUF + j * 1024u); } while (0)
#define MOE_DMAW(slot, kt) do { _Pragma("unroll") for (int j = 0; j < 2; ++j) glds16(wp + (size_t)((kt) * 32 + 2 * j) * ldw, wdst + (unsigned)(slot) * MOE_WBUF + j * 1024u); } while (0)
#define MOE_CVT(wslot, bslot) do { float c_[8]; _Pragma("unroll") for (int i = 0; i < 8; ++i) c_[i] = *(const LAS float*)(L + cvr + (wslot) * MOE_WBUF + i * 512); \
        u32x4v o_; o_.x = pg8::cvt_pk_bf16(c_[0], c_[1]); o_.y = pg8::cvt_pk_bf16(c_[2], c_[3]); o_.z = pg8::cvt_pk_bf16(c_[4], c_[5]); o_.w = pg8::cvt_pk_bf16(c_[6], c_[7]); \
        *(LAS u32x4v*)(L + cvw + (bslot) * MOE_BBUF) = o_; } while (0)
#define MOE_COMPUTE(aslot, bslot) do { const bf16x8 b0 = *(const LAS bf16x8*)(L + (bslot) * MOE_BBUF + bfr0), b1 = *(const LAS bf16x8*)(L + (bslot) * MOE_BBUF + bfr0 + 16 * MOE_RS); \
        _Pragma("unroll") for (int mh = 0; mh < 4; ++mh) { if (mh * 128 < mrows) { bf16x8 af[4]; \
            _Pragma("unroll") for (int m = 0; m < 4; ++m) af[m] = *(const LAS bf16x8*)(L + (aslot) * MOE_ABUF + afr0 + (mh * 4 + m) * 2048); \
            _Pragma("unroll") for (int m = 0; m < 4; ++m) { \
                acc[mh * 4 + m][0] = __builtin_amdgcn_mfma_f32_16x16x32_bf16(b0, af[m], acc[mh * 4 + m][0], 0, 0, 0); \
                acc[mh * 4 + m][1] = __builtin_amdgcn_mfma_f32_16x16x32_bf16(b1, af[m], acc[mh * 4 + m][1], 0, 0, 0); } } } } while (0)
#define MOE_SYNC(n) do { asm volatile("s_waitcnt vmcnt(" #n ")\n\ts_waitcnt lgkmcnt(0)" ::: "memory"); __builtin_amdgcn_s_barrier(); asm volatile("" ::: "memory"); } while (0)
    MOE_DMAA(0, 0); MOE_DMAW(0, 0); MOE_DMAW(1, 1); MOE_DMAW(2, 2);
    MOE_SYNC(2);
    MOE_CVT(0, 0);
    MOE_SYNC(2);
#pragma unroll 1
    for (int kt = 0; kt < NK; ++kt) {
        const int ka = kt + 1 < NK ? kt + 1 : NK - 1, kw = kt + 3 < NK ? kt + 3 : NK - 1;
        MOE_DMAA((kt + 1) & 1, ka); MOE_DMAW((kt + 3) & 3, kw);
        MOE_COMPUTE(kt & 1, kt & 1);
        MOE_CVT((kt + 1) & 3, (kt + 1) & 1);
        MOE_SYNC(2);
    }
    asm volatile("s_waitcnt vmcnt(0)" ::: "memory");
#undef MOE_DMAA
#undef MOE_DMAW
#undef MOE_CVT
#undef MOE_COMPUTE
#undef MOE_SYNC
#pragma unroll
    for (int m = 0; m < 16; ++m) { const int rl = (2 * m + wr) * 16 + li; const size_t row = (size_t)orow0 + rl;
        if (rl < valid) {
            if (GATEUP) { float h[4];
#pragma unroll
                for (int r = 0; r < 4; ++r) { const float gt = acc[m][0][r], up = acc[m][1][r]; h[r] = gt / (1.f + __expf(-gt)) * up; }
                *(uint2*)(Hout + row * DFF + ocol0 + wc * 16 + 4 * g) = make_uint2(pg8::cvt_pk_bf16(h[0], h[1]), pg8::cvt_pk_bf16(h[2], h[3]));
            } else {
#pragma unroll
                for (int n = 0; n < 2; ++n) *(uint2*)(Yout + row * D + ocol0 + wc * 32 + n * 16 + 4 * g) = make_uint2(pg8::cvt_pk_bf16(acc[m][n][0], acc[m][n][1]), pg8::cvt_pk_bf16(acc[m][n][2], acc[m][n][3]));
            }
        }
    }
    __syncthreads();
}
__device__ __forceinline__ int moe_tables(const int* __restrict__ cnt, LAS int* tab, int tid) {
    __syncthreads();
    if (tid == 0) { int off = 0, nb = 0;
        for (int e = 0; e < NE; ++e) { tab[e] = off; const int c = cnt[e]; const int n = (c + 511) >> 9; for (int i = 0; i < n; ++i) tab[64 + nb + i] = (e << 8) | i; nb += n; off += c; }
        tab[64 + 192] = nb; }
    __syncthreads();
    return tab[64 + 192];
}

template <int NTL, bool COMBINE>
__device__ __forceinline__ float norm_proj_unit(float* __restrict__ X, int t0, const float* __restrict__ gain, const float* __restrict__ Wt, u16* __restrict__ HB,
                                                LAS float* part, LAS float* ssp, int wave, int lane,
                                                const LAS int* mtab, const int* __restrict__ tok_e, const int* __restrict__ tok_pos, const float* __restrict__ tok_g, const u16* __restrict__ Yb) {
    const int li = lane & 15, g4 = lane >> 4, t = t0 + li; const int kb = 256 * wave + 4 * g4;
    float* xp = X + (size_t)t * D + kb;
    float4 xv[16];
#pragma unroll
    for (int j = 0; j < 16; ++j) xv[j] = *(const float4*)(xp + 16 * j);
    if (COMBINE) {
        const u16* y0 = Yb + (size_t)(mtab[tok_e[2 * t]] + tok_pos[2 * t]) * D + kb; const u16* y1 = Yb + (size_t)(mtab[tok_e[2 * t + 1]] + tok_pos[2 * t + 1]) * D + kb;
        const float g0 = tok_g[2 * t], g1 = tok_g[2 * t + 1];
#pragma unroll
        for (int j = 0; j < 16; ++j) { const uint2 ua = *(const uint2*)(y0 + 16 * j), ub = *(const uint2*)(y1 + 16 * j);
            const float4 a = make_float4(__uint_as_float(ua.x << 16), __uint_as_float(ua.x & 0xffff0000u), __uint_as_float(ua.y << 16), __uint_as_float(ua.y & 0xffff0000u));
            const float4 b = make_float4(__uint_as_float(ub.x << 16), __uint_as_float(ub.x & 0xffff0000u), __uint_as_float(ub.y << 16), __uint_as_float(ub.y & 0xffff0000u));
            xv[j].x += g0 * a.x + g1 * b.x; xv[j].y += g0 * a.y + g1 * b.y; xv[j].z += g0 * a.z + g1 * b.z; xv[j].w += g0 * a.w + g1 * b.w;
            *(float4*)(xp + 16 * j) = xv[j]; }
    }
    float ss = 0.f;
#pragma unroll
    for (int j = 0; j < 16; ++j) ss += (xv[j].x * xv[j].x + xv[j].y * xv[j].y) + (xv[j].z * xv[j].z + xv[j].w * xv[j].w);
    ss += bperm(lane ^ 16, ss); ss += bperm(lane ^ 32, ss);
    if (g4 == 0) ssp[wave * 16 + li] = ss;
    f32x4 acc[NTL];
#pragma unroll
    for (int nt = 0; nt < NTL; ++nt) acc[nt] = (f32x4){0.f, 0.f, 0.f, 0.f};
    const float* rb = Wt + (size_t)li * D + kb;
#pragma unroll
    for (int j = 0; j < 16; ++j) {
#pragma unroll
        for (int nt = 0; nt < NTL; ++nt) { const float4 rv = *(const float4*)(rb + (size_t)nt * 16 * D + 16 * j);
            acc[nt] = __builtin_amdgcn_mfma_f32_16x16x4f32(xv[j].x, rv.x, acc[nt], 0, 0, 0); acc[nt] = __builtin_amdgcn_mfma_f32_16x16x4f32(xv[j].y, rv.y, acc[nt], 0, 0, 0);
            acc[nt] = __builtin_amdgcn_mfma_f32_16x16x4f32(xv[j].z, rv.z, acc[nt], 0, 0, 0); acc[nt] = __builtin_amdgcn_mfma_f32_16x16x4f32(xv[j].w, rv.w, acc[nt], 0, 0, 0); }
    }
#pragma unroll
    for (int nt = 0; nt < NTL; ++nt)
#pragma unroll
        for (int r = 0; r < 4; ++r) part[(wave * 16 + 4 * g4 + r) * (NTL * 16) + nt * 16 + li] = acc[nt][r];
    __syncthreads();
    float tot = 0.f;
#pragma unroll
    for (int w = 0; w < 8; ++w) tot += ssp[w * 16 + li];
    const float rs = rsqrtf(tot / D + EPS);
    u16* hp = HB + (size_t)t * D + kb; const float* gq = gain + kb;
#pragma unroll
    for (int j = 0; j < 16; ++j) { const float4 gg = *(const float4*)(gq + 16 * j);
        *(uint2*)(hp + 16 * j) = make_uint2(pk2(xv[j].x * rs * gg.x, xv[j].y * rs * gg.y), pk2(xv[j].z * rs * gg.z, xv[j].w * rs * gg.w)); }
    return rs;
}

typedef const Params __attribute__((address_space(4)))* KP;
#define PARAMS KP kp_ = (KP)__builtin_amdgcn_kernarg_segment_ptr(); asm volatile("" : "+s"(kp_)); const __attribute__((address_space(4))) Params& p = *kp_;
__global__ void __launch_bounds__(NTHR, 2) mega(Params pk_unused) {
    extern __shared__ __attribute__((aligned(16))) char smem[];
    if (threadIdx.x == 0) *(uint4*)smem = make_uint4(0u, 0u, 0u, 0u);
    __syncthreads();
    XcdBarrier bar; { PARAMS bar = xcd_barrier_post(p.bar, (volatile LAS unsigned*)smem); }
    char* lds = smem + 16;
    LAS unsigned char* glds = (LAS unsigned char*)(smem + 16);
    const int G = gridDim.x, NGW = G * NWAVE;
    const long gsize = (long)G * NTHR;
#define IDS PARAMS int tid = threadIdx.x; asm volatile("" : "+v"(tid)); const int wave = tid >> 6, lane = tid & 63; const int gw = blockIdx.x * NWAVE + wave; const long gtid = (long)blockIdx.x * NTHR + tid; (void)wave; (void)lane; (void)gw; (void)gtid;

    { IDS
        const float4* s = (const float4*)p.x_in; float4* d = (float4*)p.X;
        for (long i = gtid; i < (long)T * D / 4; i += gsize) d[i] = s[i];
        float* scr = (float*)lds + wave * (64 * 33);
        constexpr int I_A = 32 * 48, I_B = 32 * 112, I_O = 32 * 64, I_L = I_A + I_B + I_O;
        for (int it = gw; it < 2 * I_L; it += NGW) {
            const int l = it / I_L; int r = it % I_L;
            const float* Wl = p.w_in + (size_t)l * D * DIN; u16* WTl = p.WinT + (size_t)l * DP * D;
            if (r < I_A) { transpose_item(Wl, DIN, 0, D, WTl, 0, 48, r, scr, lane); continue; } r -= I_A;
            if (r < I_B) { transpose_item(Wl, DIN, 1544, D, WTl, 1536, 112, r, scr, lane); continue; } r -= I_B;
            transpose_item(p.w_out + (size_t)l * D * D, D, 0, D, p.WoutT + (size_t)l * D * D, 0, 64, r, scr, lane);
        }
        for (long i = gtid; i < 2L * 80 * D; i += gsize) { const int l = (int)(i / (80 * D)), r = (int)(i % (80 * D)), c = r / D, k = r % D;
            const float w = (c < 8) ? p.rg_w[(size_t)l * D * 8 + k * 8 + c] : (c < 72) ? p.re_w[(size_t)l * D * 64 + k * 64 + (c - 8)] : 0.f;
            p.RT[i] = w * p.norm2_g[l * D + k]; }
        for (long i = gtid; i < 2L * 4 * 128 * 128; i += gsize) { const int e = (int)(i & 127), c = (int)((i >> 7) & 127); const long lg = i >> 14;
            p.WpT[(lg << 14) + e * 128 + c] = f2bf(p.pool_w[i]); }
        for (long i = gtid; i < 2L * 16 * D; i += gsize) { const int l = (int)(i / (16 * D)), r = (int)(i % (16 * D)), j = r / D, k = r % D;
            p.WDT[i] = j < 8 ? p.w_in[(size_t)l * D * DIN + (size_t)k * DIN + 1536 + j] * p.norm1_g[l * D + k] : 0.f; }
    }
    xcd_barrier(bar);

#pragma unroll 1
    for (int l = 0; l < 2; ++l) {
        { IDS
            LAS float* part = (LAS float*)(smem + 16); LAS float* ssp = part + 8 * 16 * 16; LAS int* mtab = (LAS int*)(ssp + 128);
            if (l > 0) moe_tables(p.ctrl + (l - 1) * 64, mtab, tid);
            const float* g1 = p.norm1_g + l * D; const float* wdt = p.WDT + (size_t)l * 16 * D;
            for (int u = blockIdx.x; u < T / 16; u += G) {
                __syncthreads();
                float rs;
                if (l > 0) rs = norm_proj_unit<1, true>(p.X, u * 16, g1, wdt, p.HB, part, ssp, wave, lane, mtab, p.tok_e, p.tok_pos, p.tok_g, p.Yb);
                else       rs = norm_proj_unit<1, false>(p.X, u * 16, g1, wdt, p.HB, part, ssp, wave, lane, mtab, p.tok_e, p.tok_pos, p.tok_g, p.Yb);
                (void)rs;
                if (tid < 128) { const int tk = tid >> 3, q = tid & 7; float s = 0.f, tot = 0.f;
#pragma unroll
                    for (int w = 0; w < 8; ++w) { s += part[(w * 16 + tk) * 16 + q]; tot += ssp[w * 16 + tk]; }
                    p.DTR[(size_t)(u * 16 + tk) * 8 + q] = s * rsqrtf(tot / D + EPS); }
            }
        }
        xcd_barrier(bar);
        {
            PARAMS
            pg8::Gemm g{p.HB, p.WinT + (size_t)l * DP * D, T, DP, D};
            pg8::StaticOrder so; so.init(T, DP, G, blockIdx.x);
            pg8::EpiStoreBf16 ep{p.PROJ, DP};
            pg8::gemm_phase(glds, g, so, ep, nullptr);
        }
        xcd_barrier(bar);
        { IDS
            for (int it = gw; it < T * 2; it += NGW) {
                const int t = it >> 1, mix = it & 1;
                u16* base = p.PROJ + (size_t)t * DP + (mix ? C_DIL : C_SB) + lane * 16;
                const float* gp = (mix ? (lane < 32 ? p.dq_g : p.dk_g) : (lane < 32 ? p.sbq_g : p.sbk_g)) + l * 64 + (lane & 3) * 16;
                const bf16x8 a = *(const bf16x8*)base, b = *(const bf16x8*)(base + 8);
                float v[16]; float ss = 0.f;
#pragma unroll
                for (int j = 0; j < 8; ++j) { v[j] = bf2f((u16)a[j]); v[8 + j] = bf2f((u16)b[j]); }
#pragma unroll
                for (int j = 0; j < 16; ++j) ss += v[j] * v[j];
                ss += swz_xor<1>(ss); ss += swz_xor<2>(ss);
                const float r = rsqrtf(ss / 64.f + EPS) * (lane < 32 ? 0.125f : 1.f);
                u32x4v o0, o1;
                { const float4 g0 = *(const float4*)gp, g1 = *(const float4*)(gp + 4), g2 = *(const float4*)(gp + 8), g3 = *(const float4*)(gp + 12);
                  o0.x = pk2(v[0] * r * g0.x, v[1] * r * g0.y); o0.y = pk2(v[2] * r * g0.z, v[3] * r * g0.w); o0.z = pk2(v[4] * r * g1.x, v[5] * r * g1.y); o0.w = pk2(v[6] * r * g1.z, v[7] * r * g1.w);
                  o1.x = pk2(v[8] * r * g2.x, v[9] * r * g2.y); o1.y = pk2(v[10] * r * g2.z, v[11] * r * g2.w); o1.z = pk2(v[12] * r * g3.x, v[13] * r * g3.y); o1.w = pk2(v[14] * r * g3.z, v[15] * r * g3.w); }
                *(u32x4v*)base = o0; *(u32x4v*)(base + 8) = o1;
            }
            for (int u = blockIdx.x; u < NB * 32 * 8; u += G) {
                const int b = u >> 8, c = (u >> 3) & 31, h = u & 7;
                ssd_chunk_unit(p.PROJ, p.DTR, p.conv_w + l * 4 * 1024, p.conv_b + l * 1024, p.dt_bias[l * 8 + h], -__expf(p.a_log[l * 8 + h]), p.ssd_d[l * 8 + h],
                               b, c, h, tid, (LAS char*)(smem + 16), p.YD, p.SS, p.ATOT, p.ACS, p.CG);
            }
            __syncthreads();
            {
                constexpr int PRS = 1040;
                LAS char* PL = (LAS char*)(smem + 16);
                const float* psc = p.pool_sc + l * 512; const u16* wpt = p.WpT + (size_t)l * 4 * 16384;
                for (int u = blockIdx.x; u < T / 32; u += G) {
                    const int tb0 = u * 32; __syncthreads();
                    { const int c = tid, gq = c >> 7, w = 2 << gq;
                      for (int tt = 0; tt < 32; ++tt) { const int t = tb0 + tt, s = t % SEQ; const int cn = min(w, s + 1);
                          float sum = 0.f; for (int i = 0; i < cn; ++i) sum += bf2f(p.PROJ[(size_t)(t - i) * DP + C_POOL + c]);
                          *(LAS u16*)(PL + tt * PRS + c * 2) = f2bf(sum / (float)cn - bf2f(p.PROJ[(size_t)t * DP + C_POOL + c])); } }
                    __syncthreads();
                    const int li = lane & 15, g4 = lane >> 4, gq = wave >> 1, eh = wave & 1;
                    f32x4 acc[4][2];
#pragma unroll
                    for (int et = 0; et < 4; ++et) { acc[et][0] = (f32x4){0.f, 0.f, 0.f, 0.f}; acc[et][1] = (f32x4){0.f, 0.f, 0.f, 0.f}; }
#pragma unroll
                    for (int ks = 0; ks < 4; ++ks) {
                        bf16x8 pf[2];
#pragma unroll
                        for (int tt = 0; tt < 2; ++tt) pf[tt] = *(const LAS bf16x8*)(PL + (tt * 16 + li) * PRS + (gq * 128 + ks * 32 + g4 * 8) * 2);
#pragma unroll
                        for (int et = 0; et < 4; ++et) { const bf16x8 wf = *(const bf16x8*)(wpt + gq * 16384 + (eh * 64 + et * 16 + li) * 128 + ks * 32 + g4 * 8);
                            acc[et][0] = __builtin_amdgcn_mfma_f32_16x16x32_bf16(wf, pf[0], acc[et][0], 0, 0, 0);
                            acc[et][1] = __builtin_amdgcn_mfma_f32_16x16x32_bf16(wf, pf[1], acc[et][1], 0, 0, 0); }
                    }
#pragma unroll
                    for (int tt = 0; tt < 2; ++tt)
#pragma unroll
                        for (int et = 0; et < 4; ++et) { const int col = gq * 128 + eh * 64 + et * 16 + 4 * g4; const float4 sc = *(const float4*)(psc + col);
                            *(uint2*)(p.MIXED + (size_t)(tb0 + tt * 16 + li) * D + 1536 + col) =
                                make_uint2(pk2(acc[et][tt][0] * sc.x, acc[et][tt][1] * sc.y), pk2(acc[et][tt][2] * sc.z, acc[et][tt][3] * sc.w)); }
                }
            }
        }
        xcd_barrier(bar);
        { IDS
        {
            for (int e = (int)gtid; e < NB * 8 * 8192; e += (int)gsize) {
                const int b = e >> 16, h = (e >> 13) & 7, pn = e & 8191; float st = 0.f;
#pragma unroll 8
                for (int c = 0; c < 32; ++c) { const size_t cu = ((size_t)b * 32 + c) * 8 + h; const size_t idx = (cu << 13) + pn;
                    p.PREV[idx] = f2bf(st); st = st * __expf(p.ATOT[cu]) + p.SS[idx]; }
            }
            LAS char* vl = (LAS char*)(smem + 16) + wave * ATT_VBYTES;
            LAS float* red = (LAS float*)((LAS char*)(smem + 16) + NWAVE * ATT_VBYTES);
            int par = 0;
            for (int u = blockIdx.x; u < 256 + 512; u += G, par ^= 1) {
                if (u < 256) sb_unit(p.PROJ, u >> 7, u & 127, wave, lane, vl, red + par * 512, p.sbo_g + l * 512, p.MIXED);
                else { const int v = u - 256; dil_unit(p.PROJ, v >> 8, (v >> 4) & 15, v & 15, wave, lane, vl, red + par * 512, p.do_g + l * 512, p.MIXED); }
            }
        }
        }
        xcd_barrier(bar);
        { IDS
            LAS float* red = (LAS float*)(smem + 16);
            int par = 0;
            for (int u = blockIdx.x; u < NB * 128; u += G, par ^= 1)
                ssd_out_unit(p.PROJ, p.PREV, p.CG, p.YD, p.ACS, p.ssd_ng + l * 512, u >> 7, u & 127, wave, lane, red + par * 512, p.MIXED);
        }
        xcd_barrier(bar);
        {
            PARAMS
            pg8::Gemm g{p.MIXED, p.WoutT + (size_t)l * D * D, T, D, D};
            pg8::StaticOrder so; so.init(T, D, G, blockIdx.x);
            pg8::EpiAddF32 ep{p.X, D};
            pg8::gemm_phase(glds, g, so, ep, nullptr);
        }
        xcd_barrier(bar);
        { IDS
            const float* g2 = p.norm2_g + l * D; const float* RTl = p.RT + (size_t)l * 80 * D; int* cnt = p.ctrl + l * 64;
            LAS float* part = (LAS float*)(smem + 16);
            LAS float* ssp = part + 8 * 16 * 80;
            LAS float* lg = ssp + 128;
            for (int u = blockIdx.x; u < T / 16; u += G) {
                const int t0 = u * 16;
                __syncthreads();
                norm_proj_unit<5, false>(p.X, t0, g2, RTl, p.HB, part, ssp, wave, lane, nullptr, nullptr, nullptr, nullptr, nullptr);
                for (int i = tid; i < 16 * 72; i += NTHR) { const int tk = i / 72, c = i % 72; float s = 0.f, tot = 0.f;
#pragma unroll
                    for (int w = 0; w < 8; ++w) { s += part[(w * 16 + tk) * 80 + c]; tot += ssp[w * 16 + tk]; }
                    lg[tk * 80 + c] = s * rsqrtf(tot / D + EPS) + (c < 8 ? p.rg_b[l * 8 + c] : p.re_b[l * 64 + c - 8]); }
                __syncthreads();
                if (tid < 16) {
                    const LAS float* gl = lg + tid * 80; const int t = t0 + tid;
                    int gi = 0; float gm = gl[0];
                    for (int j = 1; j < 8; ++j) if (gl[j] > gm) { gm = gl[j]; gi = j; }
                    float gs = 0.f;
                    for (int j = 0; j < 8; ++j) gs += __expf(gl[j] - gm);
                    const float gp = 1.f / gs;
                    const LAS float* el = gl + 8 + gi * 8;
                    int i1 = 0; float m1 = el[0];
                    for (int j = 1; j < 8; ++j) if (el[j] > m1) { m1 = el[j]; i1 = j; }
                    int i2 = -1; float m2 = -1e30f;
                    for (int j = 0; j < 8; ++j) if (j != i1 && el[j] > m2) { m2 = el[j]; i2 = j; }
                    const float p2 = __expf(m2 - m1); const float ga = gp / (1.f + p2), gb = gp * p2 / (1.f + p2);
                    const int e1 = gi * 8 + i1, e2 = gi * 8 + i2;
                    p.tok_e[t * 2] = e1; p.tok_e[t * 2 + 1] = e2; p.tok_g[t * 2] = ga; p.tok_g[t * 2 + 1] = gb;
                    const int q1 = atomicAdd(&cnt[e1], 1), q2 = atomicAdd(&cnt[e2], 1);
                    p.tok_pos[t * 2] = q1; p.tok_pos[t * 2 + 1] = q2; p.tlist[e1 * T + q1] = t; p.tlist[e2 * T + q2] = t;
                }
            }
        }
        xcd_barrier(bar);
        { IDS
            LAS char* L = (LAS char*)(smem + 16); LAS int* tab = (LAS int*)(L + MOE_LDS_TAB + 2048); LAS int* rowtab = (LAS int*)(L + MOE_LDS_TAB);
            const int* cnt = p.ctrl + l * 64;
            const int nblk = moe_tables(cnt, tab, tid);
            const int xq = blockIdx.x & 7, xr = blockIdx.x >> 3, xR = G >> 3; const int nx = (nblk - xq + 7) >> 3;
            for (int ui = xr; ui < nx * 8; ui += xR) {
                const int mb = xq + 8 * (ui >> 3), nt = ui & 7; const int em = tab[64 + mb], e = em >> 8, mt = em & 255; const int valid = min(cnt[e] - mt * 512, 512);
                __syncthreads();
                { const int* tl = p.tlist + e * T + mt * 512; rowtab[tid] = tl[tid < valid ? tid : 0]; }
                __syncthreads();
                const size_t wo = ((size_t)l * NE + e) * (size_t)D * DFF;
                moe_unit<true, D / 32>(p.HB, D, p.wg + wo, p.wu + wo, DFF, nt * 64, valid, tab[e] + mt * 512, nt * 64, p.Hb, nullptr, L, tid);
            }
        }
        xcd_barrier(bar);
        { IDS
            LAS char* L = (LAS char*)(smem + 16); LAS int* tab = (LAS int*)(L + MOE_LDS_TAB + 2048); LAS int* rowtab = (LAS int*)(L + MOE_LDS_TAB);
            const int* cnt = p.ctrl + l * 64;
            const int nblk = moe_tables(cnt, tab, tid);
            const int xq = blockIdx.x & 7, xr = blockIdx.x >> 3, xR = G >> 3; const int nx = (nblk - xq + 7) >> 3;
            for (int ui = xr; ui < nx * 16; ui += xR) {
                const int mb = xq + 8 * (ui >> 4), nt = ui & 15; const int em = tab[64 + mb], e = em >> 8, mt = em & 255; const int valid = min(cnt[e] - mt * 512, 512); const int r0 = tab[e] + mt * 512;
                __syncthreads();
                rowtab[tid] = r0 + (tid < valid ? tid : 0);
                __syncthreads();
                moe_unit<false, DFF / 32>(p.Hb, DFF, p.wd + ((size_t)l * NE + e) * (size_t)D * DFF, nullptr, D, nt * 128, valid, r0, nt * 128, nullptr, p.Yb, L, tid);
            }
        }
        xcd_barrier(bar);
    }
    { IDS
    LAS int* mtab = (LAS int*)(smem + 16);
    moe_tables(p.ctrl + 64, mtab, tid);
    for (int t = gw; t < T; t += NGW) {
        float4* xr = (float4*)(p.X + (size_t)t * D) + lane;
        const int r0 = mtab[p.tok_e[2 * t]] + p.tok_pos[2 * t], r1 = mtab[p.tok_e[2 * t + 1]] + p.tok_pos[2 * t + 1]; const float g0 = p.tok_g[2 * t], g1 = p.tok_g[2 * t + 1];
        const uint2* y0 = (const uint2*)(p.Yb + (size_t)r0 * D) + lane; const uint2* y1 = (const uint2*)(p.Yb + (size_t)r1 * D) + lane;
#pragma unroll
        for (int j = 0; j < 8; ++j) { float4 v = xr[64 * j]; const uint2 ua = y0[64 * j], ub = y1[64 * j];
            const float4 a = make_float4(__uint_as_float(ua.x << 16), __uint_as_float(ua.x & 0xffff0000u), __uint_as_float(ua.y << 16), __uint_as_float(ua.y & 0xffff0000u));
            const float4 b = make_float4(__uint_as_float(ub.x << 16), __uint_as_float(ub.x & 0xffff0000u), __uint_as_float(ub.y << 16), __uint_as_float(ub.y & 0xffff0000u));
            v.x += g0 * a.x + g1 * b.x; v.y += g0 * a.y + g1 * b.y; v.z += g0 * a.z + g1 * b.z; v.w += g0 * a.w + g1 * b.w; xr[64 * j] = v; }
    }
    }
}

extern "C" void kernel_launch(void* const* d_in, const int* in_sizes, int n_in, void* d_out, int out_size, void* d_ws, size_t ws_size, hipStream_t stream) {
    Params p{};
    const float** pin = (const float**)&p;
    for (int i = 0; i < 26; ++i) pin[i] = (const float*)d_in[i];
    p.X = (float*)d_out;
    char* ws = (char*)d_ws; size_t off = 0;
    auto alloc = [&](size_t bytes) { void* q = ws + off; off += (bytes + 255) & ~(size_t)255; return q; };
    constexpr size_t CTL_BYTES = (size_t)XCD_BAR_WORDS * 4 + CTRL_INTS * 4;
    p.bar = (unsigned*)alloc(CTL_BYTES); p.ctrl = (int*)(p.bar + XCD_BAR_WORDS);
    p.HB = (u16*)alloc((size_t)T * D * 2);
    p.MIXED = (u16*)alloc((size_t)T * D * 2);
    p.PROJ = (u16*)alloc((size_t)T * DP * 2);
    p.DTR = (float*)alloc((size_t)T * 8 * 4);
    p.YD = (float*)alloc((size_t)T * 512 * 4);
    p.SS = (float*)alloc((size_t)NB * 32 * 8 * 8192 * 4);
    p.PREV = (u16*)alloc((size_t)NB * 32 * 8 * 8192 * 2);
    p.ATOT = (float*)alloc((size_t)NB * 32 * 8 * 4);
    p.ACS = (float*)alloc((size_t)T * 8 * 4);
    p.CG = (u16*)alloc((size_t)T * 256 * 2);
    p.WinT = (u16*)alloc((size_t)2 * DP * D * 2);
    p.WoutT = (u16*)alloc((size_t)2 * D * D * 2);
    p.RT = (float*)alloc((size_t)2 * 80 * D * 4);
    p.WpT = (u16*)alloc((size_t)2 * 4 * 128 * 128 * 2);
    p.WDT = (float*)alloc((size_t)2 * 16 * D * 4);
    p.tok_e = (int*)alloc((size_t)T * 2 * 4); p.tok_pos = (int*)alloc((size_t)T * 2 * 4); p.tlist = (int*)alloc((size_t)NE * T * 4);
    p.tok_g = (float*)alloc((size_t)T * 2 * 4);
    p.Hb = (u16*)alloc((size_t)2 * T * DFF * 2);
    p.Yb = (u16*)alloc((size_t)2 * T * D * 2);
    static int grid = 0;
    if (grid == 0) {
        if (off > ws_size || n_in != 26) { fprintf(stderr, "kernel_launch: workspace too small (%zu > %zu) or n_in %d\n", off, ws_size, n_in); grid = -1; return; }
        int dev = 0, cus = 0, per_cu = 0;
        if (hipGetDevice(&dev) != hipSuccess || hipDeviceGetAttribute(&cus, hipDeviceAttributeMultiprocessorCount, dev) != hipSuccess) { grid = -1; return; }
        if (hipFuncSetAttribute((const void*)mega, hipFuncAttributeMaxDynamicSharedMemorySize, LDS_BYTES) != hipSuccess) { fprintf(stderr, "hipFuncSetAttribute failed\n"); grid = -1; return; }
        if (hipOccupancyMaxActiveBlocksPerMultiprocessor(&per_cu, (const void*)mega, NTHR, LDS_BYTES) != hipSuccess || per_cu < 1)
            fprintf(stderr, "kernel_launch: occupancy query reports %d blocks per CU\n", per_cu);
        (void)hipGetLastError();
        grid = cus;
    }
    if (grid < 0) return;
    if (hipMemsetAsync(p.bar, 0, CTL_BYTES, stream) != hipSuccess) return;
    hipLaunchKernelGGL(mega, dim3(grid), dim3(NTHR), LDS_BYTES, stream, p);
}
```

```cpp
#include <hip/hip_runtime.h>
#include <hip/hip_bf16.h>
#include <stdint.h>
#include <stdio.h>

typedef unsigned short u16;
using bf16x8 = __attribute__((ext_vector_type(8))) short;
using f32x4  = __attribute__((ext_vector_type(4))) float;
#define LAS __attribute__((address_space(3)))

constexpr int NB = 2, SEQ = 4096, T = NB * SEQ, D = 2048, DIN = 5128, DP = 5120;
constexpr int NE = 64, DFF = 512;
constexpr float EPS = 1e-6f;
constexpr int C_XBC = 0, C_SB = 1024, C_DIL = 2560;
constexpr int NTHR = 512, NWAVE = 8;
constexpr int LDS_BYTES = 16 + 159744 + 64;

__device__ __forceinline__ float bf2f(u16 h) { return __uint_as_float(((unsigned)h) << 16); }
__device__ __forceinline__ u16 f2bf(float f) { unsigned u = __float_as_uint(f); u += 0x7fffu + ((u >> 16) & 1u); return (u16)(u >> 16); }
__device__ __forceinline__ unsigned pk2(float lo, float hi) { return (unsigned)f2bf(lo) | ((unsigned)f2bf(hi) << 16); }
template <int O> __device__ __forceinline__ float swz_xor(float v) { return __int_as_float(__builtin_amdgcn_ds_swizzle(__float_as_int(v), (O << 10) | 0x1F)); }
__device__ __forceinline__ float rdlane(float v, int l) { return __int_as_float(__builtin_amdgcn_readlane(__float_as_int(v), l)); }
__device__ __forceinline__ float wave_sum(float v) {
    v += swz_xor<1>(v); v += swz_xor<2>(v); v += swz_xor<4>(v); v += swz_xor<8>(v); v += swz_xor<16>(v);
    return rdlane(v, 0) + rdlane(v, 32);
}
__device__ __forceinline__ float siluf(float x) { return x / (1.f + __expf(-x)); }
__device__ __forceinline__ float softplusf(float x) { return fmaxf(x, 0.f) + log1pf(__expf(-fabsf(x))); }

#define XB_TMO      128
#define XB_XCNT(j)  (256  + 64 * (j))
#define XB_XSUB(j)  (1280 + 64 * (j))
#define XB_XGEN(j)  (2304 + 64 * (j))
#define XB_TOP      3328
#define XB_TOPGEN   3392
#define XCD_BAR_WORDS 3456
#define XB_SPIN_CAP (1u << 18)
__device__ __forceinline__ unsigned xb_ld(unsigned* p)              { return __hip_atomic_load(p, __ATOMIC_RELAXED, __HIP_MEMORY_SCOPE_AGENT); }
__device__ __forceinline__ unsigned xb_add(unsigned* p, unsigned v) { return __hip_atomic_fetch_add(p, v, __ATOMIC_RELAXED, __HIP_MEMORY_SCOPE_AGENT); }
__device__ __forceinline__ unsigned xb_xcc_id() { return (unsigned)__builtin_amdgcn_s_getreg((3 << 11) | 20) & 0xFu; }
#define XB_SPIN(cond, bar) do { unsigned _sp = 0; while (cond) { __builtin_amdgcn_s_sleep(1); \
    if ((++_sp & 255u) == 0u) { if (xb_ld(&(bar)[XB_TMO])) break; if (_sp > XB_SPIN_CAP) { atomicAdd(&(bar)[XB_TMO], 1u); break; } } } } while (0)
struct XcdBarrier { unsigned* bar; unsigned x; volatile LAS unsigned* st; };
__device__ __forceinline__ XcdBarrier xcd_barrier_post(unsigned* bar, volatile LAS unsigned* st) {
    XcdBarrier b; b.bar = bar; b.x = xb_xcc_id(); b.st = st;
    if (threadIdx.x == 0) (void)xb_add(&bar[XB_XCNT(b.x)], 1u);
    return b;
}
__device__ __forceinline__ void xcd_barrier_complete(unsigned* bar, unsigned x, unsigned& nloc, unsigned& nx) {
    const unsigned G = gridDim.x * gridDim.y * gridDim.z;
    unsigned sum, cnt, mine, sp = 0u;
    for (;;) {
        sum = 0u; cnt = 0u; mine = 0u;
#pragma unroll
        for (unsigned j = 0; j < 16; ++j) { const unsigned c = xb_ld(&bar[XB_XCNT(j)]); sum += c; cnt += (c > 0u) ? 1u : 0u; mine = (j == x) ? c : mine; }
        if (sum == G) break;
        __builtin_amdgcn_s_sleep(1);
        if ((++sp & 255u) == 0u) { if (xb_ld(&bar[XB_TMO])) break; if (sp > XB_SPIN_CAP) { atomicAdd(&bar[XB_TMO], 1u); break; } }
    }
    nloc = mine > 0u ? mine : 1u; nx = cnt > 0u ? cnt : 1u;
}
__device__ __forceinline__ void xcd_barrier(const XcdBarrier& b) {
    asm volatile("s_waitcnt vmcnt(0)" ::: "memory");
    __syncthreads();
    if (threadIdx.x == 0) {
        unsigned* bar = b.bar; unsigned bx = b.x;
        asm volatile("" : "+s"(bar), "+s"(bx));
        __builtin_amdgcn_s_waitcnt(0);
        unsigned nloc = b.st[0], nx = b.st[1];
        if (nloc == 0u) { xcd_barrier_complete(bar, bx, nloc, nx); b.st[0] = nloc; b.st[1] = nx; }
        const unsigned old = xb_add(&bar[XB_XSUB(bx)], 1u);
        const unsigned gen = old / nloc;
        if (old + 1u == (gen + 1u) * nloc) {
            __builtin_amdgcn_fence(__ATOMIC_RELEASE, "agent");
            asm volatile("s_waitcnt vmcnt(0)" ::: "memory");
            const unsigned og = xb_add(&bar[XB_TOP], 1u);
            const unsigned tg = og / nx;
            if (og + 1u == (tg + 1u) * nx) xb_add(&bar[XB_TOPGEN], 1u);
            else XB_SPIN(xb_ld(&bar[XB_TOPGEN]) == tg, bar);
            __builtin_amdgcn_fence(__ATOMIC_ACQUIRE, "agent");
            xb_add(&bar[XB_XGEN(bx)], 1u);
            asm volatile("s_waitcnt vmcnt(0)" ::: "memory");
        } else {
            XB_SPIN(xb_ld(&bar[XB_XGEN(bx)]) == gen, bar);
            __builtin_amdgcn_fence(__ATOMIC_ACQUIRE, "agent");
            asm volatile("s_waitcnt vmcnt(0)" ::: "memory");
        }
    }
    __syncthreads();
}

struct Params {
    const float *x_in, *norm1_g, *w_in, *conv_w, *conv_b, *dt_bias, *a_log, *ssd_d, *ssd_ng, *sbq_g, *sbk_g, *sbo_g, *dq_g, *dk_g, *do_g,
                *pool_w, *pool_sc, *w_out, *norm2_g, *rg_w, *rg_b, *re_w, *re_b, *wg, *wu, *wd;
    float* X; unsigned* bar; int* ctrl;
    u16 *HB, *MIXED, *WinT, *WoutT, *Hb;
    u16 *PROJ, *PREV, *CG, *WpT, *PZ0, *PZ1; float *DTR, *YD, *SS, *ATOT, *ACS, *RT, *WDT, *tok_g; u16* Yb;
    int *tok_e, *tok_pos, *tlist;
};
constexpr int CTRL_INTS = 1024;

namespace pg8 {
#define PG8_LAS __attribute__((address_space(3)))
typedef unsigned short bf16_t;
typedef short bf16x8 __attribute__((ext_vector_type(8)));
typedef float f32x4 __attribute__((ext_vector_type(4)));
typedef unsigned u32x4 __attribute__((ext_vector_type(4)));
constexpr int BM = 256, BK = 64, HALF = 128, HTB = HALF * BK * 2  , STAGE_BYTES = 8 * HTB, NXCD = 8, WGM = 8;

__host__ __device__ __forceinline__ int lds_byte(int r, int c) { const int st = (r >> 4) * 2 + (c >> 5), rr = r & 15, cc = c & 31, ob = rr * 64 + cc * 2; return st * 1024 + (ob ^ (((ob >> 9) & 1) << 5)); }
__host__ __device__ __forceinline__ void stage_rc(int b, int& R, int& C) { const int st = b / 1024, sb = b % 1024, swz = sb ^ (((sb >> 9) & 1) << 5); R = (st >> 1) * 16 + swz / 64; C = (st & 1) * 32 + (swz % 64) / 2; }
__host__ __device__ __forceinline__ int perm32(int rho) { const int n = rho >> 4, i = rho & 15; return 8 * (i >> 2) + 4 * n + (i & 3); }

struct Unit { int pm, pn; };
struct Gemm { const bf16_t* A; const bf16_t* Bt; int M, N, K, ld; };

struct StaticOrder {
    int nM, nN, nwg, G, c;
    __host__ __device__ void init(int M, int N, int G_, int c_) { nM = M / BM; nN = N / BM; nwg = nM * nN; G = G_; c = c_; }
    __host__ __device__ bool next(int i, Unit& u) const {
        const long L = (long)i * G + c; if (L >= nwg) return false;
        int wgid = (int)L; { const int q = nwg / NXCD, r = nwg % NXCD, xcd = wgid % NXCD, off = wgid / NXCD; wgid = (xcd < r ? xcd * (q + 1) : r * (q + 1) + (xcd - r) * q) + off; }
        const int nig = WGM * nN, gid = wgid / nig, fm = gid * WGM, gsz = (nM - fm) < WGM ? (nM - fm) : WGM;
        u.pm = fm + ((wgid % nig) % gsz); u.pn = (wgid % nig) / gsz; return true;
    }
    __device__ __forceinline__ void a_ready(const Unit&) const {}
    __device__ __forceinline__ void done(const Unit&) const {}
};
__device__ __forceinline__ unsigned cvt_pk_bf16(float lo, float hi) { unsigned r; asm volatile("v_cvt_pk_bf16_f32 %0, %1, %2" : "=v"(r) : "v"(lo), "v"(hi)); return r; }
typedef float f32x2 __attribute__((ext_vector_type(2)));
struct EpiF32 {
    static constexpr bool PERM = false, AFTER_DRAIN = false;
    float* C; int ldc; const float* bias;
    __device__ __forceinline__ void operator()(const f32x4 (&acc)[2][2][4][2], const Unit& u, int wr, int wc, int fr, int fq) const {
        const int row0 = u.pm * BM + wr * 64 + fr, col0 = u.pn * BM + wc * 32 + 4 * fq;
        f32x4 bv[2][2];
#pragma unroll
        for (int bj = 0; bj < 2; ++bj)
#pragma unroll
            for (int n = 0; n < 2; ++n) bv[bj][n] = bias ? *(const f32x4*)(bias + col0 + bj * HALF + n * 16) : (f32x4){0.f, 0.f, 0.f, 0.f};
#pragma unroll
        for (int ai = 0; ai < 2; ++ai)
#pragma unroll
            for (int m = 0; m < 4; ++m) { float* rowp = C + (size_t)(row0 + ai * HALF + m * 16) * ldc + col0;
#pragma unroll
                for (int bj = 0; bj < 2; ++bj)
#pragma unroll
                    for (int n = 0; n < 2; ++n) *(f32x4*)(rowp + bj * HALF + n * 16) = acc[ai][bj][m][n] + bv[bj][n]; }
    }
};
template <class Epi, class Sched, bool STAMP = false>
__device__ __forceinline__ void gemm_phase(PG8_LAS unsigned char* lds, const Gemm g, const Sched& S, const Epi& E, unsigned long long* stamps) {
    int tid = threadIdx.x; asm volatile("" : "+v"(tid));
    const int wid = __builtin_amdgcn_readfirstlane(tid >> 6), lane = tid & 63, wr = wid >> 2, wc = wid & 3, fr = lane & 15, fq = lane >> 4;
    const int K = g.K, nt = K / BK, LD = g.ld;
    int ts_lo = 0, ts_hi = 0, nts = 0; const unsigned long long rt_entry = STAMP ? (unsigned long long)wall_clock64() : 0ull;
#define PG8_STAMP() do { if (STAMP && wid == 0 && nts < 64) { const unsigned long long _c = (unsigned long long)clock64(); \
        ts_lo = (lane == nts) ? (int)(unsigned)_c : ts_lo; ts_hi = (lane == nts) ? (int)(unsigned)(_c >> 32) : ts_hi; ++nts; } } while (0)
    PG8_STAMP();
    unsigned voffA[2], voffB[2];
#pragma unroll
    for (int i = 0; i < 2; ++i) { int R, C; stage_rc(tid * 16 + i * 8192, R, C); const int Rb = Epi::PERM ? ((R & ~31) + perm32(R & 31)) : R;
        voffA[i] = (unsigned)(R * LD + C) * 2u; voffB[i] = (unsigned)(Rb * LD + C) * 2u; }
    const size_t kstep = (size_t)(BK * 2);
    const size_t hstep = (size_t)HALF * LD * 2;
    const size_t tstep = 2 * hstep;
    const unsigned ldsw = (unsigned)wid * 1024u;
    const int aoff = lds_byte(wr * 64 + fr, fq * 8), boff = lds_byte(wc * 32 + fr, fq * 8);
#define PG8_SA(b, h) (((b) * 2 + (h)) * HTB)
#define PG8_SB(b, h) ((4 + (b) * 2 + (h)) * HTB)
#define PG8_STAGE(bufoff, gbase, voff) do { _Pragma("unroll") for (int _i = 0; _i < 2; ++_i) \
        __builtin_amdgcn_global_load_lds((const unsigned*)((const char*)(gbase) + (voff)[_i]), (PG8_LAS unsigned*)(lds + (bufoff) + ldsw + _i * 8192), 16, 0, 0); } while (0)
#define PG8_LDA(dst, b, h) do { _Pragma("unroll") for (int m = 0; m < 4; ++m) _Pragma("unroll") for (int k = 0; k < 2; ++k) dst[m][k] = *(const PG8_LAS bf16x8*)(lds + PG8_SA(b, h) + aoff + m * 2048 + k * 1024); } while (0)
#define PG8_LDB(dst, b, h) do { _Pragma("unroll") for (int n = 0; n < 2; ++n) _Pragma("unroll") for (int k = 0; k < 2; ++k) dst[n][k] = *(const PG8_LAS bf16x8*)(lds + PG8_SB(b, h) + boff + n * 2048 + k * 1024); } while (0)
#define PG8_MMA(ai, bj, At, Bt) do { __builtin_amdgcn_s_setprio(1); _Pragma("unroll") for (int m = 0; m < 4; ++m) _Pragma("unroll") for (int n = 0; n < 2; ++n) _Pragma("unroll") for (int k = 0; k < 2; ++k) \
        acc[ai][bj][m][n] = __builtin_amdgcn_mfma_f32_16x16x32_bf16(Bt[n][k], At[m][k], acc[ai][bj][m][n], 0, 0, 0); __builtin_amdgcn_s_setprio(0); } while (0)
#define PG8_WAIT_V(n) asm volatile("s_waitcnt vmcnt(" #n ")" ::: "memory")
#define PG8_WAIT_L(n) asm volatile("s_waitcnt lgkmcnt(" #n ")" ::: "memory")
#define PG8_BAR __builtin_amdgcn_s_barrier()
#define PG8_SCHED __builtin_amdgcn_sched_barrier(0)
    Unit cur, nxt; int ui = 0;
    if (!S.next(0, cur)) return;
    f32x4 acc[2][2][4][2];
#pragma unroll
    for (int a = 0; a < 2; ++a)
#pragma unroll
        for (int b = 0; b < 2; ++b)
#pragma unroll
            for (int m = 0; m < 4; ++m)
#pragma unroll
                for (int n = 0; n < 2; ++n) acc[a][b][m][n] = (f32x4){0.f, 0.f, 0.f, 0.f};
    bf16x8 At[4][2], B0[2][2], B1[2][2];
    const char* cA = (const char*)g.A + (size_t)cur.pm * tstep; const char* cB = (const char*)g.Bt + (size_t)cur.pn * tstep;
    S.a_ready(cur);
    PG8_STAGE(PG8_SB(0, 0), cB, voffB); PG8_STAGE(PG8_SA(0, 0), cA, voffA); PG8_STAGE(PG8_SB(0, 1), cB + hstep, voffB); PG8_STAGE(PG8_SA(0, 1), cA + hstep, voffA);
    if (wr == 1) PG8_BAR;
    PG8_WAIT_V(4); PG8_BAR;
    PG8_STAGE(PG8_SB(1, 0), cB + kstep, voffB); PG8_STAGE(PG8_SA(1, 0), cA + kstep, voffA); PG8_STAGE(PG8_SB(1, 1), cB + hstep + kstep, voffB);
    PG8_WAIT_V(6); PG8_BAR;
    PG8_STAMP();
    for (;;) {
        const bool has_next = S.next(ui + 1, nxt);
        const char* nA = has_next ? (const char*)g.A + (size_t)nxt.pm * tstep : cA; const char* nB = has_next ? (const char*)g.Bt + (size_t)nxt.pn * tstep : cB;
        for (int t = 0; t < nt; t += 2) {
            const bool last = (t == nt - 2);
            const char* a1 = cA + (size_t)(t + 1) * kstep;
            const char* a2 = last ? nA : cA + (size_t)(t + 2) * kstep; const char* b2 = last ? nB : cB + (size_t)(t + 2) * kstep;
            const char* a3 = a2 + kstep; const char* b3 = b2 + kstep;
            if (last && has_next) S.a_ready(nxt);
            PG8_LDB(B0, 0, 0); PG8_SCHED; PG8_LDA(At, 0, 0); PG8_STAGE(PG8_SA(1, 1), a1 + hstep, voffA);
            PG8_WAIT_L(8); PG8_BAR; PG8_WAIT_L(0); PG8_MMA(0, 0, At, B0); PG8_BAR; PG8_SCHED;
            PG8_LDB(B1, 0, 1); PG8_STAGE(PG8_SB(0, 0), b2, voffB);
            PG8_BAR; PG8_WAIT_L(0); PG8_MMA(0, 1, At, B1); PG8_BAR;
            PG8_LDA(At, 0, 1); PG8_STAGE(PG8_SA(0, 0), a2, voffA);
            PG8_BAR; PG8_WAIT_L(0); PG8_MMA(1, 0, At, B0); PG8_BAR; PG8_SCHED;
            PG8_STAGE(PG8_SB(0, 1), b2 + hstep, voffB);
            PG8_WAIT_V(6); PG8_BAR; PG8_MMA(1, 1, At, B1); PG8_BAR;
            PG8_LDB(B0, 1, 0); PG8_SCHED; PG8_LDA(At, 1, 0); PG8_STAGE(PG8_SA(0, 1), a2 + hstep, voffA);
            PG8_WAIT_L(8); PG8_BAR; PG8_WAIT_L(0); PG8_MMA(0, 0, At, B0); PG8_BAR; PG8_SCHED;
            PG8_LDB(B1, 1, 1); PG8_STAGE(PG8_SB(1, 0), b3, voffB);
            PG8_BAR; PG8_WAIT_L(0); PG8_MMA(0, 1, At, B1); PG8_BAR;
            PG8_LDA(At, 1, 1); PG8_STAGE(PG8_SA(1, 0), a3, voffA);
            PG8_BAR; PG8_WAIT_L(0); PG8_MMA(1, 0, At, B0); PG8_BAR; PG8_SCHED;
            PG8_STAGE(PG8_SB(1, 1), b3 + hstep, voffB);
            PG8_WAIT_V(6); PG8_BAR; PG8_MMA(1, 1, At, B1); PG8_BAR;
        }
        PG8_STAMP();
        if constexpr (!Epi::AFTER_DRAIN) { E(acc, cur, wr, wc, fr, fq); S.done(cur); }
        PG8_STAMP();
        if (!has_next) break;
#pragma unroll
        for (int a = 0; a < 2; ++a)
#pragma unroll
            for (int b = 0; b < 2; ++b)
#pragma unroll
                for (int m = 0; m < 4; ++m)
#pragma unroll
                    for (int n = 0; n < 2; ++n) acc[a][b][m][n] = (f32x4){0.f, 0.f, 0.f, 0.f};
        cur = nxt; cA = nA; cB = nB; ++ui;
    }
    PG8_WAIT_V(0);
    if (wr == 0) PG8_BAR;
    PG8_BAR;
    if constexpr (Epi::AFTER_DRAIN) { E.fused(acc, cur, wr, wc, fr, fq, lds, wid, lane); S.done(cur); }
    PG8_STAMP();
    if (STAMP && wid == 0) { stamps[lane] = lane < nts ? (((unsigned long long)(unsigned)ts_hi << 32) | (unsigned)ts_lo) : 0ull;
        if (lane == 62) stamps[62] = rt_entry; if (lane == 63) stamps[63] = (unsigned long long)wall_clock64(); }
#undef PG8_STAMP
#undef PG8_SA
#undef PG8_SB
#undef PG8_STAGE
#undef PG8_LDA
#undef PG8_LDB
#undef PG8_MMA
#undef PG8_WAIT_V
#undef PG8_WAIT_L
#undef PG8_BAR
#undef PG8_SCHED
}
}

namespace pg8 {
struct EpiStoreBf16 {
    static constexpr bool PERM = true, AFTER_DRAIN = false;
    bf16_t* O; int ldc;
    __device__ __forceinline__ void operator()(const f32x4 (&acc)[2][2][4][2], const Unit& u, int wr, int wc, int fr, int fq) const {
        const int row0 = u.pm * BM + wr * 64 + fr, col0 = u.pn * BM + wc * 32 + 8 * fq;
#pragma unroll
        for (int ai = 0; ai < 2; ++ai)
#pragma unroll
            for (int m = 0; m < 4; ++m) { bf16_t* rowp = O + (size_t)(row0 + ai * HALF + m * 16) * ldc + col0;
#pragma unroll
                for (int bj = 0; bj < 2; ++bj) { const f32x4 v0 = acc[ai][bj][m][0], v1 = acc[ai][bj][m][1];
                    u32x4 w; w.x = cvt_pk_bf16(v0[0], v0[1]); w.y = cvt_pk_bf16(v0[2], v0[3]); w.z = cvt_pk_bf16(v1[0], v1[1]); w.w = cvt_pk_bf16(v1[2], v1[3]);
                    *(u32x4*)(rowp + bj * HALF) = w; } }
    }
};
struct EpiAddF32 {
    static constexpr bool PERM = false, AFTER_DRAIN = false;
    float* C; int ldc;
    __device__ __forceinline__ void operator()(const f32x4 (&acc)[2][2][4][2], const Unit& u, int wr, int wc, int fr, int fq) const {
        const int row0 = u.pm * BM + wr * 64 + fr, col0 = u.pn * BM + wc * 32 + 4 * fq;
#pragma unroll
        for (int ai = 0; ai < 2; ++ai)
#pragma unroll
            for (int m = 0; m < 4; ++m) { float* rowp = C + (size_t)(row0 + ai * HALF + m * 16) * ldc + col0;
#pragma unroll
                for (int bj = 0; bj < 2; ++bj)
#pragma unroll
                    for (int n = 0; n < 2; ++n) { f32x4* q = (f32x4*)(rowp + bj * HALF + n * 16); *q = *q + acc[ai][bj][m][n]; } }
    }
};
struct EpiDownF32 {
    static constexpr bool PERM = false, AFTER_DRAIN = false;
    float* C;
    __device__ __forceinline__ void operator()(const f32x4 (&acc)[2][2][4][2], const Unit& u, int wr, int wc, int fr, int fq) const {
        const int row0 = u.pm * BM + wr * 64 + fr, col0 = (u.pn & 7) * BM + wc * 32 + 4 * fq;
#pragma unroll
        for (int ai = 0; ai < 2; ++ai)
#pragma unroll
            for (int m = 0; m < 4; ++m) { float* rowp = C + (size_t)(row0 + ai * HALF + m * 16) * 2048 + col0;
#pragma unroll
                for (int bj = 0; bj < 2; ++bj)
#pragma unroll
                    for (int n = 0; n < 2; ++n) *(f32x4*)(rowp + bj * HALF + n * 16) = acc[ai][bj][m][n]; }
    }
};
struct EpiSwiglu {
    static constexpr bool PERM = true, AFTER_DRAIN = false;
    bf16_t* H;
    __device__ __forceinline__ void operator()(const f32x4 (&acc)[2][2][4][2], const Unit& u, int wr, int wc, int fr, int fq) const {
        const int row0 = u.pm * BM + wr * 64 + fr, col0 = (u.pn & 3) * 128 + wc * 32 + 8 * fq;
#pragma unroll
        for (int ai = 0; ai < 2; ++ai)
#pragma unroll
            for (int m = 0; m < 4; ++m) { bf16_t* rowp = H + (size_t)(row0 + ai * HALF + m * 16) * 512 + col0;
                float h[8];
#pragma unroll
                for (int n = 0; n < 2; ++n)
#pragma unroll
                    for (int j = 0; j < 4; ++j) { const float g = acc[ai][0][m][n][j], up = acc[ai][1][m][n][j]; h[n * 4 + j] = g / (1.f + __expf(-g)) * up; }
                u32x4 w; w.x = cvt_pk_bf16(h[0], h[1]); w.y = cvt_pk_bf16(h[2], h[3]); w.z = cvt_pk_bf16(h[4], h[5]); w.w = cvt_pk_bf16(h[6], h[7]);
                *(u32x4*)rowp = w; }
    }
};
struct HalfOrder {
    int c;
    __device__ __forceinline__ bool next(int i, Unit& u) const { if (i > 0 || (c >> 1) >= 128) return false; u.pm = (c >> 1) >> 2; u.pn = (c >> 1) & 3; return true; }
    __device__ __forceinline__ void a_ready(const Unit&) const {}
    __device__ __forceinline__ void done(const Unit&) const {}
};
struct MoeOrder {
    const int* blk_e; int ntile, G, c, shift;
    __device__ __forceinline__ bool next(int i, Unit& u) const {
        const int L = i * G + c; if (L >= ntile) return false;
        const int mb = L >> shift, nt = L & ((1 << shift) - 1);
        u.pm = mb; u.pn = (blk_e[mb] << shift) + nt; return true;
    }
    __device__ __forceinline__ void a_ready(const Unit&) const {}
    __device__ __forceinline__ void done(const Unit&) const {}
};
}

__device__ __forceinline__ void transpose_item(const float* __restrict__ W, int ldin, int n0, int K, u16* __restrict__ WT, int row0, int nbn, int item, float* scr, int lane, int ilv = -1) {
    const int kb = item / nbn, nb = item % nbn, k0 = 64 * kb, nn = 32 * nb;
    const int rb = ilv < 0 ? row0 + nn : row0 + (nn >> 7) * 256 + ilv * 128 + (nn & 127);
#pragma unroll 8
    for (int i = 0; i < 32; ++i) { const int kk = 2 * i + (lane >> 5); scr[kk * 33 + (lane & 31)] = __builtin_nontemporal_load(&W[(size_t)(k0 + kk) * ldin + n0 + nn + (lane & 31)]); }
    asm volatile("s_waitcnt lgkmcnt(0)" ::: "memory");
    const int c = lane & 7;
#pragma unroll
    for (int j = 0; j < 4; ++j) { const int n = (lane >> 3) + 8 * j; const float* s = scr + (8 * c) * 33 + n;
        uint4 o; o.x = pk2(s[0 * 33], s[1 * 33]); o.y = pk2(s[2 * 33], s[3 * 33]); o.z = pk2(s[4 * 33], s[5 * 33]); o.w = pk2(s[6 * 33], s[7 * 33]);
        *(uint4*)(WT + (size_t)(rb + n) * K + k0 + 8 * c) = o; }
    asm volatile("s_waitcnt lgkmcnt(0)" ::: "memory");
}
__device__ __forceinline__ void convert_moe_weights(const float* wg, const float* wu, const float* wd, u16* WguT, u16* WdT, int l, float* scr, int gw, int NGW, int lane) {
    constexpr int IPE = 512;
    for (int it = gw; it < 3 * NE * IPE; it += NGW) {
        const int which = it / (NE * IPE), r = it % (NE * IPE), e = r / IPE, item = r % IPE;
        const size_t eo = ((size_t)l * NE + e) * (size_t)D * DFF;
        if (which == 0)      transpose_item(wg + eo, DFF, 0, D, WguT + (size_t)e * 1024 * D, 0, DFF / 32, item, scr, lane, 0);
        else if (which == 1) transpose_item(wu + eo, DFF, 0, D, WguT + (size_t)e * 1024 * D, 0, DFF / 32, item, scr, lane, 1);
        else                 transpose_item(wd + eo, D, 0, DFF, WdT + (size_t)e * D * DFF, 0, D / 32, item, scr, lane);
    }
}


constexpr int ATT_RS = 144;
constexpr int ATT_VBYTES = 32 * ATT_RS;
typedef long long i64;
typedef unsigned u32x4v __attribute__((ext_vector_type(4)));
typedef unsigned u32x2v __attribute__((ext_vector_type(2)));
__device__ __forceinline__ float bperm(int srclane, float v) { return __int_as_float(__builtin_amdgcn_ds_bpermute(srclane << 2, __float_as_int(v))); }
__device__ __forceinline__ float softplus_fast(float z) { return fmaxf(z, 0.f) + __logf(1.f + __expf(-fabsf(z))); }
__device__ __forceinline__ void vt_frags(unsigned vaddr, int lane, bf16x8 (&vf)[4]) {
    const unsigned a = vaddr + (unsigned)((4 * (lane >> 4) + ((lane & 15) >> 2)) * ATT_RS + (lane & 3) * 8);
    i64 r0, r1, r2, r3, r4, r5, r6, r7;
    asm volatile("s_waitcnt lgkmcnt(0)\n\t"
                 "ds_read_b64_tr_b16 %0, %8\n\tds_read_b64_tr_b16 %1, %8 offset:2304\n\t"
                 "ds_read_b64_tr_b16 %2, %8 offset:32\n\tds_read_b64_tr_b16 %3, %8 offset:2336\n\t"
                 "ds_read_b64_tr_b16 %4, %8 offset:64\n\tds_read_b64_tr_b16 %5, %8 offset:2368\n\t"
                 "ds_read_b64_tr_b16 %6, %8 offset:96\n\tds_read_b64_tr_b16 %7, %8 offset:2400\n\t"
                 "s_waitcnt lgkmcnt(0)"
                 : "=&v"(r0), "=&v"(r1), "=&v"(r2), "=&v"(r3), "=&v"(r4), "=&v"(r5), "=&v"(r6), "=&v"(r7) : "v"(a) : "memory");
    typedef i64 i64x2 __attribute__((ext_vector_type(2)));
    i64x2 t; t.x = r0; t.y = r1; vf[0] = __builtin_bit_cast(bf16x8, t); t.x = r2; t.y = r3; vf[1] = __builtin_bit_cast(bf16x8, t);
    t.x = r4; t.y = r5; vf[2] = __builtin_bit_cast(bf16x8, t); t.x = r6; t.y = r7; vf[3] = __builtin_bit_cast(bf16x8, t);
}
__device__ __forceinline__ bf16x8 pack8(const float (&a)[4], const float (&b)[4]) {
    u32x4v w; w.x = pk2(a[0], a[1]); w.y = pk2(a[2], a[3]); w.z = pk2(b[0], b[1]); w.w = pk2(b[2], b[3]);
    return __builtin_bit_cast(bf16x8, w);
}
__device__ __forceinline__ void store_out_tile(const f32x4 (&o)[4], float scale, const float* __restrict__ gain, u16* __restrict__ dst  , int g) {
#pragma unroll
    for (int dt = 0; dt < 4; ++dt) { const float4 gg = *(const float4*)(gain + dt * 16 + 4 * g);
        *(uint2*)(dst + dt * 16 + 4 * g) = make_uint2(pk2(o[dt][0] * scale * gg.x, o[dt][1] * scale * gg.y), pk2(o[dt][2] * scale * gg.z, o[dt][3] * scale * gg.w)); }
}

__device__ __forceinline__ void sb_unit(const u16* __restrict__ PROJ, int b, int qb, int h, int lane, LAS char* vl, LAS float* red,
                                        const float* __restrict__ gout, u16* __restrict__ MIXED) {
    const int li = lane & 15, g = lane >> 4; const size_t tb = (size_t)b * SEQ; const int q0 = qb * 32;
    const u16* Qp = PROJ + C_SB + h * 64; const u16* Kp = Qp + 512; const u16* Vp = Qp + 1024;
    const unsigned vaddr = (unsigned)(size_t)vl;
    bf16x8 qf[2][2];
#pragma unroll
    for (int qt = 0; qt < 2; ++qt)
#pragma unroll
        for (int s = 0; s < 2; ++s) qf[qt][s] = *(const bf16x8*)(Qp + (tb + q0 + qt * 16 + li) * DP + 32 * s + 8 * g);
    f32x4 acc[2][4];
#pragma unroll
    for (int qt = 0; qt < 2; ++qt)
#pragma unroll
        for (int dt = 0; dt < 4; ++dt) acc[qt][dt] = (f32x4){0.f, 0.f, 0.f, 0.f};
    float carry[2] = {0.f, 0.f};
    bf16x8 kn[2][2]; u32x4v vn[4];
#define SB_LOAD(kk) do { _Pragma("unroll") for (int kt = 0; kt < 2; ++kt) _Pragma("unroll") for (int s = 0; s < 2; ++s) kn[kt][s] = *(const bf16x8*)(Kp + (tb + (kk) + kt * 16 + li) * DP + 32 * s + 8 * g); \
        _Pragma("unroll") for (int u = 0; u < 4; ++u) { const int c = lane + 64 * u; vn[u] = *(const u32x4v*)(Vp + (tb + (kk) + (c >> 3)) * DP + (c & 7) * 8); } } while (0)
    SB_LOAD(q0);
    for (int k0 = q0; k0 >= 0; k0 -= 32) {
        bf16x8 kf[2][2];
#pragma unroll
        for (int kt = 0; kt < 2; ++kt)
#pragma unroll
            for (int s = 0; s < 2; ++s) kf[kt][s] = kn[kt][s];
#pragma unroll
        for (int u = 0; u < 4; ++u) { const int c = lane + 64 * u; *(LAS u32x4v*)(vl + (c >> 3) * ATT_RS + (c & 7) * 16) = vn[u]; }
        if (k0 >= 32) SB_LOAD(k0 - 32);
        bf16x8 pf[2];
#pragma unroll
        for (int qt = 0; qt < 2; ++qt) {
            const int qpos = q0 + qt * 16 + li;
            float w[2][4];
#pragma unroll
            for (int kt = 1; kt >= 0; --kt) {
                f32x4 st = __builtin_amdgcn_mfma_f32_16x16x32_bf16(kf[kt][0], qf[qt][0], (f32x4){0.f, 0.f, 0.f, 0.f}, 0, 0, 0);
                st = __builtin_amdgcn_mfma_f32_16x16x32_bf16(kf[kt][1], qf[qt][1], st, 0, 0, 0);
                const int kb = k0 + kt * 16 + 4 * g;
                float sp[4];
#pragma unroll
                for (int r = 0; r < 4; ++r) sp[r] = (kb + r < qpos) ? softplus_fast(st[r]) : 0.f;
                const float G = (sp[0] + sp[1]) + (sp[2] + sp[3]);
                const float x1 = bperm(lane ^ 16, G), hs = G + x1, x2 = bperm(lane ^ 32, hs);
                float rs = carry[qt] + (g == 3 ? 0.f : g == 2 ? x1 : g == 1 ? x2 : x1 + x2);
#pragma unroll
                for (int r = 3; r >= 0; --r) { w[kt][r] = (kb + r < qpos) ? __expf(st[r] - sp[r] - rs) : 0.f; rs += sp[r]; }
                carry[qt] += hs + x2;
            }
            pf[qt] = pack8(w[0], w[1]);
        }
        bf16x8 vf[4]; vt_frags(vaddr, lane, vf);
#pragma unroll
        for (int qt = 0; qt < 2; ++qt)
#pragma unroll
            for (int dt = 0; dt < 4; ++dt) acc[qt][dt] = __builtin_amdgcn_mfma_f32_16x16x32_bf16(vf[dt], pf[qt], acc[qt][dt], 0, 0, 0);
        if (k0 + 32 <= q0 && __all(fminf(carry[0], carry[1]) > 104.f)) break;
    }
#undef SB_LOAD
    float ss[2];
#pragma unroll
    for (int qt = 0; qt < 2; ++qt) { float s = 0.f;
#pragma unroll
        for (int dt = 0; dt < 4; ++dt) s += (acc[qt][dt][0] * acc[qt][dt][0] + acc[qt][dt][1] * acc[qt][dt][1]) + (acc[qt][dt][2] * acc[qt][dt][2] + acc[qt][dt][3] * acc[qt][dt][3]);
        s += bperm(lane ^ 16, s); s += bperm(lane ^ 32, s); ss[qt] = s;
        if (g == 0) red[h * 64 + qt * 16 + li] = s; }
    __syncthreads();
#pragma unroll
    for (int qt = 0; qt < 2; ++qt) { float tot = 0.f;
#pragma unroll
        for (int hh = 0; hh < 8; ++hh) tot += red[hh * 64 + qt * 16 + li];
        const float sc = rsqrtf(tot / 512.f + EPS);
        store_out_tile(acc[qt], sc, gout + h * 64, MIXED + (tb + q0 + qt * 16 + li) * D + 512 + h * 64, g); }
}

__device__ __forceinline__ void dil_unit(const u16* __restrict__ PROJ, int b, int w, int r, int h, int lane, LAS char* vl, LAS float* red,
                                         const float* __restrict__ gout, u16* __restrict__ MIXED) {
    const int li = lane & 15, g = lane >> 4; const size_t tb = (size_t)b * SEQ; const int qpos = w * 256 + r + 16 * li;
    const u16* Qp = PROJ + C_DIL + h * 64; const u16* Kp = Qp + 512; const u16* Vp = Qp + 1024;
    const unsigned vaddr = (unsigned)(size_t)vl;
    bf16x8 qf[2];
#pragma unroll
    for (int s = 0; s < 2; ++s) qf[s] = *(const bf16x8*)(Qp + (tb + qpos) * DP + 32 * s + 8 * g);
    f32x4 acc[4];
#pragma unroll
    for (int dt = 0; dt < 4; ++dt) acc[dt] = (f32x4){0.f, 0.f, 0.f, 0.f};
    float mrun = -1e30f, lrun = 0.f;
#pragma unroll 1
    for (int br = 0; br < 3; ++br) {
        const int dsh = br == 0 ? 4 : br == 1 ? 2 : 0;
        const int nstep = br == 0 ? 5 : br == 1 ? 6 : 12;
        const int base = w * 256 + r - (128 << dsh);
        const int rat = li << (4 - dsh);
        const int nbf = base < 0 ? ((-base + (1 << dsh) - 1) >> dsh) : 0;
        const int sbeg = nbf >> 5;
        bf16x8 kn[2][2]; u32x4v vn[4];
#define DIL_LOAD(mm) do { _Pragma("unroll") for (int kt = 0; kt < 2; ++kt) { int pos = base + (((mm) + kt * 16 + li) << dsh); pos = min(max(pos, 0), SEQ - 1); \
            _Pragma("unroll") for (int s = 0; s < 2; ++s) kn[kt][s] = *(const bf16x8*)(Kp + (tb + pos) * DP + 32 * s + 8 * g); } \
        _Pragma("unroll") for (int u = 0; u < 4; ++u) { const int c = lane + 64 * u; int pos = base + (((mm) + (c >> 3)) << dsh); pos = min(max(pos, 0), SEQ - 1); \
            vn[u] = *(const u32x4v*)(Vp + (tb + pos) * DP + (c & 7) * 8); } } while (0)
        DIL_LOAD(sbeg * 32);
#pragma unroll 1
        for (int st_ = sbeg; st_ < nstep; ++st_) {
            const int m0 = st_ * 32;
            bf16x8 kf[2][2];
#pragma unroll
            for (int kt = 0; kt < 2; ++kt)
#pragma unroll
                for (int s = 0; s < 2; ++s) kf[kt][s] = kn[kt][s];
#pragma unroll
            for (int u = 0; u < 4; ++u) { const int c = lane + 64 * u; *(LAS u32x4v*)(vl + (c >> 3) * ATT_RS + (c & 7) * 16) = vn[u]; }
            if (st_ + 1 < nstep) DIL_LOAD(m0 + 32);
            float z[2][4]; bool ok[2][4]; float zmax = -1e30f;
#pragma unroll
            for (int kt = 0; kt < 2; ++kt) {
                f32x4 st = __builtin_amdgcn_mfma_f32_16x16x32_bf16(kf[kt][0], qf[0], (f32x4){0.f, 0.f, 0.f, 0.f}, 0, 0, 0);
                st = __builtin_amdgcn_mfma_f32_16x16x32_bf16(kf[kt][1], qf[1], st, 0, 0, 0);
#pragma unroll
                for (int rr = 0; rr < 4; ++rr) { const int m = m0 + kt * 16 + 4 * g + rr; const int dm = m - rat;
                    ok[kt][rr] = (dm >= 0) && (dm <= 128) && (base + (m << dsh) >= 0);
                    z[kt][rr] = st[rr]; if (ok[kt][rr]) zmax = fmaxf(zmax, st[rr]); }
            }
            zmax = fmaxf(zmax, bperm(lane ^ 16, zmax)); zmax = fmaxf(zmax, bperm(lane ^ 32, zmax));
            const float mn = fmaxf(mrun, zmax); const float al = __expf(mrun - mn); mrun = mn;
            float pw[2][4]; float ps = 0.f;
#pragma unroll
            for (int kt = 0; kt < 2; ++kt)
#pragma unroll
                for (int rr = 0; rr < 4; ++rr) { pw[kt][rr] = ok[kt][rr] ? __expf(z[kt][rr] - mn) : 0.f; ps += pw[kt][rr]; }
            lrun = lrun * al + ps;
#pragma unroll
            for (int dt = 0; dt < 4; ++dt) acc[dt] = acc[dt] * al;
            const bf16x8 pf = pack8(pw[0], pw[1]);
            bf16x8 vf[4]; vt_frags(vaddr, lane, vf);
#pragma unroll
            for (int dt = 0; dt < 4; ++dt) acc[dt] = __builtin_amdgcn_mfma_f32_16x16x32_bf16(vf[dt], pf, acc[dt], 0, 0, 0);
        }
    }
#undef DIL_LOAD
    lrun += bperm(lane ^ 16, lrun); lrun += bperm(lane ^ 32, lrun);
    const float inv = 1.f / lrun;
    float s = 0.f;
#pragma unroll
    for (int dt = 0; dt < 4; ++dt) { acc[dt] = acc[dt] * inv; s += (acc[dt][0] * acc[dt][0] + acc[dt][1] * acc[dt][1]) + (acc[dt][2] * acc[dt][2] + acc[dt][3] * acc[dt][3]); }
    s += bperm(lane ^ 16, s); s += bperm(lane ^ 32, s);
    if (g == 0) red[h * 64 + li] = s;
    __syncthreads();
    float tot = 0.f;
#pragma unroll
    for (int hh = 0; hh < 8; ++hh) tot += red[hh * 64 + li];
    const float sc = rsqrtf(tot / 512.f + EPS);
    store_out_tile(acc, sc, gout + h * 64, MIXED + (tb + qpos) * D + 1024 + h * 64, g);
}


template <int RS> __device__ __forceinline__ void tr_frags4(unsigned addr, int lane, bf16x8 (&f)[4]) {
    const unsigned a = addr + (unsigned)((4 * (lane >> 4) + ((lane & 15) >> 2)) * RS + (lane & 3) * 8);
    i64 r0, r1, r2, r3, r4, r5, r6, r7;
    asm volatile("s_waitcnt lgkmcnt(0)\n\t"
                 "ds_read_b64_tr_b16 %0, %8\n\tds_read_b64_tr_b16 %1, %8 offset:%9\n\t"
                 "ds_read_b64_tr_b16 %2, %8 offset:32\n\tds_read_b64_tr_b16 %3, %8 offset:%10\n\t"
                 "ds_read_b64_tr_b16 %4, %8 offset:64\n\tds_read_b64_tr_b16 %5, %8 offset:%11\n\t"
                 "ds_read_b64_tr_b16 %6, %8 offset:96\n\tds_read_b64_tr_b16 %7, %8 offset:%12\n\t"
                 "s_waitcnt lgkmcnt(0)"
                 : "=&v"(r0), "=&v"(r1), "=&v"(r2), "=&v"(r3), "=&v"(r4), "=&v"(r5), "=&v"(r6), "=&v"(r7)
                 : "v"(a), "i"(16 * RS), "i"(16 * RS + 32), "i"(16 * RS + 64), "i"(16 * RS + 96) : "memory");
    typedef i64 i64x2 __attribute__((ext_vector_type(2)));
    i64x2 t; t.x = r0; t.y = r1; f[0] = __builtin_bit_cast(bf16x8, t); t.x = r2; t.y = r3; f[1] = __builtin_bit_cast(bf16x8, t);
    t.x = r4; t.y = r5; f[2] = __builtin_bit_cast(bf16x8, t); t.x = r6; t.y = r7; f[3] = __builtin_bit_cast(bf16x8, t);
}
template <int RS> __device__ __forceinline__ bf16x8 tr_frag1(unsigned addr, int lane) {
    const unsigned a = addr + (unsigned)((4 * (lane >> 4) + ((lane & 15) >> 2)) * RS + (lane & 3) * 8);
    i64 r0, r1;
    asm volatile("s_waitcnt lgkmcnt(0)\n\tds_read_b64_tr_b16 %0, %2\n\tds_read_b64_tr_b16 %1, %2 offset:%3\n\ts_waitcnt lgkmcnt(0)"
                 : "=&v"(r0), "=&v"(r1) : "v"(a), "i"(16 * RS) : "memory");
    typedef i64 i64x2 __attribute__((ext_vector_type(2)));
    i64x2 t; t.x = r0; t.y = r1; return __builtin_bit_cast(bf16x8, t);
}
constexpr int SSD_RB = 272, SSD_RX = 144;
constexpr int SSD_OFF_B = 0, SSD_OFF_C = 128 * SSD_RB, SSD_OFF_X = 2 * 128 * SSD_RB, SSD_OFF_XW = SSD_OFF_X + 128 * SSD_RX, SSD_OFF_F = SSD_OFF_XW + 128 * SSD_RX;
__device__ __forceinline__ void ssd_chunk_unit(const u16* __restrict__ PROJ, const float* __restrict__ DTR, const float* __restrict__ cw, const float* __restrict__ cb,
                                               float dtbias, float aneg, float dskip, int b, int c, int h, int tid, LAS char* L,
                                               float* __restrict__ YD, float* __restrict__ SS, float* __restrict__ ATOT, float* __restrict__ ACS, u16* __restrict__ CG) {
    const int wave = tid >> 6, lane = tid & 63, li = lane & 15, g = lane >> 4, grp = h >> 2;
    const size_t t0 = (size_t)b * SEQ + (size_t)c * 128;
    LAS float* acs = (LAS float*)(L + SSD_OFF_F); LAS float* dts = acs + 128; LAS float* wls = acs + 256;
    __syncthreads();
    if (wave == 0) {
        const float d0 = softplusf(DTR[(t0 + 2 * lane) * 8 + h] + dtbias), d1 = softplusf(DTR[(t0 + 2 * lane + 1) * 8 + h] + dtbias);
        const float a0 = d0 * aneg, a1 = d1 * aneg;
        float v = a0 + a1;
#pragma unroll
        for (int o = 1; o < 64; o <<= 1) { const float t = bperm(lane - o, v); if (lane >= o) v += t; }
        acs[2 * lane] = v - a1; acs[2 * lane + 1] = v; dts[2 * lane] = d0; dts[2 * lane + 1] = d1;
    }
    __syncthreads();
    if (tid < 128) { const float a = acs[tid]; wls[tid] = dts[tid] * __expf(acs[127] - a); ACS[(t0 + tid) * 8 + h] = a; if (tid == 0) ATOT[((size_t)b * 32 + c) * 8 + h] = acs[127]; }
    __syncthreads();
    if (tid < 480) {
        const int cg = tid % 40, tp = tid / 40;
        const int ch = cg < 8 ? h * 64 + cg * 8 : cg < 24 ? 512 + grp * 128 + (cg - 8) * 8 : 768 + grp * 128 + (cg - 24) * 8;
        float wk[4][8], bs[8];
#pragma unroll
        for (int k = 0; k < 4; ++k) { const float4 w0 = *(const float4*)(cw + k * 1024 + ch), w1 = *(const float4*)(cw + k * 1024 + ch + 4);
            wk[k][0] = w0.x; wk[k][1] = w0.y; wk[k][2] = w0.z; wk[k][3] = w0.w; wk[k][4] = w1.x; wk[k][5] = w1.y; wk[k][6] = w1.z; wk[k][7] = w1.w; }
        { const float4 b0 = *(const float4*)(cb + ch), b1 = *(const float4*)(cb + ch + 4); bs[0] = b0.x; bs[1] = b0.y; bs[2] = b0.z; bs[3] = b0.w; bs[4] = b1.x; bs[5] = b1.y; bs[6] = b1.z; bs[7] = b1.w; }
        const int tl0 = tp * 11, tl1 = min(tl0 + 11, 128);
        const u16* src = PROJ + t0 * DP + C_XBC + ch;
        const bf16x8 zero8 = {0, 0, 0, 0, 0, 0, 0, 0};
        bf16x8 r0, r1, r2;
        { const int sl = c * 128 + tl0;
          r0 = sl - 3 >= 0 ? *(const bf16x8*)(src + (long)(tl0 - 3) * DP) : zero8; r1 = sl - 2 >= 0 ? *(const bf16x8*)(src + (long)(tl0 - 2) * DP) : zero8;
          r2 = sl - 1 >= 0 ? *(const bf16x8*)(src + (long)(tl0 - 1) * DP) : zero8; }
        for (int tl = tl0; tl < tl1; ++tl) {
            const bf16x8 r3 = *(const bf16x8*)(src + (long)tl * DP);
            float a[8];
#pragma unroll
            for (int j = 0; j < 8; ++j) a[j] = siluf(bs[j] + wk[0][j] * bf2f((u16)r0[j]) + wk[1][j] * bf2f((u16)r1[j]) + wk[2][j] * bf2f((u16)r2[j]) + wk[3][j] * bf2f((u16)r3[j]));
            r0 = r1; r1 = r2; r2 = r3;
            u32x4v o; o.x = pk2(a[0], a[1]); o.y = pk2(a[2], a[3]); o.z = pk2(a[4], a[5]); o.w = pk2(a[6], a[7]);
            if (cg < 8) {
                *(LAS u32x4v*)(L + SSD_OFF_X + tl * SSD_RX + cg * 16) = o;
                const float wl = wls[tl]; u32x4v ow; ow.x = pk2(a[0] * wl, a[1] * wl); ow.y = pk2(a[2] * wl, a[3] * wl); ow.z = pk2(a[4] * wl, a[5] * wl); ow.w = pk2(a[6] * wl, a[7] * wl);
                *(LAS u32x4v*)(L + SSD_OFF_XW + tl * SSD_RX + cg * 16) = ow;
            } else if (cg < 24) *(LAS u32x4v*)(L + SSD_OFF_B + tl * SSD_RB + (cg - 8) * 16) = o;
            else { *(LAS u32x4v*)(L + SSD_OFF_C + tl * SSD_RB + (cg - 24) * 16) = o;
                   if ((h & 3) == 0) *(u32x4v*)(CG + (t0 + tl) * 256 + grp * 128 + (cg - 24) * 8) = o; }
        }
    }
    __syncthreads();
    const unsigned Lb = (unsigned)(size_t)L;
    {
        const int lt = wave, lrow = lt * 16 + li; const float acl = acs[lrow];
        bf16x8 cf[4];
#pragma unroll
        for (int ks = 0; ks < 4; ++ks) cf[ks] = *(const LAS bf16x8*)(L + SSD_OFF_C + lrow * SSD_RB + ks * 64 + g * 16);
        f32x4 acc[4];
#pragma unroll
        for (int pt = 0; pt < 4; ++pt) acc[pt] = (f32x4){0.f, 0.f, 0.f, 0.f};
        for (int s0 = 0; s0 <= lt * 16; s0 += 32) {
            float w[2][4];
#pragma unroll
            for (int kt = 0; kt < 2; ++kt) {
                f32x4 st = (f32x4){0.f, 0.f, 0.f, 0.f};
#pragma unroll
                for (int ks = 0; ks < 4; ++ks) { const bf16x8 bfr = *(const LAS bf16x8*)(L + SSD_OFF_B + (s0 + kt * 16 + li) * SSD_RB + ks * 64 + g * 16);
                    st = __builtin_amdgcn_mfma_f32_16x16x32_bf16(bfr, cf[ks], st, 0, 0, 0); }
                const int sb = s0 + kt * 16 + 4 * g;
                const f32x4 as4 = *(const LAS f32x4*)(acs + sb), dt4 = *(const LAS f32x4*)(dts + sb);
#pragma unroll
                for (int r = 0; r < 4; ++r) w[kt][r] = (sb + r <= lrow) ? st[r] * __expf(acl - as4[r]) * dt4[r] : 0.f;
            }
            const bf16x8 pf = pack8(w[0], w[1]);
            bf16x8 xf[4]; tr_frags4<SSD_RX>(Lb + SSD_OFF_X + s0 * SSD_RX, lane, xf);
#pragma unroll
            for (int pt = 0; pt < 4; ++pt) acc[pt] = __builtin_amdgcn_mfma_f32_16x16x32_bf16(xf[pt], pf, acc[pt], 0, 0, 0);
        }
#pragma unroll
        for (int pt = 0; pt < 4; ++pt) {
            const u32x2v xr = *(const LAS u32x2v*)(L + SSD_OFF_X + lrow * SSD_RX + (pt * 16 + 4 * g) * 2);
            float4 o; o.x = acc[pt][0] + dskip * __uint_as_float(xr.x << 16); o.y = acc[pt][1] + dskip * __uint_as_float(xr.x & 0xffff0000u);
            o.z = acc[pt][2] + dskip * __uint_as_float(xr.y << 16); o.w = acc[pt][3] + dskip * __uint_as_float(xr.y & 0xffff0000u);
            *(float4*)(YD + (t0 + lrow) * 512 + h * 64 + pt * 16 + 4 * g) = o;
        }
    }
    {
        f32x4 acc[4];
#pragma unroll
        for (int pt = 0; pt < 4; ++pt) acc[pt] = (f32x4){0.f, 0.f, 0.f, 0.f};
#pragma unroll
        for (int ks = 0; ks < 4; ++ks) {
            const bf16x8 bt = tr_frag1<SSD_RB>(Lb + SSD_OFF_B + ks * 32 * SSD_RB + wave * 32, lane);
            bf16x8 xf[4]; tr_frags4<SSD_RX>(Lb + SSD_OFF_XW + ks * 32 * SSD_RX, lane, xf);
#pragma unroll
            for (int pt = 0; pt < 4; ++pt) acc[pt] = __builtin_amdgcn_mfma_f32_16x16x32_bf16(bt, xf[pt], acc[pt], 0, 0, 0);
        }
        float* so = SS + ((((size_t)b * 32 + c) * 8 + h) << 13);
#pragma unroll
        for (int pt = 0; pt < 4; ++pt) *(float4*)(so + (pt * 16 + li) * 128 + wave * 16 + 4 * g) = make_float4(acc[pt][0], acc[pt][1], acc[pt][2], acc[pt][3]);
    }
}
__device__ __forceinline__ void ssd_out_unit(const u16* __restrict__ PZ0, const u16* __restrict__ PZ1, const u16* __restrict__ PREV, const u16* __restrict__ CG, const float* __restrict__ YD,
                                             const float* __restrict__ ACS, const float* __restrict__ ng, int b, int j, int h, int lane, LAS float* red, u16* __restrict__ MIXED) {
    const int li = lane & 15, g = lane >> 4, grp = h >> 2, c = j >> 2; const size_t t0 = (size_t)b * SEQ + (size_t)j * 32;
    const u16* pv = PREV + ((((size_t)b * 32 + c) * 8 + h) << 13);
    f32x4 acc[4][2];
#pragma unroll
    for (int pt = 0; pt < 4; ++pt) { acc[pt][0] = (f32x4){0.f, 0.f, 0.f, 0.f}; acc[pt][1] = (f32x4){0.f, 0.f, 0.f, 0.f}; }
#pragma unroll
    for (int ks = 0; ks < 4; ++ks) {
        bf16x8 cf[2];
#pragma unroll
        for (int lt = 0; lt < 2; ++lt) cf[lt] = *(const bf16x8*)(CG + (t0 + lt * 16 + li) * 256 + grp * 128 + ks * 32 + g * 8);
#pragma unroll
        for (int pt = 0; pt < 4; ++pt) { const bf16x8 pf = *(const bf16x8*)(pv + (pt * 16 + li) * 128 + ks * 32 + g * 8);
            acc[pt][0] = __builtin_amdgcn_mfma_f32_16x16x32_bf16(pf, cf[0], acc[pt][0], 0, 0, 0);
            acc[pt][1] = __builtin_amdgcn_mfma_f32_16x16x32_bf16(pf, cf[1], acc[pt][1], 0, 0, 0); }
    }
    float ssq[2];
#pragma unroll
    for (int lt = 0; lt < 2; ++lt) {
        const size_t t = t0 + lt * 16 + li; const float ea = __expf(ACS[t * 8 + h]); float s = 0.f;
#pragma unroll
        for (int pt = 0; pt < 4; ++pt) {
            const int col = h * 64 + pt * 16 + 4 * g;
            const float4 yd = *(const float4*)(YD + t * 512 + col); const uint2 za = *(const uint2*)(PZ0 + t * 1024 + col), zb = *(const uint2*)(PZ1 + t * 1024 + col);
            const float z0 = __uint_as_float(za.x << 16) + __uint_as_float(zb.x << 16), z1 = __uint_as_float(za.x & 0xffff0000u) + __uint_as_float(zb.x & 0xffff0000u);
            const float z2 = __uint_as_float(za.y << 16) + __uint_as_float(zb.y << 16), z3 = __uint_as_float(za.y & 0xffff0000u) + __uint_as_float(zb.y & 0xffff0000u);
            f32x4 y; y[0] = (yd.x + ea * acc[pt][lt][0]) * siluf(z0); y[1] = (yd.y + ea * acc[pt][lt][1]) * siluf(z1);
            y[2] = (yd.z + ea * acc[pt][lt][2]) * siluf(z2); y[3] = (yd.w + ea * acc[pt][lt][3]) * siluf(z3);
            acc[pt][lt] = y; s += (y[0] * y[0] + y[1] * y[1]) + (y[2] * y[2] + y[3] * y[3]);
        }
        s += bperm(lane ^ 16, s); s += bperm(lane ^ 32, s); ssq[lt] = s;
        if (g == 0) red[h * 64 + lt * 16 + li] = s;
    }
    __syncthreads();
#pragma unroll
    for (int lt = 0; lt < 2; ++lt) {
        float tot = 0.f;
#pragma unroll
        for (int hh = 0; hh < 8; ++hh) tot += red[hh * 64 + lt * 16 + li];
        const float sc = rsqrtf(tot / 512.f + EPS);
        f32x4 o[4];
#pragma unroll
        for (int pt = 0; pt < 4; ++pt) o[pt] = acc[pt][lt];
        store_out_tile(o, sc, ng + h * 64, MIXED + (t0 + lt * 16 + li) * D + h * 64, g);
    }
}


#ifndef MOE_TR
#define MOE_TR 512
#endif
constexpr int MOE_WBUF = 16384, MOE_LDS_TAB = 155648;
__device__ __forceinline__ void glds16(const void* gsrc, unsigned lds_dst) {
    unsigned keep;
    asm volatile("s_mov_b32 %0, m0\n\ts_mov_b32 m0, %2\n\ts_nop 0\n\tglobal_load_lds_dwordx4 %1, off\n\ts_mov_b32 m0, %0" : "=&s"(keep) : "v"(gsrc), "s"(lds_dst) : "memory");
}
__device__ __forceinline__ void glds16_nt(const void* gsrc, unsigned lds_dst) {
    unsigned keep;
    asm volatile("s_mov_b32 %0, m0\n\ts_mov_b32 m0, %2\n\ts_nop 0\n\tglobal_load_lds_dwordx4 %1, off nt\n\ts_mov_b32 m0, %0" : "=&s"(keep) : "v"(gsrc), "s"(lds_dst) : "memory");
}
template <int N> __device__ __forceinline__ void vm_wait() { asm volatile("s_waitcnt vmcnt(%0)" :: "i"(N) : "memory"); }
template <bool GATEUP, int NK, int NAP>
__device__ __forceinline__ void moe_unit(const u16* __restrict__ Abase, int lda, const float* __restrict__ W0, const float* __restrict__ W1, int ldw, int wcol0, int valid,
                                         int orow0, int ocol0, u16* __restrict__ Hout, u16* __restrict__ Yout, LAS char* L, int tid) {
    constexpr int LAA = NAP == 4 ? 1 : 2, ASLOTS = LAA + 1, ASZ = NAP * 8192, WSLOTS = NAP == 2 ? 6 : 5, LAW = WSLOTS - 1, AOFF = WSLOTS * MOE_WBUF, MT = NAP * 4;
    constexpr int WAITN = 2 + (LAA - 1) * (NAP + 2);
    static_assert(NK > LAW + 1 && AOFF + ASLOTS * ASZ <= MOE_LDS_TAB && LAW >= LAA + 1, "ring geometry");
    const int wid = __builtin_amdgcn_readfirstlane(tid >> 6), lane = tid & 63, wr = wid >> 2, wc = wid & 3, li = lane & 15, g = lane >> 4;
    const LAS int* rowtab = (const LAS int*)(L + MOE_LDS_TAB);
    const unsigned Lb = (unsigned)(size_t)L;
    const u16* ap[NAP];
#pragma unroll
    for (int j = 0; j < NAP; ++j) ap[j] = Abase + (size_t)rowtab[(wid * NAP + j) * 16 + (lane >> 2)] * lda + ((lane & 3) ^ ((lane >> 4) & 3)) * 8;
    const unsigned adst = Lb + AOFF + (unsigned)(wid * NAP) * 1024u;
    const int cpc = lane & 31;
    const float* wp = (GATEUP ? ((cpc < 16 ? W0 : W1) + wcol0 + 4 * (cpc & 15)) : (W0 + wcol0 + 4 * cpc)) + (size_t)(4 * wid + (lane >> 5)) * ldw;
    const unsigned wdst = Lb + (unsigned)(wid * 2) * 1024u;
    const unsigned bfr0 = (unsigned)((8 * g) * 512 + (GATEUP ? 16 * wc + li : 32 * wc + li) * 4);
    constexpr unsigned BN1 = GATEUP ? 64 * 4 : 16 * 4;
    const unsigned afr0 = (unsigned)(AOFF + (wr * 16 + li) * 64 + ((g ^ ((li >> 2) & 3)) * 16));
    const int mrows = valid - wr * 16;
    f32x4 acc[MT][2];
#pragma unroll
    for (int m = 0; m < MT; ++m) { acc[m][0] = (f32x4){0.f, 0.f, 0.f, 0.f}; acc[m][1] = (f32x4){0.f, 0.f, 0.f, 0.f}; }
#define MOE_DMAA(slot, kt) do { _Pragma("unroll") for (int j = 0; j < NAP; ++j) glds16(ap[j] + (kt) * 32, adst + (unsigned)(slot) * ASZ + j * 1024u); } while (0)
#define MOE_DMAW(slot, kt) do { _Pragma("unroll") for (int j = 0; j < 2; ++j) glds16_nt(wp + (size_t)((kt) * 32 + 2 * j) * ldw, wdst + (unsigned)(slot) * MOE_WBUF + j * 1024u); } while (0)
#define MOE_BFRAG(dst, wslot, n) do { float c_[8]; _Pragma("unroll") for (int i = 0; i < 8; ++i) c_[i] = *(const LAS float*)(L + (wslot) * MOE_WBUF + bfr0 + (n) * BN1 + i * 512); \
        u32x4v o_; o_.x = pg8::cvt_pk_bf16(c_[0], c_[1]); o_.y = pg8::cvt_pk_bf16(c_[2], c_[3]); o_.z = pg8::cvt_pk_bf16(c_[4], c_[5]); o_.w = pg8::cvt_pk_bf16(c_[6], c_[7]); \
        dst = __builtin_bit_cast(bf16x8, o_); } while (0)
#define MOE_COMPUTE(aslot, wslot) do { bf16x8 b0, b1; MOE_BFRAG(b0, wslot, 0); MOE_BFRAG(b1, wslot, 1); \
        _Pragma("unroll") for (int mh = 0; mh < MT / 4; ++mh) { if (mh * 128 < mrows) { bf16x8 af[4]; \
            _Pragma("unroll") for (int m = 0; m < 4; ++m) af[m] = *(const LAS bf16x8*)(L + (aslot) * ASZ + afr0 + (mh * 4 + m) * 2048); \
            _Pragma("unroll") for (int m = 0; m < 4; ++m) { \
                acc[mh * 4 + m][0] = __builtin_amdgcn_mfma_f32_16x16x32_bf16(b0, af[m], acc[mh * 4 + m][0], 0, 0, 0); \
                acc[mh * 4 + m][1] = __builtin_amdgcn_mfma_f32_16x16x32_bf16(b1, af[m], acc[mh * 4 + m][1], 0, 0, 0); } } } } while (0)
    MOE_DMAA(0, 0); MOE_DMAW(0, 0);
    if (LAA == 2) { MOE_DMAA(1, 1); }
#pragma unroll
    for (int k = 1; k < LAW; ++k) MOE_DMAW(k, k);
    vm_wait<(LAA == 2 ? NAP : 0) + 2 * (LAW - 1)>();
    __builtin_amdgcn_s_barrier(); asm volatile("" ::: "memory");
    int as_cur = 0, as_iss = LAA % ASLOTS, ws_cur = 0, ws_iss = LAW;
#pragma unroll 1
    for (int kt = 0; kt < NK; ++kt) {
        const int ka = kt + LAA < NK ? kt + LAA : NK - 1, kw = kt + LAW < NK ? kt + LAW : NK - 1;
        MOE_DMAA(as_iss, ka); MOE_DMAW(ws_iss, kw);
        MOE_COMPUTE(as_cur, ws_cur);
        vm_wait<WAITN>(); asm volatile("s_waitcnt lgkmcnt(0)" ::: "memory"); __builtin_amdgcn_s_barrier(); asm volatile("" ::: "memory");
        as_cur = as_cur == ASLOTS - 1 ? 0 : as_cur + 1; as_iss = as_iss == ASLOTS - 1 ? 0 : as_iss + 1;
        ws_cur = ws_cur == WSLOTS - 1 ? 0 : ws_cur + 1; ws_iss = ws_iss == WSLOTS - 1 ? 0 : ws_iss + 1;
    }
    vm_wait<0>();
#undef MOE_DMAA
#undef MOE_DMAW
#undef MOE_BFRAG
#undef MOE_COMPUTE
#pragma unroll
    for (int m = 0; m < MT; ++m) { const int rl = (2 * m + wr) * 16 + li; const size_t row = (size_t)orow0 + rl;
        if (rl < valid) {
            if (GATEUP) { float h[4];
#pragma unroll
                for (int r = 0; r < 4; ++r) { const float gt = acc[m][0][r], up = acc[m][1][r]; h[r] = gt / (1.f + __expf(-gt)) * up; }
                *(uint2*)(Hout + row * DFF + ocol0 + wc * 16 + 4 * g) = make_uint2(pg8::cvt_pk_bf16(h[0], h[1]), pg8::cvt_pk_bf16(h[2], h[3]));
            } else {
#pragma unroll
                for (int n = 0; n < 2; ++n) *(uint2*)(Yout + row * D + ocol0 + wc * 32 + n * 16 + 4 * g) = make_uint2(pg8::cvt_pk_bf16(acc[m][n][0], acc[m][n][1]), pg8::cvt_pk_bf16(acc[m][n][2], acc[m][n][3]));
            }
        }
    }
    __syncthreads();
}
__device__ __forceinline__ int moe_tables(const int* __restrict__ cnt, LAS int* tab, int tid) {
    __syncthreads();
    if (tid < NE) tab[258 + tid] = cnt[tid];
    __syncthreads();
    if (tid == 0) { int off = 0, nb = 0;
        for (int e = 0; e < NE; ++e) { tab[e] = off; const int c = tab[258 + e]; const int n = (c + MOE_TR - 1) / MOE_TR; for (int i = 0; i < n; ++i) tab[64 + nb + i] = (e << 8) | i; nb += n; off += c; }
        tab[64 + 192] = nb; }
    __syncthreads();
    return tab[64 + 192];
}

__device__ __forceinline__ void moe_order(const int* __restrict__ cnt, LAS int* tab, int nblk, int tid) {
    if (tid < nblk) { const int em = tab[64 + tid]; const int vi = min(tab[258 + (em >> 8)] - (em & 255) * MOE_TR, MOE_TR); int rank = 0;
        for (int j = 0; j < nblk; ++j) { const int ej = tab[64 + j]; const int vj = min(tab[258 + (ej >> 8)] - (ej & 255) * MOE_TR, MOE_TR); rank += (vj > vi) || (vj == vi && j < tid); }
        tab[322 + rank] = tid; }
    __syncthreads();
}
__device__ __forceinline__ int moe_dequeue(int* ctr, LAS int* tab, int tid) {
    __syncthreads();
    if (tid == 0) tab[257] = atomicAdd(ctr, 1);
    __syncthreads();
    return tab[257];
}

template <int NTL, bool COMBINE, bool COPYIN = false>
__device__ __forceinline__ float norm_proj_unit(float* __restrict__ X, const float* __restrict__ Xin, int t0, const LAS float* gain, const float* __restrict__ Wt, u16* __restrict__ HB,
                                                LAS float* part, LAS float* ssp, int wave, int lane,
                                                const LAS int* mtab, const int* __restrict__ tok_e, const int* __restrict__ tok_pos, const float* __restrict__ tok_g, const u16* __restrict__ Yb) {
    asm volatile("" : "+v"(lane));
    const int li = lane & 15, g4 = lane >> 4, t = t0 + li; const int kb = 256 * wave + 4 * g4;
    float* xp = X + (size_t)t * D + kb;
    float4 xv[16];
    if (COPYIN) { const float* xi = Xin + (size_t)t * D + kb;
#pragma unroll
        for (int j = 0; j < 16; ++j) { xv[j] = *(const float4*)(xi + 16 * j); *(float4*)(xp + 16 * j) = xv[j]; }
    } else {
#pragma unroll
        for (int j = 0; j < 16; ++j) xv[j] = *(const float4*)(xp + 16 * j);
    }
    if (COMBINE) {
        const u16* y0 = Yb + (size_t)(mtab[tok_e[2 * t]] + tok_pos[2 * t]) * D + kb; const u16* y1 = Yb + (size_t)(mtab[tok_e[2 * t + 1]] + tok_pos[2 * t + 1]) * D + kb;
        const float g0 = tok_g[2 * t], g1 = tok_g[2 * t + 1];
#pragma unroll
        for (int j = 0; j < 16; ++j) { const uint2 ua = *(const uint2*)(y0 + 16 * j), ub = *(const uint2*)(y1 + 16 * j);
            const float4 a = make_float4(__uint_as_float(ua.x << 16), __uint_as_float(ua.x & 0xffff0000u), __uint_as_float(ua.y << 16), __uint_as_float(ua.y & 0xffff0000u));
            const float4 b = make_float4(__uint_as_float(ub.x << 16), __uint_as_float(ub.x & 0xffff0000u), __uint_as_float(ub.y << 16), __uint_as_float(ub.y & 0xffff0000u));
            xv[j].x += g0 * a.x + g1 * b.x; xv[j].y += g0 * a.y + g1 * b.y; xv[j].z += g0 * a.z + g1 * b.z; xv[j].w += g0 * a.w + g1 * b.w;
            *(float4*)(xp + 16 * j) = xv[j]; }
    }
    float ss = 0.f;
#pragma unroll
    for (int j = 0; j < 16; ++j) ss += (xv[j].x * xv[j].x + xv[j].y * xv[j].y) + (xv[j].z * xv[j].z + xv[j].w * xv[j].w);
    ss += bperm(lane ^ 16, ss); ss += bperm(lane ^ 32, ss);
    if (g4 == 0) ssp[wave * 16 + li] = ss;
    f32x4 acc[NTL];
#pragma unroll
    for (int nt = 0; nt < NTL; ++nt) acc[nt] = (f32x4){0.f, 0.f, 0.f, 0.f};
    const float* rb = Wt + (size_t)wave * (16 * NTL * 256) + lane * 4;
#pragma unroll
    for (int j = 0; j < 16; ++j) {
#pragma unroll
        for (int n0 = 0; n0 < NTL; n0 += 3) {
            constexpr int dummy_ = 0; (void)dummy_;
            float4 rv[3];
#pragma unroll
            for (int q = 0; q < 3; ++q) if (n0 + q < NTL) rv[q] = *(const float4*)(rb + (j * NTL + n0 + q) * 256);
#pragma unroll
            for (int q = 0; q < 3; ++q) if (n0 + q < NTL) acc[n0 + q] = __builtin_amdgcn_mfma_f32_16x16x4f32(xv[j].x, rv[q].x, acc[n0 + q], 0, 0, 0);
#pragma unroll
            for (int q = 0; q < 3; ++q) if (n0 + q < NTL) acc[n0 + q] = __builtin_amdgcn_mfma_f32_16x16x4f32(xv[j].y, rv[q].y, acc[n0 + q], 0, 0, 0);
#pragma unroll
            for (int q = 0; q < 3; ++q) if (n0 + q < NTL) acc[n0 + q] = __builtin_amdgcn_mfma_f32_16x16x4f32(xv[j].z, rv[q].z, acc[n0 + q], 0, 0, 0);
#pragma unroll
            for (int q = 0; q < 3; ++q) if (n0 + q < NTL) acc[n0 + q] = __builtin_amdgcn_mfma_f32_16x16x4f32(xv[j].w, rv[q].w, acc[n0 + q], 0, 0, 0);
        }
    }
#pragma unroll
    for (int nt = 0; nt < NTL; ++nt)
#pragma unroll
        for (int r = 0; r < 4; ++r) part[(wave * 16 + 4 * g4 + r) * (NTL * 16) + nt * 16 + li] = acc[nt][r];
    __syncthreads();
    float tot = 0.f;
#pragma unroll
    for (int w = 0; w < 8; ++w) tot += ssp[w * 16 + li];
    const float rs = rsqrtf(tot / D + EPS);
    u16* hp = HB + (size_t)t * D + kb; const LAS float* gq = gain + kb;
#pragma unroll
    for (int j = 0; j < 16; ++j) { const f32x4 g4v = *(const LAS f32x4*)(gq + 16 * j); const float4 gg = make_float4(g4v[0], g4v[1], g4v[2], g4v[3]);
        *(uint2*)(hp + 16 * j) = make_uint2(pk2(xv[j].x * rs * gg.x, xv[j].y * rs * gg.y), pk2(xv[j].z * rs * gg.z, xv[j].w * rs * gg.w)); }
    return rs;
}

typedef const Params __attribute__((address_space(4)))* KP;
#define PARAMS KP kp_ = (KP)__builtin_amdgcn_kernarg_segment_ptr(); asm volatile("" : "+s"(kp_)); const __attribute__((address_space(4))) Params& p = *kp_;
__global__ void __launch_bounds__(NTHR, 2) mega(Params pk_unused) {
    extern __shared__ __attribute__((aligned(16))) char smem[];
    if (threadIdx.x == 0) *(uint4*)smem = make_uint4(0u, 0u, 0u, 0u);
    __syncthreads();
    XcdBarrier bar; { PARAMS bar = xcd_barrier_post(p.bar, (volatile LAS unsigned*)smem); }
    char* lds = smem + 16;
    LAS unsigned char* glds = (LAS unsigned char*)(smem + 16);
    const int G = gridDim.x, NGW = G * NWAVE;
    const long gsize = (long)G * NTHR;
#define IDS PARAMS int tid = threadIdx.x; asm volatile("" : "+v"(tid)); const int wave = tid >> 6, lane = tid & 63; const int gw = blockIdx.x * NWAVE + wave; const long gtid = (long)blockIdx.x * NTHR + tid; (void)wave; (void)lane; (void)gw; (void)gtid;

    { IDS
        float* scr = (float*)lds + wave * (64 * 33);
        constexpr int I_A = 32 * 48, I_B = 32 * 112, I_O = 32 * 64, I_L = I_A + I_B + I_O;
        for (int it = gw; it < 2 * I_L; it += NGW) {
            const int l = it / I_L; int r = it % I_L;
            const float* Wl = p.w_in + (size_t)l * D * DIN; u16* WTl = p.WinT + (size_t)l * DP * D;
            if (r < 512)  { transpose_item(Wl, DIN, 0, D, WTl, 4096, 16, r, scr, lane); continue; } r -= 512;
            if (r < 1024) { transpose_item(Wl, DIN, 512, D, WTl, 0, 32, r, scr, lane); continue; } r -= 1024;
            if (r < 3072) { transpose_item(Wl, DIN, 1544, D, WTl, 1024, 96, r, scr, lane); continue; } r -= 3072;
            if (r < 512)  { transpose_item(Wl, DIN, 4616, D, WTl, 4608, 16, r, scr, lane); continue; } r -= 512;
            transpose_item(p.w_out + (size_t)l * D * D, D, 0, D, p.WoutT + (size_t)l * D * D, 0, 64, r, scr, lane);
        }
        for (long i = gtid; i < 2L * 80 * D; i += gsize) {
            const int l = (int)(i / (80 * D)); int r = (int)(i % (80 * D)); const int e = r & 3; r >>= 2; const int ln = r & 63; r >>= 6; const int nt = r % 5; r /= 5; const int j = r & 15, w = r >> 4;
            const int c = 16 * nt + (ln & 15), k = 256 * w + 16 * j + 4 * (ln >> 4) + e;
            const float wv = (c < 8) ? p.rg_w[(size_t)l * D * 8 + k * 8 + c] : (c < 72) ? p.re_w[(size_t)l * D * 64 + k * 64 + (c - 8)] : 0.f;
            p.RT[i] = wv * p.norm2_g[l * D + k]; }
        for (long i = gtid; i < 2L * 4 * 128 * 128; i += gsize) { const int e = (int)(i & 127), c = (int)((i >> 7) & 127); const long lg = i >> 14;
            p.WpT[(lg << 14) + e * 128 + c] = f2bf(p.pool_w[i]); }
        for (long i = gtid; i < 2L * 16 * D; i += gsize) {
            const int l = (int)(i / (16 * D)); int r = (int)(i % (16 * D)); const int e = r & 3; r >>= 2; const int ln = r & 63; r >>= 6; const int j = r & 15, w = r >> 4;
            const int c = ln & 15, k = 256 * w + 16 * j + 4 * (ln >> 4) + e;
            p.WDT[i] = c < 8 ? p.w_in[(size_t)l * D * DIN + (size_t)k * DIN + 1536 + c] * p.norm1_g[l * D + k] : 0.f; }
    }
    xcd_barrier(bar);

#pragma unroll 1
    for (int l = 0; l < 2; ++l) {
        { IDS
            LAS float* part = (LAS float*)(smem + 16); LAS float* ssp = part + 8 * 16 * 16; LAS int* mtab = (LAS int*)(ssp + 128);
            if (l > 0) moe_tables(p.ctrl + (l - 1) * 64, mtab, tid);
            const float* wdt = p.WDT + (size_t)l * 16 * D;
            LAS float* g1 = (LAS float*)(mtab + 336);
            for (int i = tid; i < D; i += NTHR) g1[i] = p.norm1_g[l * D + i];
            for (int u = blockIdx.x; u < T / 16; u += G) {
                __syncthreads();
                float rs;
                if (l > 0) rs = norm_proj_unit<1, true>(p.X, nullptr, u * 16, g1, wdt, p.HB, part, ssp, wave, lane, mtab, p.tok_e, p.tok_pos, p.tok_g, p.Yb);
                else       rs = norm_proj_unit<1, false, true>(p.X, p.x_in, u * 16, g1, wdt, p.HB, part, ssp, wave, lane, mtab, p.tok_e, p.tok_pos, p.tok_g, p.Yb);
                (void)rs;
                if (tid < 128) { const int tk = tid >> 3, q = tid & 7; float s = 0.f, tot = 0.f;
#pragma unroll
                    for (int w = 0; w < 8; ++w) { s += part[(w * 16 + tk) * 16 + q]; tot += ssp[w * 16 + tk]; }
                    p.DTR[(size_t)(u * 16 + tk) * 8 + q] = s * rsqrtf(tot / D + EPS); }
            }
        }
        xcd_barrier(bar);
        {
            PARAMS
            const u16* wt = p.WinT + (size_t)l * DP * D;
            { pg8::Gemm g{p.HB, wt, T, 4096, D, D};
              pg8::StaticOrder so; so.init(T, 4096, G, blockIdx.x);
              pg8::EpiStoreBf16 ep{p.PROJ, DP};
              pg8::gemm_phase(glds, g, so, ep, nullptr); }
            { const int kh = blockIdx.x & 1;
              pg8::Gemm g{p.HB + kh * 1024, wt + (size_t)4096 * D + kh * 1024, T, 1024, 1024, D};
              pg8::HalfOrder ho{(int)blockIdx.x};
              pg8::EpiStoreBf16 ep{kh ? p.PZ1 : p.PZ0, 1024};
              pg8::gemm_phase(glds, g, ho, ep, nullptr); }
        }
        xcd_barrier(bar);
        { IDS
            for (int it0 = gw; it0 < T * 2; it0 += 2 * NGW) {
                u16* base[2]; bf16x8 a[2], b[2];
#pragma unroll
                for (int q = 0; q < 2; ++q) { const int it = it0 + q * NGW < T * 2 ? it0 + q * NGW : it0; const int t = it >> 1, mix = it & 1;
                    base[q] = p.PROJ + (size_t)t * DP + (mix ? C_DIL : C_SB) + lane * 16;
                    a[q] = *(const bf16x8*)base[q]; b[q] = *(const bf16x8*)(base[q] + 8); }
#pragma unroll
                for (int q = 0; q < 2; ++q) { const int it = it0 + q * NGW; if (it < T * 2) { const int mix = it & 1;
                    const float* gp = (mix ? (lane < 32 ? p.dq_g : p.dk_g) : (lane < 32 ? p.sbq_g : p.sbk_g)) + l * 64 + (lane & 3) * 16;
                    float v[16]; float ss = 0.f;
#pragma unroll
                    for (int j = 0; j < 8; ++j) { v[j] = bf2f((u16)a[q][j]); v[8 + j] = bf2f((u16)b[q][j]); }
#pragma unroll
                    for (int j = 0; j < 16; ++j) ss += v[j] * v[j];
                    ss += swz_xor<1>(ss); ss += swz_xor<2>(ss);
                    const float r = rsqrtf(ss / 64.f + EPS) * (lane < 32 ? 0.125f : 1.f);
                    u32x4v o0, o1;
                    { const float4 g0 = *(const float4*)gp, g1 = *(const float4*)(gp + 4), g2 = *(const float4*)(gp + 8), g3 = *(const float4*)(gp + 12);
                      o0.x = pk2(v[0] * r * g0.x, v[1] * r * g0.y); o0.y = pk2(v[2] * r * g0.z, v[3] * r * g0.w); o0.z = pk2(v[4] * r * g1.x, v[5] * r * g1.y); o0.w = pk2(v[6] * r * g1.z, v[7] * r * g1.w);
                      o1.x = pk2(v[8] * r * g2.x, v[9] * r * g2.y); o1.y = pk2(v[10] * r * g2.z, v[11] * r * g2.w); o1.z = pk2(v[12] * r * g3.x, v[13] * r * g3.y); o1.w = pk2(v[14] * r * g3.z, v[15] * r * g3.w); }
                    *(u32x4v*)base[q] = o0; *(u32x4v*)(base[q] + 8) = o1; } }
            }
            for (int u = blockIdx.x; u < NB * 32 * 8; u += G) {
                const int b = u >> 8, c = (u >> 3) & 31, h = u & 7;
                ssd_chunk_unit(p.PROJ, p.DTR, p.conv_w + l * 4 * 1024, p.conv_b + l * 1024, p.dt_bias[l * 8 + h], -__expf(p.a_log[l * 8 + h]), p.ssd_d[l * 8 + h],
                               b, c, h, tid, (LAS char*)(smem + 16), p.YD, p.SS, p.ATOT, p.ACS, p.CG);
            }
            __syncthreads();
            {
                constexpr int PRS = 1040;
                LAS char* PL = (LAS char*)(smem + 16);
                const float* psc = p.pool_sc + l * 512; const u16* wpt = p.WpT + (size_t)l * 4 * 16384;
                for (int u = blockIdx.x; u < T / 32; u += G) {
                    const int tb0 = u * 32; __syncthreads();
                    { const int c = tid, gq = c >> 7, w = 2 << gq; const int s0 = tb0 % SEQ;
                      const u16* ca = p.PZ0 + (size_t)tb0 * 1024 + 512 + c; const u16* cb2 = p.PZ1 + (size_t)tb0 * 1024 + 512 + c;
                      float sum = 0.f; { const int c0 = min(w, s0 + 1); for (int i = 0; i < c0; ++i) sum += bf2f(ca[-(long)i * 1024]) + bf2f(cb2[-(long)i * 1024]); }
                      float ucur = bf2f(ca[0]) + bf2f(cb2[0]);
#pragma unroll 4
                      for (int tt = 0; tt < 32; ++tt) { const int s = s0 + tt; const int cn = min(w, s + 1);
                          *(LAS u16*)(PL + tt * PRS + c * 2) = f2bf(sum / (float)cn - ucur);
                          if (tt < 31) { ucur = bf2f(ca[(long)(tt + 1) * 1024]) + bf2f(cb2[(long)(tt + 1) * 1024]); sum += ucur; if (s + 1 >= w) sum -= bf2f(ca[(long)(tt + 1 - w) * 1024]) + bf2f(cb2[(long)(tt + 1 - w) * 1024]); } } }
                    __syncthreads();
                    const int li = lane & 15, g4 = lane >> 4, gq = wave >> 1, eh = wave & 1;
                    f32x4 acc[4][2];
#pragma unroll
                    for (int et = 0; et < 4; ++et) { acc[et][0] = (f32x4){0.f, 0.f, 0.f, 0.f}; acc[et][1] = (f32x4){0.f, 0.f, 0.f, 0.f}; }
#pragma unroll
                    for (int ks = 0; ks < 4; ++ks) {
                        bf16x8 pf[2];
#pragma unroll
                        for (int tt = 0; tt < 2; ++tt) pf[tt] = *(const LAS bf16x8*)(PL + (tt * 16 + li) * PRS + (gq * 128 + ks * 32 + g4 * 8) * 2);
#pragma unroll
                        for (int et = 0; et < 4; ++et) { const bf16x8 wf = *(const bf16x8*)(wpt + gq * 16384 + (eh * 64 + et * 16 + li) * 128 + ks * 32 + g4 * 8);
                            acc[et][0] = __builtin_amdgcn_mfma_f32_16x16x32_bf16(wf, pf[0], acc[et][0], 0, 0, 0);
                            acc[et][1] = __builtin_amdgcn_mfma_f32_16x16x32_bf16(wf, pf[1], acc[et][1], 0, 0, 0); }
                    }
#pragma unroll
                    for (int tt = 0; tt < 2; ++tt)
#pragma unroll
                        for (int et = 0; et < 4; ++et) { const int col = gq * 128 + eh * 64 + et * 16 + 4 * g4; const float4 sc = *(const float4*)(psc + col);
                            *(uint2*)(p.MIXED + (size_t)(tb0 + tt * 16 + li) * D + 1536 + col) =
                                make_uint2(pk2(acc[et][tt][0] * sc.x, acc[et][tt][1] * sc.y), pk2(acc[et][tt][2] * sc.z, acc[et][tt][3] * sc.w)); }
                }
            }
        }
        xcd_barrier(bar);
        { IDS
        {
            for (int e = (int)gtid; e < NB * 8 * 8192; e += (int)gsize) {
                const int b = e >> 16, h = (e >> 13) & 7, pn = e & 8191; float st = 0.f;
#pragma unroll 8
                for (int c = 0; c < 32; ++c) { const size_t cu = ((size_t)b * 32 + c) * 8 + h; const size_t idx = (cu << 13) + pn;
                    p.PREV[idx] = f2bf(st); st = st * __expf(p.ATOT[cu]) + p.SS[idx]; }
            }
            LAS char* vl = (LAS char*)(smem + 16) + wave * ATT_VBYTES;
            LAS float* red = (LAS float*)((LAS char*)(smem + 16) + NWAVE * ATT_VBYTES);
            LAS int* qslot = (LAS int*)(red + 1024); int* qctr = p.ctrl + 520 + l;
            int par = 0;
            for (;; par ^= 1) {
                __syncthreads();
                if (tid == 0) *qslot = atomicAdd(qctr, 1);
                __syncthreads();
                const int u = *qslot; if (u >= 512 + 256) break;
                if (u >= 512) { const int v = u - 512; sb_unit(p.PROJ, v >> 7, v & 127, wave, lane, vl, red + par * 512, p.sbo_g + l * 512, p.MIXED); }
                else dil_unit(p.PROJ, u >> 8, (u >> 4) & 15, u & 15, wave, lane, vl, red + par * 512, p.do_g + l * 512, p.MIXED);
            }
        }
        }
        xcd_barrier(bar);
        { IDS
            LAS float* red = (LAS float*)(smem + 16);
            int par = 0;
            for (int u = blockIdx.x; u < NB * 128; u += G, par ^= 1)
                ssd_out_unit(p.PZ0, p.PZ1, p.PREV, p.CG, p.YD, p.ACS, p.ssd_ng + l * 512, u >> 7, u & 127, wave, lane, red + par * 512, p.MIXED);
        }
        xcd_barrier(bar);
        {
            PARAMS
            pg8::Gemm g{p.MIXED, p.WoutT + (size_t)l * D * D, T, D, D, D};
            pg8::StaticOrder so; so.init(T, D, G, blockIdx.x);
            pg8::EpiAddF32 ep{p.X, D};
            pg8::gemm_phase(glds, g, so, ep, nullptr);
        }
        xcd_barrier(bar);
        { IDS
            const float* RTl = p.RT + (size_t)l * 80 * D; int* cnt = p.ctrl + l * 64;
            LAS float* part = (LAS float*)(smem + 16);
            LAS float* ssp = part + 8 * 16 * 80;
            LAS float* lg = ssp + 128;
            LAS float* rbias = lg + 16 * 80;
            LAS float* g2 = rbias + 128;
            for (int i = tid; i < D; i += NTHR) g2[i] = p.norm2_g[l * D + i];
            if (tid < 72) rbias[tid] = tid < 8 ? p.rg_b[l * 8 + tid] : p.re_b[l * 64 + tid - 8];
            for (int u = blockIdx.x; u < T / 16; u += G) {
                const int t0 = u * 16;
                __syncthreads();
                norm_proj_unit<5, false>(p.X, nullptr, t0, g2, RTl, p.HB, part, ssp, wave, lane, nullptr, nullptr, nullptr, nullptr, nullptr);
                for (int i = tid; i < 16 * 72; i += NTHR) { const int tk = i / 72, c = i % 72; float s = 0.f, tot = 0.f;
#pragma unroll
                    for (int w = 0; w < 8; ++w) { s += part[(w * 16 + tk) * 80 + c]; tot += ssp[w * 16 + tk]; }
                    lg[tk * 80 + c] = s * rsqrtf(tot / D + EPS) + rbias[c]; }
                __syncthreads();
                if (tid < 16) {
                    const LAS float* gl = lg + tid * 80; const int t = t0 + tid;
                    int gi = 0; float gm = gl[0];
                    for (int j = 1; j < 8; ++j) if (gl[j] > gm) { gm = gl[j]; gi = j; }
                    float gs = 0.f;
                    for (int j = 0; j < 8; ++j) gs += __expf(gl[j] - gm);
                    const float gp = 1.f / gs;
                    const LAS float* el = gl + 8 + gi * 8;
                    int i1 = 0; float m1 = el[0];
                    for (int j = 1; j < 8; ++j) if (el[j] > m1) { m1 = el[j]; i1 = j; }
                    int i2 = -1; float m2 = -1e30f;
                    for (int j = 0; j < 8; ++j) if (j != i1 && el[j] > m2) { m2 = el[j]; i2 = j; }
                    const float p2 = __expf(m2 - m1); const float ga = gp / (1.f + p2), gb = gp * p2 / (1.f + p2);
                    const int e1 = gi * 8 + i1, e2 = gi * 8 + i2;
                    p.tok_e[t * 2] = e1; p.tok_e[t * 2 + 1] = e2; p.tok_g[t * 2] = ga; p.tok_g[t * 2 + 1] = gb;
                    const int q1 = atomicAdd(&cnt[e1], 1), q2 = atomicAdd(&cnt[e2], 1);
                    p.tok_pos[t * 2] = q1; p.tok_pos[t * 2 + 1] = q2; p.tlist[e1 * T + q1] = t; p.tlist[e2 * T + q2] = t;
                }
            }
        }
        xcd_barrier(bar);
        { IDS
            LAS char* L = (LAS char*)(smem + 16); LAS int* tab = (LAS int*)(L + MOE_LDS_TAB + 2048); LAS int* rowtab = (LAS int*)(L + MOE_LDS_TAB);
            const int* cnt = p.ctrl + l * 64;
            const int nblk = moe_tables(cnt, tab, tid);
            moe_order(cnt, tab, nblk, tid);
            int* qctr = p.ctrl + 512 + l * 2;
            for (;;) {
                const int ui = moe_dequeue(qctr, tab, tid); if (ui >= nblk * 8) break;
                const int mb = tab[322 + (ui >> 3)], nt = ui & 7; const int em = tab[64 + mb], e = em >> 8, mt = em & 255; const int valid = min(cnt[e] - mt * MOE_TR, MOE_TR);
                __syncthreads();
                { const int* tl = p.tlist + e * T + mt * MOE_TR; rowtab[tid] = tl[tid < valid ? tid : 0]; }
                __syncthreads();
                const size_t wo = ((size_t)l * NE + e) * (size_t)D * DFF;
                if (valid <= 256)      moe_unit<true, D / 32, 2>(p.HB, D, p.wg + wo, p.wu + wo, DFF, nt * 64, valid, tab[e] + mt * MOE_TR, nt * 64, p.Hb, nullptr, L, tid);
                else if (valid <= 384) moe_unit<true, D / 32, 3>(p.HB, D, p.wg + wo, p.wu + wo, DFF, nt * 64, valid, tab[e] + mt * MOE_TR, nt * 64, p.Hb, nullptr, L, tid);
                else                   moe_unit<true, D / 32, 4>(p.HB, D, p.wg + wo, p.wu + wo, DFF, nt * 64, valid, tab[e] + mt * MOE_TR, nt * 64, p.Hb, nullptr, L, tid);
            }
        }
        xcd_barrier(bar);
        { IDS
            LAS char* L = (LAS char*)(smem + 16); LAS int* tab = (LAS int*)(L + MOE_LDS_TAB + 2048); LAS int* rowtab = (LAS int*)(L + MOE_LDS_TAB);
            const int* cnt = p.ctrl + l * 64;
            const int nblk = moe_tables(cnt, tab, tid);
            moe_order(cnt, tab, nblk, tid);
            int* qctr = p.ctrl + 512 + l * 2 + 1;
            for (;;) {
                const int ui = moe_dequeue(qctr, tab, tid); if (ui >= nblk * 16) break;
                const int mb = tab[322 + (ui >> 4)], nt = ui & 15; const int em = tab[64 + mb], e = em >> 8, mt = em & 255; const int valid = min(cnt[e] - mt * MOE_TR, MOE_TR); const int r0 = tab[e] + mt * MOE_TR;
                __syncthreads();
                rowtab[tid] = r0 + (tid < valid ? tid : 0);
                __syncthreads();
                { const float* wdp = p.wd + ((size_t)l * NE + e) * (size_t)D * DFF;
                  if (valid <= 256)      moe_unit<false, DFF / 32, 2>(p.Hb, DFF, wdp, nullptr, D, nt * 128, valid, r0, nt * 128, nullptr, p.Yb, L, tid);
                  else if (valid <= 384) moe_unit<false, DFF / 32, 3>(p.Hb, DFF, wdp, nullptr, D, nt * 128, valid, r0, nt * 128, nullptr, p.Yb, L, tid);
                  else                   moe_unit<false, DFF / 32, 4>(p.Hb, DFF, wdp, nullptr, D, nt * 128, valid, r0, nt * 128, nullptr, p.Yb, L, tid); }
            }
        }
        xcd_barrier(bar);
    }
    { IDS
    LAS int* mtab = (LAS int*)(smem + 16);
    moe_tables(p.ctrl + 64, mtab, tid);
    for (int t = gw; t < T; t += NGW) {
        float4* xr = (float4*)(p.X + (size_t)t * D) + lane;
        const int r0 = mtab[p.tok_e[2 * t]] + p.tok_pos[2 * t], r1 = mtab[p.tok_e[2 * t + 1]] + p.tok_pos[2 * t + 1]; const float g0 = p.tok_g[2 * t], g1 = p.tok_g[2 * t + 1];
        const uint2* y0 = (const uint2*)(p.Yb + (size_t)r0 * D) + lane; const uint2* y1 = (const uint2*)(p.Yb + (size_t)r1 * D) + lane;
#pragma unroll
        for (int j = 0; j < 8; ++j) { float4 v = xr[64 * j]; const uint2 ua = y0[64 * j], ub = y1[64 * j];
            const float4 a = make_float4(__uint_as_float(ua.x << 16), __uint_as_float(ua.x & 0xffff0000u), __uint_as_float(ua.y << 16), __uint_as_float(ua.y & 0xffff0000u));
            const float4 b = make_float4(__uint_as_float(ub.x << 16), __uint_as_float(ub.x & 0xffff0000u), __uint_as_float(ub.y << 16), __uint_as_float(ub.y & 0xffff0000u));
            v.x += g0 * a.x + g1 * b.x; v.y += g0 * a.y + g1 * b.y; v.z += g0 * a.z + g1 * b.z; v.w += g0 * a.w + g1 * b.w; xr[64 * j] = v; }
    }
    }
}

extern "C" void kernel_launch(void* const* d_in, const int* in_sizes, int n_in, void* d_out, int out_size, void* d_ws, size_t ws_size, hipStream_t stream) {
    Params p{};
    const float** pin = (const float**)&p;
    for (int i = 0; i < 26; ++i) pin[i] = (const float*)d_in[i];
    p.X = (float*)d_out;
    char* ws = (char*)d_ws; size_t off = 0;
    auto alloc = [&](size_t bytes) { void* q = ws + off; off += (bytes + 255) & ~(size_t)255; return q; };
    constexpr size_t CTL_BYTES = (size_t)XCD_BAR_WORDS * 4 + CTRL_INTS * 4;
    p.bar = (unsigned*)alloc(CTL_BYTES); p.ctrl = (int*)(p.bar + XCD_BAR_WORDS);
    p.HB = (u16*)alloc((size_t)T * D * 2);
    p.MIXED = (u16*)alloc((size_t)T * D * 2);
    p.PROJ = (u16*)alloc((size_t)T * DP * 2);
    p.PZ0 = (u16*)alloc((size_t)T * 1024 * 2); p.PZ1 = (u16*)alloc((size_t)T * 1024 * 2);
    p.DTR = (float*)alloc((size_t)T * 8 * 4);
    p.YD = (float*)alloc((size_t)T * 512 * 4);
    p.SS = (float*)alloc((size_t)NB * 32 * 8 * 8192 * 4);
    p.PREV = (u16*)alloc((size_t)NB * 32 * 8 * 8192 * 2);
    p.ATOT = (float*)alloc((size_t)NB * 32 * 8 * 4);
    p.ACS = (float*)alloc((size_t)T * 8 * 4);
    p.CG = (u16*)alloc((size_t)T * 256 * 2);
    p.WinT = (u16*)alloc((size_t)2 * DP * D * 2);
    p.WoutT = (u16*)alloc((size_t)2 * D * D * 2);
    p.RT = (float*)alloc((size_t)2 * 80 * D * 4);
    p.WpT = (u16*)alloc((size_t)2 * 4 * 128 * 128 * 2);
    p.WDT = (float*)alloc((size_t)2 * 16 * D * 4);
    p.tok_e = (int*)alloc((size_t)T * 2 * 4); p.tok_pos = (int*)alloc((size_t)T * 2 * 4); p.tlist = (int*)alloc((size_t)NE * T * 4);
    p.tok_g = (float*)alloc((size_t)T * 2 * 4);
    p.Hb = (u16*)alloc((size_t)2 * T * DFF * 2);
    p.Yb = (u16*)alloc((size_t)2 * T * D * 2);
    static int grid = 0;
    if (grid == 0) {
        if (off > ws_size || n_in != 26) { fprintf(stderr, "kernel_launch: workspace too small (%zu > %zu) or n_in %d\n", off, ws_size, n_in); grid = -1; return; }
        int dev = 0, cus = 0, per_cu = 0;
        if (hipGetDevice(&dev) != hipSuccess || hipDeviceGetAttribute(&cus, hipDeviceAttributeMultiprocessorCount, dev) != hipSuccess) { grid = -1; return; }
        if (hipFuncSetAttribute((const void*)mega, hipFuncAttributeMaxDynamicSharedMemorySize, LDS_BYTES) != hipSuccess) { fprintf(stderr, "hipFuncSetAttribute failed\n"); grid = -1; return; }
        if (hipOccupancyMaxActiveBlocksPerMultiprocessor(&per_cu, (const void*)mega, NTHR, LDS_BYTES) != hipSuccess || per_cu < 1)
            fprintf(stderr, "kernel_launch: occupancy query reports %d blocks per CU\n", per_cu);
        (void)hipGetLastError();
        grid = cus;
    }
    if (grid < 0) return;
    if (hipMemsetAsync(p.bar, 0, CTL_BYTES, stream) != hipSuccess) return;
    hipLaunchKernelGGL(mega, dim3(grid), dim3(NTHR), LDS_BYTES, stream, p);
}
```

```cpp
#include <hip/hip_runtime.h>
#include <hip/hip_bf16.h>
#include <stdint.h>
#include <stdio.h>

typedef unsigned short u16;
using bf16x8 = __attribute__((ext_vector_type(8))) short;
using f32x4  = __attribute__((ext_vector_type(4))) float;
#define LAS __attribute__((address_space(3)))

constexpr int NB = 2, SEQ = 4096, T = NB * SEQ, D = 2048, DIN = 5128, DP = 5120;
constexpr int NE = 64, DFF = 512;
constexpr float EPS = 1e-6f;
constexpr int C_XBC = 0, C_SB = 1024, C_DIL = 2560;
constexpr int NTHR = 512, NWAVE = 8;
constexpr int LDS_BYTES = 16 + 159744 + 64;

__device__ __forceinline__ float bf2f(u16 h) { return __uint_as_float(((unsigned)h) << 16); }
__device__ __forceinline__ u16 f2bf(float f) { unsigned u = __float_as_uint(f); u += 0x7fffu + ((u >> 16) & 1u); return (u16)(u >> 16); }
__device__ __forceinline__ unsigned pk2(float lo, float hi) { return (unsigned)f2bf(lo) | ((unsigned)f2bf(hi) << 16); }
template <int O> __device__ __forceinline__ float swz_xor(float v) { return __int_as_float(__builtin_amdgcn_ds_swizzle(__float_as_int(v), (O << 10) | 0x1F)); }
__device__ __forceinline__ float rdlane(float v, int l) { return __int_as_float(__builtin_amdgcn_readlane(__float_as_int(v), l)); }
__device__ __forceinline__ float wave_sum(float v) {
    v += swz_xor<1>(v); v += swz_xor<2>(v); v += swz_xor<4>(v); v += swz_xor<8>(v); v += swz_xor<16>(v);
    return rdlane(v, 0) + rdlane(v, 32);
}
__device__ __forceinline__ float siluf(float x) { return x / (1.f + __expf(-x)); }
__device__ __forceinline__ float softplusf(float x) { return fmaxf(x, 0.f) + log1pf(__expf(-fabsf(x))); }

#define XB_TMO      128
#define XB_XCNT(j)  (256  + 64 * (j))
#define XB_XSUB(j)  (1280 + 64 * (j))
#define XB_XGEN(j)  (2304 + 64 * (j))
#define XB_TOP      3328
#define XB_TOPGEN   3392
#define XCD_BAR_WORDS 3456
#define XB_SPIN_CAP (1u << 18)
__device__ __forceinline__ unsigned xb_ld(unsigned* p)              { return __hip_atomic_load(p, __ATOMIC_RELAXED, __HIP_MEMORY_SCOPE_AGENT); }
__device__ __forceinline__ unsigned xb_add(unsigned* p, unsigned v) { return __hip_atomic_fetch_add(p, v, __ATOMIC_RELAXED, __HIP_MEMORY_SCOPE_AGENT); }
__device__ __forceinline__ unsigned xb_xcc_id() { return (unsigned)__builtin_amdgcn_s_getreg((3 << 11) | 20) & 0xFu; }
#define XB_SPIN(cond, bar) do { unsigned _sp = 0; while (cond) { __builtin_amdgcn_s_sleep(1); \
    if ((++_sp & 255u) == 0u) { if (xb_ld(&(bar)[XB_TMO])) break; if (_sp > XB_SPIN_CAP) { atomicAdd(&(bar)[XB_TMO], 1u); break; } } } } while (0)
struct XcdBarrier { unsigned* bar; unsigned x; volatile LAS unsigned* st; };
__device__ __forceinline__ XcdBarrier xcd_barrier_post(unsigned* bar, volatile LAS unsigned* st) {
    XcdBarrier b; b.bar = bar; b.x = xb_xcc_id(); b.st = st;
    if (threadIdx.x == 0) (void)xb_add(&bar[XB_XCNT(b.x)], 1u);
    return b;
}
__device__ __forceinline__ void xcd_barrier_complete(unsigned* bar, unsigned x, unsigned& nloc, unsigned& nx) {
    const unsigned G = gridDim.x * gridDim.y * gridDim.z;
    unsigned sum, cnt, mine, sp = 0u;
    for (;;) {
        sum = 0u; cnt = 0u; mine = 0u;
#pragma unroll
        for (unsigned j = 0; j < 16; ++j) { const unsigned c = xb_ld(&bar[XB_XCNT(j)]); sum += c; cnt += (c > 0u) ? 1u : 0u; mine = (j == x) ? c : mine; }
        if (sum == G) break;
        __builtin_amdgcn_s_sleep(1);
        if ((++sp & 255u) == 0u) { if (xb_ld(&bar[XB_TMO])) break; if (sp > XB_SPIN_CAP) { atomicAdd(&bar[XB_TMO], 1u); break; } }
    }
    nloc = mine > 0u ? mine : 1u; nx = cnt > 0u ? cnt : 1u;
}
__device__ __forceinline__ void xcd_barrier(const XcdBarrier& b) {
    asm volatile("s_waitcnt vmcnt(0)" ::: "memory");
    __syncthreads();
    if (threadIdx.x == 0) {
        unsigned* bar = b.bar; unsigned bx = b.x;
        asm volatile("" : "+s"(bar), "+s"(bx));
        __builtin_amdgcn_s_waitcnt(0);
        unsigned nloc = b.st[0], nx = b.st[1];
        if (nloc == 0u) { xcd_barrier_complete(bar, bx, nloc, nx); b.st[0] = nloc; b.st[1] = nx; }
        const unsigned old = xb_add(&bar[XB_XSUB(bx)], 1u);
        const unsigned gen = old / nloc;
        if (old + 1u == (gen + 1u) * nloc) {
            __builtin_amdgcn_fence(__ATOMIC_RELEASE, "agent");
            asm volatile("s_waitcnt vmcnt(0)" ::: "memory");
            const unsigned og = xb_add(&bar[XB_TOP], 1u);
            const unsigned tg = og / nx;
            if (og + 1u == (tg + 1u) * nx) xb_add(&bar[XB_TOPGEN], 1u);
            else XB_SPIN(xb_ld(&bar[XB_TOPGEN]) == tg, bar);
            __builtin_amdgcn_fence(__ATOMIC_ACQUIRE, "agent");
            xb_add(&bar[XB_XGEN(bx)], 1u);
            asm volatile("s_waitcnt vmcnt(0)" ::: "memory");
        } else {
            XB_SPIN(xb_ld(&bar[XB_XGEN(bx)]) == gen, bar);
            __builtin_amdgcn_fence(__ATOMIC_ACQUIRE, "agent");
            asm volatile("s_waitcnt vmcnt(0)" ::: "memory");
        }
    }
    __syncthreads();
}

struct Params {
    const float *x_in, *norm1_g, *w_in, *conv_w, *conv_b, *dt_bias, *a_log, *ssd_d, *ssd_ng, *sbq_g, *sbk_g, *sbo_g, *dq_g, *dk_g, *do_g,
                *pool_w, *pool_sc, *w_out, *norm2_g, *rg_w, *rg_b, *re_w, *re_b, *wg, *wu, *wd;
    float* X; unsigned* bar; int* ctrl;
    u16 *HB, *MIXED, *WinT, *WoutT, *Hb;
    u16 *PROJ, *PREV, *CG, *WpT, *PZ0, *PZ1; float *DTR, *YD, *SS, *ATOT, *ACS, *RT, *WDT, *tok_g; u16* Yb;
    int *tok_e, *tok_pos, *tlist;
};
constexpr int CTRL_INTS = 1024;

namespace pg8 {
#define PG8_LAS __attribute__((address_space(3)))
typedef unsigned short bf16_t;
typedef short bf16x8 __attribute__((ext_vector_type(8)));
typedef float f32x4 __attribute__((ext_vector_type(4)));
typedef unsigned u32x4 __attribute__((ext_vector_type(4)));
constexpr int BM = 256, BK = 64, HALF = 128, HTB = HALF * BK * 2  , STAGE_BYTES = 8 * HTB, NXCD = 8, WGM = 8;

__host__ __device__ __forceinline__ int lds_byte(int r, int c) { const int st = (r >> 4) * 2 + (c >> 5), rr = r & 15, cc = c & 31, ob = rr * 64 + cc * 2; return st * 1024 + (ob ^ (((ob >> 9) & 1) << 5)); }
__host__ __device__ __forceinline__ void stage_rc(int b, int& R, int& C) { const int st = b / 1024, sb = b % 1024, swz = sb ^ (((sb >> 9) & 1) << 5); R = (st >> 1) * 16 + swz / 64; C = (st & 1) * 32 + (swz % 64) / 2; }
__host__ __device__ __forceinline__ int perm32(int rho) { const int n = rho >> 4, i = rho & 15; return 8 * (i >> 2) + 4 * n + (i & 3); }

struct Unit { int pm, pn; };
struct Gemm { const bf16_t* A; const bf16_t* Bt; int M, N, K, ld; };

struct StaticOrder {
    int nM, nN, nwg, G, c;
    __host__ __device__ void init(int M, int N, int G_, int c_) { nM = M / BM; nN = N / BM; nwg = nM * nN; G = G_; c = c_; }
    __host__ __device__ bool next(int i, Unit& u) const {
        const long L = (long)i * G + c; if (L >= nwg) return false;
        int wgid = (int)L; { const int q = nwg / NXCD, r = nwg % NXCD, xcd = wgid % NXCD, off = wgid / NXCD; wgid = (xcd < r ? xcd * (q + 1) : r * (q + 1) + (xcd - r) * q) + off; }
        const int nig = WGM * nN, gid = wgid / nig, fm = gid * WGM, gsz = (nM - fm) < WGM ? (nM - fm) : WGM;
        u.pm = fm + ((wgid % nig) % gsz); u.pn = (wgid % nig) / gsz; return true;
    }
    __device__ __forceinline__ void a_ready(const Unit&) const {}
    __device__ __forceinline__ void done(const Unit&) const {}
};
__device__ __forceinline__ unsigned cvt_pk_bf16(float lo, float hi) { unsigned r; asm volatile("v_cvt_pk_bf16_f32 %0, %1, %2" : "=v"(r) : "v"(lo), "v"(hi)); return r; }
typedef float f32x2 __attribute__((ext_vector_type(2)));
struct EpiF32 {
    static constexpr bool PERM = false, AFTER_DRAIN = false;
    float* C; int ldc; const float* bias;
    __device__ __forceinline__ void operator()(const f32x4 (&acc)[2][2][4][2], const Unit& u, int wr, int wc, int fr, int fq) const {
        const int row0 = u.pm * BM + wr * 64 + fr, col0 = u.pn * BM + wc * 32 + 4 * fq;
        f32x4 bv[2][2];
#pragma unroll
        for (int bj = 0; bj < 2; ++bj)
#pragma unroll
            for (int n = 0; n < 2; ++n) bv[bj][n] = bias ? *(const f32x4*)(bias + col0 + bj * HALF + n * 16) : (f32x4){0.f, 0.f, 0.f, 0.f};
#pragma unroll
        for (int ai = 0; ai < 2; ++ai)
#pragma unroll
            for (int m = 0; m < 4; ++m) { float* rowp = C + (size_t)(row0 + ai * HALF + m * 16) * ldc + col0;
#pragma unroll
                for (int bj = 0; bj < 2; ++bj)
#pragma unroll
                    for (int n = 0; n < 2; ++n) *(f32x4*)(rowp + bj * HALF + n * 16) = acc[ai][bj][m][n] + bv[bj][n]; }
    }
};
template <class Epi, class Sched, bool STAMP = false>
__device__ __forceinline__ void gemm_phase(PG8_LAS unsigned char* lds, const Gemm g, const Sched& S, const Epi& E, unsigned long long* stamps) {
    int tid = threadIdx.x; asm volatile("" : "+v"(tid));
    const int wid = __builtin_amdgcn_readfirstlane(tid >> 6), lane = tid & 63, wr = wid >> 2, wc = wid & 3, fr = lane & 15, fq = lane >> 4;
    const int K = g.K, nt = K / BK, LD = g.ld;
    int ts_lo = 0, ts_hi = 0, nts = 0; const unsigned long long rt_entry = STAMP ? (unsigned long long)wall_clock64() : 0ull;
#define PG8_STAMP() do { if (STAMP && wid == 0 && nts < 64) { const unsigned long long _c = (unsigned long long)clock64(); \
        ts_lo = (lane == nts) ? (int)(unsigned)_c : ts_lo; ts_hi = (lane == nts) ? (int)(unsigned)(_c >> 32) : ts_hi; ++nts; } } while (0)
    PG8_STAMP();
    unsigned voffA[2], voffB[2];
#pragma unroll
    for (int i = 0; i < 2; ++i) { int R, C; stage_rc(tid * 16 + i * 8192, R, C); const int Rb = Epi::PERM ? ((R & ~31) + perm32(R & 31)) : R;
        voffA[i] = (unsigned)(R * LD + C) * 2u; voffB[i] = (unsigned)(Rb * LD + C) * 2u; }
    const size_t kstep = (size_t)(BK * 2);
    const size_t hstep = (size_t)HALF * LD * 2;
    const size_t tstep = 2 * hstep;
    const unsigned ldsw = (unsigned)wid * 1024u;
    const int aoff = lds_byte(wr * 64 + fr, fq * 8), boff = lds_byte(wc * 32 + fr, fq * 8);
#define PG8_SA(b, h) (((b) * 2 + (h)) * HTB)
#define PG8_SB(b, h) ((4 + (b) * 2 + (h)) * HTB)
#define PG8_STAGE(bufoff, gbase, voff) do { _Pragma("unroll") for (int _i = 0; _i < 2; ++_i) \
        __builtin_amdgcn_global_load_lds((const unsigned*)((const char*)(gbase) + (voff)[_i]), (PG8_LAS unsigned*)(lds + (bufoff) + ldsw + _i * 8192), 16, 0, 0); } while (0)
#define PG8_LDA(dst, b, h) do { _Pragma("unroll") for (int m = 0; m < 4; ++m) _Pragma("unroll") for (int k = 0; k < 2; ++k) dst[m][k] = *(const PG8_LAS bf16x8*)(lds + PG8_SA(b, h) + aoff + m * 2048 + k * 1024); } while (0)
#define PG8_LDB(dst, b, h) do { _Pragma("unroll") for (int n = 0; n < 2; ++n) _Pragma("unroll") for (int k = 0; k < 2; ++k) dst[n][k] = *(const PG8_LAS bf16x8*)(lds + PG8_SB(b, h) + boff + n * 2048 + k * 1024); } while (0)
#define PG8_MMA(ai, bj, At, Bt) do { __builtin_amdgcn_s_setprio(1); _Pragma("unroll") for (int m = 0; m < 4; ++m) _Pragma("unroll") for (int n = 0; n < 2; ++n) _Pragma("unroll") for (int k = 0; k < 2; ++k) \
        acc[ai][bj][m][n] = __builtin_amdgcn_mfma_f32_16x16x32_bf16(Bt[n][k], At[m][k], acc[ai][bj][m][n], 0, 0, 0); __builtin_amdgcn_s_setprio(0); } while (0)
#define PG8_WAIT_V(n) asm volatile("s_waitcnt vmcnt(" #n ")" ::: "memory")
#define PG8_WAIT_L(n) asm volatile("s_waitcnt lgkmcnt(" #n ")" ::: "memory")
#define PG8_BAR __builtin_amdgcn_s_barrier()
#define PG8_SCHED __builtin_amdgcn_sched_barrier(0)
    Unit cur, nxt; int ui = 0;
    if (!S.next(0, cur)) return;
    f32x4 acc[2][2][4][2];
#pragma unroll
    for (int a = 0; a < 2; ++a)
#pragma unroll
        for (int b = 0; b < 2; ++b)
#pragma unroll
            for (int m = 0; m < 4; ++m)
#pragma unroll
                for (int n = 0; n < 2; ++n) acc[a][b][m][n] = (f32x4){0.f, 0.f, 0.f, 0.f};
    bf16x8 At[4][2], B0[2][2], B1[2][2];
    const char* cA = (const char*)g.A + (size_t)cur.pm * tstep; const char* cB = (const char*)g.Bt + (size_t)cur.pn * tstep;
    S.a_ready(cur);
    PG8_STAGE(PG8_SB(0, 0), cB, voffB); PG8_STAGE(PG8_SA(0, 0), cA, voffA); PG8_STAGE(PG8_SB(0, 1), cB + hstep, voffB); PG8_STAGE(PG8_SA(0, 1), cA + hstep, voffA);
    if (wr == 1) PG8_BAR;
    PG8_WAIT_V(4); PG8_BAR;
    PG8_STAGE(PG8_SB(1, 0), cB + kstep, voffB); PG8_STAGE(PG8_SA(1, 0), cA + kstep, voffA); PG8_STAGE(PG8_SB(1, 1), cB + hstep + kstep, voffB);
    PG8_WAIT_V(6); PG8_BAR;
    PG8_STAMP();
    for (;;) {
        const bool has_next = S.next(ui + 1, nxt);
        const char* nA = has_next ? (const char*)g.A + (size_t)nxt.pm * tstep : cA; const char* nB = has_next ? (const char*)g.Bt + (size_t)nxt.pn * tstep : cB;
        for (int t = 0; t < nt; t += 2) {
            const bool last = (t == nt - 2);
            const char* a1 = cA + (size_t)(t + 1) * kstep;
            const char* a2 = last ? nA : cA + (size_t)(t + 2) * kstep; const char* b2 = last ? nB : cB + (size_t)(t + 2) * kstep;
            const char* a3 = a2 + kstep; const char* b3 = b2 + kstep;
            if (last && has_next) S.a_ready(nxt);
            PG8_LDB(B0, 0, 0); PG8_SCHED; PG8_LDA(At, 0, 0); PG8_STAGE(PG8_SA(1, 1), a1 + hstep, voffA);
            PG8_WAIT_L(8); PG8_BAR; PG8_WAIT_L(0); PG8_MMA(0, 0, At, B0); PG8_BAR; PG8_SCHED;
            PG8_LDB(B1, 0, 1); PG8_STAGE(PG8_SB(0, 0), b2, voffB);
            PG8_BAR; PG8_WAIT_L(0); PG8_MMA(0, 1, At, B1); PG8_BAR;
            PG8_LDA(At, 0, 1); PG8_STAGE(PG8_SA(0, 0), a2, voffA);
            PG8_BAR; PG8_WAIT_L(0); PG8_MMA(1, 0, At, B0); PG8_BAR; PG8_SCHED;
            PG8_STAGE(PG8_SB(0, 1), b2 + hstep, voffB);
            PG8_WAIT_V(6); PG8_BAR; PG8_MMA(1, 1, At, B1); PG8_BAR;
            PG8_LDB(B0, 1, 0); PG8_SCHED; PG8_LDA(At, 1, 0); PG8_STAGE(PG8_SA(0, 1), a2 + hstep, voffA);
            PG8_WAIT_L(8); PG8_BAR; PG8_WAIT_L(0); PG8_MMA(0, 0, At, B0); PG8_BAR; PG8_SCHED;
            PG8_LDB(B1, 1, 1); PG8_STAGE(PG8_SB(1, 0), b3, voffB);
            PG8_BAR; PG8_WAIT_L(0); PG8_MMA(0, 1, At, B1); PG8_BAR;
            PG8_LDA(At, 1, 1); PG8_STAGE(PG8_SA(1, 0), a3, voffA);
            PG8_BAR; PG8_WAIT_L(0); PG8_MMA(1, 0, At, B0); PG8_BAR; PG8_SCHED;
            PG8_STAGE(PG8_SB(1, 1), b3 + hstep, voffB);
            PG8_WAIT_V(6); PG8_BAR; PG8_MMA(1, 1, At, B1); PG8_BAR;
        }
        PG8_STAMP();
        if constexpr (!Epi::AFTER_DRAIN) { E(acc, cur, wr, wc, fr, fq); S.done(cur); }
        PG8_STAMP();
        if (!has_next) break;
#pragma unroll
        for (int a = 0; a < 2; ++a)
#pragma unroll
            for (int b = 0; b < 2; ++b)
#pragma unroll
                for (int m = 0; m < 4; ++m)
#pragma unroll
                    for (int n = 0; n < 2; ++n) acc[a][b][m][n] = (f32x4){0.f, 0.f, 0.f, 0.f};
        cur = nxt; cA = nA; cB = nB; ++ui;
    }
    PG8_WAIT_V(0);
    if (wr == 0) PG8_BAR;
    PG8_BAR;
    if constexpr (Epi::AFTER_DRAIN) { E.fused(acc, cur, wr, wc, fr, fq, lds, wid, lane); S.done(cur); }
    PG8_STAMP();
    if (STAMP && wid == 0) { stamps[lane] = lane < nts ? (((unsigned long long)(unsigned)ts_hi << 32) | (unsigned)ts_lo) : 0ull;
        if (lane == 62) stamps[62] = rt_entry; if (lane == 63) stamps[63] = (unsigned long long)wall_clock64(); }
#undef PG8_STAMP
#undef PG8_SA
#undef PG8_SB
#undef PG8_STAGE
#undef PG8_LDA
#undef PG8_LDB
#undef PG8_MMA
#undef PG8_WAIT_V
#undef PG8_WAIT_L
#undef PG8_BAR
#undef PG8_SCHED
}
}

namespace pg8 {
struct EpiStoreBf16 {
    static constexpr bool PERM = true, AFTER_DRAIN = false;
    bf16_t* O; int ldc;
    __device__ __forceinline__ void operator()(const f32x4 (&acc)[2][2][4][2], const Unit& u, int wr, int wc, int fr, int fq) const {
        const int row0 = u.pm * BM + wr * 64 + fr, col0 = u.pn * BM + wc * 32 + 8 * fq;
#pragma unroll
        for (int ai = 0; ai < 2; ++ai)
#pragma unroll
            for (int m = 0; m < 4; ++m) { bf16_t* rowp = O + (size_t)(row0 + ai * HALF + m * 16) * ldc + col0;
#pragma unroll
                for (int bj = 0; bj < 2; ++bj) { const f32x4 v0 = acc[ai][bj][m][0], v1 = acc[ai][bj][m][1];
                    u32x4 w; w.x = cvt_pk_bf16(v0[0], v0[1]); w.y = cvt_pk_bf16(v0[2], v0[3]); w.z = cvt_pk_bf16(v1[0], v1[1]); w.w = cvt_pk_bf16(v1[2], v1[3]);
                    *(u32x4*)(rowp + bj * HALF) = w; } }
    }
};
struct EpiAddF32 {
    static constexpr bool PERM = false, AFTER_DRAIN = false;
    float* C; int ldc;
    __device__ __forceinline__ void operator()(const f32x4 (&acc)[2][2][4][2], const Unit& u, int wr, int wc, int fr, int fq) const {
        const int row0 = u.pm * BM + wr * 64 + fr, col0 = u.pn * BM + wc * 32 + 4 * fq;
#pragma unroll
        for (int ai = 0; ai < 2; ++ai)
#pragma unroll
            for (int m = 0; m < 4; ++m) { float* rowp = C + (size_t)(row0 + ai * HALF + m * 16) * ldc + col0;
#pragma unroll
                for (int bj = 0; bj < 2; ++bj)
#pragma unroll
                    for (int n = 0; n < 2; ++n) { f32x4* q = (f32x4*)(rowp + bj * HALF + n * 16); *q = *q + acc[ai][bj][m][n]; } }
    }
};
struct EpiDownF32 {
    static constexpr bool PERM = false, AFTER_DRAIN = false;
    float* C;
    __device__ __forceinline__ void operator()(const f32x4 (&acc)[2][2][4][2], const Unit& u, int wr, int wc, int fr, int fq) const {
        const int row0 = u.pm * BM + wr * 64 + fr, col0 = (u.pn & 7) * BM + wc * 32 + 4 * fq;
#pragma unroll
        for (int ai = 0; ai < 2; ++ai)
#pragma unroll
            for (int m = 0; m < 4; ++m) { float* rowp = C + (size_t)(row0 + ai * HALF + m * 16) * 2048 + col0;
#pragma unroll
                for (int bj = 0; bj < 2; ++bj)
#pragma unroll
                    for (int n = 0; n < 2; ++n) *(f32x4*)(rowp + bj * HALF + n * 16) = acc[ai][bj][m][n]; }
    }
};
struct EpiSwiglu {
    static constexpr bool PERM = true, AFTER_DRAIN = false;
    bf16_t* H;
    __device__ __forceinline__ void operator()(const f32x4 (&acc)[2][2][4][2], const Unit& u, int wr, int wc, int fr, int fq) const {
        const int row0 = u.pm * BM + wr * 64 + fr, col0 = (u.pn & 3) * 128 + wc * 32 + 8 * fq;
#pragma unroll
        for (int ai = 0; ai < 2; ++ai)
#pragma unroll
            for (int m = 0; m < 4; ++m) { bf16_t* rowp = H + (size_t)(row0 + ai * HALF + m * 16) * 512 + col0;
                float h[8];
#pragma unroll
                for (int n = 0; n < 2; ++n)
#pragma unroll
                    for (int j = 0; j < 4; ++j) { const float g = acc[ai][0][m][n][j], up = acc[ai][1][m][n][j]; h[n * 4 + j] = g / (1.f + __expf(-g)) * up; }
                u32x4 w; w.x = cvt_pk_bf16(h[0], h[1]); w.y = cvt_pk_bf16(h[2], h[3]); w.z = cvt_pk_bf16(h[4], h[5]); w.w = cvt_pk_bf16(h[6], h[7]);
                *(u32x4*)rowp = w; }
    }
};
struct HalfOrder {
    int c, G;
    __device__ __forceinline__ bool next(int i, Unit& u) const { const int L = i * G + c; if (L >= 256) return false; u.pm = (L >> 1) >> 2; u.pn = (L >> 1) & 3; return true; }
    __device__ __forceinline__ void a_ready(const Unit&) const {}
    __device__ __forceinline__ void done(const Unit&) const {}
};
struct MoeOrder {
    const int* blk_e; int ntile, G, c, shift;
    __device__ __forceinline__ bool next(int i, Unit& u) const {
        const int L = i * G + c; if (L >= ntile) return false;
        const int mb = L >> shift, nt = L & ((1 << shift) - 1);
        u.pm = mb; u.pn = (blk_e[mb] << shift) + nt; return true;
    }
    __device__ __forceinline__ void a_ready(const Unit&) const {}
    __device__ __forceinline__ void done(const Unit&) const {}
};
}

__device__ __forceinline__ void transpose_item(const float* __restrict__ W, int ldin, int n0, int K, u16* __restrict__ WT, int row0, int nbn, int item, float* scr, int lane, int ilv = -1) {
    const int kb = item / nbn, nb = item % nbn, k0 = 64 * kb, nn = 32 * nb;
    const int rb = ilv < 0 ? row0 + nn : row0 + (nn >> 7) * 256 + ilv * 128 + (nn & 127);
#pragma unroll 8
    for (int i = 0; i < 32; ++i) { const int kk = 2 * i + (lane >> 5); scr[kk * 33 + (lane & 31)] = __builtin_nontemporal_load(&W[(size_t)(k0 + kk) * ldin + n0 + nn + (lane & 31)]); }
    asm volatile("s_waitcnt lgkmcnt(0)" ::: "memory");
    const int c = lane & 7;
#pragma unroll
    for (int j = 0; j < 4; ++j) { const int n = (lane >> 3) + 8 * j; const float* s = scr + (8 * c) * 33 + n;
        uint4 o; o.x = pk2(s[0 * 33], s[1 * 33]); o.y = pk2(s[2 * 33], s[3 * 33]); o.z = pk2(s[4 * 33], s[5 * 33]); o.w = pk2(s[6 * 33], s[7 * 33]);
        *(uint4*)(WT + (size_t)(rb + n) * K + k0 + 8 * c) = o; }
    asm volatile("s_waitcnt lgkmcnt(0)" ::: "memory");
}
__device__ __forceinline__ void convert_moe_weights(const float* wg, const float* wu, const float* wd, u16* WguT, u16* WdT, int l, float* scr, int gw, int NGW, int lane) {
    constexpr int IPE = 512;
    for (int it = gw; it < 3 * NE * IPE; it += NGW) {
        const int which = it / (NE * IPE), r = it % (NE * IPE), e = r / IPE, item = r % IPE;
        const size_t eo = ((size_t)l * NE + e) * (size_t)D * DFF;
        if (which == 0)      transpose_item(wg + eo, DFF, 0, D, WguT + (size_t)e * 1024 * D, 0, DFF / 32, item, scr, lane, 0);
        else if (which == 1) transpose_item(wu + eo, DFF, 0, D, WguT + (size_t)e * 1024 * D, 0, DFF / 32, item, scr, lane, 1);
        else                 transpose_item(wd + eo, D, 0, DFF, WdT + (size_t)e * D * DFF, 0, D / 32, item, scr, lane);
    }
}


constexpr int ATT_RS = 144;
constexpr int ATT_VBYTES = 32 * ATT_RS;
typedef long long i64;
typedef unsigned u32x4v __attribute__((ext_vector_type(4)));
typedef unsigned u32x2v __attribute__((ext_vector_type(2)));
__device__ __forceinline__ float bperm(int srclane, float v) { return __int_as_float(__builtin_amdgcn_ds_bpermute(srclane << 2, __float_as_int(v))); }
__device__ __forceinline__ float softplus_fast(float z) { return fmaxf(z, 0.f) + __logf(1.f + __expf(-fabsf(z))); }
__device__ __forceinline__ void vt_frags(unsigned vaddr, int lane, bf16x8 (&vf)[4]) {
    const unsigned a = vaddr + (unsigned)((4 * (lane >> 4) + ((lane & 15) >> 2)) * ATT_RS + (lane & 3) * 8);
    i64 r0, r1, r2, r3, r4, r5, r6, r7;
    asm volatile("s_waitcnt lgkmcnt(0)\n\t"
                 "ds_read_b64_tr_b16 %0, %8\n\tds_read_b64_tr_b16 %1, %8 offset:2304\n\t"
                 "ds_read_b64_tr_b16 %2, %8 offset:32\n\tds_read_b64_tr_b16 %3, %8 offset:2336\n\t"
                 "ds_read_b64_tr_b16 %4, %8 offset:64\n\tds_read_b64_tr_b16 %5, %8 offset:2368\n\t"
                 "ds_read_b64_tr_b16 %6, %8 offset:96\n\tds_read_b64_tr_b16 %7, %8 offset:2400\n\t"
                 "s_waitcnt lgkmcnt(0)"
                 : "=&v"(r0), "=&v"(r1), "=&v"(r2), "=&v"(r3), "=&v"(r4), "=&v"(r5), "=&v"(r6), "=&v"(r7) : "v"(a) : "memory");
    typedef i64 i64x2 __attribute__((ext_vector_type(2)));
    i64x2 t; t.x = r0; t.y = r1; vf[0] = __builtin_bit_cast(bf16x8, t); t.x = r2; t.y = r3; vf[1] = __builtin_bit_cast(bf16x8, t);
    t.x = r4; t.y = r5; vf[2] = __builtin_bit_cast(bf16x8, t); t.x = r6; t.y = r7; vf[3] = __builtin_bit_cast(bf16x8, t);
}
__device__ __forceinline__ bf16x8 pack8(const float (&a)[4], const float (&b)[4]) {
    u32x4v w; w.x = pk2(a[0], a[1]); w.y = pk2(a[2], a[3]); w.z = pk2(b[0], b[1]); w.w = pk2(b[2], b[3]);
    return __builtin_bit_cast(bf16x8, w);
}
__device__ __forceinline__ void store_out_tile(const f32x4 (&o)[4], float scale, const float* __restrict__ gain, u16* __restrict__ dst  , int g) {
#pragma unroll
    for (int dt = 0; dt < 4; ++dt) { const float4 gg = *(const float4*)(gain + dt * 16 + 4 * g);
        *(uint2*)(dst + dt * 16 + 4 * g) = make_uint2(pk2(o[dt][0] * scale * gg.x, o[dt][1] * scale * gg.y), pk2(o[dt][2] * scale * gg.z, o[dt][3] * scale * gg.w)); }
}

__device__ __forceinline__ void sb_unit(const u16* __restrict__ PROJ, int b, int qb, int h, int lane, LAS char* vl, LAS float* red,
                                        const float* __restrict__ gout, u16* __restrict__ MIXED) {
    const int li = lane & 15, g = lane >> 4; const size_t tb = (size_t)b * SEQ; const int q0 = qb * 32;
    const u16* Qp = PROJ + C_SB + h * 64; const u16* Kp = Qp + 512; const u16* Vp = Qp + 1024;
    const unsigned vaddr = (unsigned)(size_t)vl;
    bf16x8 qf[2][2];
#pragma unroll
    for (int qt = 0; qt < 2; ++qt)
#pragma unroll
        for (int s = 0; s < 2; ++s) qf[qt][s] = *(const bf16x8*)(Qp + (tb + q0 + qt * 16 + li) * DP + 32 * s + 8 * g);
    f32x4 acc[2][4];
#pragma unroll
    for (int qt = 0; qt < 2; ++qt)
#pragma unroll
        for (int dt = 0; dt < 4; ++dt) acc[qt][dt] = (f32x4){0.f, 0.f, 0.f, 0.f};
    float carry[2] = {0.f, 0.f};
    bf16x8 kn[2][2]; u32x4v vn[4];
#define SB_LOAD(kk) do { _Pragma("unroll") for (int kt = 0; kt < 2; ++kt) _Pragma("unroll") for (int s = 0; s < 2; ++s) kn[kt][s] = *(const bf16x8*)(Kp + (tb + (kk) + kt * 16 + li) * DP + 32 * s + 8 * g); \
        _Pragma("unroll") for (int u = 0; u < 4; ++u) { const int c = lane + 64 * u; vn[u] = *(const u32x4v*)(Vp + (tb + (kk) + (c >> 3)) * DP + (c & 7) * 8); } } while (0)
    SB_LOAD(q0);
    for (int k0 = q0; k0 >= 0; k0 -= 32) {
        bf16x8 kf[2][2];
#pragma unroll
        for (int kt = 0; kt < 2; ++kt)
#pragma unroll
            for (int s = 0; s < 2; ++s) kf[kt][s] = kn[kt][s];
#pragma unroll
        for (int u = 0; u < 4; ++u) { const int c = lane + 64 * u; *(LAS u32x4v*)(vl + (c >> 3) * ATT_RS + (c & 7) * 16) = vn[u]; }
        if (k0 >= 32) SB_LOAD(k0 - 32);
        bf16x8 pf[2];
#pragma unroll
        for (int qt = 0; qt < 2; ++qt) {
            const int qpos = q0 + qt * 16 + li;
            float w[2][4];
#pragma unroll
            for (int kt = 1; kt >= 0; --kt) {
                f32x4 st = __builtin_amdgcn_mfma_f32_16x16x32_bf16(kf[kt][0], qf[qt][0], (f32x4){0.f, 0.f, 0.f, 0.f}, 0, 0, 0);
                st = __builtin_amdgcn_mfma_f32_16x16x32_bf16(kf[kt][1], qf[qt][1], st, 0, 0, 0);
                const int kb = k0 + kt * 16 + 4 * g;
                float sp[4];
#pragma unroll
                for (int r = 0; r < 4; ++r) sp[r] = (kb + r < qpos) ? softplus_fast(st[r]) : 0.f;
                const float G = (sp[0] + sp[1]) + (sp[2] + sp[3]);
                const float x1 = bperm(lane ^ 16, G), hs = G + x1, x2 = bperm(lane ^ 32, hs);
                float rs = carry[qt] + (g == 3 ? 0.f : g == 2 ? x1 : g == 1 ? x2 : x1 + x2);
#pragma unroll
                for (int r = 3; r >= 0; --r) { w[kt][r] = (kb + r < qpos) ? __expf(st[r] - sp[r] - rs) : 0.f; rs += sp[r]; }
                carry[qt] += hs + x2;
            }
            pf[qt] = pack8(w[0], w[1]);
        }
        bf16x8 vf[4]; vt_frags(vaddr, lane, vf);
#pragma unroll
        for (int qt = 0; qt < 2; ++qt)
#pragma unroll
            for (int dt = 0; dt < 4; ++dt) acc[qt][dt] = __builtin_amdgcn_mfma_f32_16x16x32_bf16(vf[dt], pf[qt], acc[qt][dt], 0, 0, 0);
        if (k0 + 32 <= q0 && __all(fminf(carry[0], carry[1]) > 104.f)) break;
    }
#undef SB_LOAD
    float ss[2];
#pragma unroll
    for (int qt = 0; qt < 2; ++qt) { float s = 0.f;
#pragma unroll
        for (int dt = 0; dt < 4; ++dt) s += (acc[qt][dt][0] * acc[qt][dt][0] + acc[qt][dt][1] * acc[qt][dt][1]) + (acc[qt][dt][2] * acc[qt][dt][2] + acc[qt][dt][3] * acc[qt][dt][3]);
        s += bperm(lane ^ 16, s); s += bperm(lane ^ 32, s); ss[qt] = s;
        if (g == 0) red[h * 64 + qt * 16 + li] = s; }
    __syncthreads();
#pragma unroll
    for (int qt = 0; qt < 2; ++qt) { float tot = 0.f;
#pragma unroll
        for (int hh = 0; hh < 8; ++hh) tot += red[hh * 64 + qt * 16 + li];
        const float sc = rsqrtf(tot / 512.f + EPS);
        store_out_tile(acc[qt], sc, gout + h * 64, MIXED + (tb + q0 + qt * 16 + li) * D + 512 + h * 64, g); }
}

__device__ __forceinline__ void dil_unit(const u16* __restrict__ PROJ, int b, int w, int r, int h, int lane, LAS char* vl, LAS float* red,
                                         const float* __restrict__ gout, u16* __restrict__ MIXED) {
    const int li = lane & 15, g = lane >> 4; const size_t tb = (size_t)b * SEQ; const int qpos = w * 256 + r + 16 * li;
    const u16* Qp = PROJ + C_DIL + h * 64; const u16* Kp = Qp + 512; const u16* Vp = Qp + 1024;
    const unsigned vaddr = (unsigned)(size_t)vl;
    bf16x8 qf[2];
#pragma unroll
    for (int s = 0; s < 2; ++s) qf[s] = *(const bf16x8*)(Qp + (tb + qpos) * DP + 32 * s + 8 * g);
    f32x4 acc[4];
#pragma unroll
    for (int dt = 0; dt < 4; ++dt) acc[dt] = (f32x4){0.f, 0.f, 0.f, 0.f};
    float mrun = -1e30f, lrun = 0.f;
#pragma unroll 1
    for (int br = 0; br < 3; ++br) {
        const int dsh = br == 0 ? 4 : br == 1 ? 2 : 0;
        const int nstep = br == 0 ? 5 : br == 1 ? 6 : 12;
        const int base = w * 256 + r - (128 << dsh);
        const int rat = li << (4 - dsh);
        const int nbf = base < 0 ? ((-base + (1 << dsh) - 1) >> dsh) : 0;
        const int sbeg = nbf >> 5;
        bf16x8 kn[2][2]; u32x4v vn[4];
#define DIL_LOAD(mm) do { _Pragma("unroll") for (int kt = 0; kt < 2; ++kt) { int pos = base + (((mm) + kt * 16 + li) << dsh); pos = min(max(pos, 0), SEQ - 1); \
            _Pragma("unroll") for (int s = 0; s < 2; ++s) kn[kt][s] = *(const bf16x8*)(Kp + (tb + pos) * DP + 32 * s + 8 * g); } \
        _Pragma("unroll") for (int u = 0; u < 4; ++u) { const int c = lane + 64 * u; int pos = base + (((mm) + (c >> 3)) << dsh); pos = min(max(pos, 0), SEQ - 1); \
            vn[u] = *(const u32x4v*)(Vp + (tb + pos) * DP + (c & 7) * 8); } } while (0)
        DIL_LOAD(sbeg * 32);
#pragma unroll 1
        for (int st_ = sbeg; st_ < nstep; ++st_) {
            const int m0 = st_ * 32;
            bf16x8 kf[2][2];
#pragma unroll
            for (int kt = 0; kt < 2; ++kt)
#pragma unroll
                for (int s = 0; s < 2; ++s) kf[kt][s] = kn[kt][s];
#pragma unroll
            for (int u = 0; u < 4; ++u) { const int c = lane + 64 * u; *(LAS u32x4v*)(vl + (c >> 3) * ATT_RS + (c & 7) * 16) = vn[u]; }
            if (st_ + 1 < nstep) DIL_LOAD(m0 + 32);
            float z[2][4]; bool ok[2][4]; float zmax = -1e30f;
#pragma unroll
            for (int kt = 0; kt < 2; ++kt) {
                f32x4 st = __builtin_amdgcn_mfma_f32_16x16x32_bf16(kf[kt][0], qf[0], (f32x4){0.f, 0.f, 0.f, 0.f}, 0, 0, 0);
                st = __builtin_amdgcn_mfma_f32_16x16x32_bf16(kf[kt][1], qf[1], st, 0, 0, 0);
#pragma unroll
                for (int rr = 0; rr < 4; ++rr) { const int m = m0 + kt * 16 + 4 * g + rr; const int dm = m - rat;
                    ok[kt][rr] = (dm >= 0) && (dm <= 128) && (base + (m << dsh) >= 0);
                    z[kt][rr] = st[rr]; if (ok[kt][rr]) zmax = fmaxf(zmax, st[rr]); }
            }
            zmax = fmaxf(zmax, bperm(lane ^ 16, zmax)); zmax = fmaxf(zmax, bperm(lane ^ 32, zmax));
            const float mn = fmaxf(mrun, zmax); const float al = __expf(mrun - mn); mrun = mn;
            float pw[2][4]; float ps = 0.f;
#pragma unroll
            for (int kt = 0; kt < 2; ++kt)
#pragma unroll
                for (int rr = 0; rr < 4; ++rr) { pw[kt][rr] = ok[kt][rr] ? __expf(z[kt][rr] - mn) : 0.f; ps += pw[kt][rr]; }
            lrun = lrun * al + ps;
#pragma unroll
            for (int dt = 0; dt < 4; ++dt) acc[dt] = acc[dt] * al;
            const bf16x8 pf = pack8(pw[0], pw[1]);
            bf16x8 vf[4]; vt_frags(vaddr, lane, vf);
#pragma unroll
            for (int dt = 0; dt < 4; ++dt) acc[dt] = __builtin_amdgcn_mfma_f32_16x16x32_bf16(vf[dt], pf, acc[dt], 0, 0, 0);
        }
    }
#undef DIL_LOAD
    lrun += bperm(lane ^ 16, lrun); lrun += bperm(lane ^ 32, lrun);
    const float inv = 1.f / lrun;
    float s = 0.f;
#pragma unroll
    for (int dt = 0; dt < 4; ++dt) { acc[dt] = acc[dt] * inv; s += (acc[dt][0] * acc[dt][0] + acc[dt][1] * acc[dt][1]) + (acc[dt][2] * acc[dt][2] + acc[dt][3] * acc[dt][3]); }
    s += bperm(lane ^ 16, s); s += bperm(lane ^ 32, s);
    if (g == 0) red[h * 64 + li] = s;
    __syncthreads();
    float tot = 0.f;
#pragma unroll
    for (int hh = 0; hh < 8; ++hh) tot += red[hh * 64 + li];
    const float sc = rsqrtf(tot / 512.f + EPS);
    store_out_tile(acc, sc, gout + h * 64, MIXED + (tb + qpos) * D + 1024 + h * 64, g);
}


template <int RS> __device__ __forceinline__ void tr_frags4(unsigned addr, int lane, bf16x8 (&f)[4]) {
    const unsigned a = addr + (unsigned)((4 * (lane >> 4) + ((lane & 15) >> 2)) * RS + (lane & 3) * 8);
    i64 r0, r1, r2, r3, r4, r5, r6, r7;
    asm volatile("s_waitcnt lgkmcnt(0)\n\t"
                 "ds_read_b64_tr_b16 %0, %8\n\tds_read_b64_tr_b16 %1, %8 offset:%9\n\t"
                 "ds_read_b64_tr_b16 %2, %8 offset:32\n\tds_read_b64_tr_b16 %3, %8 offset:%10\n\t"
                 "ds_read_b64_tr_b16 %4, %8 offset:64\n\tds_read_b64_tr_b16 %5, %8 offset:%11\n\t"
                 "ds_read_b64_tr_b16 %6, %8 offset:96\n\tds_read_b64_tr_b16 %7, %8 offset:%12\n\t"
                 "s_waitcnt lgkmcnt(0)"
                 : "=&v"(r0), "=&v"(r1), "=&v"(r2), "=&v"(r3), "=&v"(r4), "=&v"(r5), "=&v"(r6), "=&v"(r7)
                 : "v"(a), "i"(16 * RS), "i"(16 * RS + 32), "i"(16 * RS + 64), "i"(16 * RS + 96) : "memory");
    typedef i64 i64x2 __attribute__((ext_vector_type(2)));
    i64x2 t; t.x = r0; t.y = r1; f[0] = __builtin_bit_cast(bf16x8, t); t.x = r2; t.y = r3; f[1] = __builtin_bit_cast(bf16x8, t);
    t.x = r4; t.y = r5; f[2] = __builtin_bit_cast(bf16x8, t); t.x = r6; t.y = r7; f[3] = __builtin_bit_cast(bf16x8, t);
}
template <int RS> __device__ __forceinline__ bf16x8 tr_frag1(unsigned addr, int lane) {
    const unsigned a = addr + (unsigned)((4 * (lane >> 4) + ((lane & 15) >> 2)) * RS + (lane & 3) * 8);
    i64 r0, r1;
    asm volatile("s_waitcnt lgkmcnt(0)\n\tds_read_b64_tr_b16 %0, %2\n\tds_read_b64_tr_b16 %1, %2 offset:%3\n\ts_waitcnt lgkmcnt(0)"
                 : "=&v"(r0), "=&v"(r1) : "v"(a), "i"(16 * RS) : "memory");
    typedef i64 i64x2 __attribute__((ext_vector_type(2)));
    i64x2 t; t.x = r0; t.y = r1; return __builtin_bit_cast(bf16x8, t);
}
constexpr int SSD_RB = 272, SSD_RX = 144;
constexpr int SSD_OFF_B = 0, SSD_OFF_C = 128 * SSD_RB, SSD_OFF_X = 2 * 128 * SSD_RB, SSD_OFF_XW = SSD_OFF_X + 128 * SSD_RX, SSD_OFF_F = SSD_OFF_XW + 128 * SSD_RX;
__device__ __forceinline__ void ssd_chunk_unit(const u16* __restrict__ PROJ, const float* __restrict__ DTR, const float* __restrict__ cw, const float* __restrict__ cb,
                                               float dtbias, float aneg, float dskip, int b, int c, int h, int tid, LAS char* L,
                                               float* __restrict__ YD, float* __restrict__ SS, float* __restrict__ ATOT, float* __restrict__ ACS, u16* __restrict__ CG) {
    const int wave = tid >> 6, lane = tid & 63, li = lane & 15, g = lane >> 4, grp = h >> 2;
    const size_t t0 = (size_t)b * SEQ + (size_t)c * 128;
    LAS float* acs = (LAS float*)(L + SSD_OFF_F); LAS float* dts = acs + 128; LAS float* wls = acs + 256;
    __syncthreads();
    if (wave == 0) {
        const float d0 = softplusf(DTR[(t0 + 2 * lane) * 8 + h] + dtbias), d1 = softplusf(DTR[(t0 + 2 * lane + 1) * 8 + h] + dtbias);
        const float a0 = d0 * aneg, a1 = d1 * aneg;
        float v = a0 + a1;
#pragma unroll
        for (int o = 1; o < 64; o <<= 1) { const float t = bperm(lane - o, v); if (lane >= o) v += t; }
        acs[2 * lane] = v - a1; acs[2 * lane + 1] = v; dts[2 * lane] = d0; dts[2 * lane + 1] = d1;
    }
    __syncthreads();
    if (tid < 128) { const float a = acs[tid]; wls[tid] = dts[tid] * __expf(acs[127] - a); ACS[(t0 + tid) * 8 + h] = a; if (tid == 0) ATOT[((size_t)b * 32 + c) * 8 + h] = acs[127]; }
    __syncthreads();
    if (tid < 480) {
        const int cg = tid % 40, tp = tid / 40;
        const int ch = cg < 8 ? h * 64 + cg * 8 : cg < 24 ? 512 + grp * 128 + (cg - 8) * 8 : 768 + grp * 128 + (cg - 24) * 8;
        float wk[4][8], bs[8];
#pragma unroll
        for (int k = 0; k < 4; ++k) { const float4 w0 = *(const float4*)(cw + k * 1024 + ch), w1 = *(const float4*)(cw + k * 1024 + ch + 4);
            wk[k][0] = w0.x; wk[k][1] = w0.y; wk[k][2] = w0.z; wk[k][3] = w0.w; wk[k][4] = w1.x; wk[k][5] = w1.y; wk[k][6] = w1.z; wk[k][7] = w1.w; }
        { const float4 b0 = *(const float4*)(cb + ch), b1 = *(const float4*)(cb + ch + 4); bs[0] = b0.x; bs[1] = b0.y; bs[2] = b0.z; bs[3] = b0.w; bs[4] = b1.x; bs[5] = b1.y; bs[6] = b1.z; bs[7] = b1.w; }
        const int tl0 = tp * 11, tl1 = min(tl0 + 11, 128);
        const u16* src = PROJ + t0 * DP + C_XBC + ch;
        const bf16x8 zero8 = {0, 0, 0, 0, 0, 0, 0, 0};
        bf16x8 r0, r1, r2;
        { const int sl = c * 128 + tl0;
          r0 = sl - 3 >= 0 ? *(const bf16x8*)(src + (long)(tl0 - 3) * DP) : zero8; r1 = sl - 2 >= 0 ? *(const bf16x8*)(src + (long)(tl0 - 2) * DP) : zero8;
          r2 = sl - 1 >= 0 ? *(const bf16x8*)(src + (long)(tl0 - 1) * DP) : zero8; }
        for (int tl = tl0; tl < tl1; ++tl) {
            const bf16x8 r3 = *(const bf16x8*)(src + (long)tl * DP);
            float a[8];
#pragma unroll
            for (int j = 0; j < 8; ++j) a[j] = siluf(bs[j] + wk[0][j] * bf2f((u16)r0[j]) + wk[1][j] * bf2f((u16)r1[j]) + wk[2][j] * bf2f((u16)r2[j]) + wk[3][j] * bf2f((u16)r3[j]));
            r0 = r1; r1 = r2; r2 = r3;
            u32x4v o; o.x = pk2(a[0], a[1]); o.y = pk2(a[2], a[3]); o.z = pk2(a[4], a[5]); o.w = pk2(a[6], a[7]);
            if (cg < 8) {
                *(LAS u32x4v*)(L + SSD_OFF_X + tl * SSD_RX + cg * 16) = o;
                const float wl = wls[tl]; u32x4v ow; ow.x = pk2(a[0] * wl, a[1] * wl); ow.y = pk2(a[2] * wl, a[3] * wl); ow.z = pk2(a[4] * wl, a[5] * wl); ow.w = pk2(a[6] * wl, a[7] * wl);
                *(LAS u32x4v*)(L + SSD_OFF_XW + tl * SSD_RX + cg * 16) = ow;
            } else if (cg < 24) *(LAS u32x4v*)(L + SSD_OFF_B + tl * SSD_RB + (cg - 8) * 16) = o;
            else { *(LAS u32x4v*)(L + SSD_OFF_C + tl * SSD_RB + (cg - 24) * 16) = o;
                   if ((h & 3) == 0) *(u32x4v*)(CG + (t0 + tl) * 256 + grp * 128 + (cg - 24) * 8) = o; }
        }
    }
    __syncthreads();
    const unsigned Lb = (unsigned)(size_t)L;
    {
        const int lt = wave, lrow = lt * 16 + li; const float acl = acs[lrow];
        bf16x8 cf[4];
#pragma unroll
        for (int ks = 0; ks < 4; ++ks) cf[ks] = *(const LAS bf16x8*)(L + SSD_OFF_C + lrow * SSD_RB + ks * 64 + g * 16);
        f32x4 acc[4];
#pragma unroll
        for (int pt = 0; pt < 4; ++pt) acc[pt] = (f32x4){0.f, 0.f, 0.f, 0.f};
        for (int s0 = 0; s0 <= lt * 16; s0 += 32) {
            float w[2][4];
#pragma unroll
            for (int kt = 0; kt < 2; ++kt) {
                f32x4 st = (f32x4){0.f, 0.f, 0.f, 0.f};
#pragma unroll
                for (int ks = 0; ks < 4; ++ks) { const bf16x8 bfr = *(const LAS bf16x8*)(L + SSD_OFF_B + (s0 + kt * 16 + li) * SSD_RB + ks * 64 + g * 16);
                    st = __builtin_amdgcn_mfma_f32_16x16x32_bf16(bfr, cf[ks], st, 0, 0, 0); }
                const int sb = s0 + kt * 16 + 4 * g;
                const f32x4 as4 = *(const LAS f32x4*)(acs + sb), dt4 = *(const LAS f32x4*)(dts + sb);
#pragma unroll
                for (int r = 0; r < 4; ++r) w[kt][r] = (sb + r <= lrow) ? st[r] * __expf(acl - as4[r]) * dt4[r] : 0.f;
            }
            const bf16x8 pf = pack8(w[0], w[1]);
            bf16x8 xf[4]; tr_frags4<SSD_RX>(Lb + SSD_OFF_X + s0 * SSD_RX, lane, xf);
#pragma unroll
            for (int pt = 0; pt < 4; ++pt) acc[pt] = __builtin_amdgcn_mfma_f32_16x16x32_bf16(xf[pt], pf, acc[pt], 0, 0, 0);
        }
#pragma unroll
        for (int pt = 0; pt < 4; ++pt) {
            const u32x2v xr = *(const LAS u32x2v*)(L + SSD_OFF_X + lrow * SSD_RX + (pt * 16 + 4 * g) * 2);
            float4 o; o.x = acc[pt][0] + dskip * __uint_as_float(xr.x << 16); o.y = acc[pt][1] + dskip * __uint_as_float(xr.x & 0xffff0000u);
            o.z = acc[pt][2] + dskip * __uint_as_float(xr.y << 16); o.w = acc[pt][3] + dskip * __uint_as_float(xr.y & 0xffff0000u);
            *(float4*)(YD + (t0 + lrow) * 512 + h * 64 + pt * 16 + 4 * g) = o;
        }
    }
    {
        f32x4 acc[4];
#pragma unroll
        for (int pt = 0; pt < 4; ++pt) acc[pt] = (f32x4){0.f, 0.f, 0.f, 0.f};
#pragma unroll
        for (int ks = 0; ks < 4; ++ks) {
            const bf16x8 bt = tr_frag1<SSD_RB>(Lb + SSD_OFF_B + ks * 32 * SSD_RB + wave * 32, lane);
            bf16x8 xf[4]; tr_frags4<SSD_RX>(Lb + SSD_OFF_XW + ks * 32 * SSD_RX, lane, xf);
#pragma unroll
            for (int pt = 0; pt < 4; ++pt) acc[pt] = __builtin_amdgcn_mfma_f32_16x16x32_bf16(bt, xf[pt], acc[pt], 0, 0, 0);
        }
        float* so = SS + ((((size_t)b * 32 + c) * 8 + h) << 13);
#pragma unroll
        for (int pt = 0; pt < 4; ++pt) *(float4*)(so + (pt * 16 + li) * 128 + wave * 16 + 4 * g) = make_float4(acc[pt][0], acc[pt][1], acc[pt][2], acc[pt][3]);
    }
}
__device__ __forceinline__ void ssd_out_unit(const u16* __restrict__ PZ0, const u16* __restrict__ PZ1, const u16* __restrict__ PREV, const u16* __restrict__ CG, const float* __restrict__ YD,
                                             const float* __restrict__ ACS, const float* __restrict__ ng, int b, int j, int h, int lane, LAS float* red, u16* __restrict__ MIXED) {
    const int li = lane & 15, g = lane >> 4, grp = h >> 2, c = j >> 2; const size_t t0 = (size_t)b * SEQ + (size_t)j * 32;
    const u16* pv = PREV + ((((size_t)b * 32 + c) * 8 + h) << 13);
    f32x4 acc[4][2];
#pragma unroll
    for (int pt = 0; pt < 4; ++pt) { acc[pt][0] = (f32x4){0.f, 0.f, 0.f, 0.f}; acc[pt][1] = (f32x4){0.f, 0.f, 0.f, 0.f}; }
#pragma unroll
    for (int ks = 0; ks < 4; ++ks) {
        bf16x8 cf[2];
#pragma unroll
        for (int lt = 0; lt < 2; ++lt) cf[lt] = *(const bf16x8*)(CG + (t0 + lt * 16 + li) * 256 + grp * 128 + ks * 32 + g * 8);
#pragma unroll
        for (int pt = 0; pt < 4; ++pt) { const bf16x8 pf = *(const bf16x8*)(pv + (pt * 16 + li) * 128 + ks * 32 + g * 8);
            acc[pt][0] = __builtin_amdgcn_mfma_f32_16x16x32_bf16(pf, cf[0], acc[pt][0], 0, 0, 0);
            acc[pt][1] = __builtin_amdgcn_mfma_f32_16x16x32_bf16(pf, cf[1], acc[pt][1], 0, 0, 0); }
    }
    float ssq[2];
#pragma unroll
    for (int lt = 0; lt < 2; ++lt) {
        const size_t t = t0 + lt * 16 + li; const float ea = __expf(ACS[t * 8 + h]); float s = 0.f;
#pragma unroll
        for (int pt = 0; pt < 4; ++pt) {
            const int col = h * 64 + pt * 16 + 4 * g;
            const float4 yd = *(const float4*)(YD + t * 512 + col); const uint2 za = *(const uint2*)(PZ0 + t * 1024 + col), zb = *(const uint2*)(PZ1 + t * 1024 + col);
            const float z0 = __uint_as_float(za.x << 16) + __uint_as_float(zb.x << 16), z1 = __uint_as_float(za.x & 0xffff0000u) + __uint_as_float(zb.x & 0xffff0000u);
            const float z2 = __uint_as_float(za.y << 16) + __uint_as_float(zb.y << 16), z3 = __uint_as_float(za.y & 0xffff0000u) + __uint_as_float(zb.y & 0xffff0000u);
            f32x4 y; y[0] = (yd.x + ea * acc[pt][lt][0]) * siluf(z0); y[1] = (yd.y + ea * acc[pt][lt][1]) * siluf(z1);
            y[2] = (yd.z + ea * acc[pt][lt][2]) * siluf(z2); y[3] = (yd.w + ea * acc[pt][lt][3]) * siluf(z3);
            acc[pt][lt] = y; s += (y[0] * y[0] + y[1] * y[1]) + (y[2] * y[2] + y[3] * y[3]);
        }
        s += bperm(lane ^ 16, s); s += bperm(lane ^ 32, s); ssq[lt] = s;
        if (g == 0) red[h * 64 + lt * 16 + li] = s;
    }
    __syncthreads();
#pragma unroll
    for (int lt = 0; lt < 2; ++lt) {
        float tot = 0.f;
#pragma unroll
        for (int hh = 0; hh < 8; ++hh) tot += red[hh * 64 + lt * 16 + li];
        const float sc = rsqrtf(tot / 512.f + EPS);
        f32x4 o[4];
#pragma unroll
        for (int pt = 0; pt < 4; ++pt) o[pt] = acc[pt][lt];
        store_out_tile(o, sc, ng + h * 64, MIXED + (t0 + lt * 16 + li) * D + h * 64, g);
    }
}


#ifndef MOE_TR
#define MOE_TR 512
#endif
constexpr int MOE_WBUF = 16384, MOE_LDS_TAB = 155648;
__device__ __forceinline__ void glds16(const void* gsrc, unsigned lds_dst) {
    unsigned keep;
    asm volatile("s_mov_b32 %0, m0\n\ts_mov_b32 m0, %2\n\ts_nop 0\n\tglobal_load_lds_dwordx4 %1, off\n\ts_mov_b32 m0, %0" : "=&s"(keep) : "v"(gsrc), "s"(lds_dst) : "memory");
}
__device__ __forceinline__ void glds16_nt(const void* gsrc, unsigned lds_dst) {
    unsigned keep;
    asm volatile("s_mov_b32 %0, m0\n\ts_mov_b32 m0, %2\n\ts_nop 0\n\tglobal_load_lds_dwordx4 %1, off nt\n\ts_mov_b32 m0, %0" : "=&s"(keep) : "v"(gsrc), "s"(lds_dst) : "memory");
}
template <int N> __device__ __forceinline__ void vm_wait() { asm volatile("s_waitcnt vmcnt(%0)" :: "i"(N) : "memory"); }
template <bool GATEUP, int NK, int NAP>
__device__ __forceinline__ void moe_unit(const u16* __restrict__ Abase, int lda, const float* __restrict__ W0, const float* __restrict__ W1, int ldw, int wcol0, int valid,
                                         int orow0, int ocol0, u16* __restrict__ Hout, u16* __restrict__ Yout, LAS char* L, int tid) {
    constexpr int LAA = NAP == 4 ? 1 : 2, ASLOTS = LAA + 1, ASZ = NAP * 8192, WSLOTS = NAP == 2 ? 6 : 5, LAW = WSLOTS - 1, AOFF = WSLOTS * MOE_WBUF, MT = NAP * 4;
    constexpr int WAITN = 2 + (LAA - 1) * (NAP + 2);
    static_assert(NK > LAW + 1 && AOFF + ASLOTS * ASZ <= MOE_LDS_TAB && LAW >= LAA + 1, "ring geometry");
    const int wid = __builtin_amdgcn_readfirstlane(tid >> 6), lane = tid & 63, wr = wid >> 2, wc = wid & 3, li = lane & 15, g = lane >> 4;
    const LAS int* rowtab = (const LAS int*)(L + MOE_LDS_TAB);
    const unsigned Lb = (unsigned)(size_t)L;
    const u16* ap[NAP];
#pragma unroll
    for (int j = 0; j < NAP; ++j) ap[j] = Abase + (size_t)rowtab[(wid * NAP + j) * 16 + (lane >> 2)] * lda + ((lane & 3) ^ ((lane >> 4) & 3)) * 8;
    const unsigned adst = Lb + AOFF + (unsigned)(wid * NAP) * 1024u;
    const int cpc = lane & 31;
    const float* wp = (GATEUP ? ((cpc < 16 ? W0 : W1) + wcol0 + 4 * (cpc & 15)) : (W0 + wcol0 + 4 * cpc)) + (size_t)(4 * wid + (lane >> 5)) * ldw;
    const unsigned wdst = Lb + (unsigned)(wid * 2) * 1024u;
    const unsigned bfr0 = (unsigned)((8 * g) * 512 + (GATEUP ? 16 * wc + li : 32 * wc + li) * 4);
    constexpr unsigned BN1 = GATEUP ? 64 * 4 : 16 * 4;
    const unsigned afr0 = (unsigned)(AOFF + (wr * 16 + li) * 64 + ((g ^ ((li >> 2) & 3)) * 16));
    const int mrows = valid - wr * 16;
    f32x4 acc[MT][2];
#pragma unroll
    for (int m = 0; m < MT; ++m) { acc[m][0] = (f32x4){0.f, 0.f, 0.f, 0.f}; acc[m][1] = (f32x4){0.f, 0.f, 0.f, 0.f}; }
#define MOE_DMAA(slot, kt) do { _Pragma("unroll") for (int j = 0; j < NAP; ++j) glds16(ap[j] + (kt) * 32, adst + (unsigned)(slot) * ASZ + j * 1024u); } while (0)
#define MOE_DMAW(slot, kt) do { _Pragma("unroll") for (int j = 0; j < 2; ++j) glds16_nt(wp + (size_t)((kt) * 32 + 2 * j) * ldw, wdst + (unsigned)(slot) * MOE_WBUF + j * 1024u); } while (0)
#define MOE_BFRAG(dst, wslot, n) do { float c_[8]; _Pragma("unroll") for (int i = 0; i < 8; ++i) c_[i] = *(const LAS float*)(L + (wslot) * MOE_WBUF + bfr0 + (n) * BN1 + i * 512); \
        u32x4v o_; o_.x = pg8::cvt_pk_bf16(c_[0], c_[1]); o_.y = pg8::cvt_pk_bf16(c_[2], c_[3]); o_.z = pg8::cvt_pk_bf16(c_[4], c_[5]); o_.w = pg8::cvt_pk_bf16(c_[6], c_[7]); \
        dst = __builtin_bit_cast(bf16x8, o_); } while (0)
#define MOE_COMPUTE(aslot, wslot) do { bf16x8 b0, b1; MOE_BFRAG(b0, wslot, 0); MOE_BFRAG(b1, wslot, 1); \
        _Pragma("unroll") for (int mh = 0; mh < MT / 4; ++mh) { if (mh * 128 < mrows) { bf16x8 af[4]; \
            _Pragma("unroll") for (int m = 0; m < 4; ++m) af[m] = *(const LAS bf16x8*)(L + (aslot) * ASZ + afr0 + (mh * 4 + m) * 2048); \
            _Pragma("unroll") for (int m = 0; m < 4; ++m) { \
                acc[mh * 4 + m][0] = __builtin_amdgcn_mfma_f32_16x16x32_bf16(b0, af[m], acc[mh * 4 + m][0], 0, 0, 0); \
                acc[mh * 4 + m][1] = __builtin_amdgcn_mfma_f32_16x16x32_bf16(b1, af[m], acc[mh * 4 + m][1], 0, 0, 0); } } } } while (0)
    MOE_DMAA(0, 0); MOE_DMAW(0, 0);
    if (LAA == 2) { MOE_DMAA(1, 1); }
#pragma unroll
    for (int k = 1; k < LAW; ++k) MOE_DMAW(k, k);
    vm_wait<(LAA == 2 ? NAP : 0) + 2 * (LAW - 1)>();
    __builtin_amdgcn_s_barrier(); asm volatile("" ::: "memory");
    int as_cur = 0, as_iss = LAA % ASLOTS, ws_cur = 0, ws_iss = LAW;
#pragma unroll 1
    for (int kt = 0; kt < NK; ++kt) {
        const int ka = kt + LAA < NK ? kt + LAA : NK - 1, kw = kt + LAW < NK ? kt + LAW : NK - 1;
        MOE_DMAA(as_iss, ka); MOE_DMAW(ws_iss, kw);
        MOE_COMPUTE(as_cur, ws_cur);
        vm_wait<WAITN>(); asm volatile("s_waitcnt lgkmcnt(0)" ::: "memory"); __builtin_amdgcn_s_barrier(); asm volatile("" ::: "memory");
        as_cur = as_cur == ASLOTS - 1 ? 0 : as_cur + 1; as_iss = as_iss == ASLOTS - 1 ? 0 : as_iss + 1;
        ws_cur = ws_cur == WSLOTS - 1 ? 0 : ws_cur + 1; ws_iss = ws_iss == WSLOTS - 1 ? 0 : ws_iss + 1;
    }
    vm_wait<0>();
#undef MOE_DMAA
#undef MOE_DMAW
#undef MOE_BFRAG
#undef MOE_COMPUTE
#pragma unroll
    for (int m = 0; m < MT; ++m) { const int rl = (2 * m + wr) * 16 + li; const size_t row = (size_t)orow0 + rl;
        if (rl < valid) {
            if (GATEUP) { float h[4];
#pragma unroll
                for (int r = 0; r < 4; ++r) { const float gt = acc[m][0][r], up = acc[m][1][r]; h[r] = gt / (1.f + __expf(-gt)) * up; }
                *(uint2*)(Hout + row * DFF + ocol0 + wc * 16 + 4 * g) = make_uint2(pg8::cvt_pk_bf16(h[0], h[1]), pg8::cvt_pk_bf16(h[2], h[3]));
            } else {
#pragma unroll
                for (int n = 0; n < 2; ++n) *(uint2*)(Yout + row * D + ocol0 + wc * 32 + n * 16 + 4 * g) = make_uint2(pg8::cvt_pk_bf16(acc[m][n][0], acc[m][n][1]), pg8::cvt_pk_bf16(acc[m][n][2], acc[m][n][3]));
            }
        }
    }
    __syncthreads();
}
__device__ __forceinline__ int moe_tables(const int* __restrict__ cnt, LAS int* tab, int tid) {
    __syncthreads();
    if (tid < NE) tab[258 + tid] = cnt[tid];
    __syncthreads();
    if (tid == 0) { int off = 0, nb = 0;
        for (int e = 0; e < NE; ++e) { tab[e] = off; const int c = tab[258 + e]; const int n = (c + MOE_TR - 1) / MOE_TR; for (int i = 0; i < n; ++i) tab[64 + nb + i] = (e << 8) | i; nb += n; off += c; }
        tab[64 + 192] = nb; }
    __syncthreads();
    return tab[64 + 192];
}

__device__ __forceinline__ void moe_order(const int* __restrict__ cnt, LAS int* tab, int nblk, int tid) {
    if (tid < nblk) { const int em = tab[64 + tid]; const int vi = min(tab[258 + (em >> 8)] - (em & 255) * MOE_TR, MOE_TR); int rank = 0;
        for (int j = 0; j < nblk; ++j) { const int ej = tab[64 + j]; const int vj = min(tab[258 + (ej >> 8)] - (ej & 255) * MOE_TR, MOE_TR); rank += (vj > vi) || (vj == vi && j < tid); }
        tab[322 + rank] = tid; }
    __syncthreads();
}
__device__ __forceinline__ int moe_dequeue(int* ctr, LAS int* tab, int tid) {
    __syncthreads();
    if (tid == 0) tab[257] = atomicAdd(ctr, 1);
    __syncthreads();
    return tab[257];
}

template <int NTL, bool COMBINE, bool COPYIN = false>
__device__ __forceinline__ float norm_proj_unit(float* __restrict__ X, const float* __restrict__ Xin, int t0, const LAS float* gain, const float* __restrict__ Wt, u16* __restrict__ HB,
                                                LAS float* part, LAS float* ssp, int wave, int lane,
                                                const LAS int* mtab, const int* __restrict__ tok_e, const int* __restrict__ tok_pos, const float* __restrict__ tok_g, const u16* __restrict__ Yb) {
    asm volatile("" : "+v"(lane));
    const int li = lane & 15, g4 = lane >> 4, t = t0 + li; const int kb = 256 * wave + 4 * g4;
    float* xp = X + (size_t)t * D + kb;
    float4 xv[16];
    if (COPYIN) { const float* xi = Xin + (size_t)t * D + kb;
#pragma unroll
        for (int j = 0; j < 16; ++j) { xv[j] = *(const float4*)(xi + 16 * j); *(float4*)(xp + 16 * j) = xv[j]; }
    } else {
#pragma unroll
        for (int j = 0; j < 16; ++j) xv[j] = *(const float4*)(xp + 16 * j);
    }
    if (COMBINE) {
        const u16* y0 = Yb + (size_t)(mtab[tok_e[2 * t]] + tok_pos[2 * t]) * D + kb; const u16* y1 = Yb + (size_t)(mtab[tok_e[2 * t + 1]] + tok_pos[2 * t + 1]) * D + kb;
        const float g0 = tok_g[2 * t], g1 = tok_g[2 * t + 1];
#pragma unroll
        for (int j = 0; j < 16; ++j) { const uint2 ua = *(const uint2*)(y0 + 16 * j), ub = *(const uint2*)(y1 + 16 * j);
            const float4 a = make_float4(__uint_as_float(ua.x << 16), __uint_as_float(ua.x & 0xffff0000u), __uint_as_float(ua.y << 16), __uint_as_float(ua.y & 0xffff0000u));
            const float4 b = make_float4(__uint_as_float(ub.x << 16), __uint_as_float(ub.x & 0xffff0000u), __uint_as_float(ub.y << 16), __uint_as_float(ub.y & 0xffff0000u));
            xv[j].x += g0 * a.x + g1 * b.x; xv[j].y += g0 * a.y + g1 * b.y; xv[j].z += g0 * a.z + g1 * b.z; xv[j].w += g0 * a.w + g1 * b.w;
            *(float4*)(xp + 16 * j) = xv[j]; }
    }
    float ss = 0.f;
#pragma unroll
    for (int j = 0; j < 16; ++j) ss += (xv[j].x * xv[j].x + xv[j].y * xv[j].y) + (xv[j].z * xv[j].z + xv[j].w * xv[j].w);
    ss += bperm(lane ^ 16, ss); ss += bperm(lane ^ 32, ss);
    if (g4 == 0) ssp[wave * 16 + li] = ss;
    f32x4 acc[NTL];
#pragma unroll
    for (int nt = 0; nt < NTL; ++nt) acc[nt] = (f32x4){0.f, 0.f, 0.f, 0.f};
    const float* rb = Wt + (size_t)wave * (16 * NTL * 256) + lane * 4;
#pragma unroll
    for (int j = 0; j < 16; ++j) {
#pragma unroll
        for (int n0 = 0; n0 < NTL; n0 += 3) {
            constexpr int dummy_ = 0; (void)dummy_;
            float4 rv[3];
#pragma unroll
            for (int q = 0; q < 3; ++q) if (n0 + q < NTL) rv[q] = *(const float4*)(rb + (j * NTL + n0 + q) * 256);
#pragma unroll
            for (int q = 0; q < 3; ++q) if (n0 + q < NTL) acc[n0 + q] = __builtin_amdgcn_mfma_f32_16x16x4f32(xv[j].x, rv[q].x, acc[n0 + q], 0, 0, 0);
#pragma unroll
            for (int q = 0; q < 3; ++q) if (n0 + q < NTL) acc[n0 + q] = __builtin_amdgcn_mfma_f32_16x16x4f32(xv[j].y, rv[q].y, acc[n0 + q], 0, 0, 0);
#pragma unroll
            for (int q = 0; q < 3; ++q) if (n0 + q < NTL) acc[n0 + q] = __builtin_amdgcn_mfma_f32_16x16x4f32(xv[j].z, rv[q].z, acc[n0 + q], 0, 0, 0);
#pragma unroll
            for (int q = 0; q < 3; ++q) if (n0 + q < NTL) acc[n0 + q] = __builtin_amdgcn_mfma_f32_16x16x4f32(xv[j].w, rv[q].w, acc[n0 + q], 0, 0, 0);
        }
    }
#pragma unroll
    for (int nt = 0; nt < NTL; ++nt)
#pragma unroll
        for (int r = 0; r < 4; ++r) part[(wave * 16 + 4 * g4 + r) * (NTL * 16) + nt * 16 + li] = acc[nt][r];
    __syncthreads();
    float tot = 0.f;
#pragma unroll
    for (int w = 0; w < 8; ++w) tot += ssp[w * 16 + li];
    const float rs = rsqrtf(tot / D + EPS);
    u16* hp = HB + (size_t)t * D + kb; const LAS float* gq = gain + kb;
#pragma unroll
    for (int j = 0; j < 16; ++j) { const f32x4 g4v = *(const LAS f32x4*)(gq + 16 * j); const float4 gg = make_float4(g4v[0], g4v[1], g4v[2], g4v[3]);
        *(uint2*)(hp + 16 * j) = make_uint2(pk2(xv[j].x * rs * gg.x, xv[j].y * rs * gg.y), pk2(xv[j].z * rs * gg.z, xv[j].w * rs * gg.w)); }
    return rs;
}

typedef const Params __attribute__((address_space(4)))* KP;
#define PARAMS KP kp_ = (KP)__builtin_amdgcn_kernarg_segment_ptr(); asm volatile("" : "+s"(kp_)); const __attribute__((address_space(4))) Params& p = *kp_;
__global__ void __launch_bounds__(NTHR, 2) mega(Params pk_unused) {
    extern __shared__ __attribute__((aligned(16))) char smem[];
    if (threadIdx.x == 0) *(uint4*)smem = make_uint4(0u, 0u, 0u, 0u);
    __syncthreads();
    XcdBarrier bar; { PARAMS bar = xcd_barrier_post(p.bar, (volatile LAS unsigned*)smem); }
    char* lds = smem + 16;
    LAS unsigned char* glds = (LAS unsigned char*)(smem + 16);
    const int G = gridDim.x, NGW = G * NWAVE;
    const long gsize = (long)G * NTHR;
#define IDS PARAMS int tid = threadIdx.x; asm volatile("" : "+v"(tid)); const int wave = tid >> 6, lane = tid & 63; const int gw = blockIdx.x * NWAVE + wave; const long gtid = (long)blockIdx.x * NTHR + tid; (void)wave; (void)lane; (void)gw; (void)gtid;

    { IDS
        float* scr = (float*)lds + wave * (64 * 33);
        constexpr int I_A = 32 * 48, I_B = 32 * 112, I_O = 32 * 64, I_L = I_A + I_B + I_O;
        for (int it = gw; it < 2 * I_L; it += NGW) {
            const int l = it / I_L; int r = it % I_L;
            const float* Wl = p.w_in + (size_t)l * D * DIN; u16* WTl = p.WinT + (size_t)l * DP * D;
            if (r < 512)  { transpose_item(Wl, DIN, 0, D, WTl, 4096, 16, r, scr, lane); continue; } r -= 512;
            if (r < 1024) { transpose_item(Wl, DIN, 512, D, WTl, 0, 32, r, scr, lane); continue; } r -= 1024;
            if (r < 3072) { transpose_item(Wl, DIN, 1544, D, WTl, 1024, 96, r, scr, lane); continue; } r -= 3072;
            if (r < 512)  { transpose_item(Wl, DIN, 4616, D, WTl, 4608, 16, r, scr, lane); continue; } r -= 512;
            transpose_item(p.w_out + (size_t)l * D * D, D, 0, D, p.WoutT + (size_t)l * D * D, 0, 64, r, scr, lane);
        }
        for (long i = gtid; i < 2L * 80 * D; i += gsize) {
            const int l = (int)(i / (80 * D)); int r = (int)(i % (80 * D)); const int e = r & 3; r >>= 2; const int ln = r & 63; r >>= 6; const int nt = r % 5; r /= 5; const int j = r & 15, w = r >> 4;
            const int c = 16 * nt + (ln & 15), k = 256 * w + 16 * j + 4 * (ln >> 4) + e;
            const float wv = (c < 8) ? p.rg_w[(size_t)l * D * 8 + k * 8 + c] : (c < 72) ? p.re_w[(size_t)l * D * 64 + k * 64 + (c - 8)] : 0.f;
            p.RT[i] = wv * p.norm2_g[l * D + k]; }
        for (long i = gtid; i < 2L * 4 * 128 * 128; i += gsize) { const int e = (int)(i & 127), c = (int)((i >> 7) & 127); const long lg = i >> 14;
            p.WpT[(lg << 14) + e * 128 + c] = f2bf(p.pool_w[i]); }
        for (long i = gtid; i < 2L * 16 * D; i += gsize) {
            const int l = (int)(i / (16 * D)); int r = (int)(i % (16 * D)); const int e = r & 3; r >>= 2; const int ln = r & 63; r >>= 6; const int j = r & 15, w = r >> 4;
            const int c = ln & 15, k = 256 * w + 16 * j + 4 * (ln >> 4) + e;
            p.WDT[i] = c < 8 ? p.w_in[(size_t)l * D * DIN + (size_t)k * DIN + 1536 + c] * p.norm1_g[l * D + k] : 0.f; }
    }
    xcd_barrier(bar);

#pragma unroll 1
    for (int l = 0; l < 2; ++l) {
        { IDS
            LAS float* part = (LAS float*)(smem + 16); LAS float* ssp = part + 8 * 16 * 16; LAS int* mtab = (LAS int*)(ssp + 128);
            if (l > 0) moe_tables(p.ctrl + (l - 1) * 64, mtab, tid);
            const float* wdt = p.WDT + (size_t)l * 16 * D;
            LAS float* g1 = (LAS float*)(mtab + 336);
            for (int i = tid; i < D; i += NTHR) g1[i] = p.norm1_g[l * D + i];
            for (int u = blockIdx.x; u < T / 16; u += G) {
                __syncthreads();
                float rs;
                if (l > 0) rs = norm_proj_unit<1, true>(p.X, nullptr, u * 16, g1, wdt, p.HB, part, ssp, wave, lane, mtab, p.tok_e, p.tok_pos, p.tok_g, p.Yb);
                else       rs = norm_proj_unit<1, false, true>(p.X, p.x_in, u * 16, g1, wdt, p.HB, part, ssp, wave, lane, mtab, p.tok_e, p.tok_pos, p.tok_g, p.Yb);
                (void)rs;
                if (tid < 128) { const int tk = tid >> 3, q = tid & 7; float s = 0.f, tot = 0.f;
#pragma unroll
                    for (int w = 0; w < 8; ++w) { s += part[(w * 16 + tk) * 16 + q]; tot += ssp[w * 16 + tk]; }
                    p.DTR[(size_t)(u * 16 + tk) * 8 + q] = s * rsqrtf(tot / D + EPS); }
            }
        }
        xcd_barrier(bar);
        {
            PARAMS
            const u16* wt = p.WinT + (size_t)l * DP * D;
            { pg8::Gemm g{p.HB, wt, T, 4096, D, D};
              pg8::StaticOrder so; so.init(T, 4096, G, blockIdx.x);
              pg8::EpiStoreBf16 ep{p.PROJ, DP};
              pg8::gemm_phase(glds, g, so, ep, nullptr); }
            { const int kh = blockIdx.x & 1;
              pg8::Gemm g{p.HB + kh * 1024, wt + (size_t)4096 * D + kh * 1024, T, 1024, 1024, D};
              pg8::HalfOrder ho{(int)blockIdx.x, G};
              pg8::EpiStoreBf16 ep{kh ? p.PZ1 : p.PZ0, 1024};
              pg8::gemm_phase(glds, g, ho, ep, nullptr); }
        }
        xcd_barrier(bar);
        { IDS
            for (int it0 = gw; it0 < T * 2; it0 += 2 * NGW) {
                u16* base[2]; bf16x8 a[2], b[2];
#pragma unroll
                for (int q = 0; q < 2; ++q) { const int it = it0 + q * NGW < T * 2 ? it0 + q * NGW : it0; const int t = it >> 1, mix = it & 1;
                    base[q] = p.PROJ + (size_t)t * DP + (mix ? C_DIL : C_SB) + lane * 16;
                    a[q] = *(const bf16x8*)base[q]; b[q] = *(const bf16x8*)(base[q] + 8); }
#pragma unroll
                for (int q = 0; q < 2; ++q) { const int it = it0 + q * NGW; if (it < T * 2) { const int mix = it & 1;
                    const float* gp = (mix ? (lane < 32 ? p.dq_g : p.dk_g) : (lane < 32 ? p.sbq_g : p.sbk_g)) + l * 64 + (lane & 3) * 16;
                    float v[16]; float ss = 0.f;
#pragma unroll
                    for (int j = 0; j < 8; ++j) { v[j] = bf2f((u16)a[q][j]); v[8 + j] = bf2f((u16)b[q][j]); }
#pragma unroll
                    for (int j = 0; j < 16; ++j) ss += v[j] * v[j];
                    ss += swz_xor<1>(ss); ss += swz_xor<2>(ss);
                    const float r = rsqrtf(ss / 64.f + EPS) * (lane < 32 ? 0.125f : 1.f);
                    u32x4v o0, o1;
                    { const float4 g0 = *(const float4*)gp, g1 = *(const float4*)(gp + 4), g2 = *(const float4*)(gp + 8), g3 = *(const float4*)(gp + 12);
                      o0.x = pk2(v[0] * r * g0.x, v[1] * r * g0.y); o0.y = pk2(v[2] * r * g0.z, v[3] * r * g0.w); o0.z = pk2(v[4] * r * g1.x, v[5] * r * g1.y); o0.w = pk2(v[6] * r * g1.z, v[7] * r * g1.w);
                      o1.x = pk2(v[8] * r * g2.x, v[9] * r * g2.y); o1.y = pk2(v[10] * r * g2.z, v[11] * r * g2.w); o1.z = pk2(v[12] * r * g3.x, v[13] * r * g3.y); o1.w = pk2(v[14] * r * g3.z, v[15] * r * g3.w); }
                    *(u32x4v*)base[q] = o0; *(u32x4v*)(base[q] + 8) = o1; } }
            }
            for (int u = blockIdx.x; u < NB * 32 * 8; u += G) {
                const int b = u >> 8, c = (u >> 3) & 31, h = u & 7;
                ssd_chunk_unit(p.PROJ, p.DTR, p.conv_w + l * 4 * 1024, p.conv_b + l * 1024, p.dt_bias[l * 8 + h], -__expf(p.a_log[l * 8 + h]), p.ssd_d[l * 8 + h],
                               b, c, h, tid, (LAS char*)(smem + 16), p.YD, p.SS, p.ATOT, p.ACS, p.CG);
            }
            __syncthreads();
            {
                constexpr int PRS = 1040;
                LAS char* PL = (LAS char*)(smem + 16);
                const float* psc = p.pool_sc + l * 512; const u16* wpt = p.WpT + (size_t)l * 4 * 16384;
                for (int u = blockIdx.x; u < T / 32; u += G) {
                    const int tb0 = u * 32; __syncthreads();
                    { const int c = tid, gq = c >> 7, w = 2 << gq; const int s0 = tb0 % SEQ;
                      const u16* ca = p.PZ0 + (size_t)tb0 * 1024 + 512 + c; const u16* cb2 = p.PZ1 + (size_t)tb0 * 1024 + 512 + c;
                      float sum = 0.f; { const int c0 = min(w, s0 + 1); for (int i = 0; i < c0; ++i) sum += bf2f(ca[-(long)i * 1024]) + bf2f(cb2[-(long)i * 1024]); }
                      float ucur = bf2f(ca[0]) + bf2f(cb2[0]);
#pragma unroll 4
                      for (int tt = 0; tt < 32; ++tt) { const int s = s0 + tt; const int cn = min(w, s + 1);
                          *(LAS u16*)(PL + tt * PRS + c * 2) = f2bf(sum / (float)cn - ucur);
                          if (tt < 31) { ucur = bf2f(ca[(long)(tt + 1) * 1024]) + bf2f(cb2[(long)(tt + 1) * 1024]); sum += ucur; if (s + 1 >= w) sum -= bf2f(ca[(long)(tt + 1 - w) * 1024]) + bf2f(cb2[(long)(tt + 1 - w) * 1024]); } } }
                    __syncthreads();
                    const int li = lane & 15, g4 = lane >> 4, gq = wave >> 1, eh = wave & 1;
                    f32x4 acc[4][2];
#pragma unroll
                    for (int et = 0; et < 4; ++et) { acc[et][0] = (f32x4){0.f, 0.f, 0.f, 0.f}; acc[et][1] = (f32x4){0.f, 0.f, 0.f, 0.f}; }
#pragma unroll
                    for (int ks = 0; ks < 4; ++ks) {
                        bf16x8 pf[2];
#pragma unroll
                        for (int tt = 0; tt < 2; ++tt) pf[tt] = *(const LAS bf16x8*)(PL + (tt * 16 + li) * PRS + (gq * 128 + ks * 32 + g4 * 8) * 2);
#pragma unroll
                        for (int et = 0; et < 4; ++et) { const bf16x8 wf = *(const bf16x8*)(wpt + gq * 16384 + (eh * 64 + et * 16 + li) * 128 + ks * 32 + g4 * 8);
                            acc[et][0] = __builtin_amdgcn_mfma_f32_16x16x32_bf16(wf, pf[0], acc[et][0], 0, 0, 0);
                            acc[et][1] = __builtin_amdgcn_mfma_f32_16x16x32_bf16(wf, pf[1], acc[et][1], 0, 0, 0); }
                    }
#pragma unroll
                    for (int tt = 0; tt < 2; ++tt)
#pragma unroll
                        for (int et = 0; et < 4; ++et) { const int col = gq * 128 + eh * 64 + et * 16 + 4 * g4; const float4 sc = *(const float4*)(psc + col);
                            *(uint2*)(p.MIXED + (size_t)(tb0 + tt * 16 + li) * D + 1536 + col) =
                                make_uint2(pk2(acc[et][tt][0] * sc.x, acc[et][tt][1] * sc.y), pk2(acc[et][tt][2] * sc.z, acc[et][tt][3] * sc.w)); }
                }
            }
        }
        xcd_barrier(bar);
        { IDS
        {
            for (int e = (int)gtid; e < NB * 8 * 8192; e += (int)gsize) {
                const int b = e >> 16, h = (e >> 13) & 7, pn = e & 8191; float st = 0.f;
#pragma unroll 8
                for (int c = 0; c < 32; ++c) { const size_t cu = ((size_t)b * 32 + c) * 8 + h; const size_t idx = (cu << 13) + pn;
                    p.PREV[idx] = f2bf(st); st = st * __expf(p.ATOT[cu]) + p.SS[idx]; }
            }
            LAS char* vl = (LAS char*)(smem + 16) + wave * ATT_VBYTES;
            LAS float* red = (LAS float*)((LAS char*)(smem + 16) + NWAVE * ATT_VBYTES);
            LAS int* qslot = (LAS int*)(red + 1024); int* qctr = p.ctrl + 520 + l;
            int par = 0;
            for (;; par ^= 1) {
                __syncthreads();
                if (tid == 0) *qslot = atomicAdd(qctr, 1);
                __syncthreads();
                const int u = *qslot; if (u >= 512 + 256) break;
                if (u >= 512) { const int v = u - 512; sb_unit(p.PROJ, v >> 7, v & 127, wave, lane, vl, red + par * 512, p.sbo_g + l * 512, p.MIXED); }
                else dil_unit(p.PROJ, u >> 8, (u >> 4) & 15, u & 15, wave, lane, vl, red + par * 512, p.do_g + l * 512, p.MIXED);
            }
        }
        }
        xcd_barrier(bar);
        { IDS
            LAS float* red = (LAS float*)(smem + 16);
            int par = 0;
            for (int u = blockIdx.x; u < NB * 128; u += G, par ^= 1)
                ssd_out_unit(p.PZ0, p.PZ1, p.PREV, p.CG, p.YD, p.ACS, p.ssd_ng + l * 512, u >> 7, u & 127, wave, lane, red + par * 512, p.MIXED);
        }
        xcd_barrier(bar);
        {
            PARAMS
            pg8::Gemm g{p.MIXED, p.WoutT + (size_t)l * D * D, T, D, D, D};
            pg8::StaticOrder so; so.init(T, D, G, blockIdx.x);
            pg8::EpiAddF32 ep{p.X, D};
            pg8::gemm_phase(glds, g, so, ep, nullptr);
        }
        xcd_barrier(bar);
        { IDS
            const float* RTl = p.RT + (size_t)l * 80 * D; int* cnt = p.ctrl + l * 64;
            LAS float* part = (LAS float*)(smem + 16);
            LAS float* ssp = part + 8 * 16 * 80;
            LAS float* lg = ssp + 128;
            LAS float* rbias = lg + 16 * 80;
            LAS float* g2 = rbias + 128;
            for (int i = tid; i < D; i += NTHR) g2[i] = p.norm2_g[l * D + i];
            if (tid < 72) rbias[tid] = tid < 8 ? p.rg_b[l * 8 + tid] : p.re_b[l * 64 + tid - 8];
            for (int u = blockIdx.x; u < T / 16; u += G) {
                const int t0 = u * 16;
                __syncthreads();
                norm_proj_unit<5, false>(p.X, nullptr, t0, g2, RTl, p.HB, part, ssp, wave, lane, nullptr, nullptr, nullptr, nullptr, nullptr);
                for (int i = tid; i < 16 * 72; i += NTHR) { const int tk = i / 72, c = i % 72; float s = 0.f, tot = 0.f;
#pragma unroll
                    for (int w = 0; w < 8; ++w) { s += part[(w * 16 + tk) * 80 + c]; tot += ssp[w * 16 + tk]; }
                    lg[tk * 80 + c] = s * rsqrtf(tot / D + EPS) + rbias[c]; }
                __syncthreads();
                if (tid < 16) {
                    const LAS float* gl = lg + tid * 80; const int t = t0 + tid;
                    int gi = 0; float gm = gl[0];
                    for (int j = 1; j < 8; ++j) if (gl[j] > gm) { gm = gl[j]; gi = j; }
                    float gs = 0.f;
                    for (int j = 0; j < 8; ++j) gs += __expf(gl[j] - gm);
                    const float gp = 1.f / gs;
                    const LAS float* el = gl + 8 + gi * 8;
                    int i1 = 0; float m1 = el[0];
                    for (int j = 1; j < 8; ++j) if (el[j] > m1) { m1 = el[j]; i1 = j; }
                    int i2 = -1; float m2 = -1e30f;
                    for (int j = 0; j < 8; ++j) if (j != i1 && el[j] > m2) { m2 = el[j]; i2 = j; }
                    const float p2 = __expf(m2 - m1); const float ga = gp / (1.f + p2), gb = gp * p2 / (1.f + p2);
                    const int e1 = gi * 8 + i1, e2 = gi * 8 + i2;
                    p.tok_e[t * 2] = e1; p.tok_e[t * 2 + 1] = e2; p.tok_g[t * 2] = ga; p.tok_g[t * 2 + 1] = gb;
                    const int q1 = atomicAdd(&cnt[e1], 1), q2 = atomicAdd(&cnt[e2], 1);
                    p.tok_pos[t * 2] = q1; p.tok_pos[t * 2 + 1] = q2; p.tlist[e1 * T + q1] = t; p.tlist[e2 * T + q2] = t;
                }
            }
        }
        xcd_barrier(bar);
        { IDS
            LAS char* L = (LAS char*)(smem + 16); LAS int* tab = (LAS int*)(L + MOE_LDS_TAB + 2048); LAS int* rowtab = (LAS int*)(L + MOE_LDS_TAB);
            const int* cnt = p.ctrl + l * 64;
            const int nblk = moe_tables(cnt, tab, tid);
            moe_order(cnt, tab, nblk, tid);
            int* qctr = p.ctrl + 512 + l * 2;
            for (;;) {
                const int ui = moe_dequeue(qctr, tab, tid); if (ui >= nblk * 8) break;
                const int mb = tab[322 + (ui >> 3)], nt = ui & 7; const int em = tab[64 + mb], e = em >> 8, mt = em & 255; const int valid = min(cnt[e] - mt * MOE_TR, MOE_TR);
                __syncthreads();
                { const int* tl = p.tlist + e * T + mt * MOE_TR; rowtab[tid] = tl[tid < valid ? tid : 0]; }
                __syncthreads();
                const size_t wo = ((size_t)l * NE + e) * (size_t)D * DFF;
                if (valid <= 256)      moe_unit<true, D / 32, 2>(p.HB, D, p.wg + wo, p.wu + wo, DFF, nt * 64, valid, tab[e] + mt * MOE_TR, nt * 64, p.Hb, nullptr, L, tid);
                else if (valid <= 384) moe_unit<true, D / 32, 3>(p.HB, D, p.wg + wo, p.wu + wo, DFF, nt * 64, valid, tab[e] + mt * MOE_TR, nt * 64, p.Hb, nullptr, L, tid);
                else                   moe_unit<true, D / 32, 4>(p.HB, D, p.wg + wo, p.wu + wo, DFF, nt * 64, valid, tab[e] + mt * MOE_TR, nt * 64, p.Hb, nullptr, L, tid);
            }
        }
        xcd_barrier(bar);
        { IDS
            LAS char* L = (LAS char*)(smem + 16); LAS int* tab = (LAS int*)(L + MOE_LDS_TAB + 2048); LAS int* rowtab = (LAS int*)(L + MOE_LDS_TAB);
            const int* cnt = p.ctrl + l * 64;
            const int nblk = moe_tables(cnt, tab, tid);
            moe_order(cnt, tab, nblk, tid);
            int* qctr = p.ctrl + 512 + l * 2 + 1;
            for (;;) {
                const int ui = moe_dequeue(qctr, tab, tid); if (ui >= nblk * 16) break;
                const int mb = tab[322 + (ui >> 4)], nt = ui & 15; const int em = tab[64 + mb], e = em >> 8, mt = em & 255; const int valid = min(cnt[e] - mt * MOE_TR, MOE_TR); const int r0 = tab[e] + mt * MOE_TR;
                __syncthreads();
                rowtab[tid] = r0 + (tid < valid ? tid : 0);
                __syncthreads();
                { const float* wdp = p.wd + ((size_t)l * NE + e) * (size_t)D * DFF;
                  if (valid <= 256)      moe_unit<false, DFF / 32, 2>(p.Hb, DFF, wdp, nullptr, D, nt * 128, valid, r0, nt * 128, nullptr, p.Yb, L, tid);
                  else if (valid <= 384) moe_unit<false, DFF / 32, 3>(p.Hb, DFF, wdp, nullptr, D, nt * 128, valid, r0, nt * 128, nullptr, p.Yb, L, tid);
                  else                   moe_unit<false, DFF / 32, 4>(p.Hb, DFF, wdp, nullptr, D, nt * 128, valid, r0, nt * 128, nullptr, p.Yb, L, tid); }
            }
        }
        xcd_barrier(bar);
    }
    { IDS
    LAS int* mtab = (LAS int*)(smem + 16);
    moe_tables(p.ctrl + 64, mtab, tid);
    for (int t = gw; t < T; t += NGW) {
        float4* xr = (float4*)(p.X + (size_t)t * D) + lane;
        const int r0 = mtab[p.tok_e[2 * t]] + p.tok_pos[2 * t], r1 = mtab[p.tok_e[2 * t + 1]] + p.tok_pos[2 * t + 1]; const float g0 = p.tok_g[2 * t], g1 = p.tok_g[2 * t + 1];
        const uint2* y0 = (const uint2*)(p.Yb + (size_t)r0 * D) + lane; const uint2* y1 = (const uint2*)(p.Yb + (size_t)r1 * D) + lane;
#pragma unroll
        for (int j = 0; j < 8; ++j) { float4 v = xr[64 * j]; const uint2 ua = y0[64 * j], ub = y1[64 * j];
            const float4 a = make_float4(__uint_as_float(ua.x << 16), __uint_as_float(ua.x & 0xffff0000u), __uint_as_float(ua.y << 16), __uint_as_float(ua.y & 0xffff0000u));
            const float4 b = make_float4(__uint_as_float(ub.x << 16), __uint_as_float(ub.x & 0xffff0000u), __uint_as_float(ub.y << 16), __uint_as_float(ub.y & 0xffff0000u));
            v.x += g0 * a.x + g1 * b.x; v.y += g0 * a.y + g1 * b.y; v.z += g0 * a.z + g1 * b.z; v.w += g0 * a.w + g1 * b.w; xr[64 * j] = v; }
    }
    }
}

extern "C" void kernel_launch(void* const* d_in, const int* in_sizes, int n_in, void* d_out, int out_size, void* d_ws, size_t ws_size, hipStream_t stream) {
    Params p{};
    const float** pin = (const float**)&p;
    for (int i = 0; i < 26; ++i) pin[i] = (const float*)d_in[i];
    p.X = (float*)d_out;
    char* ws = (char*)d_ws; size_t off = 0;
    auto alloc = [&](size_t bytes) { void* q = ws + off; off += (bytes + 255) & ~(size_t)255; return q; };
    constexpr size_t CTL_BYTES = (size_t)XCD_BAR_WORDS * 4 + CTRL_INTS * 4;
    p.bar = (unsigned*)alloc(CTL_BYTES); p.ctrl = (int*)(p.bar + XCD_BAR_WORDS);
    p.HB = (u16*)alloc((size_t)T * D * 2);
    p.MIXED = (u16*)alloc((size_t)T * D * 2);
    p.PROJ = (u16*)alloc((size_t)T * DP * 2);
    p.PZ0 = (u16*)alloc((size_t)T * 1024 * 2); p.PZ1 = (u16*)alloc((size_t)T * 1024 * 2);
    p.DTR = (float*)alloc((size_t)T * 8 * 4);
    p.YD = (float*)alloc((size_t)T * 512 * 4);
    p.SS = (float*)alloc((size_t)NB * 32 * 8 * 8192 * 4);
    p.PREV = (u16*)alloc((size_t)NB * 32 * 8 * 8192 * 2);
    p.ATOT = (float*)alloc((size_t)NB * 32 * 8 * 4);
    p.ACS = (float*)alloc((size_t)T * 8 * 4);
    p.CG = (u16*)alloc((size_t)T * 256 * 2);
    p.WinT = (u16*)alloc((size_t)2 * DP * D * 2);
    p.WoutT = (u16*)alloc((size_t)2 * D * D * 2);
    p.RT = (float*)alloc((size_t)2 * 80 * D * 4);
    p.WpT = (u16*)alloc((size_t)2 * 4 * 128 * 128 * 2);
    p.WDT = (float*)alloc((size_t)2 * 16 * D * 4);
    p.tok_e = (int*)alloc((size_t)T * 2 * 4); p.tok_pos = (int*)alloc((size_t)T * 2 * 4); p.tlist = (int*)alloc((size_t)NE * T * 4);
    p.tok_g = (float*)alloc((size_t)T * 2 * 4);
    p.Hb = (u16*)alloc((size_t)2 * T * DFF * 2);
    p.Yb = (u16*)alloc((size_t)2 * T * D * 2);
    static int grid = 0;
    if (grid == 0) {
        if (off > ws_size || n_in != 26) { fprintf(stderr, "kernel_launch: workspace too small (%zu > %zu) or n_in %d\n", off, ws_size, n_in); grid = -1; return; }
        int dev = 0, cus = 0, per_cu = 0;
        if (hipGetDevice(&dev) != hipSuccess || hipDeviceGetAttribute(&cus, hipDeviceAttributeMultiprocessorCount, dev) != hipSuccess) { grid = -1; return; }
        if (hipFuncSetAttribute((const void*)mega, hipFuncAttributeMaxDynamicSharedMemorySize, LDS_BYTES) != hipSuccess) { fprintf(stderr, "hipFuncSetAttribute failed\n"); grid = -1; return; }
        if (hipOccupancyMaxActiveBlocksPerMultiprocessor(&per_cu, (const void*)mega, NTHR, LDS_BYTES) != hipSuccess || per_cu < 1)
            fprintf(stderr, "kernel_launch: occupancy query reports %d blocks per CU\n", per_cu);
        (void)hipGetLastError();
        grid = cus;
    }
    if (grid < 0) return;
    if (hipMemsetAsync(p.bar, 0, CTL_BYTES, stream) != hipSuccess) return;
    hipLaunchKernelGGL(mega, dim3(grid), dim3(NTHR), LDS_BYTES, stream, p);
}
```

```cpp
#include <hip/hip_runtime.h>
#include <hip/hip_bf16.h>
#include <stdint.h>
#include <stdio.h>

typedef unsigned short u16;
using bf16x8 = __attribute__((ext_vector_type(8))) short;
using f32x4  = __attribute__((ext_vector_type(4))) float;
#define LAS __attribute__((address_space(3)))

constexpr int NB = 2, SEQ = 4096, T = NB * SEQ, D = 2048, DIN = 5128, DP = 5120;
constexpr int NE = 64, DFF = 512;
constexpr float EPS = 1e-6f;
constexpr int C_XBC = 0, C_SB = 1024, C_DIL = 2560;
constexpr int NTHR = 512, NWAVE = 8;
constexpr int LDS_BYTES = 16 + 159744 + 64;

__device__ __forceinline__ float bf2f(u16 h) { return __uint_as_float(((unsigned)h) << 16); }
__device__ __forceinline__ u16 f2bf(float f) { unsigned u = __float_as_uint(f); u += 0x7fffu + ((u >> 16) & 1u); return (u16)(u >> 16); }
__device__ __forceinline__ unsigned pk2(float lo, float hi) { return (unsigned)f2bf(lo) | ((unsigned)f2bf(hi) << 16); }
template <int O> __device__ __forceinline__ float swz_xor(float v) { return __int_as_float(__builtin_amdgcn_ds_swizzle(__float_as_int(v), (O << 10) | 0x1F)); }
__device__ __forceinline__ float rdlane(float v, int l) { return __int_as_float(__builtin_amdgcn_readlane(__float_as_int(v), l)); }
__device__ __forceinline__ float wave_sum(float v) {
    v += swz_xor<1>(v); v += swz_xor<2>(v); v += swz_xor<4>(v); v += swz_xor<8>(v); v += swz_xor<16>(v);
    return rdlane(v, 0) + rdlane(v, 32);
}
__device__ __forceinline__ float siluf(float x) { return x / (1.f + __expf(-x)); }
__device__ __forceinline__ float softplusf(float x) { return fmaxf(x, 0.f) + log1pf(__expf(-fabsf(x))); }

#define XB_TMO      128
#define XB_XCNT(j)  (256  + 64 * (j))
#define XB_XSUB(j)  (1280 + 64 * (j))
#define XB_XGEN(j)  (2304 + 64 * (j))
#define XB_TOP      3328
#define XB_TOPGEN   3392
#define XCD_BAR_WORDS 3456
#define XB_SPIN_CAP (1u << 18)
__device__ __forceinline__ unsigned xb_ld(unsigned* p)              { return __hip_atomic_load(p, __ATOMIC_RELAXED, __HIP_MEMORY_SCOPE_AGENT); }
__device__ __forceinline__ unsigned xb_add(unsigned* p, unsigned v) { return __hip_atomic_fetch_add(p, v, __ATOMIC_RELAXED, __HIP_MEMORY_SCOPE_AGENT); }
__device__ __forceinline__ unsigned xb_xcc_id() { return (unsigned)__builtin_amdgcn_s_getreg((3 << 11) | 20) & 0xFu; }
#define XB_SPIN(cond, bar) do { unsigned _sp = 0; while (cond) { __builtin_amdgcn_s_sleep(1); \
    if ((++_sp & 255u) == 0u) { if (xb_ld(&(bar)[XB_TMO])) break; if (_sp > XB_SPIN_CAP) { atomicAdd(&(bar)[XB_TMO], 1u); break; } } } } while (0)
struct XcdBarrier { unsigned* bar; unsigned x; volatile LAS unsigned* st; };
__device__ __forceinline__ XcdBarrier xcd_barrier_post(unsigned* bar, volatile LAS unsigned* st) {
    XcdBarrier b; b.bar = bar; b.x = xb_xcc_id(); b.st = st;
    if (threadIdx.x == 0) (void)xb_add(&bar[XB_XCNT(b.x)], 1u);
    return b;
}
__device__ __forceinline__ void xcd_barrier_complete(unsigned* bar, unsigned x, unsigned& nloc, unsigned& nx) {
    const unsigned G = gridDim.x * gridDim.y * gridDim.z;
    unsigned sum, cnt, mine, sp = 0u;
    for (;;) {
        sum = 0u; cnt = 0u; mine = 0u;
#pragma unroll
        for (unsigned j = 0; j < 16; ++j) { const unsigned c = xb_ld(&bar[XB_XCNT(j)]); sum += c; cnt += (c > 0u) ? 1u : 0u; mine = (j == x) ? c : mine; }
        if (sum == G) break;
        __builtin_amdgcn_s_sleep(1);
        if ((++sp & 255u) == 0u) { if (xb_ld(&bar[XB_TMO])) break; if (sp > XB_SPIN_CAP) { atomicAdd(&bar[XB_TMO], 1u); break; } }
    }
    nloc = mine > 0u ? mine : 1u; nx = cnt > 0u ? cnt : 1u;
}
__device__ __forceinline__ void xcd_barrier(const XcdBarrier& b) {
    asm volatile("s_waitcnt vmcnt(0)" ::: "memory");
    __syncthreads();
    if (threadIdx.x == 0) {
        unsigned* bar = b.bar; unsigned bx = b.x;
        asm volatile("" : "+s"(bar), "+s"(bx));
        __builtin_amdgcn_s_waitcnt(0);
        unsigned nloc = b.st[0], nx = b.st[1];
        if (nloc == 0u) { xcd_barrier_complete(bar, bx, nloc, nx); b.st[0] = nloc; b.st[1] = nx; }
        const unsigned old = xb_add(&bar[XB_XSUB(bx)], 1u);
        const unsigned gen = old / nloc;
        if (old + 1u == (gen + 1u) * nloc) {
            __builtin_amdgcn_fence(__ATOMIC_RELEASE, "agent");
            asm volatile("s_waitcnt vmcnt(0)" ::: "memory");
            const unsigned og = xb_add(&bar[XB_TOP], 1u);
            const unsigned tg = og / nx;
            if (og + 1u == (tg + 1u) * nx) xb_add(&bar[XB_TOPGEN], 1u);
            else XB_SPIN(xb_ld(&bar[XB_TOPGEN]) == tg, bar);
            __builtin_amdgcn_fence(__ATOMIC_ACQUIRE, "agent");
            xb_add(&bar[XB_XGEN(bx)], 1u);
            asm volatile("s_waitcnt vmcnt(0)" ::: "memory");
        } else {
            XB_SPIN(xb_ld(&bar[XB_XGEN(bx)]) == gen, bar);
            __builtin_amdgcn_fence(__ATOMIC_ACQUIRE, "agent");
            asm volatile("s_waitcnt vmcnt(0)" ::: "memory");
        }
    }
    __syncthreads();
}

struct Params {
    const float *x_in, *norm1_g, *w_in, *conv_w, *conv_b, *dt_bias, *a_log, *ssd_d, *ssd_ng, *sbq_g, *sbk_g, *sbo_g, *dq_g, *dk_g, *do_g,
                *pool_w, *pool_sc, *w_out, *norm2_g, *rg_w, *rg_b, *re_w, *re_b, *wg, *wu, *wd;
    float* X; unsigned* bar; int* ctrl;
    u16 *HB, *MIXED, *WinT, *WoutT, *Hb;
    u16 *PROJ, *PREV, *CG, *WpT, *PZ0, *PZ1; float *DTR, *YD, *SS, *ATOT, *ACS, *RT, *WDT, *tok_g; u16* Yb;
    int *tok_e, *tok_pos, *tlist;
};
constexpr int CTRL_INTS = 1024;

namespace pg8 {
#define PG8_LAS __attribute__((address_space(3)))
typedef unsigned short bf16_t;
typedef short bf16x8 __attribute__((ext_vector_type(8)));
typedef float f32x4 __attribute__((ext_vector_type(4)));
typedef unsigned u32x4 __attribute__((ext_vector_type(4)));
constexpr int BM = 256, BK = 64, HALF = 128, HTB = HALF * BK * 2  , STAGE_BYTES = 8 * HTB, NXCD = 8, WGM = 8;

__host__ __device__ __forceinline__ int lds_byte(int r, int c) { const int st = (r >> 4) * 2 + (c >> 5), rr = r & 15, cc = c & 31, ob = rr * 64 + cc * 2; return st * 1024 + (ob ^ (((ob >> 9) & 1) << 5)); }
__host__ __device__ __forceinline__ void stage_rc(int b, int& R, int& C) { const int st = b / 1024, sb = b % 1024, swz = sb ^ (((sb >> 9) & 1) << 5); R = (st >> 1) * 16 + swz / 64; C = (st & 1) * 32 + (swz % 64) / 2; }
__host__ __device__ __forceinline__ int perm32(int rho) { const int n = rho >> 4, i = rho & 15; return 8 * (i >> 2) + 4 * n + (i & 3); }

struct Unit { int pm, pn; };
struct Gemm { const bf16_t* A; const bf16_t* Bt; int M, N, K, ld; };

struct StaticOrder {
    int nM, nN, nwg, G, c;
    __host__ __device__ void init(int M, int N, int G_, int c_) { nM = M / BM; nN = N / BM; nwg = nM * nN; G = G_; c = c_; }
    __host__ __device__ bool next(int i, Unit& u) const {
        const long L = (long)i * G + c; if (L >= nwg) return false;
        int wgid = (int)L; { const int q = nwg / NXCD, r = nwg % NXCD, xcd = wgid % NXCD, off = wgid / NXCD; wgid = (xcd < r ? xcd * (q + 1) : r * (q + 1) + (xcd - r) * q) + off; }
        const int nig = WGM * nN, gid = wgid / nig, fm = gid * WGM, gsz = (nM - fm) < WGM ? (nM - fm) : WGM;
        u.pm = fm + ((wgid % nig) % gsz); u.pn = (wgid % nig) / gsz; return true;
    }
    __device__ __forceinline__ void a_ready(const Unit&) const {}
    __device__ __forceinline__ void done(const Unit&) const {}
};
__device__ __forceinline__ unsigned cvt_pk_bf16(float lo, float hi) { unsigned r; asm volatile("v_cvt_pk_bf16_f32 %0, %1, %2" : "=v"(r) : "v"(lo), "v"(hi)); return r; }
typedef float f32x2 __attribute__((ext_vector_type(2)));
struct EpiF32 {
    static constexpr bool PERM = false, AFTER_DRAIN = false;
    float* C; int ldc; const float* bias;
    __device__ __forceinline__ void operator()(const f32x4 (&acc)[2][2][4][2], const Unit& u, int wr, int wc, int fr, int fq) const {
        const int row0 = u.pm * BM + wr * 64 + fr, col0 = u.pn * BM + wc * 32 + 4 * fq;
        f32x4 bv[2][2];
#pragma unroll
        for (int bj = 0; bj < 2; ++bj)
#pragma unroll
            for (int n = 0; n < 2; ++n) bv[bj][n] = bias ? *(const f32x4*)(bias + col0 + bj * HALF + n * 16) : (f32x4){0.f, 0.f, 0.f, 0.f};
#pragma unroll
        for (int ai = 0; ai < 2; ++ai)
#pragma unroll
            for (int m = 0; m < 4; ++m) { float* rowp = C + (size_t)(row0 + ai * HALF + m * 16) * ldc + col0;
#pragma unroll
                for (int bj = 0; bj < 2; ++bj)
#pragma unroll
                    for (int n = 0; n < 2; ++n) *(f32x4*)(rowp + bj * HALF + n * 16) = acc[ai][bj][m][n] + bv[bj][n]; }
    }
};
template <class Epi, class Sched, bool STAMP = false>
__device__ __forceinline__ void gemm_phase(PG8_LAS unsigned char* lds, const Gemm g, const Sched& S, const Epi& E, unsigned long long* stamps) {
    int tid = threadIdx.x; asm volatile("" : "+v"(tid));
    const int wid = __builtin_amdgcn_readfirstlane(tid >> 6), lane = tid & 63, wr = wid >> 2, wc = wid & 3, fr = lane & 15, fq = lane >> 4;
    const int K = g.K, nt = K / BK, LD = g.ld;
    int ts_lo = 0, ts_hi = 0, nts = 0; const unsigned long long rt_entry = STAMP ? (unsigned long long)wall_clock64() : 0ull;
#define PG8_STAMP() do { if (STAMP && wid == 0 && nts < 64) { const unsigned long long _c = (unsigned long long)clock64(); \
        ts_lo = (lane == nts) ? (int)(unsigned)_c : ts_lo; ts_hi = (lane == nts) ? (int)(unsigned)(_c >> 32) : ts_hi; ++nts; } } while (0)
    PG8_STAMP();
    unsigned voffA[2], voffB[2];
#pragma unroll
    for (int i = 0; i < 2; ++i) { int R, C; stage_rc(tid * 16 + i * 8192, R, C); const int Rb = Epi::PERM ? ((R & ~31) + perm32(R & 31)) : R;
        voffA[i] = (unsigned)(R * LD + C) * 2u; voffB[i] = (unsigned)(Rb * LD + C) * 2u; }
    const size_t kstep = (size_t)(BK * 2);
    const size_t hstep = (size_t)HALF * LD * 2;
    const size_t tstep = 2 * hstep;
    const unsigned ldsw = (unsigned)wid * 1024u;
    const int aoff = lds_byte(wr * 64 + fr, fq * 8), boff = lds_byte(wc * 32 + fr, fq * 8);
#define PG8_SA(b, h) (((b) * 2 + (h)) * HTB)
#define PG8_SB(b, h) ((4 + (b) * 2 + (h)) * HTB)
#define PG8_STAGE(bufoff, gbase, voff) do { _Pragma("unroll") for (int _i = 0; _i < 2; ++_i) \
        __builtin_amdgcn_global_load_lds((const unsigned*)((const char*)(gbase) + (voff)[_i]), (PG8_LAS unsigned*)(lds + (bufoff) + ldsw + _i * 8192), 16, 0, 0); } while (0)
#define PG8_LDA(dst, b, h) do { _Pragma("unroll") for (int m = 0; m < 4; ++m) _Pragma("unroll") for (int k = 0; k < 2; ++k) dst[m][k] = *(const PG8_LAS bf16x8*)(lds + PG8_SA(b, h) + aoff + m * 2048 + k * 1024); } while (0)
#define PG8_LDB(dst, b, h) do { _Pragma("unroll") for (int n = 0; n < 2; ++n) _Pragma("unroll") for (int k = 0; k < 2; ++k) dst[n][k] = *(const PG8_LAS bf16x8*)(lds + PG8_SB(b, h) + boff + n * 2048 + k * 1024); } while (0)
#define PG8_MMA(ai, bj, At, Bt) do { __builtin_amdgcn_s_setprio(1); _Pragma("unroll") for (int m = 0; m < 4; ++m) _Pragma("unroll") for (int n = 0; n < 2; ++n) _Pragma("unroll") for (int k = 0; k < 2; ++k) \
        acc[ai][bj][m][n] = __builtin_amdgcn_mfma_f32_16x16x32_bf16(Bt[n][k], At[m][k], acc[ai][bj][m][n], 0, 0, 0); __builtin_amdgcn_s_setprio(0); } while (0)
#define PG8_WAIT_V(n) asm volatile("s_waitcnt vmcnt(" #n ")" ::: "memory")
#define PG8_WAIT_L(n) asm volatile("s_waitcnt lgkmcnt(" #n ")" ::: "memory")
#define PG8_BAR __builtin_amdgcn_s_barrier()
#define PG8_SCHED __builtin_amdgcn_sched_barrier(0)
    Unit cur, nxt; int ui = 0;
    if (!S.next(0, cur)) return;
    f32x4 acc[2][2][4][2];
#pragma unroll
    for (int a = 0; a < 2; ++a)
#pragma unroll
        for (int b = 0; b < 2; ++b)
#pragma unroll
            for (int m = 0; m < 4; ++m)
#pragma unroll
                for (int n = 0; n < 2; ++n) acc[a][b][m][n] = (f32x4){0.f, 0.f, 0.f, 0.f};
    bf16x8 At[4][2], B0[2][2], B1[2][2];
    const char* cA = (const char*)g.A + (size_t)cur.pm * tstep; const char* cB = (const char*)g.Bt + (size_t)cur.pn * tstep;
    S.a_ready(cur);
    PG8_STAGE(PG8_SB(0, 0), cB, voffB); PG8_STAGE(PG8_SA(0, 0), cA, voffA); PG8_STAGE(PG8_SB(0, 1), cB + hstep, voffB); PG8_STAGE(PG8_SA(0, 1), cA + hstep, voffA);
    if (wr == 1) PG8_BAR;
    PG8_WAIT_V(4); PG8_BAR;
    PG8_STAGE(PG8_SB(1, 0), cB + kstep, voffB); PG8_STAGE(PG8_SA(1, 0), cA + kstep, voffA); PG8_STAGE(PG8_SB(1, 1), cB + hstep + kstep, voffB);
    PG8_WAIT_V(6); PG8_BAR;
    PG8_STAMP();
    for (;;) {
        const bool has_next = S.next(ui + 1, nxt);
        const char* nA = has_next ? (const char*)g.A + (size_t)nxt.pm * tstep : cA; const char* nB = has_next ? (const char*)g.Bt + (size_t)nxt.pn * tstep : cB;
        for (int t = 0; t < nt; t += 2) {
            const bool last = (t == nt - 2);
            const char* a1 = cA + (size_t)(t + 1) * kstep;
            const char* a2 = last ? nA : cA + (size_t)(t + 2) * kstep; const char* b2 = last ? nB : cB + (size_t)(t + 2) * kstep;
            const char* a3 = a2 + kstep; const char* b3 = b2 + kstep;
            if (last && has_next) S.a_ready(nxt);
            PG8_LDB(B0, 0, 0); PG8_SCHED; PG8_LDA(At, 0, 0); PG8_STAGE(PG8_SA(1, 1), a1 + hstep, voffA);
            PG8_WAIT_L(8); PG8_BAR; PG8_WAIT_L(0); PG8_MMA(0, 0, At, B0); PG8_BAR; PG8_SCHED;
            PG8_LDB(B1, 0, 1); PG8_STAGE(PG8_SB(0, 0), b2, voffB);
            PG8_BAR; PG8_WAIT_L(0); PG8_MMA(0, 1, At, B1); PG8_BAR;
            PG8_LDA(At, 0, 1); PG8_STAGE(PG8_SA(0, 0), a2, voffA);
            PG8_BAR; PG8_WAIT_L(0); PG8_MMA(1, 0, At, B0); PG8_BAR; PG8_SCHED;
            PG8_STAGE(PG8_SB(0, 1), b2 + hstep, voffB);
            PG8_WAIT_V(6); PG8_BAR; PG8_MMA(1, 1, At, B1); PG8_BAR;
            PG8_LDB(B0, 1, 0); PG8_SCHED; PG8_LDA(At, 1, 0); PG8_STAGE(PG8_SA(0, 1), a2 + hstep, voffA);
            PG8_WAIT_L(8); PG8_BAR; PG8_WAIT_L(0); PG8_MMA(0, 0, At, B0); PG8_BAR; PG8_SCHED;
            PG8_LDB(B1, 1, 1); PG8_STAGE(PG8_SB(1, 0), b3, voffB);
            PG8_BAR; PG8_WAIT_L(0); PG8_MMA(0, 1, At, B1); PG8_BAR;
            PG8_LDA(At, 1, 1); PG8_STAGE(PG8_SA(1, 0), a3, voffA);
            PG8_BAR; PG8_WAIT_L(0); PG8_MMA(1, 0, At, B0); PG8_BAR; PG8_SCHED;
            PG8_STAGE(PG8_SB(1, 1), b3 + hstep, voffB);
            PG8_WAIT_V(6); PG8_BAR; PG8_MMA(1, 1, At, B1); PG8_BAR;
        }
        PG8_STAMP();
        if constexpr (!Epi::AFTER_DRAIN) { E(acc, cur, wr, wc, fr, fq); S.done(cur); }
        PG8_STAMP();
        if (!has_next) break;
#pragma unroll
        for (int a = 0; a < 2; ++a)
#pragma unroll
            for (int b = 0; b < 2; ++b)
#pragma unroll
                for (int m = 0; m < 4; ++m)
#pragma unroll
                    for (int n = 0; n < 2; ++n) acc[a][b][m][n] = (f32x4){0.f, 0.f, 0.f, 0.f};
        cur = nxt; cA = nA; cB = nB; ++ui;
    }
    PG8_WAIT_V(0);
    if (wr == 0) PG8_BAR;
    PG8_BAR;
    if constexpr (Epi::AFTER_DRAIN) { E.fused(acc, cur, wr, wc, fr, fq, lds, wid, lane); S.done(cur); }
    PG8_STAMP();
    if (STAMP && wid == 0) { stamps[lane] = lane < nts ? (((unsigned long long)(unsigned)ts_hi << 32) | (unsigned)ts_lo) : 0ull;
        if (lane == 62) stamps[62] = rt_entry; if (lane == 63) stamps[63] = (unsigned long long)wall_clock64(); }
#undef PG8_STAMP
#undef PG8_SA
#undef PG8_SB
#undef PG8_STAGE
#undef PG8_LDA
#undef PG8_LDB
#undef PG8_MMA
#undef PG8_WAIT_V
#undef PG8_WAIT_L
#undef PG8_BAR
#undef PG8_SCHED
}
}

namespace pg8 {
struct EpiStoreBf16 {
    static constexpr bool PERM = true, AFTER_DRAIN = false;
    bf16_t* O; int ldc;
    __device__ __forceinline__ void operator()(const f32x4 (&acc)[2][2][4][2], const Unit& u, int wr, int wc, int fr, int fq) const {
        const int row0 = u.pm * BM + wr * 64 + fr, col0 = u.pn * BM + wc * 32 + 8 * fq;
#pragma unroll
        for (int ai = 0; ai < 2; ++ai)
#pragma unroll
            for (int m = 0; m < 4; ++m) { bf16_t* rowp = O + (size_t)(row0 + ai * HALF + m * 16) * ldc + col0;
#pragma unroll
                for (int bj = 0; bj < 2; ++bj) { const f32x4 v0 = acc[ai][bj][m][0], v1 = acc[ai][bj][m][1];
                    u32x4 w; w.x = cvt_pk_bf16(v0[0], v0[1]); w.y = cvt_pk_bf16(v0[2], v0[3]); w.z = cvt_pk_bf16(v1[0], v1[1]); w.w = cvt_pk_bf16(v1[2], v1[3]);
                    *(u32x4*)(rowp + bj * HALF) = w; } }
    }
};
struct EpiAddF32 {
    static constexpr bool PERM = false, AFTER_DRAIN = false;
    float* C; int ldc;
    __device__ __forceinline__ void operator()(const f32x4 (&acc)[2][2][4][2], const Unit& u, int wr, int wc, int fr, int fq) const {
        const int row0 = u.pm * BM + wr * 64 + fr, col0 = u.pn * BM + wc * 32 + 4 * fq;
#pragma unroll
        for (int ai = 0; ai < 2; ++ai)
#pragma unroll
            for (int m = 0; m < 4; ++m) { float* rowp = C + (size_t)(row0 + ai * HALF + m * 16) * ldc + col0;
#pragma unroll
                for (int bj = 0; bj < 2; ++bj)
#pragma unroll
                    for (int n = 0; n < 2; ++n) { f32x4* q = (f32x4*)(rowp + bj * HALF + n * 16); *q = *q + acc[ai][bj][m][n]; } }
    }
};
struct EpiDownF32 {
    static constexpr bool PERM = false, AFTER_DRAIN = false;
    float* C;
    __device__ __forceinline__ void operator()(const f32x4 (&acc)[2][2][4][2], const Unit& u, int wr, int wc, int fr, int fq) const {
        const int row0 = u.pm * BM + wr * 64 + fr, col0 = (u.pn & 7) * BM + wc * 32 + 4 * fq;
#pragma unroll
        for (int ai = 0; ai < 2; ++ai)
#pragma unroll
            for (int m = 0; m < 4; ++m) { float* rowp = C + (size_t)(row0 + ai * HALF + m * 16) * 2048 + col0;
#pragma unroll
                for (int bj = 0; bj < 2; ++bj)
#pragma unroll
                    for (int n = 0; n < 2; ++n) *(f32x4*)(rowp + bj * HALF + n * 16) = acc[ai][bj][m][n]; }
    }
};
struct EpiSwiglu {
    static constexpr bool PERM = true, AFTER_DRAIN = false;
    bf16_t* H;
    __device__ __forceinline__ void operator()(const f32x4 (&acc)[2][2][4][2], const Unit& u, int wr, int wc, int fr, int fq) const {
        const int row0 = u.pm * BM + wr * 64 + fr, col0 = (u.pn & 3) * 128 + wc * 32 + 8 * fq;
#pragma unroll
        for (int ai = 0; ai < 2; ++ai)
#pragma unroll
            for (int m = 0; m < 4; ++m) { bf16_t* rowp = H + (size_t)(row0 + ai * HALF + m * 16) * 512 + col0;
                float h[8];
#pragma unroll
                for (int n = 0; n < 2; ++n)
#pragma unroll
                    for (int j = 0; j < 4; ++j) { const float g = acc[ai][0][m][n][j], up = acc[ai][1][m][n][j]; h[n * 4 + j] = g / (1.f + __expf(-g)) * up; }
                u32x4 w; w.x = cvt_pk_bf16(h[0], h[1]); w.y = cvt_pk_bf16(h[2], h[3]); w.z = cvt_pk_bf16(h[4], h[5]); w.w = cvt_pk_bf16(h[6], h[7]);
                *(u32x4*)rowp = w; }
    }
};
struct HalfOrder {
    int c, G;
    __device__ __forceinline__ bool next(int i, Unit& u) const { const int L = i * G + c; if (L >= 256) return false; u.pm = (L >> 1) >> 2; u.pn = (L >> 1) & 3; return true; }
    __device__ __forceinline__ void a_ready(const Unit&) const {}
    __device__ __forceinline__ void done(const Unit&) const {}
};
struct MoeOrder {
    const int* blk_e; int ntile, G, c, shift;
    __device__ __forceinline__ bool next(int i, Unit& u) const {
        const int L = i * G + c; if (L >= ntile) return false;
        const int mb = L >> shift, nt = L & ((1 << shift) - 1);
        u.pm = mb; u.pn = (blk_e[mb] << shift) + nt; return true;
    }
    __device__ __forceinline__ void a_ready(const Unit&) const {}
    __device__ __forceinline__ void done(const Unit&) const {}
};
}

__device__ __forceinline__ void transpose_item(const float* __restrict__ W, int ldin, int n0, int K, u16* __restrict__ WT, int row0, int nbn, int item, float* scr, int lane, int ilv = -1) {
    const int kb = item / nbn, nb = item % nbn, k0 = 64 * kb, nn = 32 * nb;
    const int rb = ilv < 0 ? row0 + nn : row0 + (nn >> 7) * 256 + ilv * 128 + (nn & 127);
#pragma unroll 8
    for (int i = 0; i < 32; ++i) { const int kk = 2 * i + (lane >> 5); scr[kk * 33 + (lane & 31)] = __builtin_nontemporal_load(&W[(size_t)(k0 + kk) * ldin + n0 + nn + (lane & 31)]); }
    asm volatile("s_waitcnt lgkmcnt(0)" ::: "memory");
    const int c = lane & 7;
#pragma unroll
    for (int j = 0; j < 4; ++j) { const int n = (lane >> 3) + 8 * j; const float* s = scr + (8 * c) * 33 + n;
        uint4 o; o.x = pk2(s[0 * 33], s[1 * 33]); o.y = pk2(s[2 * 33], s[3 * 33]); o.z = pk2(s[4 * 33], s[5 * 33]); o.w = pk2(s[6 * 33], s[7 * 33]);
        *(uint4*)(WT + (size_t)(rb + n) * K + k0 + 8 * c) = o; }
    asm volatile("s_waitcnt lgkmcnt(0)" ::: "memory");
}
__device__ __forceinline__ void convert_moe_weights(const float* wg, const float* wu, const float* wd, u16* WguT, u16* WdT, int l, float* scr, int gw, int NGW, int lane) {
    constexpr int IPE = 512;
    for (int it = gw; it < 3 * NE * IPE; it += NGW) {
        const int which = it / (NE * IPE), r = it % (NE * IPE), e = r / IPE, item = r % IPE;
        const size_t eo = ((size_t)l * NE + e) * (size_t)D * DFF;
        if (which == 0)      transpose_item(wg + eo, DFF, 0, D, WguT + (size_t)e * 1024 * D, 0, DFF / 32, item, scr, lane, 0);
        else if (which == 1) transpose_item(wu + eo, DFF, 0, D, WguT + (size_t)e * 1024 * D, 0, DFF / 32, item, scr, lane, 1);
        else                 transpose_item(wd + eo, D, 0, DFF, WdT + (size_t)e * D * DFF, 0, D / 32, item, scr, lane);
    }
}


constexpr int ATT_RS = 144;
constexpr int ATT_VBYTES = 32 * ATT_RS;
typedef long long i64;
typedef unsigned u32x4v __attribute__((ext_vector_type(4)));
typedef unsigned u32x2v __attribute__((ext_vector_type(2)));
__device__ __forceinline__ float bperm(int srclane, float v) { return __int_as_float(__builtin_amdgcn_ds_bpermute(srclane << 2, __float_as_int(v))); }
__device__ __forceinline__ float softplus_fast(float z) { return fmaxf(z, 0.f) + __logf(1.f + __expf(-fabsf(z))); }
__device__ __forceinline__ void vt_frags(unsigned vaddr, int lane, bf16x8 (&vf)[4]) {
    const unsigned a = vaddr + (unsigned)((4 * (lane >> 4) + ((lane & 15) >> 2)) * ATT_RS + (lane & 3) * 8);
    i64 r0, r1, r2, r3, r4, r5, r6, r7;
    asm volatile("s_waitcnt lgkmcnt(0)\n\t"
                 "ds_read_b64_tr_b16 %0, %8\n\tds_read_b64_tr_b16 %1, %8 offset:2304\n\t"
                 "ds_read_b64_tr_b16 %2, %8 offset:32\n\tds_read_b64_tr_b16 %3, %8 offset:2336\n\t"
                 "ds_read_b64_tr_b16 %4, %8 offset:64\n\tds_read_b64_tr_b16 %5, %8 offset:2368\n\t"
                 "ds_read_b64_tr_b16 %6, %8 offset:96\n\tds_read_b64_tr_b16 %7, %8 offset:2400\n\t"
                 "s_waitcnt lgkmcnt(0)"
                 : "=&v"(r0), "=&v"(r1), "=&v"(r2), "=&v"(r3), "=&v"(r4), "=&v"(r5), "=&v"(r6), "=&v"(r7) : "v"(a) : "memory");
    typedef i64 i64x2 __attribute__((ext_vector_type(2)));
    i64x2 t; t.x = r0; t.y = r1; vf[0] = __builtin_bit_cast(bf16x8, t); t.x = r2; t.y = r3; vf[1] = __builtin_bit_cast(bf16x8, t);
    t.x = r4; t.y = r5; vf[2] = __builtin_bit_cast(bf16x8, t); t.x = r6; t.y = r7; vf[3] = __builtin_bit_cast(bf16x8, t);
}
__device__ __forceinline__ bf16x8 pack8(const float (&a)[4], const float (&b)[4]) {
    u32x4v w; w.x = pk2(a[0], a[1]); w.y = pk2(a[2], a[3]); w.z = pk2(b[0], b[1]); w.w = pk2(b[2], b[3]);
    return __builtin_bit_cast(bf16x8, w);
}
__device__ __forceinline__ void store_out_tile(const f32x4 (&o)[4], float scale, const float* __restrict__ gain, u16* __restrict__ dst  , int g) {
#pragma unroll
    for (int dt = 0; dt < 4; ++dt) { const float4 gg = *(const float4*)(gain + dt * 16 + 4 * g);
        *(uint2*)(dst + dt * 16 + 4 * g) = make_uint2(pk2(o[dt][0] * scale * gg.x, o[dt][1] * scale * gg.y), pk2(o[dt][2] * scale * gg.z, o[dt][3] * scale * gg.w)); }
}

__device__ __forceinline__ void sb_unit(const u16* __restrict__ PROJ, int b, int qb, int h, int lane, LAS char* vl, LAS float* red,
                                        const float* __restrict__ gout, u16* __restrict__ MIXED) {
    const int li = lane & 15, g = lane >> 4; const size_t tb = (size_t)b * SEQ; const int q0 = qb * 32;
    const u16* Qp = PROJ + C_SB + h * 64; const u16* Kp = Qp + 512; const u16* Vp = Qp + 1024;
    const unsigned vaddr = (unsigned)(size_t)vl;
    bf16x8 qf[2][2];
#pragma unroll
    for (int qt = 0; qt < 2; ++qt)
#pragma unroll
        for (int s = 0; s < 2; ++s) qf[qt][s] = *(const bf16x8*)(Qp + (tb + q0 + qt * 16 + li) * DP + 32 * s + 8 * g);
    f32x4 acc[2][4];
#pragma unroll
    for (int qt = 0; qt < 2; ++qt)
#pragma unroll
        for (int dt = 0; dt < 4; ++dt) acc[qt][dt] = (f32x4){0.f, 0.f, 0.f, 0.f};
    float carry[2] = {0.f, 0.f};
    bf16x8 kn[2][2]; u32x4v vn[4];
#define SB_LOAD(kk) do { _Pragma("unroll") for (int kt = 0; kt < 2; ++kt) _Pragma("unroll") for (int s = 0; s < 2; ++s) kn[kt][s] = *(const bf16x8*)(Kp + (tb + (kk) + kt * 16 + li) * DP + 32 * s + 8 * g); \
        _Pragma("unroll") for (int u = 0; u < 4; ++u) { const int c = lane + 64 * u; vn[u] = *(const u32x4v*)(Vp + (tb + (kk) + (c >> 3)) * DP + (c & 7) * 8); } } while (0)
    SB_LOAD(q0);
    for (int k0 = q0; k0 >= 0; k0 -= 32) {
        bf16x8 kf[2][2];
#pragma unroll
        for (int kt = 0; kt < 2; ++kt)
#pragma unroll
            for (int s = 0; s < 2; ++s) kf[kt][s] = kn[kt][s];
#pragma unroll
        for (int u = 0; u < 4; ++u) { const int c = lane + 64 * u; *(LAS u32x4v*)(vl + (c >> 3) * ATT_RS + (c & 7) * 16) = vn[u]; }
        if (k0 >= 32) SB_LOAD(k0 - 32);
        bf16x8 pf[2];
#pragma unroll
        for (int qt = 0; qt < 2; ++qt) {
            const int qpos = q0 + qt * 16 + li;
            float w[2][4];
#pragma unroll
            for (int kt = 1; kt >= 0; --kt) {
                f32x4 st = __builtin_amdgcn_mfma_f32_16x16x32_bf16(kf[kt][0], qf[qt][0], (f32x4){0.f, 0.f, 0.f, 0.f}, 0, 0, 0);
                st = __builtin_amdgcn_mfma_f32_16x16x32_bf16(kf[kt][1], qf[qt][1], st, 0, 0, 0);
                const int kb = k0 + kt * 16 + 4 * g;
                float sp[4];
#pragma unroll
                for (int r = 0; r < 4; ++r) sp[r] = (kb + r < qpos) ? softplus_fast(st[r]) : 0.f;
                const float G = (sp[0] + sp[1]) + (sp[2] + sp[3]);
                const float x1 = bperm(lane ^ 16, G), hs = G + x1, x2 = bperm(lane ^ 32, hs);
                float rs = carry[qt] + (g == 3 ? 0.f : g == 2 ? x1 : g == 1 ? x2 : x1 + x2);
#pragma unroll
                for (int r = 3; r >= 0; --r) { w[kt][r] = (kb + r < qpos) ? __expf(st[r] - sp[r] - rs) : 0.f; rs += sp[r]; }
                carry[qt] += hs + x2;
            }
            pf[qt] = pack8(w[0], w[1]);
        }
        bf16x8 vf[4]; vt_frags(vaddr, lane, vf);
#pragma unroll
        for (int qt = 0; qt < 2; ++qt)
#pragma unroll
            for (int dt = 0; dt < 4; ++dt) acc[qt][dt] = __builtin_amdgcn_mfma_f32_16x16x32_bf16(vf[dt], pf[qt], acc[qt][dt], 0, 0, 0);
        if (k0 + 32 <= q0 && __all(fminf(carry[0], carry[1]) > 104.f)) break;
    }
#undef SB_LOAD
    float ss[2];
#pragma unroll
    for (int qt = 0; qt < 2; ++qt) { float s = 0.f;
#pragma unroll
        for (int dt = 0; dt < 4; ++dt) s += (acc[qt][dt][0] * acc[qt][dt][0] + acc[qt][dt][1] * acc[qt][dt][1]) + (acc[qt][dt][2] * acc[qt][dt][2] + acc[qt][dt][3] * acc[qt][dt][3]);
        s += bperm(lane ^ 16, s); s += bperm(lane ^ 32, s); ss[qt] = s;
        if (g == 0) red[h * 64 + qt * 16 + li] = s; }
    __syncthreads();
#pragma unroll
    for (int qt = 0; qt < 2; ++qt) { float tot = 0.f;
#pragma unroll
        for (int hh = 0; hh < 8; ++hh) tot += red[hh * 64 + qt * 16 + li];
        const float sc = rsqrtf(tot / 512.f + EPS);
        store_out_tile(acc[qt], sc, gout + h * 64, MIXED + (tb + q0 + qt * 16 + li) * D + 512 + h * 64, g); }
}

__device__ __forceinline__ void dil_unit(const u16* __restrict__ PROJ, int b, int w, int r, int h, int lane, LAS char* vl, LAS float* red,
                                         const float* __restrict__ gout, u16* __restrict__ MIXED) {
    const int li = lane & 15, g = lane >> 4; const size_t tb = (size_t)b * SEQ; const int qpos = w * 256 + r + 16 * li;
    const u16* Qp = PROJ + C_DIL + h * 64; const u16* Kp = Qp + 512; const u16* Vp = Qp + 1024;
    const unsigned vaddr = (unsigned)(size_t)vl;
    bf16x8 qf[2];
#pragma unroll
    for (int s = 0; s < 2; ++s) qf[s] = *(const bf16x8*)(Qp + (tb + qpos) * DP + 32 * s + 8 * g);
    f32x4 acc[4];
#pragma unroll
    for (int dt = 0; dt < 4; ++dt) acc[dt] = (f32x4){0.f, 0.f, 0.f, 0.f};
    float mrun = -1e30f, lrun = 0.f;
#pragma unroll 1
    for (int br = 0; br < 3; ++br) {
        const int dsh = br == 0 ? 4 : br == 1 ? 2 : 0;
        const int nstep = br == 0 ? 5 : br == 1 ? 6 : 12;
        const int base = w * 256 + r - (128 << dsh);
        const int rat = li << (4 - dsh);
        const int nbf = base < 0 ? ((-base + (1 << dsh) - 1) >> dsh) : 0;
        const int sbeg = nbf >> 5;
        bf16x8 kn[2][2]; u32x4v vn[4];
#define DIL_LOAD(mm) do { _Pragma("unroll") for (int kt = 0; kt < 2; ++kt) { int pos = base + (((mm) + kt * 16 + li) << dsh); pos = min(max(pos, 0), SEQ - 1); \
            _Pragma("unroll") for (int s = 0; s < 2; ++s) kn[kt][s] = *(const bf16x8*)(Kp + (tb + pos) * DP + 32 * s + 8 * g); } \
        _Pragma("unroll") for (int u = 0; u < 4; ++u) { const int c = lane + 64 * u; int pos = base + (((mm) + (c >> 3)) << dsh); pos = min(max(pos, 0), SEQ - 1); \
            vn[u] = *(const u32x4v*)(Vp + (tb + pos) * DP + (c & 7) * 8); } } while (0)
        DIL_LOAD(sbeg * 32);
#pragma unroll 1
        for (int st_ = sbeg; st_ < nstep; ++st_) {
            const int m0 = st_ * 32;
            bf16x8 kf[2][2];
#pragma unroll
            for (int kt = 0; kt < 2; ++kt)
#pragma unroll
                for (int s = 0; s < 2; ++s) kf[kt][s] = kn[kt][s];
#pragma unroll
            for (int u = 0; u < 4; ++u) { const int c = lane + 64 * u; *(LAS u32x4v*)(vl + (c >> 3) * ATT_RS + (c & 7) * 16) = vn[u]; }
            if (st_ + 1 < nstep) DIL_LOAD(m0 + 32);
            float z[2][4]; bool ok[2][4]; float zmax = -1e30f;
#pragma unroll
            for (int kt = 0; kt < 2; ++kt) {
                f32x4 st = __builtin_amdgcn_mfma_f32_16x16x32_bf16(kf[kt][0], qf[0], (f32x4){0.f, 0.f, 0.f, 0.f}, 0, 0, 0);
                st = __builtin_amdgcn_mfma_f32_16x16x32_bf16(kf[kt][1], qf[1], st, 0, 0, 0);
#pragma unroll
                for (int rr = 0; rr < 4; ++rr) { const int m = m0 + kt * 16 + 4 * g + rr; const int dm = m - rat;
                    ok[kt][rr] = (dm >= 0) && (dm <= 128) && (base + (m << dsh) >= 0);
                    z[kt][rr] = st[rr]; if (ok[kt][rr]) zmax = fmaxf(zmax, st[rr]); }
            }
            zmax = fmaxf(zmax, bperm(lane ^ 16, zmax)); zmax = fmaxf(zmax, bperm(lane ^ 32, zmax));
            const float mn = fmaxf(mrun, zmax); const float al = __expf(mrun - mn); mrun = mn;
            float pw[2][4]; float ps = 0.f;
#pragma unroll
            for (int kt = 0; kt < 2; ++kt)
#pragma unroll
                for (int rr = 0; rr < 4; ++rr) { pw[kt][rr] = ok[kt][rr] ? __expf(z[kt][rr] - mn) : 0.f; ps += pw[kt][rr]; }
            lrun = lrun * al + ps;
#pragma unroll
            for (int dt = 0; dt < 4; ++dt) acc[dt] = acc[dt] * al;
            const bf16x8 pf = pack8(pw[0], pw[1]);
            bf16x8 vf[4]; vt_frags(vaddr, lane, vf);
#pragma unroll
            for (int dt = 0; dt < 4; ++dt) acc[dt] = __builtin_amdgcn_mfma_f32_16x16x32_bf16(vf[dt], pf, acc[dt], 0, 0, 0);
        }
    }
#undef DIL_LOAD
    lrun += bperm(lane ^ 16, lrun); lrun += bperm(lane ^ 32, lrun);
    const float inv = 1.f / lrun;
    float s = 0.f;
#pragma unroll
    for (int dt = 0; dt < 4; ++dt) { acc[dt] = acc[dt] * inv; s += (acc[dt][0] * acc[dt][0] + acc[dt][1] * acc[dt][1]) + (acc[dt][2] * acc[dt][2] + acc[dt][3] * acc[dt][3]); }
    s += bperm(lane ^ 16, s); s += bperm(lane ^ 32, s);
    if (g == 0) red[h * 64 + li] = s;
    __syncthreads();
    float tot = 0.f;
#pragma unroll
    for (int hh = 0; hh < 8; ++hh) tot += red[hh * 64 + li];
    const float sc = rsqrtf(tot / 512.f + EPS);
    store_out_tile(acc, sc, gout + h * 64, MIXED + (tb + qpos) * D + 1024 + h * 64, g);
}


template <int RS> __device__ __forceinline__ void tr_frags4(unsigned addr, int lane, bf16x8 (&f)[4]) {
    const unsigned a = addr + (unsigned)((4 * (lane >> 4) + ((lane & 15) >> 2)) * RS + (lane & 3) * 8);
    i64 r0, r1, r2, r3, r4, r5, r6, r7;
    asm volatile("s_waitcnt lgkmcnt(0)\n\t"
                 "ds_read_b64_tr_b16 %0, %8\n\tds_read_b64_tr_b16 %1, %8 offset:%9\n\t"
                 "ds_read_b64_tr_b16 %2, %8 offset:32\n\tds_read_b64_tr_b16 %3, %8 offset:%10\n\t"
                 "ds_read_b64_tr_b16 %4, %8 offset:64\n\tds_read_b64_tr_b16 %5, %8 offset:%11\n\t"
                 "ds_read_b64_tr_b16 %6, %8 offset:96\n\tds_read_b64_tr_b16 %7, %8 offset:%12\n\t"
                 "s_waitcnt lgkmcnt(0)"
                 : "=&v"(r0), "=&v"(r1), "=&v"(r2), "=&v"(r3), "=&v"(r4), "=&v"(r5), "=&v"(r6), "=&v"(r7)
                 : "v"(a), "i"(16 * RS), "i"(16 * RS + 32), "i"(16 * RS + 64), "i"(16 * RS + 96) : "memory");
    typedef i64 i64x2 __attribute__((ext_vector_type(2)));
    i64x2 t; t.x = r0; t.y = r1; f[0] = __builtin_bit_cast(bf16x8, t); t.x = r2; t.y = r3; f[1] = __builtin_bit_cast(bf16x8, t);
    t.x = r4; t.y = r5; f[2] = __builtin_bit_cast(bf16x8, t); t.x = r6; t.y = r7; f[3] = __builtin_bit_cast(bf16x8, t);
}
template <int RS> __device__ __forceinline__ bf16x8 tr_frag1(unsigned addr, int lane) {
    const unsigned a = addr + (unsigned)((4 * (lane >> 4) + ((lane & 15) >> 2)) * RS + (lane & 3) * 8);
    i64 r0, r1;
    asm volatile("s_waitcnt lgkmcnt(0)\n\tds_read_b64_tr_b16 %0, %2\n\tds_read_b64_tr_b16 %1, %2 offset:%3\n\ts_waitcnt lgkmcnt(0)"
                 : "=&v"(r0), "=&v"(r1) : "v"(a), "i"(16 * RS) : "memory");
    typedef i64 i64x2 __attribute__((ext_vector_type(2)));
    i64x2 t; t.x = r0; t.y = r1; return __builtin_bit_cast(bf16x8, t);
}
constexpr int SSD_RB = 272, SSD_RX = 144;
constexpr int SSD_OFF_B = 0, SSD_OFF_C = 128 * SSD_RB, SSD_OFF_X = 2 * 128 * SSD_RB, SSD_OFF_XW = SSD_OFF_X + 128 * SSD_RX, SSD_OFF_F = SSD_OFF_XW + 128 * SSD_RX;
__device__ __forceinline__ void ssd_chunk_unit(const u16* __restrict__ PROJ, const float* __restrict__ DTR, const float* __restrict__ cw, const float* __restrict__ cb,
                                               float dtbias, float aneg, float dskip, int b, int c, int h, int tid, LAS char* L,
                                               float* __restrict__ YD, float* __restrict__ SS, float* __restrict__ ATOT, float* __restrict__ ACS, u16* __restrict__ CG) {
    const int wave = tid >> 6, lane = tid & 63, li = lane & 15, g = lane >> 4, grp = h >> 2;
    const size_t t0 = (size_t)b * SEQ + (size_t)c * 128;
    LAS float* acs = (LAS float*)(L + SSD_OFF_F); LAS float* dts = acs + 128; LAS float* wls = acs + 256;
    __syncthreads();
    if (wave == 0) {
        const float d0 = softplusf(DTR[(t0 + 2 * lane) * 8 + h] + dtbias), d1 = softplusf(DTR[(t0 + 2 * lane + 1) * 8 + h] + dtbias);
        const float a0 = d0 * aneg, a1 = d1 * aneg;
        float v = a0 + a1;
#pragma unroll
        for (int o = 1; o < 64; o <<= 1) { const float t = bperm(lane - o, v); if (lane >= o) v += t; }
        acs[2 * lane] = v - a1; acs[2 * lane + 1] = v; dts[2 * lane] = d0; dts[2 * lane + 1] = d1;
    }
    __syncthreads();
    if (tid < 128) { const float a = acs[tid]; wls[tid] = dts[tid] * __expf(acs[127] - a); ACS[(t0 + tid) * 8 + h] = a; if (tid == 0) ATOT[((size_t)b * 32 + c) * 8 + h] = acs[127]; }
    __syncthreads();
    if (tid < 480) {
        const int cg = tid % 40, tp = tid / 40;
        const int ch = cg < 8 ? h * 64 + cg * 8 : cg < 24 ? 512 + grp * 128 + (cg - 8) * 8 : 768 + grp * 128 + (cg - 24) * 8;
        float wk[4][8], bs[8];
#pragma unroll
        for (int k = 0; k < 4; ++k) { const float4 w0 = *(const float4*)(cw + k * 1024 + ch), w1 = *(const float4*)(cw + k * 1024 + ch + 4);
            wk[k][0] = w0.x; wk[k][1] = w0.y; wk[k][2] = w0.z; wk[k][3] = w0.w; wk[k][4] = w1.x; wk[k][5] = w1.y; wk[k][6] = w1.z; wk[k][7] = w1.w; }
        { const float4 b0 = *(const float4*)(cb + ch), b1 = *(const float4*)(cb + ch + 4); bs[0] = b0.x; bs[1] = b0.y; bs[2] = b0.z; bs[3] = b0.w; bs[4] = b1.x; bs[5] = b1.y; bs[6] = b1.z; bs[7] = b1.w; }
        const int tl0 = tp * 11, tl1 = min(tl0 + 11, 128);
        const u16* src = PROJ + t0 * DP + C_XBC + ch;
        const bf16x8 zero8 = {0, 0, 0, 0, 0, 0, 0, 0};
        bf16x8 r0, r1, r2;
        { const int sl = c * 128 + tl0;
          r0 = sl - 3 >= 0 ? *(const bf16x8*)(src + (long)(tl0 - 3) * DP) : zero8; r1 = sl - 2 >= 0 ? *(const bf16x8*)(src + (long)(tl0 - 2) * DP) : zero8;
          r2 = sl - 1 >= 0 ? *(const bf16x8*)(src + (long)(tl0 - 1) * DP) : zero8; }
        for (int tl = tl0; tl < tl1; ++tl) {
            const bf16x8 r3 = *(const bf16x8*)(src + (long)tl * DP);
            float a[8];
#pragma unroll
            for (int j = 0; j < 8; ++j) a[j] = siluf(bs[j] + wk[0][j] * bf2f((u16)r0[j]) + wk[1][j] * bf2f((u16)r1[j]) + wk[2][j] * bf2f((u16)r2[j]) + wk[3][j] * bf2f((u16)r3[j]));
            r0 = r1; r1 = r2; r2 = r3;
            u32x4v o; o.x = pk2(a[0], a[1]); o.y = pk2(a[2], a[3]); o.z = pk2(a[4], a[5]); o.w = pk2(a[6], a[7]);
            if (cg < 8) {
                *(LAS u32x4v*)(L + SSD_OFF_X + tl * SSD_RX + cg * 16) = o;
                const float wl = wls[tl]; u32x4v ow; ow.x = pk2(a[0] * wl, a[1] * wl); ow.y = pk2(a[2] * wl, a[3] * wl); ow.z = pk2(a[4] * wl, a[5] * wl); ow.w = pk2(a[6] * wl, a[7] * wl);
                *(LAS u32x4v*)(L + SSD_OFF_XW + tl * SSD_RX + cg * 16) = ow;
            } else if (cg < 24) *(LAS u32x4v*)(L + SSD_OFF_B + tl * SSD_RB + (cg - 8) * 16) = o;
            else { *(LAS u32x4v*)(L + SSD_OFF_C + tl * SSD_RB + (cg - 24) * 16) = o;
                   if ((h & 3) == 0) *(u32x4v*)(CG + (t0 + tl) * 256 + grp * 128 + (cg - 24) * 8) = o; }
        }
    }
    __syncthreads();
    const unsigned Lb = (unsigned)(size_t)L;
    {
        const int lt = wave, lrow = lt * 16 + li; const float acl = acs[lrow];
        bf16x8 cf[4];
#pragma unroll
        for (int ks = 0; ks < 4; ++ks) cf[ks] = *(const LAS bf16x8*)(L + SSD_OFF_C + lrow * SSD_RB + ks * 64 + g * 16);
        f32x4 acc[4];
#pragma unroll
        for (int pt = 0; pt < 4; ++pt) acc[pt] = (f32x4){0.f, 0.f, 0.f, 0.f};
        for (int s0 = 0; s0 <= lt * 16; s0 += 32) {
            float w[2][4];
#pragma unroll
            for (int kt = 0; kt < 2; ++kt) {
                f32x4 st = (f32x4){0.f, 0.f, 0.f, 0.f};
#pragma unroll
                for (int ks = 0; ks < 4; ++ks) { const bf16x8 bfr = *(const LAS bf16x8*)(L + SSD_OFF_B + (s0 + kt * 16 + li) * SSD_RB + ks * 64 + g * 16);
                    st = __builtin_amdgcn_mfma_f32_16x16x32_bf16(bfr, cf[ks], st, 0, 0, 0); }
                const int sb = s0 + kt * 16 + 4 * g;
                const f32x4 as4 = *(const LAS f32x4*)(acs + sb), dt4 = *(const LAS f32x4*)(dts + sb);
#pragma unroll
                for (int r = 0; r < 4; ++r) w[kt][r] = (sb + r <= lrow) ? st[r] * __expf(acl - as4[r]) * dt4[r] : 0.f;
            }
            const bf16x8 pf = pack8(w[0], w[1]);
            bf16x8 xf[4]; tr_frags4<SSD_RX>(Lb + SSD_OFF_X + s0 * SSD_RX, lane, xf);
#pragma unroll
            for (int pt = 0; pt < 4; ++pt) acc[pt] = __builtin_amdgcn_mfma_f32_16x16x32_bf16(xf[pt], pf, acc[pt], 0, 0, 0);
        }
#pragma unroll
        for (int pt = 0; pt < 4; ++pt) {
            const u32x2v xr = *(const LAS u32x2v*)(L + SSD_OFF_X + lrow * SSD_RX + (pt * 16 + 4 * g) * 2);
            float4 o; o.x = acc[pt][0] + dskip * __uint_as_float(xr.x << 16); o.y = acc[pt][1] + dskip * __uint_as_float(xr.x & 0xffff0000u);
            o.z = acc[pt][2] + dskip * __uint_as_float(xr.y << 16); o.w = acc[pt][3] + dskip * __uint_as_float(xr.y & 0xffff0000u);
            *(float4*)(YD + (t0 + lrow) * 512 + h * 64 + pt * 16 + 4 * g) = o;
        }
    }
    {
        f32x4 acc[4];
#pragma unroll
        for (int pt = 0; pt < 4; ++pt) acc[pt] = (f32x4){0.f, 0.f, 0.f, 0.f};
#pragma unroll
        for (int ks = 0; ks < 4; ++ks) {
            const bf16x8 bt = tr_frag1<SSD_RB>(Lb + SSD_OFF_B + ks * 32 * SSD_RB + wave * 32, lane);
            bf16x8 xf[4]; tr_frags4<SSD_RX>(Lb + SSD_OFF_XW + ks * 32 * SSD_RX, lane, xf);
#pragma unroll
            for (int pt = 0; pt < 4; ++pt) acc[pt] = __builtin_amdgcn_mfma_f32_16x16x32_bf16(bt, xf[pt], acc[pt], 0, 0, 0);
        }
        float* so = SS + ((((size_t)b * 32 + c) * 8 + h) << 13);
#pragma unroll
        for (int pt = 0; pt < 4; ++pt) *(float4*)(so + (pt * 16 + li) * 128 + wave * 16 + 4 * g) = make_float4(acc[pt][0], acc[pt][1], acc[pt][2], acc[pt][3]);
    }
}
__device__ __forceinline__ void ssd_out_unit(const u16* __restrict__ PZ0, const u16* __restrict__ PZ1, const u16* __restrict__ PREV, const u16* __restrict__ CG, const float* __restrict__ YD,
                                             const float* __restrict__ ACS, const float* __restrict__ ng, int b, int j, int h, int lane, LAS float* red, u16* __restrict__ MIXED) {
    const int li = lane & 15, g = lane >> 4, grp = h >> 2, c = j >> 2; const size_t t0 = (size_t)b * SEQ + (size_t)j * 32;
    const u16* pv = PREV + ((((size_t)b * 32 + c) * 8 + h) << 13);
    f32x4 acc[4][2];
#pragma unroll
    for (int pt = 0; pt < 4; ++pt) { acc[pt][0] = (f32x4){0.f, 0.f, 0.f, 0.f}; acc[pt][1] = (f32x4){0.f, 0.f, 0.f, 0.f}; }
#pragma unroll
    for (int ks = 0; ks < 4; ++ks) {
        bf16x8 cf[2];
#pragma unroll
        for (int lt = 0; lt < 2; ++lt) cf[lt] = *(const bf16x8*)(CG + (t0 + lt * 16 + li) * 256 + grp * 128 + ks * 32 + g * 8);
#pragma unroll
        for (int pt = 0; pt < 4; ++pt) { const bf16x8 pf = *(const bf16x8*)(pv + (pt * 16 + li) * 128 + ks * 32 + g * 8);
            acc[pt][0] = __builtin_amdgcn_mfma_f32_16x16x32_bf16(pf, cf[0], acc[pt][0], 0, 0, 0);
            acc[pt][1] = __builtin_amdgcn_mfma_f32_16x16x32_bf16(pf, cf[1], acc[pt][1], 0, 0, 0); }
    }
    float ssq[2];
#pragma unroll
    for (int lt = 0; lt < 2; ++lt) {
        const size_t t = t0 + lt * 16 + li; const float ea = __expf(ACS[t * 8 + h]); float s = 0.f;
#pragma unroll
        for (int pt = 0; pt < 4; ++pt) {
            const int col = h * 64 + pt * 16 + 4 * g;
            const float4 yd = *(const float4*)(YD + t * 512 + col); const uint2 za = *(const uint2*)(PZ0 + t * 1024 + col), zb = *(const uint2*)(PZ1 + t * 1024 + col);
            const float z0 = __uint_as_float(za.x << 16) + __uint_as_float(zb.x << 16), z1 = __uint_as_float(za.x & 0xffff0000u) + __uint_as_float(zb.x & 0xffff0000u);
            const float z2 = __uint_as_float(za.y << 16) + __uint_as_float(zb.y << 16), z3 = __uint_as_float(za.y & 0xffff0000u) + __uint_as_float(zb.y & 0xffff0000u);
            f32x4 y; y[0] = (yd.x + ea * acc[pt][lt][0]) * siluf(z0); y[1] = (yd.y + ea * acc[pt][lt][1]) * siluf(z1);
            y[2] = (yd.z + ea * acc[pt][lt][2]) * siluf(z2); y[3] = (yd.w + ea * acc[pt][lt][3]) * siluf(z3);
            acc[pt][lt] = y; s += (y[0] * y[0] + y[1] * y[1]) + (y[2] * y[2] + y[3] * y[3]);
        }
        s += bperm(lane ^ 16, s); s += bperm(lane ^ 32, s); ssq[lt] = s;
        if (g == 0) red[h * 64 + lt * 16 + li] = s;
    }
    __syncthreads();
#pragma unroll
    for (int lt = 0; lt < 2; ++lt) {
        float tot = 0.f;
#pragma unroll
        for (int hh = 0; hh < 8; ++hh) tot += red[hh * 64 + lt * 16 + li];
        const float sc = rsqrtf(tot / 512.f + EPS);
        f32x4 o[4];
#pragma unroll
        for (int pt = 0; pt < 4; ++pt) o[pt] = acc[pt][lt];
        store_out_tile(o, sc, ng + h * 64, MIXED + (t0 + lt * 16 + li) * D + h * 64, g);
    }
}


#ifndef MOE_TR
#define MOE_TR 512
#endif
constexpr int MOE_WBUF = 16384, MOE_LDS_TAB = 155648;
__device__ __forceinline__ void glds16(const void* gsrc, unsigned lds_dst) {
    unsigned keep;
    asm volatile("s_mov_b32 %0, m0\n\ts_mov_b32 m0, %2\n\ts_nop 0\n\tglobal_load_lds_dwordx4 %1, off\n\ts_mov_b32 m0, %0" : "=&s"(keep) : "v"(gsrc), "s"(lds_dst) : "memory");
}
__device__ __forceinline__ void glds16_nt(const void* gsrc, unsigned lds_dst) {
    unsigned keep;
    asm volatile("s_mov_b32 %0, m0\n\ts_mov_b32 m0, %2\n\ts_nop 0\n\tglobal_load_lds_dwordx4 %1, off nt\n\ts_mov_b32 m0, %0" : "=&s"(keep) : "v"(gsrc), "s"(lds_dst) : "memory");
}
template <int N> __device__ __forceinline__ void vm_wait() { asm volatile("s_waitcnt vmcnt(%0)" :: "i"(N) : "memory"); }
template <bool GATEUP, int NK, int NAP>
__device__ __forceinline__ void moe_unit(const u16* __restrict__ Abase, int lda, const float* __restrict__ W0, const float* __restrict__ W1, int ldw, int wcol0, int valid,
                                         int orow0, int ocol0, u16* __restrict__ Hout, u16* __restrict__ Yout, LAS char* L, int tid) {
    constexpr int LAA = NAP == 4 ? 1 : 2, ASLOTS = LAA + 1, ASZ = NAP * 8192, WSLOTS = NAP == 2 ? 6 : 5, LAW = WSLOTS - 1, AOFF = WSLOTS * MOE_WBUF, MT = NAP * 4;
    constexpr int WAITN = 2 + (LAA - 1) * (NAP + 2);
    static_assert(NK > LAW + 1 && AOFF + ASLOTS * ASZ <= MOE_LDS_TAB && LAW >= LAA + 1, "ring geometry");
    const int wid = __builtin_amdgcn_readfirstlane(tid >> 6), lane = tid & 63, wr = wid >> 2, wc = wid & 3, li = lane & 15, g = lane >> 4;
    const LAS int* rowtab = (const LAS int*)(L + MOE_LDS_TAB);
    const unsigned Lb = (unsigned)(size_t)L;
    const u16* ap[NAP];
#pragma unroll
    for (int j = 0; j < NAP; ++j) ap[j] = Abase + (size_t)rowtab[(wid * NAP + j) * 16 + (lane >> 2)] * lda + ((lane & 3) ^ ((lane >> 4) & 3)) * 8;
    const unsigned adst = Lb + AOFF + (unsigned)(wid * NAP) * 1024u;
    const int cpc = lane & 31;
    const float* wp = (GATEUP ? ((cpc < 16 ? W0 : W1) + wcol0 + 4 * (cpc & 15)) : (W0 + wcol0 + 4 * cpc)) + (size_t)(4 * wid + (lane >> 5)) * ldw;
    const unsigned wdst = Lb + (unsigned)(wid * 2) * 1024u;
    const unsigned bfr0 = (unsigned)((8 * g) * 512 + (GATEUP ? 16 * wc + li : 32 * wc + li) * 4);
    constexpr unsigned BN1 = GATEUP ? 64 * 4 : 16 * 4;
    const unsigned afr0 = (unsigned)(AOFF + (wr * 16 + li) * 64 + ((g ^ ((li >> 2) & 3)) * 16));
    const int mrows = valid - wr * 16;
    f32x4 acc[MT][2];
#pragma unroll
    for (int m = 0; m < MT; ++m) { acc[m][0] = (f32x4){0.f, 0.f, 0.f, 0.f}; acc[m][1] = (f32x4){0.f, 0.f, 0.f, 0.f}; }
#define MOE_DMAA(slot, kt) do { _Pragma("unroll") for (int j = 0; j < NAP; ++j) glds16(ap[j] + (kt) * 32, adst + (unsigned)(slot) * ASZ + j * 1024u); } while (0)
#define MOE_DMAW(slot, kt) do { _Pragma("unroll") for (int j = 0; j < 2; ++j) glds16_nt(wp + (size_t)((kt) * 32 + 2 * j) * ldw, wdst + (unsigned)(slot) * MOE_WBUF + j * 1024u); } while (0)
#define MOE_BFRAG(dst, wslot, n) do { float c_[8]; _Pragma("unroll") for (int i = 0; i < 8; ++i) c_[i] = *(const LAS float*)(L + (wslot) * MOE_WBUF + bfr0 + (n) * BN1 + i * 512); \
        u32x4v o_; o_.x = pg8::cvt_pk_bf16(c_[0], c_[1]); o_.y = pg8::cvt_pk_bf16(c_[2], c_[3]); o_.z = pg8::cvt_pk_bf16(c_[4], c_[5]); o_.w = pg8::cvt_pk_bf16(c_[6], c_[7]); \
        dst = __builtin_bit_cast(bf16x8, o_); } while (0)
#define MOE_COMPUTE(aslot, wslot) do { bf16x8 b0, b1; MOE_BFRAG(b0, wslot, 0); MOE_BFRAG(b1, wslot, 1); \
        _Pragma("unroll") for (int mh = 0; mh < MT / 4; ++mh) { if (mh * 128 < mrows) { bf16x8 af[4]; \
            _Pragma("unroll") for (int m = 0; m < 4; ++m) af[m] = *(const LAS bf16x8*)(L + (aslot) * ASZ + afr0 + (mh * 4 + m) * 2048); \
            _Pragma("unroll") for (int m = 0; m < 4; ++m) { \
                acc[mh * 4 + m][0] = __builtin_amdgcn_mfma_f32_16x16x32_bf16(b0, af[m], acc[mh * 4 + m][0], 0, 0, 0); \
                acc[mh * 4 + m][1] = __builtin_amdgcn_mfma_f32_16x16x32_bf16(b1, af[m], acc[mh * 4 + m][1], 0, 0, 0); } } } } while (0)
    MOE_DMAA(0, 0); MOE_DMAW(0, 0);
    if (LAA == 2) { MOE_DMAA(1, 1); }
#pragma unroll
    for (int k = 1; k < LAW; ++k) MOE_DMAW(k, k);
    vm_wait<(LAA == 2 ? NAP : 0) + 2 * (LAW - 1)>();
    __builtin_amdgcn_s_barrier(); asm volatile("" ::: "memory");
    int as_cur = 0, as_iss = LAA % ASLOTS, ws_cur = 0, ws_iss = LAW;
#pragma unroll 1
    for (int kt = 0; kt < NK; ++kt) {
        const int ka = kt + LAA < NK ? kt + LAA : NK - 1, kw = kt + LAW < NK ? kt + LAW : NK - 1;
        MOE_DMAA(as_iss, ka); MOE_DMAW(ws_iss, kw);
        MOE_COMPUTE(as_cur, ws_cur);
        vm_wait<WAITN>(); asm volatile("s_waitcnt lgkmcnt(0)" ::: "memory"); __builtin_amdgcn_s_barrier(); asm volatile("" ::: "memory");
        as_cur = as_cur == ASLOTS - 1 ? 0 : as_cur + 1; as_iss = as_iss == ASLOTS - 1 ? 0 : as_iss + 1;
        ws_cur = ws_cur == WSLOTS - 1 ? 0 : ws_cur + 1; ws_iss = ws_iss == WSLOTS - 1 ? 0 : ws_iss + 1;
    }
    vm_wait<0>();
#undef MOE_DMAA
#undef MOE_DMAW
#undef MOE_BFRAG
#undef MOE_COMPUTE
#pragma unroll
    for (int m = 0; m < MT; ++m) { const int rl = (2 * m + wr) * 16 + li; const size_t row = (size_t)orow0 + rl;
        if (rl < valid) {
            if (GATEUP) { float h[4];
#pragma unroll
                for (int r = 0; r < 4; ++r) { const float gt = acc[m][0][r], up = acc[m][1][r]; h[r] = gt / (1.f + __expf(-gt)) * up; }
                *(uint2*)(Hout + row * DFF + ocol0 + wc * 16 + 4 * g) = make_uint2(pg8::cvt_pk_bf16(h[0], h[1]), pg8::cvt_pk_bf16(h[2], h[3]));
            } else {
#pragma unroll
                for (int n = 0; n < 2; ++n) *(uint2*)(Yout + row * D + ocol0 + wc * 32 + n * 16 + 4 * g) = make_uint2(pg8::cvt_pk_bf16(acc[m][n][0], acc[m][n][1]), pg8::cvt_pk_bf16(acc[m][n][2], acc[m][n][3]));
            }
        }
    }
    __syncthreads();
}
__device__ __forceinline__ int moe_tables(const int* __restrict__ cnt, LAS int* tab, int tid) {
    __syncthreads();
    if (tid < NE) tab[258 + tid] = cnt[tid];
    __syncthreads();
    if (tid == 0) { int off = 0, nb = 0;
        for (int e = 0; e < NE; ++e) { tab[e] = off; const int c = tab[258 + e]; const int n = (c + MOE_TR - 1) / MOE_TR; for (int i = 0; i < n; ++i) tab[64 + nb + i] = (e << 8) | i; nb += n; off += c; }
        tab[64 + 192] = nb; }
    __syncthreads();
    return tab[64 + 192];
}

__device__ __forceinline__ void moe_order(const int* __restrict__ cnt, LAS int* tab, int nblk, int tid) {
    if (tid < nblk) { const int em = tab[64 + tid]; const int vi = min(tab[258 + (em >> 8)] - (em & 255) * MOE_TR, MOE_TR); int rank = 0;
        for (int j = 0; j < nblk; ++j) { const int ej = tab[64 + j]; const int vj = min(tab[258 + (ej >> 8)] - (ej & 255) * MOE_TR, MOE_TR); rank += (vj > vi) || (vj == vi && j < tid); }
        tab[322 + rank] = tid; }
    __syncthreads();
}
__device__ __forceinline__ int moe_dequeue(int* ctr, LAS int* tab, int tid) {
    __syncthreads();
    if (tid == 0) tab[257] = atomicAdd(ctr, 1);
    __syncthreads();
    return tab[257];
}

template <int NTL, bool COMBINE, bool COPYIN = false>
__device__ __forceinline__ float norm_proj_unit(float* __restrict__ X, const float* __restrict__ Xin, int t0, const LAS float* gain, const float* __restrict__ Wt, u16* __restrict__ HB,
                                                LAS float* part, LAS float* ssp, int wave, int lane,
                                                const LAS int* mtab, const int* __restrict__ tok_e, const int* __restrict__ tok_pos, const float* __restrict__ tok_g, const u16* __restrict__ Yb) {
    asm volatile("" : "+v"(lane));
    const int li = lane & 15, g4 = lane >> 4, t = t0 + li; const int kb = 256 * wave + 4 * g4;
    float* xp = X + (size_t)t * D + kb;
    float4 xv[16];
    if (COPYIN) { const float* xi = Xin + (size_t)t * D + kb;
#pragma unroll
        for (int j = 0; j < 16; ++j) { xv[j] = *(const float4*)(xi + 16 * j); *(float4*)(xp + 16 * j) = xv[j]; }
    } else {
#pragma unroll
        for (int j = 0; j < 16; ++j) xv[j] = *(const float4*)(xp + 16 * j);
    }
    if (COMBINE) {
        const u16* y0 = Yb + (size_t)(mtab[tok_e[2 * t]] + tok_pos[2 * t]) * D + kb; const u16* y1 = Yb + (size_t)(mtab[tok_e[2 * t + 1]] + tok_pos[2 * t + 1]) * D + kb;
        const float g0 = tok_g[2 * t], g1 = tok_g[2 * t + 1];
#pragma unroll
        for (int j = 0; j < 16; ++j) { const uint2 ua = *(const uint2*)(y0 + 16 * j), ub = *(const uint2*)(y1 + 16 * j);
            const float4 a = make_float4(__uint_as_float(ua.x << 16), __uint_as_float(ua.x & 0xffff0000u), __uint_as_float(ua.y << 16), __uint_as_float(ua.y & 0xffff0000u));
            const float4 b = make_float4(__uint_as_float(ub.x << 16), __uint_as_float(ub.x & 0xffff0000u), __uint_as_float(ub.y << 16), __uint_as_float(ub.y & 0xffff0000u));
            xv[j].x += g0 * a.x + g1 * b.x; xv[j].y += g0 * a.y + g1 * b.y; xv[j].z += g0 * a.z + g1 * b.z; xv[j].w += g0 * a.w + g1 * b.w;
            *(float4*)(xp + 16 * j) = xv[j]; }
    }
    float ss = 0.f;
#pragma unroll
    for (int j = 0; j < 16; ++j) ss += (xv[j].x * xv[j].x + xv[j].y * xv[j].y) + (xv[j].z * xv[j].z + xv[j].w * xv[j].w);
    ss += bperm(lane ^ 16, ss); ss += bperm(lane ^ 32, ss);
    if (g4 == 0) ssp[wave * 16 + li] = ss;
    f32x4 acc[NTL];
#pragma unroll
    for (int nt = 0; nt < NTL; ++nt) acc[nt] = (f32x4){0.f, 0.f, 0.f, 0.f};
    const float* rb = Wt + (size_t)wave * (16 * NTL * 256) + lane * 4;
#pragma unroll
    for (int j = 0; j < 16; ++j) {
#pragma unroll
        for (int n0 = 0; n0 < NTL; n0 += 3) {
            constexpr int dummy_ = 0; (void)dummy_;
            float4 rv[3];
#pragma unroll
            for (int q = 0; q < 3; ++q) if (n0 + q < NTL) rv[q] = *(const float4*)(rb + (j * NTL + n0 + q) * 256);
#pragma unroll
            for (int q = 0; q < 3; ++q) if (n0 + q < NTL) acc[n0 + q] = __builtin_amdgcn_mfma_f32_16x16x4f32(xv[j].x, rv[q].x, acc[n0 + q], 0, 0, 0);
#pragma unroll
            for (int q = 0; q < 3; ++q) if (n0 + q < NTL) acc[n0 + q] = __builtin_amdgcn_mfma_f32_16x16x4f32(xv[j].y, rv[q].y, acc[n0 + q], 0, 0, 0);
#pragma unroll
            for (int q = 0; q < 3; ++q) if (n0 + q < NTL) acc[n0 + q] = __builtin_amdgcn_mfma_f32_16x16x4f32(xv[j].z, rv[q].z, acc[n0 + q], 0, 0, 0);
#pragma unroll
            for (int q = 0; q < 3; ++q) if (n0 + q < NTL) acc[n0 + q] = __builtin_amdgcn_mfma_f32_16x16x4f32(xv[j].w, rv[q].w, acc[n0 + q], 0, 0, 0);
        }
    }
#pragma unroll
    for (int nt = 0; nt < NTL; ++nt)
#pragma unroll
        for (int r = 0; r < 4; ++r) part[(wave * 16 + 4 * g4 + r) * (NTL * 16) + nt * 16 + li] = acc[nt][r];
    __syncthreads();
    float tot = 0.f;
#pragma unroll
    for (int w = 0; w < 8; ++w) tot += ssp[w * 16 + li];
    const float rs = rsqrtf(tot / D + EPS);
    u16* hp = HB + (size_t)t * D + kb; const LAS float* gq = gain + kb;
#pragma unroll
    for (int j = 0; j < 16; ++j) { const f32x4 g4v = *(const LAS f32x4*)(gq + 16 * j); const float4 gg = make_float4(g4v[0], g4v[1], g4v[2], g4v[3]);
        *(uint2*)(hp + 16 * j) = make_uint2(pk2(xv[j].x * rs * gg.x, xv[j].y * rs * gg.y), pk2(xv[j].z * rs * gg.z, xv[j].w * rs * gg.w)); }
    return rs;
}

typedef const Params __attribute__((address_space(4)))* KP;
#define PARAMS KP kp_ = (KP)__builtin_amdgcn_kernarg_segment_ptr(); asm volatile("" : "+s"(kp_)); const __attribute__((address_space(4))) Params& p = *kp_;
__global__ void __launch_bounds__(NTHR, 2) mega(Params pk_unused) {
    extern __shared__ __attribute__((aligned(16))) char smem[];
    if (threadIdx.x == 0) *(uint4*)smem = make_uint4(0u, 0u, 0u, 0u);
    __syncthreads();
    XcdBarrier bar; { PARAMS bar = xcd_barrier_post(p.bar, (volatile LAS unsigned*)smem); }
    char* lds = smem + 16;
    LAS unsigned char* glds = (LAS unsigned char*)(smem + 16);
    const int G = gridDim.x, NGW = G * NWAVE;
    const long gsize = (long)G * NTHR;
#define IDS PARAMS int tid = threadIdx.x; asm volatile("" : "+v"(tid)); const int wave = tid >> 6, lane = tid & 63; const int gw = blockIdx.x * NWAVE + wave; const long gtid = (long)blockIdx.x * NTHR + tid; (void)wave; (void)lane; (void)gw; (void)gtid;

    { IDS
        float* scr = (float*)lds + wave * (64 * 33);
        constexpr int I_A = 32 * 48, I_B = 32 * 112, I_O = 32 * 64, I_L = I_A + I_B + I_O;
        for (int it = gw; it < 2 * I_L; it += NGW) {
            const int l = it / I_L; int r = it % I_L;
            const float* Wl = p.w_in + (size_t)l * D * DIN; u16* WTl = p.WinT + (size_t)l * DP * D;
            if (r < 512)  { transpose_item(Wl, DIN, 0, D, WTl, 4096, 16, r, scr, lane); continue; } r -= 512;
            if (r < 1024) { transpose_item(Wl, DIN, 512, D, WTl, 0, 32, r, scr, lane); continue; } r -= 1024;
            if (r < 3072) { transpose_item(Wl, DIN, 1544, D, WTl, 1024, 96, r, scr, lane); continue; } r -= 3072;
            if (r < 512)  { transpose_item(Wl, DIN, 4616, D, WTl, 4608, 16, r, scr, lane); continue; } r -= 512;
            transpose_item(p.w_out + (size_t)l * D * D, D, 0, D, p.WoutT + (size_t)l * D * D, 0, 64, r, scr, lane);
        }
        for (long i = gtid; i < 2L * 80 * D; i += gsize) {
            const int l = (int)(i / (80 * D)); int r = (int)(i % (80 * D)); const int e = r & 3; r >>= 2; const int ln = r & 63; r >>= 6; const int nt = r % 5; r /= 5; const int j = r & 15, w = r >> 4;
            const int c = 16 * nt + (ln & 15), k = 256 * w + 16 * j + 4 * (ln >> 4) + e;
            const float wv = (c < 8) ? p.rg_w[(size_t)l * D * 8 + k * 8 + c] : (c < 72) ? p.re_w[(size_t)l * D * 64 + k * 64 + (c - 8)] : 0.f;
            p.RT[i] = wv * p.norm2_g[l * D + k]; }
        for (long i = gtid; i < 2L * 4 * 128 * 128; i += gsize) { const int e = (int)(i & 127), c = (int)((i >> 7) & 127); const long lg = i >> 14;
            p.WpT[(lg << 14) + e * 128 + c] = f2bf(p.pool_w[i]); }
        for (long i = gtid; i < 2L * 16 * D; i += gsize) {
            const int l = (int)(i / (16 * D)); int r = (int)(i % (16 * D)); const int e = r & 3; r >>= 2; const int ln = r & 63; r >>= 6; const int j = r & 15, w = r >> 4;
            const int c = ln & 15, k = 256 * w + 16 * j + 4 * (ln >> 4) + e;
            p.WDT[i] = c < 8 ? p.w_in[(size_t)l * D * DIN + (size_t)k * DIN + 1536 + c] * p.norm1_g[l * D + k] : 0.f; }
    }
    xcd_barrier(bar);

#pragma unroll 1
    for (int l = 0; l < 2; ++l) {
        { IDS
            LAS float* part = (LAS float*)(smem + 16); LAS float* ssp = part + 8 * 16 * 16; LAS int* mtab = (LAS int*)(ssp + 128);
            if (l > 0) moe_tables(p.ctrl + (l - 1) * 64, mtab, tid);
            const float* wdt = p.WDT + (size_t)l * 16 * D;
            LAS float* g1 = (LAS float*)(mtab + 336);
            for (int i = tid; i < D; i += NTHR) g1[i] = p.norm1_g[l * D + i];
            for (int u = blockIdx.x; u < T / 16; u += G) {
                __syncthreads();
                float rs;
                if (l > 0) rs = norm_proj_unit<1, true>(p.X, nullptr, u * 16, g1, wdt, p.HB, part, ssp, wave, lane, mtab, p.tok_e, p.tok_pos, p.tok_g, p.Yb);
                else       rs = norm_proj_unit<1, false, true>(p.X, p.x_in, u * 16, g1, wdt, p.HB, part, ssp, wave, lane, mtab, p.tok_e, p.tok_pos, p.tok_g, p.Yb);
                (void)rs;
                if (tid < 128) { const int tk = tid >> 3, q = tid & 7; float s = 0.f, tot = 0.f;
#pragma unroll
                    for (int w = 0; w < 8; ++w) { s += part[(w * 16 + tk) * 16 + q]; tot += ssp[w * 16 + tk]; }
                    p.DTR[(size_t)(u * 16 + tk) * 8 + q] = s * rsqrtf(tot / D + EPS); }
            }
        }
        xcd_barrier(bar);
        {
            PARAMS
            const u16* wt = p.WinT + (size_t)l * DP * D;
            { pg8::Gemm g{p.HB, wt, T, 4096, D, D};
              pg8::StaticOrder so; so.init(T, 4096, G, blockIdx.x);
              pg8::EpiStoreBf16 ep{p.PROJ, DP};
              pg8::gemm_phase(glds, g, so, ep, nullptr); }
            { const int kh = blockIdx.x & 1;
              pg8::Gemm g{p.HB + kh * 1024, wt + (size_t)4096 * D + kh * 1024, T, 1024, 1024, D};
              pg8::HalfOrder ho{(int)blockIdx.x, G};
              pg8::EpiStoreBf16 ep{kh ? p.PZ1 : p.PZ0, 1024};
              pg8::gemm_phase(glds, g, ho, ep, nullptr); }
        }
        xcd_barrier(bar);
        { IDS
            for (int it0 = gw; it0 < T * 2; it0 += 2 * NGW) {
                u16* base[2]; bf16x8 a[2], b[2];
#pragma unroll
                for (int q = 0; q < 2; ++q) { const int it = it0 + q * NGW < T * 2 ? it0 + q * NGW : it0; const int t = it >> 1, mix = it & 1;
                    base[q] = p.PROJ + (size_t)t * DP + (mix ? C_DIL : C_SB) + lane * 16;
                    a[q] = *(const bf16x8*)base[q]; b[q] = *(const bf16x8*)(base[q] + 8); }
#pragma unroll
                for (int q = 0; q < 2; ++q) { const int it = it0 + q * NGW; if (it < T * 2) { const int mix = it & 1;
                    const float* gp = (mix ? (lane < 32 ? p.dq_g : p.dk_g) : (lane < 32 ? p.sbq_g : p.sbk_g)) + l * 64 + (lane & 3) * 16;
                    float v[16]; float ss = 0.f;
#pragma unroll
                    for (int j = 0; j < 8; ++j) { v[j] = bf2f((u16)a[q][j]); v[8 + j] = bf2f((u16)b[q][j]); }
#pragma unroll
                    for (int j = 0; j < 16; ++j) ss += v[j] * v[j];
                    ss += swz_xor<1>(ss); ss += swz_xor<2>(ss);
                    const float r = rsqrtf(ss / 64.f + EPS) * (lane < 32 ? 0.125f : 1.f);
                    u32x4v o0, o1;
                    { const float4 g0 = *(const float4*)gp, g1 = *(const float4*)(gp + 4), g2 = *(const float4*)(gp + 8), g3 = *(const float4*)(gp + 12);
                      o0.x = pk2(v[0] * r * g0.x, v[1] * r * g0.y); o0.y = pk2(v[2] * r * g0.z, v[3] * r * g0.w); o0.z = pk2(v[4] * r * g1.x, v[5] * r * g1.y); o0.w = pk2(v[6] * r * g1.z, v[7] * r * g1.w);
                      o1.x = pk2(v[8] * r * g2.x, v[9] * r * g2.y); o1.y = pk2(v[10] * r * g2.z, v[11] * r * g2.w); o1.z = pk2(v[12] * r * g3.x, v[13] * r * g3.y); o1.w = pk2(v[14] * r * g3.z, v[15] * r * g3.w); }
                    *(u32x4v*)base[q] = o0; *(u32x4v*)(base[q] + 8) = o1; } }
            }
            for (int u = blockIdx.x; u < NB * 32 * 8; u += G) {
                const int b = u >> 8, c = (u >> 3) & 31, h = u & 7;
                ssd_chunk_unit(p.PROJ, p.DTR, p.conv_w + l * 4 * 1024, p.conv_b + l * 1024, p.dt_bias[l * 8 + h], -__expf(p.a_log[l * 8 + h]), p.ssd_d[l * 8 + h],
                               b, c, h, tid, (LAS char*)(smem + 16), p.YD, p.SS, p.ATOT, p.ACS, p.CG);
            }
            __syncthreads();
            {
                constexpr int PRS = 1040;
                LAS char* PL = (LAS char*)(smem + 16);
                const float* psc = p.pool_sc + l * 512; const u16* wpt = p.WpT + (size_t)l * 4 * 16384;
                for (int u = blockIdx.x; u < T / 32; u += G) {
                    const int tb0 = u * 32; __syncthreads();
                    { const int c = tid, gq = c >> 7, w = 2 << gq; const int s0 = tb0 % SEQ;
                      const u16* ca = p.PZ0 + (size_t)tb0 * 1024 + 512 + c; const u16* cb2 = p.PZ1 + (size_t)tb0 * 1024 + 512 + c;
                      float sum = 0.f; { const int c0 = min(w, s0 + 1); for (int i = 0; i < c0; ++i) sum += bf2f(ca[-(long)i * 1024]) + bf2f(cb2[-(long)i * 1024]); }
                      float ucur = bf2f(ca[0]) + bf2f(cb2[0]);
#pragma unroll 4
                      for (int tt = 0; tt < 32; ++tt) { const int s = s0 + tt; const int cn = min(w, s + 1);
                          *(LAS u16*)(PL + tt * PRS + c * 2) = f2bf(sum / (float)cn - ucur);
                          if (tt < 31) { ucur = bf2f(ca[(long)(tt + 1) * 1024]) + bf2f(cb2[(long)(tt + 1) * 1024]); sum += ucur; if (s + 1 >= w) sum -= bf2f(ca[(long)(tt + 1 - w) * 1024]) + bf2f(cb2[(long)(tt + 1 - w) * 1024]); } } }
                    __syncthreads();
                    const int li = lane & 15, g4 = lane >> 4, gq = wave >> 1, eh = wave & 1;
                    f32x4 acc[4][2];
#pragma unroll
                    for (int et = 0; et < 4; ++et) { acc[et][0] = (f32x4){0.f, 0.f, 0.f, 0.f}; acc[et][1] = (f32x4){0.f, 0.f, 0.f, 0.f}; }
#pragma unroll
                    for (int ks = 0; ks < 4; ++ks) {
                        bf16x8 pf[2];
#pragma unroll
                        for (int tt = 0; tt < 2; ++tt) pf[tt] = *(const LAS bf16x8*)(PL + (tt * 16 + li) * PRS + (gq * 128 + ks * 32 + g4 * 8) * 2);
#pragma unroll
                        for (int et = 0; et < 4; ++et) { const bf16x8 wf = *(const bf16x8*)(wpt + gq * 16384 + (eh * 64 + et * 16 + li) * 128 + ks * 32 + g4 * 8);
                            acc[et][0] = __builtin_amdgcn_mfma_f32_16x16x32_bf16(wf, pf[0], acc[et][0], 0, 0, 0);
                            acc[et][1] = __builtin_amdgcn_mfma_f32_16x16x32_bf16(wf, pf[1], acc[et][1], 0, 0, 0); }
                    }
#pragma unroll
                    for (int tt = 0; tt < 2; ++tt)
#pragma unroll
                        for (int et = 0; et < 4; ++et) { const int col = gq * 128 + eh * 64 + et * 16 + 4 * g4; const float4 sc = *(const float4*)(psc + col);
                            *(uint2*)(p.MIXED + (size_t)(tb0 + tt * 16 + li) * D + 1536 + col) =
                                make_uint2(pk2(acc[et][tt][0] * sc.x, acc[et][tt][1] * sc.y), pk2(acc[et][tt][2] * sc.z, acc[et][tt][3] * sc.w)); }
                }
            }
        }
        xcd_barrier(bar);
        { IDS
        {
            for (int e = (int)gtid; e < NB * 8 * 8192; e += (int)gsize) {
                const int b = e >> 16, h = (e >> 13) & 7, pn = e & 8191; float st = 0.f;
#pragma unroll 8
                for (int c = 0; c < 32; ++c) { const size_t cu = ((size_t)b * 32 + c) * 8 + h; const size_t idx = (cu << 13) + pn;
                    p.PREV[idx] = f2bf(st); st = st * __expf(p.ATOT[cu]) + p.SS[idx]; }
            }
            LAS char* vl = (LAS char*)(smem + 16) + wave * ATT_VBYTES;
            LAS float* red = (LAS float*)((LAS char*)(smem + 16) + NWAVE * ATT_VBYTES);
            LAS int* qslot = (LAS int*)(red + 1024); int* qctr = p.ctrl + 520 + l;
            int par = 0;
            for (;; par ^= 1) {
                __syncthreads();
                if (tid == 0) *qslot = atomicAdd(qctr, 1);
                __syncthreads();
                const int u = *qslot; if (u >= 512 + 256) break;
                if (u >= 512) { const int v = u - 512; sb_unit(p.PROJ, v >> 7, v & 127, wave, lane, vl, red + par * 512, p.sbo_g + l * 512, p.MIXED); }
                else dil_unit(p.PROJ, u >> 8, (u >> 4) & 15, u & 15, wave, lane, vl, red + par * 512, p.do_g + l * 512, p.MIXED);
            }
        }
        }
        xcd_barrier(bar);
        { IDS
            LAS float* red = (LAS float*)(smem + 16);
            int par = 0;
            for (int u = blockIdx.x; u < NB * 128; u += G, par ^= 1)
                ssd_out_unit(p.PZ0, p.PZ1, p.PREV, p.CG, p.YD, p.ACS, p.ssd_ng + l * 512, u >> 7, u & 127, wave, lane, red + par * 512, p.MIXED);
        }
        xcd_barrier(bar);
        {
            PARAMS
            pg8::Gemm g{p.MIXED, p.WoutT + (size_t)l * D * D, T, D, D, D};
            pg8::StaticOrder so; so.init(T, D, G, blockIdx.x);
            pg8::EpiAddF32 ep{p.X, D};
            pg8::gemm_phase(glds, g, so, ep, nullptr);
        }
        xcd_barrier(bar);
        { IDS
            const float* RTl = p.RT + (size_t)l * 80 * D; int* cnt = p.ctrl + l * 64;
            LAS float* part = (LAS float*)(smem + 16);
            LAS float* ssp = part + 8 * 16 * 80;
            LAS float* lg = ssp + 128;
            LAS float* rbias = lg + 16 * 80;
            LAS float* g2 = rbias + 128;
            for (int i = tid; i < D; i += NTHR) g2[i] = p.norm2_g[l * D + i];
            if (tid < 72) rbias[tid] = tid < 8 ? p.rg_b[l * 8 + tid] : p.re_b[l * 64 + tid - 8];
            for (int u = blockIdx.x; u < T / 16; u += G) {
                const int t0 = u * 16;
                __syncthreads();
                norm_proj_unit<5, false>(p.X, nullptr, t0, g2, RTl, p.HB, part, ssp, wave, lane, nullptr, nullptr, nullptr, nullptr, nullptr);
                for (int i = tid; i < 16 * 72; i += NTHR) { const int tk = i / 72, c = i % 72; float s = 0.f, tot = 0.f;
#pragma unroll
                    for (int w = 0; w < 8; ++w) { s += part[(w * 16 + tk) * 80 + c]; tot += ssp[w * 16 + tk]; }
                    lg[tk * 80 + c] = s * rsqrtf(tot / D + EPS) + rbias[c]; }
                __syncthreads();
                if (tid < 16) {
                    const LAS float* gl = lg + tid * 80; const int t = t0 + tid;
                    int gi = 0; float gm = gl[0];
                    for (int j = 1; j < 8; ++j) if (gl[j] > gm) { gm = gl[j]; gi = j; }
                    float gs = 0.f;
                    for (int j = 0; j < 8; ++j) gs += __expf(gl[j] - gm);
                    const float gp = 1.f / gs;
                    const LAS float* el = gl + 8 + gi * 8;
                    int i1 = 0; float m1 = el[0];
                    for (int j = 1; j < 8; ++j) if (el[j] > m1) { m1 = el[j]; i1 = j; }
                    int i2 = -1; float m2 = -1e30f;
                    for (int j = 0; j < 8; ++j) if (j != i1 && el[j] > m2) { m2 = el[j]; i2 = j; }
                    const float p2 = __expf(m2 - m1); const float ga = gp / (1.f + p2), gb = gp * p2 / (1.f + p2);
                    const int e1 = gi * 8 + i1, e2 = gi * 8 + i2;
                    p.tok_e[t * 2] = e1; p.tok_e[t * 2 + 1] = e2; p.tok_g[t * 2] = ga; p.tok_g[t * 2 + 1] = gb;
                    const int q1 = atomicAdd(&cnt[e1], 1), q2 = atomicAdd(&cnt[e2], 1);
                    p.tok_pos[t * 2] = q1; p.tok_pos[t * 2 + 1] = q2; p.tlist[e1 * T + q1] = t; p.tlist[e2 * T + q2] = t;
                }
            }
        }
        xcd_barrier(bar);
        { IDS
            LAS char* L = (LAS char*)(smem + 16); LAS int* tab = (LAS int*)(L + MOE_LDS_TAB + 2048); LAS int* rowtab = (LAS int*)(L + MOE_LDS_TAB);
            const int* cnt = p.ctrl + l * 64;
            const int nblk = moe_tables(cnt, tab, tid);
            moe_order(cnt, tab, nblk, tid);
            int* qctr = p.ctrl + 512 + l * 2; int* done = p.ctrl + 600 + l * 192;
            const int nu1 = nblk * 8, nu = nblk * 24;
            for (;;) {
                const int ui = moe_dequeue(qctr, tab, tid); if (ui >= nu) break;
                if (ui < nu1) {
                    const int mb = tab[322 + (ui >> 3)], nt = ui & 7; const int em = tab[64 + mb], e = em >> 8, mt = em & 255; const int valid = min(cnt[e] - mt * MOE_TR, MOE_TR);
                    __syncthreads();
                    { const int* tl = p.tlist + e * T + mt * MOE_TR; rowtab[tid] = tl[tid < valid ? tid : 0]; }
                    __syncthreads();
                    const size_t wo = ((size_t)l * NE + e) * (size_t)D * DFF;
                    if (valid <= 256)      moe_unit<true, D / 32, 2>(p.HB, D, p.wg + wo, p.wu + wo, DFF, nt * 64, valid, tab[e] + mt * MOE_TR, nt * 64, p.Hb, nullptr, L, tid);
                    else if (valid <= 384) moe_unit<true, D / 32, 3>(p.HB, D, p.wg + wo, p.wu + wo, DFF, nt * 64, valid, tab[e] + mt * MOE_TR, nt * 64, p.Hb, nullptr, L, tid);
                    else                   moe_unit<true, D / 32, 4>(p.HB, D, p.wg + wo, p.wu + wo, DFF, nt * 64, valid, tab[e] + mt * MOE_TR, nt * 64, p.Hb, nullptr, L, tid);
                    asm volatile("s_waitcnt vmcnt(0)" ::: "memory");
                    __syncthreads();
                    if (tid == 0) { __builtin_amdgcn_fence(__ATOMIC_RELEASE, "agent"); __hip_atomic_fetch_add(done + mb, 1, __ATOMIC_RELAXED, __HIP_MEMORY_SCOPE_AGENT); }
                } else {
                    const int di = ui - nu1;
                    const int mb = tab[322 + (di >> 4)], nt = di & 15; const int em = tab[64 + mb], e = em >> 8, mt = em & 255; const int valid = min(cnt[e] - mt * MOE_TR, MOE_TR); const int r0 = tab[e] + mt * MOE_TR;
                    if (tid == 0) { while (__hip_atomic_load(done + mb, __ATOMIC_RELAXED, __HIP_MEMORY_SCOPE_AGENT) < 8) __builtin_amdgcn_s_sleep(1); __builtin_amdgcn_fence(__ATOMIC_ACQUIRE, "agent"); }
                    __syncthreads();
                    rowtab[tid] = r0 + (tid < valid ? tid : 0);
                    __syncthreads();
                    { const float* wdp = p.wd + ((size_t)l * NE + e) * (size_t)D * DFF;
                      if (valid <= 256)      moe_unit<false, DFF / 32, 2>(p.Hb, DFF, wdp, nullptr, D, nt * 128, valid, r0, nt * 128, nullptr, p.Yb, L, tid);
                      else if (valid <= 384) moe_unit<false, DFF / 32, 3>(p.Hb, DFF, wdp, nullptr, D, nt * 128, valid, r0, nt * 128, nullptr, p.Yb, L, tid);
                      else                   moe_unit<false, DFF / 32, 4>(p.Hb, DFF, wdp, nullptr, D, nt * 128, valid, r0, nt * 128, nullptr, p.Yb, L, tid); }
                }
            }
        }
        xcd_barrier(bar);
    }
    { IDS
    LAS int* mtab = (LAS int*)(smem + 16);
    moe_tables(p.ctrl + 64, mtab, tid);
    for (int t = gw; t < T; t += NGW) {
        float4* xr = (float4*)(p.X + (size_t)t * D) + lane;
        const int r0 = mtab[p.tok_e[2 * t]] + p.tok_pos[2 * t], r1 = mtab[p.tok_e[2 * t + 1]] + p.tok_pos[2 * t + 1]; const float g0 = p.tok_g[2 * t], g1 = p.tok_g[2 * t + 1];
        const uint2* y0 = (const uint2*)(p.Yb + (size_t)r0 * D) + lane; const uint2* y1 = (const uint2*)(p.Yb + (size_t)r1 * D) + lane;
#pragma unroll
        for (int j = 0; j < 8; ++j) { float4 v = xr[64 * j]; const uint2 ua = y0[64 * j], ub = y1[64 * j];
            const float4 a = make_float4(__uint_as_float(ua.x << 16), __uint_as_float(ua.x & 0xffff0000u), __uint_as_float(ua.y << 16), __uint_as_float(ua.y & 0xffff0000u));
            const float4 b = make_float4(__uint_as_float(ub.x << 16), __uint_as_float(ub.x & 0xffff0000u), __uint_as_float(ub.y << 16), __uint_as_float(ub.y & 0xffff0000u));
            v.x += g0 * a.x + g1 * b.x; v.y += g0 * a.y + g1 * b.y; v.z += g0 * a.z + g1 * b.z; v.w += g0 * a.w + g1 * b.w; xr[64 * j] = v; }
    }
    }
}

extern "C" void kernel_launch(void* const* d_in, const int* in_sizes, int n_in, void* d_out, int out_size, void* d_ws, size_t ws_size, hipStream_t stream) {
    Params p{};
    const float** pin = (const float**)&p;
    for (int i = 0; i < 26; ++i) pin[i] = (const float*)d_in[i];
    p.X = (float*)d_out;
    char* ws = (char*)d_ws; size_t off = 0;
    auto alloc = [&](size_t bytes) { void* q = ws + off; off += (bytes + 255) & ~(size_t)255; return q; };
    constexpr size_t CTL_BYTES = (size_t)XCD_BAR_WORDS * 4 + CTRL_INTS * 4;
    p.bar = (unsigned*)alloc(CTL_BYTES); p.ctrl = (int*)(p.bar + XCD_BAR_WORDS);
    p.HB = (u16*)alloc((size_t)T * D * 2);
    p.MIXED = (u16*)alloc((size_t)T * D * 2);
    p.PROJ = (u16*)alloc((size_t)T * DP * 2);
    p.PZ0 = (u16*)alloc((size_t)T * 1024 * 2); p.PZ1 = (u16*)alloc((size_t)T * 1024 * 2);
    p.DTR = (float*)alloc((size_t)T * 8 * 4);
    p.YD = (float*)alloc((size_t)T * 512 * 4);
    p.SS = (float*)alloc((size_t)NB * 32 * 8 * 8192 * 4);
    p.PREV = (u16*)alloc((size_t)NB * 32 * 8 * 8192 * 2);
    p.ATOT = (float*)alloc((size_t)NB * 32 * 8 * 4);
    p.ACS = (float*)alloc((size_t)T * 8 * 4);
    p.CG = (u16*)alloc((size_t)T * 256 * 2);
    p.WinT = (u16*)alloc((size_t)2 * DP * D * 2);
    p.WoutT = (u16*)alloc((size_t)2 * D * D * 2);
    p.RT = (float*)alloc((size_t)2 * 80 * D * 4);
    p.WpT = (u16*)alloc((size_t)2 * 4 * 128 * 128 * 2);
    p.WDT = (float*)alloc((size_t)2 * 16 * D * 4);
    p.tok_e = (int*)alloc((size_t)T * 2 * 4); p.tok_pos = (int*)alloc((size_t)T * 2 * 4); p.tlist = (int*)alloc((size_t)NE * T * 4);
    p.tok_g = (float*)alloc((size_t)T * 2 * 4);
    p.Hb = (u16*)alloc((size_t)2 * T * DFF * 2);
    p.Yb = (u16*)alloc((size_t)2 * T * D * 2);
    static int grid = 0;
    if (grid == 0) {
        if (off > ws_size || n_in != 26) { fprintf(stderr, "kernel_launch: workspace too small (%zu > %zu) or n_in %d\n", off, ws_size, n_in); grid = -1; return; }
        int dev = 0, cus = 0, per_cu = 0;
        if (hipGetDevice(&dev) != hipSuccess || hipDeviceGetAttribute(&cus, hipDeviceAttributeMultiprocessorCount, dev) != hipSuccess) { grid = -1; return; }
        if (hipFuncSetAttribute((const void*)mega, hipFuncAttributeMaxDynamicSharedMemorySize, LDS_BYTES) != hipSuccess) { fprintf(stderr, "hipFuncSetAttribute failed\n"); grid = -1; return; }
        if (hipOccupancyMaxActiveBlocksPerMultiprocessor(&per_cu, (const void*)mega, NTHR, LDS_BYTES) != hipSuccess || per_cu < 1)
            fprintf(stderr, "kernel_launch: occupancy query reports %d blocks per CU\n", per_cu);
        (void)hipGetLastError();
        grid = cus;
    }
    if (grid < 0) return;
    if (hipMemsetAsync(p.bar, 0, CTL_BYTES, stream) != hipSuccess) return;
    hipLaunchKernelGGL(mega, dim3(grid), dim3(NTHR), LDS_BYTES, stream, p);
}
```

```cpp
#include <hip/hip_runtime.h>
#include <hip/hip_bf16.h>
#include <stdint.h>
#include <stdio.h>

typedef unsigned short u16;
using bf16x8 = __attribute__((ext_vector_type(8))) short;
using f32x4  = __attribute__((ext_vector_type(4))) float;
#define LAS __attribute__((address_space(3)))

constexpr int NB = 2, SEQ = 4096, T = NB * SEQ, D = 2048, DIN = 5128, DP = 5120;
constexpr int NE = 64, DFF = 512;
constexpr float EPS = 1e-6f;
constexpr int C_XBC = 0, C_SB = 1024, C_DIL = 2560;
constexpr int NTHR = 512, NWAVE = 8;
constexpr int LDS_BYTES = 16 + 159744 + 64 + 768;

__device__ __forceinline__ float bf2f(u16 h) { return __uint_as_float(((unsigned)h) << 16); }
__device__ __forceinline__ u16 f2bf(float f) { unsigned u = __float_as_uint(f); u += 0x7fffu + ((u >> 16) & 1u); return (u16)(u >> 16); }
__device__ __forceinline__ unsigned pk2(float lo, float hi) { return (unsigned)f2bf(lo) | ((unsigned)f2bf(hi) << 16); }
template <int O> __device__ __forceinline__ float swz_xor(float v) { return __int_as_float(__builtin_amdgcn_ds_swizzle(__float_as_int(v), (O << 10) | 0x1F)); }
__device__ __forceinline__ float rdlane(float v, int l) { return __int_as_float(__builtin_amdgcn_readlane(__float_as_int(v), l)); }
__device__ __forceinline__ float wave_sum(float v) {
    v += swz_xor<1>(v); v += swz_xor<2>(v); v += swz_xor<4>(v); v += swz_xor<8>(v); v += swz_xor<16>(v);
    return rdlane(v, 0) + rdlane(v, 32);
}
__device__ __forceinline__ float siluf(float x) { return x * __builtin_amdgcn_rcpf(1.f + __expf(-x)); }
__device__ __forceinline__ float softplusf(float x) { return fmaxf(x, 0.f) + log1pf(__expf(-fabsf(x))); }

#define XB_TMO      128
#define XB_XCNT(j)  (256  + 64 * (j))
#define XB_XSUB(j)  (1280 + 64 * (j))
#define XB_XGEN(j)  (2304 + 64 * (j))
#define XB_TOP      3328
#define XB_TOPGEN   3392
#define XCD_BAR_WORDS 3456
#define XB_SPIN_CAP (1u << 18)
__device__ __forceinline__ unsigned xb_ld(unsigned* p)              { return __hip_atomic_load(p, __ATOMIC_RELAXED, __HIP_MEMORY_SCOPE_AGENT); }
__device__ __forceinline__ unsigned xb_add(unsigned* p, unsigned v) { return __hip_atomic_fetch_add(p, v, __ATOMIC_RELAXED, __HIP_MEMORY_SCOPE_AGENT); }
__device__ __forceinline__ unsigned xb_xcc_id() { return (unsigned)__builtin_amdgcn_s_getreg((3 << 11) | 20) & 0xFu; }
#define XB_SPIN(cond, bar) do { unsigned _sp = 0; while (cond) { __builtin_amdgcn_s_sleep(1); \
    if ((++_sp & 255u) == 0u) { if (xb_ld(&(bar)[XB_TMO])) break; if (_sp > XB_SPIN_CAP) { atomicAdd(&(bar)[XB_TMO], 1u); break; } } } } while (0)
struct XcdBarrier { unsigned* bar; unsigned x; volatile LAS unsigned* st; };
__device__ __forceinline__ XcdBarrier xcd_barrier_post(unsigned* bar, volatile LAS unsigned* st) {
    XcdBarrier b; b.bar = bar; b.x = xb_xcc_id(); b.st = st;
    if (threadIdx.x == 0) (void)xb_add(&bar[XB_XCNT(b.x)], 1u);
    return b;
}
__device__ __forceinline__ void xcd_barrier_complete(unsigned* bar, unsigned x, unsigned& nloc, unsigned& nx) {
    const unsigned G = gridDim.x * gridDim.y * gridDim.z;
    unsigned sum, cnt, mine, sp = 0u;
    for (;;) {
        sum = 0u; cnt = 0u; mine = 0u;
#pragma unroll
        for (unsigned j = 0; j < 16; ++j) { const unsigned c = xb_ld(&bar[XB_XCNT(j)]); sum += c; cnt += (c > 0u) ? 1u : 0u; mine = (j == x) ? c : mine; }
        if (sum == G) break;
        __builtin_amdgcn_s_sleep(1);
        if ((++sp & 255u) == 0u) { if (xb_ld(&bar[XB_TMO])) break; if (sp > XB_SPIN_CAP) { atomicAdd(&bar[XB_TMO], 1u); break; } }
    }
    nloc = mine > 0u ? mine : 1u; nx = cnt > 0u ? cnt : 1u;
}
__device__ __forceinline__ void xcd_barrier(const XcdBarrier& b) {
    asm volatile("s_waitcnt vmcnt(0)" ::: "memory");
    __syncthreads();
    if (threadIdx.x == 0) {
        unsigned* bar = b.bar; unsigned bx = b.x;
        asm volatile("" : "+s"(bar), "+s"(bx));
        __builtin_amdgcn_s_waitcnt(0);
        unsigned nloc = b.st[0], nx = b.st[1];
        if (nloc == 0u) { xcd_barrier_complete(bar, bx, nloc, nx); b.st[0] = nloc; b.st[1] = nx; }
        const unsigned old = xb_add(&bar[XB_XSUB(bx)], 1u);
        const unsigned gen = old / nloc;
        if (old + 1u == (gen + 1u) * nloc) {
            __builtin_amdgcn_fence(__ATOMIC_RELEASE, "agent");
            asm volatile("s_waitcnt vmcnt(0)" ::: "memory");
            const unsigned og = xb_add(&bar[XB_TOP], 1u);
            const unsigned tg = og / nx;
            if (og + 1u == (tg + 1u) * nx) xb_add(&bar[XB_TOPGEN], 1u);
            else XB_SPIN(xb_ld(&bar[XB_TOPGEN]) == tg, bar);
            __builtin_amdgcn_fence(__ATOMIC_ACQUIRE, "agent");
            xb_add(&bar[XB_XGEN(bx)], 1u);
            asm volatile("s_waitcnt vmcnt(0)" ::: "memory");
        } else {
            XB_SPIN(xb_ld(&bar[XB_XGEN(bx)]) == gen, bar);
            __builtin_amdgcn_fence(__ATOMIC_ACQUIRE, "agent");
            asm volatile("s_waitcnt vmcnt(0)" ::: "memory");
        }
    }
    __syncthreads();
}

struct Params {
    const float *x_in, *norm1_g, *w_in, *conv_w, *conv_b, *dt_bias, *a_log, *ssd_d, *ssd_ng, *sbq_g, *sbk_g, *sbo_g, *dq_g, *dk_g, *do_g,
                *pool_w, *pool_sc, *w_out, *norm2_g, *rg_w, *rg_b, *re_w, *re_b, *wg, *wu, *wd;
    float* X; unsigned* bar; int* ctrl;
    u16 *HB, *MIXED, *WinT, *WoutT, *Hb;
    u16 *PROJ, *PREV, *CG, *WpT, *PZ0, *PZ1; float *DTR, *YD, *SS, *ATOT, *ACS, *RT, *WDT, *tok_g; u16* Yb;
    int *tok_e, *tok_pos, *tlist;
};
constexpr int CTRL_INTS = 1024;

namespace pg8 {
#define PG8_LAS __attribute__((address_space(3)))
typedef unsigned short bf16_t;
typedef short bf16x8 __attribute__((ext_vector_type(8)));
typedef float f32x4 __attribute__((ext_vector_type(4)));
typedef unsigned u32x4 __attribute__((ext_vector_type(4)));
constexpr int BM = 256, BK = 64, HALF = 128, HTB = HALF * BK * 2  , STAGE_BYTES = 8 * HTB, NXCD = 8, WGM = 8;

__host__ __device__ __forceinline__ int lds_byte(int r, int c) { const int st = (r >> 4) * 2 + (c >> 5), rr = r & 15, cc = c & 31, ob = rr * 64 + cc * 2; return st * 1024 + (ob ^ (((ob >> 9) & 1) << 5)); }
__host__ __device__ __forceinline__ void stage_rc(int b, int& R, int& C) { const int st = b / 1024, sb = b % 1024, swz = sb ^ (((sb >> 9) & 1) << 5); R = (st >> 1) * 16 + swz / 64; C = (st & 1) * 32 + (swz % 64) / 2; }
__host__ __device__ __forceinline__ int perm32(int rho) { const int n = rho >> 4, i = rho & 15; return 8 * (i >> 2) + 4 * n + (i & 3); }

struct Unit { int pm, pn; };
struct Gemm { const bf16_t* A; const bf16_t* Bt; int M, N, K, ld; };

struct StaticOrder {
    int nM, nN, nwg, G, c;
    __host__ __device__ void init(int M, int N, int G_, int c_) { nM = M / BM; nN = N / BM; nwg = nM * nN; G = G_; c = c_; }
    __host__ __device__ bool next(int i, Unit& u) const {
        const long L = (long)i * G + c; if (L >= nwg) return false;
        int wgid = (int)L; { const int q = nwg / NXCD, r = nwg % NXCD, xcd = wgid % NXCD, off = wgid / NXCD; wgid = (xcd < r ? xcd * (q + 1) : r * (q + 1) + (xcd - r) * q) + off; }
        const int nig = WGM * nN, gid = wgid / nig, fm = gid * WGM, gsz = (nM - fm) < WGM ? (nM - fm) : WGM;
        u.pm = fm + ((wgid % nig) % gsz); u.pn = (wgid % nig) / gsz; return true;
    }
    __device__ __forceinline__ void a_ready(const Unit&) const {}
    __device__ __forceinline__ void done(const Unit&) const {}
};
__device__ __forceinline__ unsigned cvt_pk_bf16(float lo, float hi) { unsigned r; asm volatile("v_cvt_pk_bf16_f32 %0, %1, %2" : "=v"(r) : "v"(lo), "v"(hi)); return r; }
typedef float f32x2 __attribute__((ext_vector_type(2)));
struct EpiF32 {
    static constexpr bool PERM = false, AFTER_DRAIN = false;
    float* C; int ldc; const float* bias;
    __device__ __forceinline__ void operator()(const f32x4 (&acc)[2][2][4][2], const Unit& u, int wr, int wc, int fr, int fq) const {
        const int row0 = u.pm * BM + wr * 64 + fr, col0 = u.pn * BM + wc * 32 + 4 * fq;
        f32x4 bv[2][2];
#pragma unroll
        for (int bj = 0; bj < 2; ++bj)
#pragma unroll
            for (int n = 0; n < 2; ++n) bv[bj][n] = bias ? *(const f32x4*)(bias + col0 + bj * HALF + n * 16) : (f32x4){0.f, 0.f, 0.f, 0.f};
#pragma unroll
        for (int ai = 0; ai < 2; ++ai)
#pragma unroll
            for (int m = 0; m < 4; ++m) { float* rowp = C + (size_t)(row0 + ai * HALF + m * 16) * ldc + col0;
#pragma unroll
                for (int bj = 0; bj < 2; ++bj)
#pragma unroll
                    for (int n = 0; n < 2; ++n) *(f32x4*)(rowp + bj * HALF + n * 16) = acc[ai][bj][m][n] + bv[bj][n]; }
    }
};
template <class Epi, class Sched, bool STAMP = false>
__device__ __forceinline__ void gemm_phase(PG8_LAS unsigned char* lds, const Gemm g, const Sched& S, const Epi& E, unsigned long long* stamps) {
    int tid = threadIdx.x; asm volatile("" : "+v"(tid));
    const int wid = __builtin_amdgcn_readfirstlane(tid >> 6), lane = tid & 63, wr = wid >> 2, wc = wid & 3, fr = lane & 15, fq = lane >> 4;
    const int K = g.K, nt = K / BK, LD = g.ld;
    int ts_lo = 0, ts_hi = 0, nts = 0; const unsigned long long rt_entry = STAMP ? (unsigned long long)wall_clock64() : 0ull;
#define PG8_STAMP() do { if (STAMP && wid == 0 && nts < 64) { const unsigned long long _c = (unsigned long long)clock64(); \
        ts_lo = (lane == nts) ? (int)(unsigned)_c : ts_lo; ts_hi = (lane == nts) ? (int)(unsigned)(_c >> 32) : ts_hi; ++nts; } } while (0)
    PG8_STAMP();
    unsigned voffA[2], voffB[2];
#pragma unroll
    for (int i = 0; i < 2; ++i) { int R, C; stage_rc(tid * 16 + i * 8192, R, C); const int Rb = Epi::PERM ? ((R & ~31) + perm32(R & 31)) : R;
        voffA[i] = (unsigned)(R * LD + C) * 2u; voffB[i] = (unsigned)(Rb * LD + C) * 2u; }
    const size_t kstep = (size_t)(BK * 2);
    const size_t hstep = (size_t)HALF * LD * 2;
    const size_t tstep = 2 * hstep;
    const unsigned ldsw = (unsigned)wid * 1024u;
    const int aoff = lds_byte(wr * 64 + fr, fq * 8), boff = lds_byte(wc * 32 + fr, fq * 8);
#define PG8_SA(b, h) (((b) * 2 + (h)) * HTB)
#define PG8_SB(b, h) ((4 + (b) * 2 + (h)) * HTB)
#define PG8_STAGE(bufoff, gbase, voff) do { _Pragma("unroll") for (int _i = 0; _i < 2; ++_i) \
        __builtin_amdgcn_global_load_lds((const unsigned*)((const char*)(gbase) + (voff)[_i]), (PG8_LAS unsigned*)(lds + (bufoff) + ldsw + _i * 8192), 16, 0, 0); } while (0)
#define PG8_LDA(dst, b, h) do { _Pragma("unroll") for (int m = 0; m < 4; ++m) _Pragma("unroll") for (int k = 0; k < 2; ++k) dst[m][k] = *(const PG8_LAS bf16x8*)(lds + PG8_SA(b, h) + aoff + m * 2048 + k * 1024); } while (0)
#define PG8_LDB(dst, b, h) do { _Pragma("unroll") for (int n = 0; n < 2; ++n) _Pragma("unroll") for (int k = 0; k < 2; ++k) dst[n][k] = *(const PG8_LAS bf16x8*)(lds + PG8_SB(b, h) + boff + n * 2048 + k * 1024); } while (0)
#define PG8_MMA(ai, bj, At, Bt) do { __builtin_amdgcn_s_setprio(1); _Pragma("unroll") for (int m = 0; m < 4; ++m) _Pragma("unroll") for (int n = 0; n < 2; ++n) _Pragma("unroll") for (int k = 0; k < 2; ++k) \
        acc[ai][bj][m][n] = __builtin_amdgcn_mfma_f32_16x16x32_bf16(Bt[n][k], At[m][k], acc[ai][bj][m][n], 0, 0, 0); __builtin_amdgcn_s_setprio(0); } while (0)
#define PG8_WAIT_V(n) asm volatile("s_waitcnt vmcnt(" #n ")" ::: "memory")
#define PG8_WAIT_L(n) asm volatile("s_waitcnt lgkmcnt(" #n ")" ::: "memory")
#define PG8_BAR __builtin_amdgcn_s_barrier()
#define PG8_SCHED __builtin_amdgcn_sched_barrier(0)
    Unit cur, nxt; int ui = 0;
    if (!S.next(0, cur)) return;
    f32x4 acc[2][2][4][2];
#pragma unroll
    for (int a = 0; a < 2; ++a)
#pragma unroll
        for (int b = 0; b < 2; ++b)
#pragma unroll
            for (int m = 0; m < 4; ++m)
#pragma unroll
                for (int n = 0; n < 2; ++n) acc[a][b][m][n] = (f32x4){0.f, 0.f, 0.f, 0.f};
    bf16x8 At[4][2], B0[2][2], B1[2][2];
    const char* cA = (const char*)g.A + (size_t)cur.pm * tstep; const char* cB = (const char*)g.Bt + (size_t)cur.pn * tstep;
    S.a_ready(cur);
    PG8_STAGE(PG8_SB(0, 0), cB, voffB); PG8_STAGE(PG8_SA(0, 0), cA, voffA); PG8_STAGE(PG8_SB(0, 1), cB + hstep, voffB); PG8_STAGE(PG8_SA(0, 1), cA + hstep, voffA);
    if (wr == 1) PG8_BAR;
    PG8_WAIT_V(4); PG8_BAR;
    PG8_STAGE(PG8_SB(1, 0), cB + kstep, voffB); PG8_STAGE(PG8_SA(1, 0), cA + kstep, voffA); PG8_STAGE(PG8_SB(1, 1), cB + hstep + kstep, voffB);
    PG8_WAIT_V(6); PG8_BAR;
    PG8_STAMP();
    for (;;) {
        const bool has_next = S.next(ui + 1, nxt);
        const char* nA = has_next ? (const char*)g.A + (size_t)nxt.pm * tstep : cA; const char* nB = has_next ? (const char*)g.Bt + (size_t)nxt.pn * tstep : cB;
        for (int t = 0; t < nt; t += 2) {
            const bool last = (t == nt - 2);
            const char* a1 = cA + (size_t)(t + 1) * kstep;
            const char* a2 = last ? nA : cA + (size_t)(t + 2) * kstep; const char* b2 = last ? nB : cB + (size_t)(t + 2) * kstep;
            const char* a3 = a2 + kstep; const char* b3 = b2 + kstep;
            if (last && has_next) S.a_ready(nxt);
            PG8_LDB(B0, 0, 0); PG8_SCHED; PG8_LDA(At, 0, 0); PG8_STAGE(PG8_SA(1, 1), a1 + hstep, voffA);
            PG8_WAIT_L(8); PG8_BAR; PG8_WAIT_L(0); PG8_MMA(0, 0, At, B0); PG8_BAR; PG8_SCHED;
            PG8_LDB(B1, 0, 1); PG8_STAGE(PG8_SB(0, 0), b2, voffB);
            PG8_BAR; PG8_WAIT_L(0); PG8_MMA(0, 1, At, B1); PG8_BAR;
            PG8_LDA(At, 0, 1); PG8_STAGE(PG8_SA(0, 0), a2, voffA);
            PG8_BAR; PG8_WAIT_L(0); PG8_MMA(1, 0, At, B0); PG8_BAR; PG8_SCHED;
            PG8_STAGE(PG8_SB(0, 1), b2 + hstep, voffB);
            PG8_WAIT_V(6); PG8_BAR; PG8_MMA(1, 1, At, B1); PG8_BAR;
            PG8_LDB(B0, 1, 0); PG8_SCHED; PG8_LDA(At, 1, 0); PG8_STAGE(PG8_SA(0, 1), a2 + hstep, voffA);
            PG8_WAIT_L(8); PG8_BAR; PG8_WAIT_L(0); PG8_MMA(0, 0, At, B0); PG8_BAR; PG8_SCHED;
            PG8_LDB(B1, 1, 1); PG8_STAGE(PG8_SB(1, 0), b3, voffB);
            PG8_BAR; PG8_WAIT_L(0); PG8_MMA(0, 1, At, B1); PG8_BAR;
            PG8_LDA(At, 1, 1); PG8_STAGE(PG8_SA(1, 0), a3, voffA);
            PG8_BAR; PG8_WAIT_L(0); PG8_MMA(1, 0, At, B0); PG8_BAR; PG8_SCHED;
            PG8_STAGE(PG8_SB(1, 1), b3 + hstep, voffB);
            PG8_WAIT_V(6); PG8_BAR; PG8_MMA(1, 1, At, B1); PG8_BAR;
        }
        PG8_STAMP();
        if constexpr (!Epi::AFTER_DRAIN) { E(acc, cur, wr, wc, fr, fq); S.done(cur); }
        PG8_STAMP();
        if (!has_next) break;
#pragma unroll
        for (int a = 0; a < 2; ++a)
#pragma unroll
            for (int b = 0; b < 2; ++b)
#pragma unroll
                for (int m = 0; m < 4; ++m)
#pragma unroll
                    for (int n = 0; n < 2; ++n) acc[a][b][m][n] = (f32x4){0.f, 0.f, 0.f, 0.f};
        cur = nxt; cA = nA; cB = nB; ++ui;
    }
    PG8_WAIT_V(0);
    if (wr == 0) PG8_BAR;
    PG8_BAR;
    if constexpr (Epi::AFTER_DRAIN) { E.fused(acc, cur, wr, wc, fr, fq, lds, wid, lane); S.done(cur); }
    PG8_STAMP();
    if (STAMP && wid == 0) { stamps[lane] = lane < nts ? (((unsigned long long)(unsigned)ts_hi << 32) | (unsigned)ts_lo) : 0ull;
        if (lane == 62) stamps[62] = rt_entry; if (lane == 63) stamps[63] = (unsigned long long)wall_clock64(); }
#undef PG8_STAMP
#undef PG8_SA
#undef PG8_SB
#undef PG8_STAGE
#undef PG8_LDA
#undef PG8_LDB
#undef PG8_MMA
#undef PG8_WAIT_V
#undef PG8_WAIT_L
#undef PG8_BAR
#undef PG8_SCHED
}
}

namespace pg8 {
struct EpiStoreBf16 {
    static constexpr bool PERM = true, AFTER_DRAIN = false;
    bf16_t* O; int ldc;
    __device__ __forceinline__ void operator()(const f32x4 (&acc)[2][2][4][2], const Unit& u, int wr, int wc, int fr, int fq) const {
        const int row0 = u.pm * BM + wr * 64 + fr, col0 = u.pn * BM + wc * 32 + 8 * fq;
#pragma unroll
        for (int ai = 0; ai < 2; ++ai)
#pragma unroll
            for (int m = 0; m < 4; ++m) { bf16_t* rowp = O + (size_t)(row0 + ai * HALF + m * 16) * ldc + col0;
#pragma unroll
                for (int bj = 0; bj < 2; ++bj) { const f32x4 v0 = acc[ai][bj][m][0], v1 = acc[ai][bj][m][1];
                    u32x4 w; w.x = cvt_pk_bf16(v0[0], v0[1]); w.y = cvt_pk_bf16(v0[2], v0[3]); w.z = cvt_pk_bf16(v1[0], v1[1]); w.w = cvt_pk_bf16(v1[2], v1[3]);
                    *(u32x4*)(rowp + bj * HALF) = w; } }
    }
};
struct EpiAddF32 {
    static constexpr bool PERM = false, AFTER_DRAIN = false;
    float* C; const float* Cin; int ldc;
    __device__ __forceinline__ void operator()(const f32x4 (&acc)[2][2][4][2], const Unit& u, int wr, int wc, int fr, int fq) const {
        const int row0 = u.pm * BM + wr * 64 + fr, col0 = u.pn * BM + wc * 32 + 4 * fq;
#pragma unroll
        for (int ai = 0; ai < 2; ++ai) {
            f32x4 v[4][2][2];
#pragma unroll
            for (int m = 0; m < 4; ++m) { const float* rowp = Cin + (size_t)(row0 + ai * HALF + m * 16) * ldc + col0;
#pragma unroll
                for (int bj = 0; bj < 2; ++bj)
#pragma unroll
                    for (int n = 0; n < 2; ++n) v[m][bj][n] = *(const f32x4*)(rowp + bj * HALF + n * 16); }
#pragma unroll
            for (int m = 0; m < 4; ++m) { float* rowp = C + (size_t)(row0 + ai * HALF + m * 16) * ldc + col0;
#pragma unroll
                for (int bj = 0; bj < 2; ++bj)
#pragma unroll
                    for (int n = 0; n < 2; ++n) *(f32x4*)(rowp + bj * HALF + n * 16) = v[m][bj][n] + acc[ai][bj][m][n]; }
        }
    }
};
struct EpiDownF32 {
    static constexpr bool PERM = false, AFTER_DRAIN = false;
    float* C;
    __device__ __forceinline__ void operator()(const f32x4 (&acc)[2][2][4][2], const Unit& u, int wr, int wc, int fr, int fq) const {
        const int row0 = u.pm * BM + wr * 64 + fr, col0 = (u.pn & 7) * BM + wc * 32 + 4 * fq;
#pragma unroll
        for (int ai = 0; ai < 2; ++ai)
#pragma unroll
            for (int m = 0; m < 4; ++m) { float* rowp = C + (size_t)(row0 + ai * HALF + m * 16) * 2048 + col0;
#pragma unroll
                for (int bj = 0; bj < 2; ++bj)
#pragma unroll
                    for (int n = 0; n < 2; ++n) *(f32x4*)(rowp + bj * HALF + n * 16) = acc[ai][bj][m][n]; }
    }
};
struct EpiSwiglu {
    static constexpr bool PERM = true, AFTER_DRAIN = false;
    bf16_t* H;
    __device__ __forceinline__ void operator()(const f32x4 (&acc)[2][2][4][2], const Unit& u, int wr, int wc, int fr, int fq) const {
        const int row0 = u.pm * BM + wr * 64 + fr, col0 = (u.pn & 3) * 128 + wc * 32 + 8 * fq;
#pragma unroll
        for (int ai = 0; ai < 2; ++ai)
#pragma unroll
            for (int m = 0; m < 4; ++m) { bf16_t* rowp = H + (size_t)(row0 + ai * HALF + m * 16) * 512 + col0;
                float h[8];
#pragma unroll
                for (int n = 0; n < 2; ++n)
#pragma unroll
                    for (int j = 0; j < 4; ++j) { const float g = acc[ai][0][m][n][j], up = acc[ai][1][m][n][j]; h[n * 4 + j] = g / (1.f + __expf(-g)) * up; }
                u32x4 w; w.x = cvt_pk_bf16(h[0], h[1]); w.y = cvt_pk_bf16(h[2], h[3]); w.z = cvt_pk_bf16(h[4], h[5]); w.w = cvt_pk_bf16(h[6], h[7]);
                *(u32x4*)rowp = w; }
    }
};
struct HalfOrder {
    int c, G;
    __device__ __forceinline__ bool next(int i, Unit& u) const { const int L = i * G + c; if (L >= 256) return false; u.pm = (L >> 1) >> 2; u.pn = (L >> 1) & 3; return true; }
    __device__ __forceinline__ void a_ready(const Unit&) const {}
    __device__ __forceinline__ void done(const Unit&) const {}
};
struct MoeOrder {
    const int* blk_e; int ntile, G, c, shift;
    __device__ __forceinline__ bool next(int i, Unit& u) const {
        const int L = i * G + c; if (L >= ntile) return false;
        const int mb = L >> shift, nt = L & ((1 << shift) - 1);
        u.pm = mb; u.pn = (blk_e[mb] << shift) + nt; return true;
    }
    __device__ __forceinline__ void a_ready(const Unit&) const {}
    __device__ __forceinline__ void done(const Unit&) const {}
};
}

__device__ __forceinline__ void transpose_item(const float* __restrict__ W, int ldin, int n0, int K, u16* __restrict__ WT, int row0, int nbn, int item, float* scr, int lane, int ilv = -1) {
    const int kb = item / nbn, nb = item % nbn, k0 = 64 * kb, nn = 32 * nb;
    const int rb = ilv < 0 ? row0 + nn : row0 + (nn >> 7) * 256 + ilv * 128 + (nn & 127);
#pragma unroll 8
    for (int i = 0; i < 32; ++i) { const int kk = 2 * i + (lane >> 5); scr[kk * 33 + (lane & 31)] = __builtin_nontemporal_load(&W[(size_t)(k0 + kk) * ldin + n0 + nn + (lane & 31)]); }
    asm volatile("s_waitcnt lgkmcnt(0)" ::: "memory");
    const int c = lane & 7;
#pragma unroll
    for (int j = 0; j < 4; ++j) { const int n = (lane >> 3) + 8 * j; const float* s = scr + (8 * c) * 33 + n;
        uint4 o; o.x = pk2(s[0 * 33], s[1 * 33]); o.y = pk2(s[2 * 33], s[3 * 33]); o.z = pk2(s[4 * 33], s[5 * 33]); o.w = pk2(s[6 * 33], s[7 * 33]);
        *(uint4*)(WT + (size_t)(rb + n) * K + k0 + 8 * c) = o; }
    asm volatile("s_waitcnt lgkmcnt(0)" ::: "memory");
}
__device__ __forceinline__ void convert_moe_weights(const float* wg, const float* wu, const float* wd, u16* WguT, u16* WdT, int l, float* scr, int gw, int NGW, int lane) {
    constexpr int IPE = 512;
    for (int it = gw; it < 3 * NE * IPE; it += NGW) {
        const int which = it / (NE * IPE), r = it % (NE * IPE), e = r / IPE, item = r % IPE;
        const size_t eo = ((size_t)l * NE + e) * (size_t)D * DFF;
        if (which == 0)      transpose_item(wg + eo, DFF, 0, D, WguT + (size_t)e * 1024 * D, 0, DFF / 32, item, scr, lane, 0);
        else if (which == 1) transpose_item(wu + eo, DFF, 0, D, WguT + (size_t)e * 1024 * D, 0, DFF / 32, item, scr, lane, 1);
        else                 transpose_item(wd + eo, D, 0, DFF, WdT + (size_t)e * D * DFF, 0, D / 32, item, scr, lane);
    }
}


constexpr int ATT_RS = 144;
constexpr int ATT_VBYTES = 32 * ATT_RS;
typedef long long i64;
typedef unsigned u32x4v __attribute__((ext_vector_type(4)));
typedef int i32x4v __attribute__((ext_vector_type(4)));
typedef unsigned u32x2v __attribute__((ext_vector_type(2)));
__device__ __forceinline__ float bperm(int srclane, float v) { return __int_as_float(__builtin_amdgcn_ds_bpermute(srclane << 2, __float_as_int(v))); }
__device__ __forceinline__ float softplus_fast(float z) { return fmaxf(z, 0.f) + __logf(1.f + __expf(-fabsf(z))); }
__device__ __forceinline__ void vt_frags(unsigned vaddr, int lane, bf16x8 (&vf)[4]) {
    const unsigned a = vaddr + (unsigned)((4 * (lane >> 4) + ((lane & 15) >> 2)) * ATT_RS + (lane & 3) * 8);
    i64 r0, r1, r2, r3, r4, r5, r6, r7;
    asm volatile("s_waitcnt lgkmcnt(0)\n\t"
                 "ds_read_b64_tr_b16 %0, %8\n\tds_read_b64_tr_b16 %1, %8 offset:2304\n\t"
                 "ds_read_b64_tr_b16 %2, %8 offset:32\n\tds_read_b64_tr_b16 %3, %8 offset:2336\n\t"
                 "ds_read_b64_tr_b16 %4, %8 offset:64\n\tds_read_b64_tr_b16 %5, %8 offset:2368\n\t"
                 "ds_read_b64_tr_b16 %6, %8 offset:96\n\tds_read_b64_tr_b16 %7, %8 offset:2400\n\t"
                 "s_waitcnt lgkmcnt(0)"
                 : "=&v"(r0), "=&v"(r1), "=&v"(r2), "=&v"(r3), "=&v"(r4), "=&v"(r5), "=&v"(r6), "=&v"(r7) : "v"(a) : "memory");
    typedef i64 i64x2 __attribute__((ext_vector_type(2)));
    i64x2 t; t.x = r0; t.y = r1; vf[0] = __builtin_bit_cast(bf16x8, t); t.x = r2; t.y = r3; vf[1] = __builtin_bit_cast(bf16x8, t);
    t.x = r4; t.y = r5; vf[2] = __builtin_bit_cast(bf16x8, t); t.x = r6; t.y = r7; vf[3] = __builtin_bit_cast(bf16x8, t);
}
__device__ __forceinline__ bf16x8 pack8(const float (&a)[4], const float (&b)[4]) {
    u32x4v w; w.x = pk2(a[0], a[1]); w.y = pk2(a[2], a[3]); w.z = pk2(b[0], b[1]); w.w = pk2(b[2], b[3]);
    return __builtin_bit_cast(bf16x8, w);
}
__device__ __forceinline__ void store_out_tile(const f32x4 (&o)[4], float scale, const float* __restrict__ gain, u16* __restrict__ dst  , int g) {
#pragma unroll
    for (int dt = 0; dt < 4; ++dt) { const float4 gg = *(const float4*)(gain + dt * 16 + 4 * g);
        *(uint2*)(dst + dt * 16 + 4 * g) = make_uint2(pk2(o[dt][0] * scale * gg.x, o[dt][1] * scale * gg.y), pk2(o[dt][2] * scale * gg.z, o[dt][3] * scale * gg.w)); }
}

__device__ __forceinline__ void qnorm_frags(bf16x8 (&qf)[2], const float* __restrict__ gq, int lane, int g) {
    float v[2][8]; float ss = 0.f;
#pragma unroll
    for (int s = 0; s < 2; ++s)
#pragma unroll
        for (int j = 0; j < 8; ++j) { v[s][j] = bf2f((u16)qf[s][j]); ss += v[s][j] * v[s][j]; }
    ss += bperm(lane ^ 16, ss); ss += bperm(lane ^ 32, ss);
    const float r = rsqrtf(ss / 64.f + EPS) * 0.125f;
#pragma unroll
    for (int s = 0; s < 2; ++s) { const float4 g0 = *(const float4*)(gq + 32 * s + 8 * g), g1 = *(const float4*)(gq + 32 * s + 8 * g + 4);
        u32x4v o; o.x = pk2(v[s][0] * r * g0.x, v[s][1] * r * g0.y); o.y = pk2(v[s][2] * r * g0.z, v[s][3] * r * g0.w); o.z = pk2(v[s][4] * r * g1.x, v[s][5] * r * g1.y); o.w = pk2(v[s][6] * r * g1.z, v[s][7] * r * g1.w);
        qf[s] = __builtin_bit_cast(bf16x8, o); }
}

__device__ __forceinline__ void sb_unit(const u16* __restrict__ PROJ, int b, int qb, int h, int lane, LAS char* vl, LAS float* red,
                                        const float* __restrict__ gout, u16* __restrict__ MIXED, const float* __restrict__ gq) {
    const int li = lane & 15, g = lane >> 4; const size_t tb = (size_t)b * SEQ; const int q0 = qb * 32;
    const u16* Qp = PROJ + C_SB + h * 64; const u16* Kp = Qp + 512; const u16* Vp = Qp + 1024;
    const unsigned vaddr = (unsigned)(size_t)vl;
    bf16x8 qf[2][2];
#pragma unroll
    for (int qt = 0; qt < 2; ++qt)
#pragma unroll
        for (int s = 0; s < 2; ++s) qf[qt][s] = *(const bf16x8*)(Qp + (tb + q0 + qt * 16 + li) * DP + 32 * s + 8 * g);
    qnorm_frags(qf[0], gq, lane, g); qnorm_frags(qf[1], gq, lane, g);
    f32x4 acc[2][4];
#pragma unroll
    for (int qt = 0; qt < 2; ++qt)
#pragma unroll
        for (int dt = 0; dt < 4; ++dt) acc[qt][dt] = (f32x4){0.f, 0.f, 0.f, 0.f};
    float carry[2] = {0.f, 0.f};
    bf16x8 kn[2][2]; u32x4v vn[4];
#define SB_LOAD(kk) do { _Pragma("unroll") for (int kt = 0; kt < 2; ++kt) _Pragma("unroll") for (int s = 0; s < 2; ++s) kn[kt][s] = *(const bf16x8*)(Kp + (tb + (kk) + kt * 16 + li) * DP + 32 * s + 8 * g); \
        _Pragma("unroll") for (int u = 0; u < 4; ++u) { const int c = lane + 64 * u; vn[u] = *(const u32x4v*)(Vp + (tb + (kk) + (c >> 3)) * DP + (c & 7) * 8); } } while (0)
    SB_LOAD(q0);
    for (int k0 = q0; k0 >= 0; k0 -= 32) {
        bf16x8 kf[2][2];
#pragma unroll
        for (int kt = 0; kt < 2; ++kt)
#pragma unroll
            for (int s = 0; s < 2; ++s) kf[kt][s] = kn[kt][s];
#pragma unroll
        for (int u = 0; u < 4; ++u) { const int c = lane + 64 * u; *(LAS u32x4v*)(vl + (c >> 3) * ATT_RS + (c & 7) * 16) = vn[u]; }
        if (k0 >= 32) SB_LOAD(k0 - 32);
        bf16x8 pf[2];
#pragma unroll
        for (int qt = 0; qt < 2; ++qt) {
            const int qpos = q0 + qt * 16 + li;
            float w[2][4];
#pragma unroll
            for (int kt = 1; kt >= 0; --kt) {
                f32x4 st = __builtin_amdgcn_mfma_f32_16x16x32_bf16(kf[kt][0], qf[qt][0], (f32x4){0.f, 0.f, 0.f, 0.f}, 0, 0, 0);
                st = __builtin_amdgcn_mfma_f32_16x16x32_bf16(kf[kt][1], qf[qt][1], st, 0, 0, 0);
                const int kb = k0 + kt * 16 + 4 * g;
                float sp[4];
#pragma unroll
                for (int r = 0; r < 4; ++r) sp[r] = (kb + r < qpos) ? softplus_fast(st[r]) : 0.f;
                const float G = (sp[0] + sp[1]) + (sp[2] + sp[3]);
                const float x1 = bperm(lane ^ 16, G), hs = G + x1, x2 = bperm(lane ^ 32, hs);
                float rs = carry[qt] + (g == 3 ? 0.f : g == 2 ? x1 : g == 1 ? x2 : x1 + x2);
#pragma unroll
                for (int r = 3; r >= 0; --r) { w[kt][r] = (kb + r < qpos) ? __expf(st[r] - sp[r] - rs) : 0.f; rs += sp[r]; }
                carry[qt] += hs + x2;
            }
            pf[qt] = pack8(w[0], w[1]);
        }
        bf16x8 vf[4]; vt_frags(vaddr, lane, vf);
#pragma unroll
        for (int qt = 0; qt < 2; ++qt)
#pragma unroll
            for (int dt = 0; dt < 4; ++dt) acc[qt][dt] = __builtin_amdgcn_mfma_f32_16x16x32_bf16(vf[dt], pf[qt], acc[qt][dt], 0, 0, 0);
        if (k0 + 32 <= q0 && __all(fminf(carry[0], carry[1]) > 104.f)) break;
    }
#undef SB_LOAD
    float ss[2];
#pragma unroll
    for (int qt = 0; qt < 2; ++qt) { float s = 0.f;
#pragma unroll
        for (int dt = 0; dt < 4; ++dt) s += (acc[qt][dt][0] * acc[qt][dt][0] + acc[qt][dt][1] * acc[qt][dt][1]) + (acc[qt][dt][2] * acc[qt][dt][2] + acc[qt][dt][3] * acc[qt][dt][3]);
        s += bperm(lane ^ 16, s); s += bperm(lane ^ 32, s); ss[qt] = s;
        if (g == 0) red[h * 64 + qt * 16 + li] = s; }
    __syncthreads();
#pragma unroll
    for (int qt = 0; qt < 2; ++qt) { float tot = 0.f;
#pragma unroll
        for (int hh = 0; hh < 8; ++hh) tot += red[hh * 64 + qt * 16 + li];
        const float sc = rsqrtf(tot / 512.f + EPS);
        store_out_tile(acc[qt], sc, gout + h * 64, MIXED + (tb + q0 + qt * 16 + li) * D + 512 + h * 64, g); }
}

__device__ __forceinline__ void dil_tile_step(const bf16x8 (&kf)[2][2], const bf16x8 (&qf)[2], const bf16x8 (&vf)[4], f32x4 (&acc)[4], float& mrun, float& lrun,
                                              int m0, int rat, int base, int dsh, int lane, int g) {
    float z[2][4]; bool ok[2][4]; float zmax = -1e30f;
#pragma unroll
    for (int kt = 0; kt < 2; ++kt) {
        f32x4 st = __builtin_amdgcn_mfma_f32_16x16x32_bf16(kf[kt][0], qf[0], (f32x4){0.f, 0.f, 0.f, 0.f}, 0, 0, 0);
        st = __builtin_amdgcn_mfma_f32_16x16x32_bf16(kf[kt][1], qf[1], st, 0, 0, 0);
#pragma unroll
        for (int rr = 0; rr < 4; ++rr) { const int m = m0 + kt * 16 + 4 * g + rr; const int dm = m - rat;
            ok[kt][rr] = (dm >= 0) && (dm <= 128) && (base + (m << dsh) >= 0);
            z[kt][rr] = st[rr]; if (ok[kt][rr]) zmax = fmaxf(zmax, st[rr]); }
    }
    zmax = fmaxf(zmax, bperm(lane ^ 16, zmax)); zmax = fmaxf(zmax, bperm(lane ^ 32, zmax));
    const float mn = fmaxf(mrun, zmax); const float al = __expf(mrun - mn); mrun = mn;
    float pw[2][4]; float ps = 0.f;
#pragma unroll
    for (int kt = 0; kt < 2; ++kt)
#pragma unroll
        for (int rr = 0; rr < 4; ++rr) { pw[kt][rr] = ok[kt][rr] ? __expf(z[kt][rr] - mn) : 0.f; ps += pw[kt][rr]; }
    lrun = lrun * al + ps;
#pragma unroll
    for (int dt = 0; dt < 4; ++dt) acc[dt] = acc[dt] * al;
    const bf16x8 pf = pack8(pw[0], pw[1]);
#pragma unroll
    for (int dt = 0; dt < 4; ++dt) acc[dt] = __builtin_amdgcn_mfma_f32_16x16x32_bf16(vf[dt], pf, acc[dt], 0, 0, 0);
}
__device__ __forceinline__ void dil_unit(const u16* __restrict__ PROJ, int b, int w, int r, int h, int lane, LAS char* vl, LAS float* red,
                                         const float* __restrict__ gout, u16* __restrict__ MIXED, const float* __restrict__ gq) {
    const int li = lane & 15, g = lane >> 4; const size_t tb = (size_t)b * SEQ; const int qpos = w * 256 + r + 16 * li;
    const u16* Qp = PROJ + C_DIL + h * 64; const u16* Kp = Qp + 512; const u16* Vp = Qp + 1024;
    const unsigned vaddr = (unsigned)(size_t)vl;
    bf16x8 qf0[2], qf1[2];
#pragma unroll
    for (int s = 0; s < 2; ++s) { qf0[s] = *(const bf16x8*)(Qp + (tb + qpos) * DP + 32 * s + 8 * g); qf1[s] = *(const bf16x8*)(Qp + (tb + qpos + 8) * DP + 32 * s + 8 * g); }
    qnorm_frags(qf0, gq, lane, g); qnorm_frags(qf1, gq, lane, g);
    f32x4 acc0[4], acc1[4];
#pragma unroll
    for (int dt = 0; dt < 4; ++dt) { acc0[dt] = (f32x4){0.f, 0.f, 0.f, 0.f}; acc1[dt] = (f32x4){0.f, 0.f, 0.f, 0.f}; }
    float mrun0 = -1e30f, lrun0 = 0.f, mrun1 = -1e30f, lrun1 = 0.f;
#pragma unroll 1
    for (int ps_ = 0; ps_ < 4; ++ps_) {
        const int dsh = ps_ < 2 ? 4 : ps_ == 2 ? 2 : 0;
        const int nstep = ps_ < 2 ? 5 : ps_ == 2 ? 6 : 12;
        const bool t0 = ps_ != 1, t1 = ps_ != 0;
        const int base = w * 256 + r + (ps_ == 1 ? 8 : 0) - (128 << dsh);
        const int rat = li << (4 - dsh);
        const int rat1 = rat + (ps_ >= 2 ? (8 >> dsh) : 0);
        const int nbf = base < 0 ? ((-base + (1 << dsh) - 1) >> dsh) : 0;
        const int sbeg = nbf >> 5;
        bf16x8 kn[2][2]; u32x4v vn[4];
#define DIL_LOAD(mm) do { _Pragma("unroll") for (int kt = 0; kt < 2; ++kt) { int pos = base + (((mm) + kt * 16 + li) << dsh); pos = min(max(pos, 0), SEQ - 1); \
            _Pragma("unroll") for (int s = 0; s < 2; ++s) kn[kt][s] = *(const bf16x8*)(Kp + (tb + pos) * DP + 32 * s + 8 * g); } \
        _Pragma("unroll") for (int u = 0; u < 4; ++u) { const int c = lane + 64 * u; int pos = base + (((mm) + (c >> 3)) << dsh); pos = min(max(pos, 0), SEQ - 1); \
            vn[u] = *(const u32x4v*)(Vp + (tb + pos) * DP + (c & 7) * 8); } } while (0)
        DIL_LOAD(sbeg * 32);
#pragma unroll 1
        for (int st_ = sbeg; st_ < nstep; ++st_) {
            const int m0 = st_ * 32;
            bf16x8 kf[2][2];
#pragma unroll
            for (int kt = 0; kt < 2; ++kt)
#pragma unroll
                for (int s = 0; s < 2; ++s) kf[kt][s] = kn[kt][s];
#pragma unroll
            for (int u = 0; u < 4; ++u) { const int c = lane + 64 * u; *(LAS u32x4v*)(vl + (c >> 3) * ATT_RS + (c & 7) * 16) = vn[u]; }
            if (st_ + 1 < nstep) DIL_LOAD(m0 + 32);
            bf16x8 vf[4]; vt_frags(vaddr, lane, vf);
            if (t0) dil_tile_step(kf, qf0, vf, acc0, mrun0, lrun0, m0, rat, base, dsh, lane, g);
            if (t1) dil_tile_step(kf, qf1, vf, acc1, mrun1, lrun1, m0, rat1, base, dsh, lane, g);
        }
    }
#undef DIL_LOAD
    lrun0 += bperm(lane ^ 16, lrun0); lrun0 += bperm(lane ^ 32, lrun0); lrun1 += bperm(lane ^ 16, lrun1); lrun1 += bperm(lane ^ 32, lrun1);
    const float inv0 = 1.f / lrun0, inv1 = 1.f / lrun1;
    float s0 = 0.f, s1 = 0.f;
#pragma unroll
    for (int dt = 0; dt < 4; ++dt) { acc0[dt] = acc0[dt] * inv0; s0 += (acc0[dt][0] * acc0[dt][0] + acc0[dt][1] * acc0[dt][1]) + (acc0[dt][2] * acc0[dt][2] + acc0[dt][3] * acc0[dt][3]);
                                     acc1[dt] = acc1[dt] * inv1; s1 += (acc1[dt][0] * acc1[dt][0] + acc1[dt][1] * acc1[dt][1]) + (acc1[dt][2] * acc1[dt][2] + acc1[dt][3] * acc1[dt][3]); }
    s0 += bperm(lane ^ 16, s0); s0 += bperm(lane ^ 32, s0); s1 += bperm(lane ^ 16, s1); s1 += bperm(lane ^ 32, s1);
    if (g == 0) { red[h * 64 + li] = s0; red[h * 64 + 16 + li] = s1; }
    __syncthreads();
    float tot0 = 0.f, tot1 = 0.f;
#pragma unroll
    for (int hh = 0; hh < 8; ++hh) { tot0 += red[hh * 64 + li]; tot1 += red[hh * 64 + 16 + li]; }
    store_out_tile(acc0, rsqrtf(tot0 / 512.f + EPS), gout + h * 64, MIXED + (tb + qpos) * D + 1024 + h * 64, g);
    store_out_tile(acc1, rsqrtf(tot1 / 512.f + EPS), gout + h * 64, MIXED + (tb + qpos + 8) * D + 1024 + h * 64, g);
}


template <int RS> __device__ __forceinline__ void tr_frags4(unsigned addr, int lane, bf16x8 (&f)[4]) {
    const unsigned a = addr + (unsigned)((4 * (lane >> 4) + ((lane & 15) >> 2)) * RS + (lane & 3) * 8);
    i64 r0, r1, r2, r3, r4, r5, r6, r7;
    asm volatile("s_waitcnt lgkmcnt(0)\n\t"
                 "ds_read_b64_tr_b16 %0, %8\n\tds_read_b64_tr_b16 %1, %8 offset:%9\n\t"
                 "ds_read_b64_tr_b16 %2, %8 offset:32\n\tds_read_b64_tr_b16 %3, %8 offset:%10\n\t"
                 "ds_read_b64_tr_b16 %4, %8 offset:64\n\tds_read_b64_tr_b16 %5, %8 offset:%11\n\t"
                 "ds_read_b64_tr_b16 %6, %8 offset:96\n\tds_read_b64_tr_b16 %7, %8 offset:%12\n\t"
                 "s_waitcnt lgkmcnt(0)"
                 : "=&v"(r0), "=&v"(r1), "=&v"(r2), "=&v"(r3), "=&v"(r4), "=&v"(r5), "=&v"(r6), "=&v"(r7)
                 : "v"(a), "i"(16 * RS), "i"(16 * RS + 32), "i"(16 * RS + 64), "i"(16 * RS + 96) : "memory");
    typedef i64 i64x2 __attribute__((ext_vector_type(2)));
    i64x2 t; t.x = r0; t.y = r1; f[0] = __builtin_bit_cast(bf16x8, t); t.x = r2; t.y = r3; f[1] = __builtin_bit_cast(bf16x8, t);
    t.x = r4; t.y = r5; f[2] = __builtin_bit_cast(bf16x8, t); t.x = r6; t.y = r7; f[3] = __builtin_bit_cast(bf16x8, t);
}
template <int RS> __device__ __forceinline__ bf16x8 tr_frag1(unsigned addr, int lane) {
    const unsigned a = addr + (unsigned)((4 * (lane >> 4) + ((lane & 15) >> 2)) * RS + (lane & 3) * 8);
    i64 r0, r1;
    asm volatile("s_waitcnt lgkmcnt(0)\n\tds_read_b64_tr_b16 %0, %2\n\tds_read_b64_tr_b16 %1, %2 offset:%3\n\ts_waitcnt lgkmcnt(0)"
                 : "=&v"(r0), "=&v"(r1) : "v"(a), "i"(16 * RS) : "memory");
    typedef i64 i64x2 __attribute__((ext_vector_type(2)));
    i64x2 t; t.x = r0; t.y = r1; return __builtin_bit_cast(bf16x8, t);
}
constexpr int SSD_RB = 272, SSD_RX = 144;
constexpr int SSD_OFF_B = 0, SSD_OFF_C = 128 * SSD_RB, SSD_OFF_X = 2 * 128 * SSD_RB, SSD_OFF_XW = SSD_OFF_X + 128 * SSD_RX, SSD_OFF_F = SSD_OFF_XW + 128 * SSD_RX;
template <bool REUSE_BC>
__device__ __forceinline__ void ssd_chunk_unit(const u16* __restrict__ PROJ, const float* __restrict__ DTR, const float* __restrict__ cw, const float* __restrict__ cb,
                                               float dtbias, float aneg, float dskip, int b, int c, int h, int tid, LAS char* L,
                                               float* __restrict__ YD, float* __restrict__ SS, float* __restrict__ ATOT, float* __restrict__ ACS, u16* __restrict__ CG) {
    const int wave = tid >> 6, lane = tid & 63, li = lane & 15, g = lane >> 4, grp = h >> 2;
    const size_t t0 = (size_t)b * SEQ + (size_t)c * 128;
    LAS float* acs = (LAS float*)(L + SSD_OFF_F); LAS float* dts = acs + 128; LAS float* wls = acs + 256;
    __syncthreads();
    constexpr int NT = REUSE_BC ? 2 : 11;
    const int cg = REUSE_BC ? (tid & 7) : tid % 40, tp = REUSE_BC ? (tid >> 3) : tid / 40;
    const int ch = cg < 8 ? h * 64 + cg * 8 : cg < 24 ? 512 + grp * 128 + (cg - 8) * 8 : 768 + grp * 128 + (cg - 24) * 8;
    const int tl0 = tp * NT;
    float wk[4][8], bs[8];
    bf16x8 rr[NT + 3];
    if (REUSE_BC || tid < 480) {
#pragma unroll
        for (int k = 0; k < 4; ++k) { const float4 w0 = *(const float4*)(cw + k * 1024 + ch), w1 = *(const float4*)(cw + k * 1024 + ch + 4);
            wk[k][0] = w0.x; wk[k][1] = w0.y; wk[k][2] = w0.z; wk[k][3] = w0.w; wk[k][4] = w1.x; wk[k][5] = w1.y; wk[k][6] = w1.z; wk[k][7] = w1.w; }
        { const float4 b0 = *(const float4*)(cb + ch), b1 = *(const float4*)(cb + ch + 4); bs[0] = b0.x; bs[1] = b0.y; bs[2] = b0.z; bs[3] = b0.w; bs[4] = b1.x; bs[5] = b1.y; bs[6] = b1.z; bs[7] = b1.w; }
        const u16* src = PROJ + t0 * DP + C_XBC + ch;
        const bf16x8 zero8 = {0, 0, 0, 0, 0, 0, 0, 0};
        const int sl = c * 128 + tl0;
#pragma unroll
        for (int i = 0; i < NT + 3; ++i) rr[i] = (sl + i - 3 >= 0 && tl0 + i - 3 < 128) ? *(const bf16x8*)(src + (long)(tl0 + i - 3) * DP) : zero8;
    }
    if (wave == 0) {
        const float d0 = softplus_fast(DTR[(t0 + 2 * lane) * 8 + h] + dtbias), d1 = softplus_fast(DTR[(t0 + 2 * lane + 1) * 8 + h] + dtbias);
        const float a0 = d0 * aneg, a1 = d1 * aneg;
        float v = a0 + a1;
#pragma unroll
        for (int o = 1; o < 64; o <<= 1) { const float t = bperm(lane - o, v); if (lane >= o) v += t; }
        acs[2 * lane] = v - a1; acs[2 * lane + 1] = v; dts[2 * lane] = d0; dts[2 * lane + 1] = d1;
    }
    __syncthreads();
    if (tid < 128) { const float a = acs[tid]; wls[tid] = dts[tid] * __expf(acs[127] - a); ACS[(t0 + tid) * 8 + h] = a; if (tid == 0) ATOT[((size_t)b * 32 + c) * 8 + h] = acs[127]; }
    __syncthreads();
    if (REUSE_BC || tid < 480) {
#pragma unroll
        for (int i = 0; i < NT; ++i) {
            const int tl = tl0 + i;
            if (tl < 128) {
                float a[8];
#pragma unroll
                for (int j = 0; j < 8; ++j) a[j] = siluf(bs[j] + wk[0][j] * bf2f((u16)rr[i][j]) + wk[1][j] * bf2f((u16)rr[i + 1][j]) + wk[2][j] * bf2f((u16)rr[i + 2][j]) + wk[3][j] * bf2f((u16)rr[i + 3][j]));
                u32x4v o; o.x = pk2(a[0], a[1]); o.y = pk2(a[2], a[3]); o.z = pk2(a[4], a[5]); o.w = pk2(a[6], a[7]);
                if (cg < 8) {
                    *(LAS u32x4v*)(L + SSD_OFF_X + tl * SSD_RX + cg * 16) = o;
                    const float wl = wls[tl]; u32x4v ow; ow.x = pk2(a[0] * wl, a[1] * wl); ow.y = pk2(a[2] * wl, a[3] * wl); ow.z = pk2(a[4] * wl, a[5] * wl); ow.w = pk2(a[6] * wl, a[7] * wl);
                    *(LAS u32x4v*)(L + SSD_OFF_XW + tl * SSD_RX + cg * 16) = ow;
                } else if (cg < 24) *(LAS u32x4v*)(L + SSD_OFF_B + tl * SSD_RB + (cg - 8) * 16) = o;
                else { *(LAS u32x4v*)(L + SSD_OFF_C + tl * SSD_RB + (cg - 24) * 16) = o;
                       if ((h & 3) == 0) *(u32x4v*)(CG + (t0 + tl) * 256 + grp * 128 + (cg - 24) * 8) = o; }
            }
        }
    }
    __syncthreads();
    const unsigned Lb = (unsigned)(size_t)L;
    {
        const int lt = wave, lrow = lt * 16 + li; const float acl = acs[lrow];
        bf16x8 cf[4];
#pragma unroll
        for (int ks = 0; ks < 4; ++ks) cf[ks] = *(const LAS bf16x8*)(L + SSD_OFF_C + lrow * SSD_RB + ks * 64 + g * 16);
        f32x4 acc[4];
#pragma unroll
        for (int pt = 0; pt < 4; ++pt) acc[pt] = (f32x4){0.f, 0.f, 0.f, 0.f};
        for (int s0 = 0; s0 <= lt * 16; s0 += 32) {
            float w[2][4];
#pragma unroll
            for (int kt = 0; kt < 2; ++kt) {
                f32x4 st = (f32x4){0.f, 0.f, 0.f, 0.f};
#pragma unroll
                for (int ks = 0; ks < 4; ++ks) { const bf16x8 bfr = *(const LAS bf16x8*)(L + SSD_OFF_B + (s0 + kt * 16 + li) * SSD_RB + ks * 64 + g * 16);
                    st = __builtin_amdgcn_mfma_f32_16x16x32_bf16(bfr, cf[ks], st, 0, 0, 0); }
                const int sb = s0 + kt * 16 + 4 * g;
                const f32x4 as4 = *(const LAS f32x4*)(acs + sb), dt4 = *(const LAS f32x4*)(dts + sb);
#pragma unroll
                for (int r = 0; r < 4; ++r) w[kt][r] = (sb + r <= lrow) ? st[r] * __expf(acl - as4[r]) * dt4[r] : 0.f;
            }
            const bf16x8 pf = pack8(w[0], w[1]);
            bf16x8 xf[4]; tr_frags4<SSD_RX>(Lb + SSD_OFF_X + s0 * SSD_RX, lane, xf);
#pragma unroll
            for (int pt = 0; pt < 4; ++pt) acc[pt] = __builtin_amdgcn_mfma_f32_16x16x32_bf16(xf[pt], pf, acc[pt], 0, 0, 0);
        }
#pragma unroll
        for (int pt = 0; pt < 4; ++pt) {
            const u32x2v xr = *(const LAS u32x2v*)(L + SSD_OFF_X + lrow * SSD_RX + (pt * 16 + 4 * g) * 2);
            float4 o; o.x = acc[pt][0] + dskip * __uint_as_float(xr.x << 16); o.y = acc[pt][1] + dskip * __uint_as_float(xr.x & 0xffff0000u);
            o.z = acc[pt][2] + dskip * __uint_as_float(xr.y << 16); o.w = acc[pt][3] + dskip * __uint_as_float(xr.y & 0xffff0000u);
            *(float4*)(YD + (t0 + lrow) * 512 + h * 64 + pt * 16 + 4 * g) = o;
        }
    }
    {
        f32x4 acc[4];
#pragma unroll
        for (int pt = 0; pt < 4; ++pt) acc[pt] = (f32x4){0.f, 0.f, 0.f, 0.f};
#pragma unroll
        for (int ks = 0; ks < 4; ++ks) {
            const bf16x8 bt = tr_frag1<SSD_RB>(Lb + SSD_OFF_B + ks * 32 * SSD_RB + wave * 32, lane);
            bf16x8 xf[4]; tr_frags4<SSD_RX>(Lb + SSD_OFF_XW + ks * 32 * SSD_RX, lane, xf);
#pragma unroll
            for (int pt = 0; pt < 4; ++pt) acc[pt] = __builtin_amdgcn_mfma_f32_16x16x32_bf16(bt, xf[pt], acc[pt], 0, 0, 0);
        }
        float* so = SS + ((((size_t)b * 32 + c) * 8 + h) << 13);
#pragma unroll
        for (int pt = 0; pt < 4; ++pt) *(float4*)(so + (pt * 16 + li) * 128 + wave * 16 + 4 * g) = make_float4(acc[pt][0], acc[pt][1], acc[pt][2], acc[pt][3]);
    }
}
__device__ __forceinline__ void ssd_out_unit(const u16* __restrict__ PZ0, const u16* __restrict__ PZ1, const u16* __restrict__ PREV, const u16* __restrict__ CG, const float* __restrict__ YD,
                                             const float* __restrict__ ACS, const float* __restrict__ ng, int b, int j, int h, int lane, LAS float* red, u16* __restrict__ MIXED) {
    const int li = lane & 15, g = lane >> 4, grp = h >> 2, c = j >> 2; const size_t t0 = (size_t)b * SEQ + (size_t)j * 32;
    const u16* pv = PREV + ((((size_t)b * 32 + c) * 8 + h) << 13);
    f32x4 acc[4][2];
#pragma unroll
    for (int pt = 0; pt < 4; ++pt) { acc[pt][0] = (f32x4){0.f, 0.f, 0.f, 0.f}; acc[pt][1] = (f32x4){0.f, 0.f, 0.f, 0.f}; }
    float4 ydv[2][4]; uint2 zav[2][4], zbv[2][4]; float eav[2];
#pragma unroll
    for (int lt = 0; lt < 2; ++lt) { const size_t t = t0 + lt * 16 + li; eav[lt] = ACS[t * 8 + h];
#pragma unroll
        for (int pt = 0; pt < 4; ++pt) { const int col = h * 64 + pt * 16 + 4 * g;
            ydv[lt][pt] = *(const float4*)(YD + t * 512 + col); zav[lt][pt] = *(const uint2*)(PZ0 + t * 1024 + col); zbv[lt][pt] = *(const uint2*)(PZ1 + t * 1024 + col); } }
#pragma unroll
    for (int ks = 0; ks < 4; ++ks) {
        bf16x8 cf[2];
#pragma unroll
        for (int lt = 0; lt < 2; ++lt) cf[lt] = *(const bf16x8*)(CG + (t0 + lt * 16 + li) * 256 + grp * 128 + ks * 32 + g * 8);
#pragma unroll
        for (int pt = 0; pt < 4; ++pt) { const bf16x8 pf = *(const bf16x8*)(pv + (pt * 16 + li) * 128 + ks * 32 + g * 8);
            acc[pt][0] = __builtin_amdgcn_mfma_f32_16x16x32_bf16(pf, cf[0], acc[pt][0], 0, 0, 0);
            acc[pt][1] = __builtin_amdgcn_mfma_f32_16x16x32_bf16(pf, cf[1], acc[pt][1], 0, 0, 0); }
    }
    float ssq[2];
#pragma unroll
    for (int lt = 0; lt < 2; ++lt) {
        const float ea = __expf(eav[lt]); float s = 0.f;
#pragma unroll
        for (int pt = 0; pt < 4; ++pt) {
            const float4 yd = ydv[lt][pt]; const uint2 za = zav[lt][pt], zb = zbv[lt][pt];
            const float z0 = __uint_as_float(za.x << 16) + __uint_as_float(zb.x << 16), z1 = __uint_as_float(za.x & 0xffff0000u) + __uint_as_float(zb.x & 0xffff0000u);
            const float z2 = __uint_as_float(za.y << 16) + __uint_as_float(zb.y << 16), z3 = __uint_as_float(za.y & 0xffff0000u) + __uint_as_float(zb.y & 0xffff0000u);
            f32x4 y; y[0] = (yd.x + ea * acc[pt][lt][0]) * siluf(z0); y[1] = (yd.y + ea * acc[pt][lt][1]) * siluf(z1);
            y[2] = (yd.z + ea * acc[pt][lt][2]) * siluf(z2); y[3] = (yd.w + ea * acc[pt][lt][3]) * siluf(z3);
            acc[pt][lt] = y; s += (y[0] * y[0] + y[1] * y[1]) + (y[2] * y[2] + y[3] * y[3]);
        }
        s += bperm(lane ^ 16, s); s += bperm(lane ^ 32, s); ssq[lt] = s;
        if (g == 0) red[h * 64 + lt * 16 + li] = s;
    }
    __syncthreads();
#pragma unroll
    for (int lt = 0; lt < 2; ++lt) {
        float tot = 0.f;
#pragma unroll
        for (int hh = 0; hh < 8; ++hh) tot += red[hh * 64 + lt * 16 + li];
        const float sc = rsqrtf(tot / 512.f + EPS);
        f32x4 o[4];
#pragma unroll
        for (int pt = 0; pt < 4; ++pt) o[pt] = acc[pt][lt];
        store_out_tile(o, sc, ng + h * 64, MIXED + (t0 + lt * 16 + li) * D + h * 64, g);
    }
}


#ifndef MOE_TR
#define MOE_TR 512
#endif
constexpr int MOE_WBUF = 16384, MOE_LDS_TAB = 155648;
__device__ __forceinline__ void glds16(const void* gsrc, unsigned lds_dst) {
    unsigned keep;
    asm volatile("s_mov_b32 %0, m0\n\ts_mov_b32 m0, %2\n\ts_nop 0\n\tglobal_load_lds_dwordx4 %1, off\n\ts_mov_b32 m0, %0" : "=&s"(keep) : "v"(gsrc), "s"(lds_dst) : "memory");
}
__device__ __forceinline__ void glds16_nt(const void* gsrc, unsigned lds_dst) {
    unsigned keep;
    asm volatile("s_mov_b32 %0, m0\n\ts_mov_b32 m0, %2\n\ts_nop 0\n\tglobal_load_lds_dwordx4 %1, off nt\n\ts_mov_b32 m0, %0" : "=&s"(keep) : "v"(gsrc), "s"(lds_dst) : "memory");
}
template <int N> __device__ __forceinline__ void vm_wait() { asm volatile("s_waitcnt vmcnt(%0)" :: "i"(N) : "memory"); }
template <bool GATEUP, int NK, int NAP>
__device__ __forceinline__ void moe_unit(const u16* __restrict__ Abase, int lda, const float* __restrict__ W0, const float* __restrict__ W1, int ldw, int wcol0, int valid,
                                         int orow0, int ocol0, u16* __restrict__ Hout, u16* __restrict__ Yout, LAS char* L, int tid) {
    constexpr int LAA = NAP == 4 ? 1 : 2, ASLOTS = LAA + 1, ASZ = NAP * 8192, WSLOTS = NAP == 2 ? 6 : 5, LAW = WSLOTS - 1, AOFF = WSLOTS * MOE_WBUF, MT = NAP * 4;
    constexpr int WAITN = 2 + (LAA - 1) * (NAP + 2);
    static_assert(NK > LAW + 1 && AOFF + ASLOTS * ASZ <= MOE_LDS_TAB && LAW >= LAA + 1, "ring geometry");
    const int wid = __builtin_amdgcn_readfirstlane(tid >> 6), lane = tid & 63, wr = wid >> 2, wc = wid & 3, li = lane & 15, g = lane >> 4;
    const LAS int* rowtab = (const LAS int*)(L + MOE_LDS_TAB);
    const unsigned Lb = (unsigned)(size_t)L;
    const u16* ap[NAP];
#pragma unroll
    for (int j = 0; j < NAP; ++j) ap[j] = Abase + (size_t)rowtab[(wid * NAP + j) * 16 + (lane >> 2)] * lda + ((lane & 3) ^ ((lane >> 4) & 3)) * 8;
    const unsigned adst = Lb + AOFF + (unsigned)(wid * NAP) * 1024u;
    const int cpc = lane & 31;
    const float* wp = (GATEUP ? ((cpc < 16 ? W0 : W1) + wcol0 + 4 * (cpc & 15)) : (W0 + wcol0 + 4 * cpc)) + (size_t)(4 * wid + (lane >> 5)) * ldw;
    const unsigned wdst = Lb + (unsigned)(wid * 2) * 1024u;
    const unsigned bfr0 = (unsigned)((8 * g) * 512 + (GATEUP ? 16 * wc + li : 32 * wc + li) * 4);
    constexpr unsigned BN1 = GATEUP ? 64 * 4 : 16 * 4;
    const unsigned afr0 = (unsigned)(AOFF + (wr * 16 + li) * 64 + ((g ^ ((li >> 2) & 3)) * 16));
    const int mrows = valid - wr * 16;
    f32x4 acc[MT][2];
#pragma unroll
    for (int m = 0; m < MT; ++m) { acc[m][0] = (f32x4){0.f, 0.f, 0.f, 0.f}; acc[m][1] = (f32x4){0.f, 0.f, 0.f, 0.f}; }
#define MOE_DMAA(slot, kt) do { _Pragma("unroll") for (int j = 0; j < NAP; ++j) glds16(ap[j] + (kt) * 32, adst + (unsigned)(slot) * ASZ + j * 1024u); } while (0)
#define MOE_DMAW(slot, kt) do { _Pragma("unroll") for (int j = 0; j < 2; ++j) glds16_nt(wp + (size_t)((kt) * 32 + 2 * j) * ldw, wdst + (unsigned)(slot) * MOE_WBUF + j * 1024u); } while (0)
#define MOE_BFRAG(dst, wslot, n) do { float c_[8]; _Pragma("unroll") for (int i = 0; i < 8; ++i) c_[i] = *(const LAS float*)(L + (wslot) * MOE_WBUF + bfr0 + (n) * BN1 + i * 512); \
        u32x4v o_; o_.x = pg8::cvt_pk_bf16(c_[0], c_[1]); o_.y = pg8::cvt_pk_bf16(c_[2], c_[3]); o_.z = pg8::cvt_pk_bf16(c_[4], c_[5]); o_.w = pg8::cvt_pk_bf16(c_[6], c_[7]); \
        dst = __builtin_bit_cast(bf16x8, o_); } while (0)
#define MOE_COMPUTE(aslot, wslot) do { bf16x8 b0, b1; MOE_BFRAG(b0, wslot, 0); MOE_BFRAG(b1, wslot, 1); \
        _Pragma("unroll") for (int mh = 0; mh < MT / 4; ++mh) { if (mh * 128 < mrows) { bf16x8 af[4]; \
            _Pragma("unroll") for (int m = 0; m < 4; ++m) af[m] = *(const LAS bf16x8*)(L + (aslot) * ASZ + afr0 + (mh * 4 + m) * 2048); \
            _Pragma("unroll") for (int m = 0; m < 4; ++m) { \
                acc[mh * 4 + m][0] = __builtin_amdgcn_mfma_f32_16x16x32_bf16(b0, af[m], acc[mh * 4 + m][0], 0, 0, 0); \
                acc[mh * 4 + m][1] = __builtin_amdgcn_mfma_f32_16x16x32_bf16(b1, af[m], acc[mh * 4 + m][1], 0, 0, 0); } } } } while (0)
    MOE_DMAA(0, 0); MOE_DMAW(0, 0);
    if (LAA == 2) { MOE_DMAA(1, 1); }
#pragma unroll
    for (int k = 1; k < LAW; ++k) MOE_DMAW(k, k);
    vm_wait<(LAA == 2 ? NAP : 0) + 2 * (LAW - 1)>();
    __builtin_amdgcn_s_barrier(); asm volatile("" ::: "memory");
    int as_cur = 0, as_iss = LAA % ASLOTS, ws_cur = 0, ws_iss = LAW;
#pragma unroll 1
    for (int kt = 0; kt < NK; ++kt) {
        const bool fa = kt + LAA < NK, fw = kt + LAW < NK; const int ka = fa ? kt + LAA : 0, kw = fw ? kt + LAW : 0;
#pragma unroll
        for (int j = 0; j < NAP; ++j) glds16(fa ? (const void*)(ap[j] + ka * 32) : (const void*)Abase, adst + (unsigned)as_iss * ASZ + j * 1024u);
#pragma unroll
        for (int j = 0; j < 2; ++j) glds16_nt(fw ? (const void*)(wp + (size_t)(kw * 32 + 2 * j) * ldw) : (const void*)W0, wdst + (unsigned)ws_iss * MOE_WBUF + j * 1024u);
        MOE_COMPUTE(as_cur, ws_cur);
        vm_wait<WAITN>(); asm volatile("s_waitcnt lgkmcnt(0)" ::: "memory"); __builtin_amdgcn_s_barrier(); asm volatile("" ::: "memory");
        as_cur = as_cur == ASLOTS - 1 ? 0 : as_cur + 1; as_iss = as_iss == ASLOTS - 1 ? 0 : as_iss + 1;
        ws_cur = ws_cur == WSLOTS - 1 ? 0 : ws_cur + 1; ws_iss = ws_iss == WSLOTS - 1 ? 0 : ws_iss + 1;
    }
    vm_wait<0>();
#undef MOE_DMAA
#undef MOE_DMAW
#undef MOE_BFRAG
#undef MOE_COMPUTE
#pragma unroll
    for (int m = 0; m < MT; ++m) { const int rl = (2 * m + wr) * 16 + li; const size_t row = (size_t)orow0 + rl;
        if (rl < valid) {
            if (GATEUP) { float h[4];
#pragma unroll
                for (int r = 0; r < 4; ++r) { const float gt = acc[m][0][r], up = acc[m][1][r]; h[r] = gt / (1.f + __expf(-gt)) * up; }
                *(uint2*)(Hout + row * DFF + ocol0 + wc * 16 + 4 * g) = make_uint2(pg8::cvt_pk_bf16(h[0], h[1]), pg8::cvt_pk_bf16(h[2], h[3]));
            } else {
#pragma unroll
                for (int n = 0; n < 2; ++n) *(uint2*)(Yout + row * D + ocol0 + wc * 32 + n * 16 + 4 * g) = make_uint2(pg8::cvt_pk_bf16(acc[m][n][0], acc[m][n][1]), pg8::cvt_pk_bf16(acc[m][n][2], acc[m][n][3]));
            }
        }
    }
    __syncthreads();
}
__device__ __forceinline__ int moe_tables(const int* __restrict__ cnt, LAS int* tab, int tid) {
    __syncthreads();
    if (tid < NE) tab[258 + tid] = cnt[tid];
    __syncthreads();
    if (tid < NE) {
        const int c = tab[258 + tid], n = (c + MOE_TR - 1) / MOE_TR; int sc = c, sn = n;
#pragma unroll
        for (int d = 1; d < 64; d <<= 1) { const int oc = __builtin_amdgcn_ds_bpermute((tid - d) << 2, sc), on = __builtin_amdgcn_ds_bpermute((tid - d) << 2, sn); if (tid >= d) { sc += oc; sn += on; } }
        tab[tid] = sc - c;
        for (int i = 0; i < n; ++i) tab[64 + sn - n + i] = (tid << 8) | i;
        if (tid == NE - 1) tab[64 + 192] = sn; }
    __syncthreads();
    return tab[64 + 192];
}

__device__ __forceinline__ void moe_order(const int* __restrict__ cnt, LAS int* tab, int nblk, int tid) {
    int vi = 0;
    if (tid < 192) { if (tid < nblk) { const int em = tab[64 + tid]; vi = min(tab[258 + (em >> 8)] - (em & 255) * MOE_TR, MOE_TR); } tab[516 + tid] = vi; }
    __syncthreads();
    if (tid < nblk) { int rank = 0; const int nb4 = (nblk + 3) >> 2;
        for (int j4 = 0; j4 < nb4; ++j4) { const i32x4v v = *(const LAS i32x4v*)(tab + 516 + 4 * j4);
#pragma unroll
            for (int q = 0; q < 4; ++q) { const int j = 4 * j4 + q; rank += (v[q] > vi) || (v[q] == vi && j < tid); } }
        tab[322 + rank] = tid; }
    __syncthreads();
}
__device__ __forceinline__ int moe_dequeue(int* ctr, LAS int* tab, int tid) {
    __syncthreads();
    if (tid == 0) tab[257] = atomicAdd(ctr, 1);
    __syncthreads();
    return tab[257];
}

__device__ __forceinline__ void norm_router_unit32(const float* __restrict__ X, int t0, const LAS float* gain, const u16* __restrict__ Wt, u16* __restrict__ HB, LAS float* part, LAS float* ssp, int wave, int lane) {
    asm volatile("" : "+v"(lane));
    const int li = lane & 15, g4 = lane >> 4; const int kb = 256 * wave + 4 * g4;
    const float* xp = X + (size_t)(t0 + li) * D + kb;
    float4 xv[2][16];
#pragma unroll
    for (int m = 0; m < 2; ++m)
#pragma unroll
        for (int j = 0; j < 16; ++j) xv[m][j] = *(const float4*)(xp + (size_t)m * 16 * D + 16 * j);
#pragma unroll
    for (int m = 0; m < 2; ++m) { float ss = 0.f;
#pragma unroll
        for (int j = 0; j < 16; ++j) ss += (xv[m][j].x * xv[m][j].x + xv[m][j].y * xv[m][j].y) + (xv[m][j].z * xv[m][j].z + xv[m][j].w * xv[m][j].w);
        ss += bperm(lane ^ 16, ss); ss += bperm(lane ^ 32, ss);
        if (g4 == 0) ssp[wave * 32 + m * 16 + li] = ss; }
    f32x4 acc[2][5];
#pragma unroll
    for (int m = 0; m < 2; ++m)
#pragma unroll
        for (int nt = 0; nt < 5; ++nt) acc[m][nt] = (f32x4){0.f, 0.f, 0.f, 0.f};
    const u16* rbh = Wt + (size_t)wave * (8 * 5 * 512) + lane * 8; const u16* rbl = rbh + (size_t)2 * 80 * D;
#pragma unroll
    for (int jj = 0; jj < 8; ++jj) {
        bf16x8 xh[2], xl[2];
#pragma unroll
        for (int m = 0; m < 2; ++m) { const float4 a = xv[m][2 * jj], b = xv[m][2 * jj + 1]; const float v[8] = {a.x, a.y, a.z, a.w, b.x, b.y, b.z, b.w};
            u32x4v h, lo;
#pragma unroll
            for (int q = 0; q < 4; ++q) { const unsigned hp = pg8::cvt_pk_bf16(v[2 * q], v[2 * q + 1]); h[q] = hp;
                lo[q] = pg8::cvt_pk_bf16(v[2 * q] - __uint_as_float(hp << 16), v[2 * q + 1] - __uint_as_float(hp & 0xffff0000u)); }
            xh[m] = __builtin_bit_cast(bf16x8, h); xl[m] = __builtin_bit_cast(bf16x8, lo); }
#pragma unroll
        for (int n0 = 0; n0 < 5; n0 += 3) {
            bf16x8 wh[3], wl[3];
#pragma unroll
            for (int q = 0; q < 3; ++q) if (n0 + q < 5) { wh[q] = *(const bf16x8*)(rbh + (jj * 5 + n0 + q) * 512); wl[q] = *(const bf16x8*)(rbl + (jj * 5 + n0 + q) * 512); }
#pragma unroll
            for (int m = 0; m < 2; ++m)
#pragma unroll
                for (int q = 0; q < 3; ++q) if (n0 + q < 5) acc[m][n0 + q] = __builtin_amdgcn_mfma_f32_16x16x32_bf16(xl[m], wh[q], acc[m][n0 + q], 0, 0, 0);
#pragma unroll
            for (int m = 0; m < 2; ++m)
#pragma unroll
                for (int q = 0; q < 3; ++q) if (n0 + q < 5) acc[m][n0 + q] = __builtin_amdgcn_mfma_f32_16x16x32_bf16(xh[m], wl[q], acc[m][n0 + q], 0, 0, 0);
#pragma unroll
            for (int m = 0; m < 2; ++m)
#pragma unroll
                for (int q = 0; q < 3; ++q) if (n0 + q < 5) acc[m][n0 + q] = __builtin_amdgcn_mfma_f32_16x16x32_bf16(xh[m], wh[q], acc[m][n0 + q], 0, 0, 0);
        }
    }
#pragma unroll
    for (int m = 0; m < 2; ++m)
#pragma unroll
        for (int nt = 0; nt < 5; ++nt)
#pragma unroll
            for (int r = 0; r < 4; ++r) part[(wave * 32 + m * 16 + 4 * g4 + r) * 80 + nt * 16 + li] = acc[m][nt][r];
    __syncthreads();
#pragma unroll
    for (int m = 0; m < 2; ++m) {
        float tot = 0.f;
#pragma unroll
        for (int w = 0; w < 8; ++w) tot += ssp[w * 32 + m * 16 + li];
        const float rs = rsqrtf(tot / D + EPS);
        u16* hp = HB + (size_t)(t0 + m * 16 + li) * D + kb; const LAS float* gq = gain + kb;
#pragma unroll
        for (int j = 0; j < 16; ++j) { const f32x4 g4v = *(const LAS f32x4*)(gq + 16 * j);
            *(uint2*)(hp + 16 * j) = make_uint2(pk2(xv[m][j].x * rs * g4v[0], xv[m][j].y * rs * g4v[1]), pk2(xv[m][j].z * rs * g4v[2], xv[m][j].w * rs * g4v[3])); }
    }
}

template <int NTL, bool COMBINE, bool COPYIN = false>
__device__ __forceinline__ float norm_proj_unit(float* __restrict__ X, const float* __restrict__ Xin, int t0, const LAS float* gain, const float* __restrict__ Wt, u16* __restrict__ HB,
                                                LAS float* part, LAS float* ssp, int wave, int lane,
                                                const LAS int* mtab, const int* __restrict__ tok_e, const int* __restrict__ tok_pos, const float* __restrict__ tok_g, const u16* __restrict__ Yb) {
    asm volatile("" : "+v"(lane));
    const int li = lane & 15, g4 = lane >> 4, t = t0 + li; const int kb = 256 * wave + 4 * g4;
    float* xp = X + (size_t)t * D + kb;
    float4 xv[16];
    if (COPYIN) { const float* xi = Xin + (size_t)t * D + kb;
#pragma unroll
        for (int j = 0; j < 16; ++j) xv[j] = *(const float4*)(xi + 16 * j);
    } else {
#pragma unroll
        for (int j = 0; j < 16; ++j) xv[j] = *(const float4*)(xp + 16 * j);
    }
    if (COMBINE) {
        const u16* y0 = Yb + (size_t)(mtab[tok_e[2 * t]] + tok_pos[2 * t]) * D + kb; const u16* y1 = Yb + (size_t)(mtab[tok_e[2 * t + 1]] + tok_pos[2 * t + 1]) * D + kb;
        const float g0 = tok_g[2 * t], g1 = tok_g[2 * t + 1];
#pragma unroll
        for (int j = 0; j < 16; ++j) { const uint2 ua = *(const uint2*)(y0 + 16 * j), ub = *(const uint2*)(y1 + 16 * j);
            const float4 a = make_float4(__uint_as_float(ua.x << 16), __uint_as_float(ua.x & 0xffff0000u), __uint_as_float(ua.y << 16), __uint_as_float(ua.y & 0xffff0000u));
            const float4 b = make_float4(__uint_as_float(ub.x << 16), __uint_as_float(ub.x & 0xffff0000u), __uint_as_float(ub.y << 16), __uint_as_float(ub.y & 0xffff0000u));
            xv[j].x += g0 * a.x + g1 * b.x; xv[j].y += g0 * a.y + g1 * b.y; xv[j].z += g0 * a.z + g1 * b.z; xv[j].w += g0 * a.w + g1 * b.w;
            *(float4*)(xp + 16 * j) = xv[j]; }
    }
    float ss = 0.f;
#pragma unroll
    for (int j = 0; j < 16; ++j) ss += (xv[j].x * xv[j].x + xv[j].y * xv[j].y) + (xv[j].z * xv[j].z + xv[j].w * xv[j].w);
    ss += bperm(lane ^ 16, ss); ss += bperm(lane ^ 32, ss);
    if (g4 == 0) ssp[wave * 16 + li] = ss;
    f32x4 acc[NTL];
#pragma unroll
    for (int nt = 0; nt < NTL; ++nt) acc[nt] = (f32x4){0.f, 0.f, 0.f, 0.f};
    const u16* rbh = (const u16*)Wt + (size_t)wave * (8 * NTL * 512) + lane * 8; const u16* rbl = rbh + (size_t)2 * 16 * NTL * D;
#pragma unroll
    for (int jj = 0; jj < 8; ++jj) {
        const float4 a = xv[2 * jj], b = xv[2 * jj + 1]; const float v[8] = {a.x, a.y, a.z, a.w, b.x, b.y, b.z, b.w};
        u32x4v h, lo;
#pragma unroll
        for (int q = 0; q < 4; ++q) { const unsigned hp = pg8::cvt_pk_bf16(v[2 * q], v[2 * q + 1]); h[q] = hp;
            lo[q] = pg8::cvt_pk_bf16(v[2 * q] - __uint_as_float(hp << 16), v[2 * q + 1] - __uint_as_float(hp & 0xffff0000u)); }
        const bf16x8 xh = __builtin_bit_cast(bf16x8, h), xl = __builtin_bit_cast(bf16x8, lo);
#pragma unroll
        for (int nt = 0; nt < NTL; ++nt) { const bf16x8 wh = *(const bf16x8*)(rbh + (jj * NTL + nt) * 512), wl = *(const bf16x8*)(rbl + (jj * NTL + nt) * 512);
            acc[nt] = __builtin_amdgcn_mfma_f32_16x16x32_bf16(xl, wh, acc[nt], 0, 0, 0);
            acc[nt] = __builtin_amdgcn_mfma_f32_16x16x32_bf16(xh, wl, acc[nt], 0, 0, 0);
            acc[nt] = __builtin_amdgcn_mfma_f32_16x16x32_bf16(xh, wh, acc[nt], 0, 0, 0); }
    }
#pragma unroll
    for (int nt = 0; nt < NTL; ++nt)
#pragma unroll
        for (int r = 0; r < 4; ++r) part[(wave * 16 + 4 * g4 + r) * (NTL * 16) + nt * 16 + li] = acc[nt][r];
    __syncthreads();
    float tot = 0.f;
#pragma unroll
    for (int w = 0; w < 8; ++w) tot += ssp[w * 16 + li];
    const float rs = rsqrtf(tot / D + EPS);
    u16* hp = HB + (size_t)t * D + kb; const LAS float* gq = gain + kb;
#pragma unroll
    for (int j = 0; j < 16; ++j) { const f32x4 g4v = *(const LAS f32x4*)(gq + 16 * j); const float4 gg = make_float4(g4v[0], g4v[1], g4v[2], g4v[3]);
        *(uint2*)(hp + 16 * j) = make_uint2(pk2(xv[j].x * rs * gg.x, xv[j].y * rs * gg.y), pk2(xv[j].z * rs * gg.z, xv[j].w * rs * gg.w)); }
    return rs;
}

typedef const Params __attribute__((address_space(4)))* KP;
#define PARAMS KP kp_ = (KP)__builtin_amdgcn_kernarg_segment_ptr(); asm volatile("" : "+s"(kp_)); const __attribute__((address_space(4))) Params& p = *kp_;
__global__ void __launch_bounds__(NTHR, 2) mega(Params pk_unused) {
    extern __shared__ __attribute__((aligned(16))) char smem[];
    if (threadIdx.x == 0) *(uint4*)smem = make_uint4(0u, 0u, 0u, 0u);
    __syncthreads();
    XcdBarrier bar; { PARAMS bar = xcd_barrier_post(p.bar, (volatile LAS unsigned*)smem); }
    char* lds = smem + 16;
    LAS unsigned char* glds = (LAS unsigned char*)(smem + 16);
    const int G = gridDim.x, NGW = G * NWAVE;
    const long gsize = (long)G * NTHR;
#define IDS PARAMS int tid = threadIdx.x; asm volatile("" : "+v"(tid)); const int wave = tid >> 6, lane = tid & 63; const int gw = blockIdx.x * NWAVE + wave; const long gtid = (long)blockIdx.x * NTHR + tid; (void)wave; (void)lane; (void)gw; (void)gtid;

    { IDS
        float* scr = (float*)lds + wave * (64 * 33);
        constexpr int I_A = 32 * 48, I_B = 32 * 112, I_O = 32 * 64, I_L = I_A + I_B + I_O;
        for (int it = gw; it < 2 * I_L; it += NGW) {
            const int l = it / I_L; int r = it % I_L;
            const float* Wl = p.w_in + (size_t)l * D * DIN; u16* WTl = p.WinT + (size_t)l * DP * D;
            if (r < 512)  { transpose_item(Wl, DIN, 0, D, WTl, 4096, 16, r, scr, lane); continue; } r -= 512;
            if (r < 1024) { transpose_item(Wl, DIN, 512, D, WTl, 0, 32, r, scr, lane); continue; } r -= 1024;
            if (r < 3072) { transpose_item(Wl, DIN, 1544, D, WTl, 1024, 96, r, scr, lane); continue; } r -= 3072;
            if (r < 512)  { transpose_item(Wl, DIN, 4616, D, WTl, 4608, 16, r, scr, lane); continue; } r -= 512;
            transpose_item(p.w_out + (size_t)l * D * D, D, 0, D, p.WoutT + (size_t)l * D * D, 0, 64, r, scr, lane);
        }
        for (long i = gtid; i < 2L * 80 * D; i += gsize) {
            const int l = (int)(i / (80 * D)); int r = (int)(i % (80 * D)); const int e8 = r & 7; r >>= 3; const int ln = r & 63; r >>= 6; const int nt = r % 5; r /= 5; const int jj = r & 7, w = r >> 3;
            const int c = 16 * nt + (ln & 15), k = 256 * w + 32 * jj + 16 * (e8 >> 2) + 4 * (ln >> 4) + (e8 & 3);
            const float wv = ((c < 8) ? p.rg_w[(size_t)l * D * 8 + k * 8 + c] : (c < 72) ? p.re_w[(size_t)l * D * 64 + k * 64 + (c - 8)] : 0.f) * p.norm2_g[l * D + k];
            const u16 hi = f2bf(wv); ((u16*)p.RT)[i] = hi; ((u16*)p.RT)[(size_t)2 * 80 * D + i] = f2bf(wv - bf2f(hi)); }
        for (long i = gtid; i < 2L * 4 * 128 * 128; i += gsize) { const int e = (int)(i & 127), c = (int)((i >> 7) & 127); const long lg = i >> 14;
            p.WpT[(lg << 14) + e * 128 + c] = f2bf(p.pool_w[i]); }
        for (long i = gtid; i < 2L * 16 * D; i += gsize) {
            const int l = (int)(i / (16 * D)); int r = (int)(i % (16 * D)); const int e8 = r & 7; r >>= 3; const int ln = r & 63; r >>= 6; const int jj = r & 7, w = r >> 3;
            const int c = ln & 15, k = 256 * w + 32 * jj + 16 * (e8 >> 2) + 4 * (ln >> 4) + (e8 & 3);
            const float wv = c < 8 ? p.w_in[(size_t)l * D * DIN + (size_t)k * DIN + 1536 + c] * p.norm1_g[l * D + k] : 0.f;
            const u16 hi = f2bf(wv); ((u16*)p.WDT)[i] = hi; ((u16*)p.WDT)[(size_t)2 * 16 * D + i] = f2bf(wv - bf2f(hi)); }
    }
    xcd_barrier(bar);

#pragma unroll 1
    for (int l = 0; l < 2; ++l) {
        { IDS
            LAS float* part = (LAS float*)(smem + 16); LAS float* ssp = part + 8 * 16 * 16; LAS int* mtab = (LAS int*)(ssp + 128);
            if (l > 0) moe_tables(p.ctrl + (l - 1) * 64, mtab, tid);
            const float* wdt = (const float*)((const u16*)p.WDT + (size_t)l * 16 * D);
            LAS float* g1 = (LAS float*)(mtab + 336);
            for (int i = tid; i < D; i += NTHR) g1[i] = p.norm1_g[l * D + i];
            for (int u = blockIdx.x; u < T / 16; u += G) {
                __syncthreads();
                float rs;
                if (l > 0) rs = norm_proj_unit<1, true>(p.X, nullptr, u * 16, g1, wdt, p.HB, part, ssp, wave, lane, mtab, p.tok_e, p.tok_pos, p.tok_g, p.Yb);
                else       rs = norm_proj_unit<1, false, true>(p.X, p.x_in, u * 16, g1, wdt, p.HB, part, ssp, wave, lane, mtab, p.tok_e, p.tok_pos, p.tok_g, p.Yb);
                (void)rs;
                if (tid < 128) { const int tk = tid >> 3, q = tid & 7; float s = 0.f, tot = 0.f;
#pragma unroll
                    for (int w = 0; w < 8; ++w) { s += part[(w * 16 + tk) * 16 + q]; tot += ssp[w * 16 + tk]; }
                    p.DTR[(size_t)(u * 16 + tk) * 8 + q] = s * rsqrtf(tot / D + EPS); }
            }
        }
        xcd_barrier(bar);
        {
            PARAMS
            const u16* wt = p.WinT + (size_t)l * DP * D;
            { pg8::Gemm g{p.HB, wt, T, 4096, D, D};
              pg8::StaticOrder so; so.init(T, 4096, G, blockIdx.x);
              pg8::EpiStoreBf16 ep{p.PROJ, DP};
              pg8::gemm_phase(glds, g, so, ep, nullptr); }
            { const int kh = blockIdx.x & 1;
              pg8::Gemm g{p.HB + kh * 1024, wt + (size_t)4096 * D + kh * 1024, T, 1024, 1024, D};
              pg8::HalfOrder ho{(int)blockIdx.x, G};
              pg8::EpiStoreBf16 ep{kh ? p.PZ1 : p.PZ0, 1024};
              pg8::gemm_phase(glds, g, ho, ep, nullptr); }
        }
        xcd_barrier(bar);
        { IDS
            for (int it0 = gw; it0 < T; it0 += 4 * NGW) {
                u16* base[4]; bf16x8 a[4], b[4];
#pragma unroll
                for (int q = 0; q < 4; ++q) { const int t = it0 + q * NGW < T ? it0 + q * NGW : it0;
                    base[q] = p.PROJ + (size_t)t * DP + (lane < 32 ? C_SB : C_DIL) + 512 + (lane & 31) * 16;
                    a[q] = *(const bf16x8*)base[q]; b[q] = *(const bf16x8*)(base[q] + 8); }
#pragma unroll
                for (int q = 0; q < 4; ++q) { const int t = it0 + q * NGW; if (t < T) {
                    const float* gp = (lane < 32 ? p.sbk_g : p.dk_g) + l * 64 + (lane & 3) * 16;
                    float v[16]; float ss = 0.f;
#pragma unroll
                    for (int j = 0; j < 8; ++j) { v[j] = bf2f((u16)a[q][j]); v[8 + j] = bf2f((u16)b[q][j]); }
#pragma unroll
                    for (int j = 0; j < 16; ++j) ss += v[j] * v[j];
                    ss += swz_xor<1>(ss); ss += swz_xor<2>(ss);
                    const float r = rsqrtf(ss / 64.f + EPS);
                    u32x4v o0, o1;
                    { const float4 g0 = *(const float4*)gp, g1 = *(const float4*)(gp + 4), g2 = *(const float4*)(gp + 8), g3 = *(const float4*)(gp + 12);
                      o0.x = pk2(v[0] * r * g0.x, v[1] * r * g0.y); o0.y = pk2(v[2] * r * g0.z, v[3] * r * g0.w); o0.z = pk2(v[4] * r * g1.x, v[5] * r * g1.y); o0.w = pk2(v[6] * r * g1.z, v[7] * r * g1.w);
                      o1.x = pk2(v[8] * r * g2.x, v[9] * r * g2.y); o1.y = pk2(v[10] * r * g2.z, v[11] * r * g2.w); o1.z = pk2(v[12] * r * g3.x, v[13] * r * g3.y); o1.w = pk2(v[14] * r * g3.z, v[15] * r * g3.w); }
                    *(u32x4v*)base[q] = o0; *(u32x4v*)(base[q] + 8) = o1; } }
            }
            for (int u = blockIdx.x; u < NB * 32 * 4; u += G) {
                const int b = u >> 7, c = (u >> 2) & 31, h0 = (u & 3) * 2;
                ssd_chunk_unit<false>(p.PROJ, p.DTR, p.conv_w + l * 4 * 1024, p.conv_b + l * 1024, p.dt_bias[l * 8 + h0], -__expf(p.a_log[l * 8 + h0]), p.ssd_d[l * 8 + h0],
                                      b, c, h0, tid, (LAS char*)(smem + 16), p.YD, p.SS, p.ATOT, p.ACS, p.CG);
                int tid2 = threadIdx.x; asm volatile("" : "+v"(tid2));
                ssd_chunk_unit<true>(p.PROJ, p.DTR, p.conv_w + l * 4 * 1024, p.conv_b + l * 1024, p.dt_bias[l * 8 + h0 + 1], -__expf(p.a_log[l * 8 + h0 + 1]), p.ssd_d[l * 8 + h0 + 1],
                                     b, c, h0 + 1, tid2, (LAS char*)(smem + 16), p.YD, p.SS, p.ATOT, p.ACS, p.CG);
            }
            __syncthreads();
            {
                constexpr int PRS = 1040;
                LAS char* PL = (LAS char*)(smem + 16); LAS float* PS = (LAS float*)(PL + 32 * PRS);
                const float* psc = p.pool_sc + l * 512; const u16* wpt = p.WpT + (size_t)l * 4 * 16384;
                for (int u = blockIdx.x; u < T / 32; u += G) {
                    const int tb0 = u * 32; __syncthreads();
                    const int s0 = tb0 % SEQ;
#pragma unroll
                    for (int q = 0; q < 6; ++q) { const int i = tid + q * NTHR;
                        if (i < 47 * 64) { const int r = i >> 6, c8 = (i & 63) * 8; f32x4 lo = (f32x4){0.f, 0.f, 0.f, 0.f}, hi = lo;
                            if (s0 - 15 + r >= 0) { const size_t go = (size_t)(tb0 - 15 + r) * 1024 + 512 + c8;
                                const u32x4v a = *(const u32x4v*)(p.PZ0 + go), b = *(const u32x4v*)(p.PZ1 + go);
                                lo[0] = __uint_as_float(a.x << 16) + __uint_as_float(b.x << 16); lo[1] = __uint_as_float(a.x & 0xffff0000u) + __uint_as_float(b.x & 0xffff0000u);
                                lo[2] = __uint_as_float(a.y << 16) + __uint_as_float(b.y << 16); lo[3] = __uint_as_float(a.y & 0xffff0000u) + __uint_as_float(b.y & 0xffff0000u);
                                hi[0] = __uint_as_float(a.z << 16) + __uint_as_float(b.z << 16); hi[1] = __uint_as_float(a.z & 0xffff0000u) + __uint_as_float(b.z & 0xffff0000u);
                                hi[2] = __uint_as_float(a.w << 16) + __uint_as_float(b.w << 16); hi[3] = __uint_as_float(a.w & 0xffff0000u) + __uint_as_float(b.w & 0xffff0000u); }
                            *(LAS f32x4*)(PS + r * 512 + c8) = lo; *(LAS f32x4*)(PS + r * 512 + c8 + 4) = hi; } }
                    __syncthreads();
                    { const int c = tid, gq = c >> 7, w = 2 << gq; const LAS float* sc = PS + 15 * 512 + c;
                      float sum = 0.f; { const int c0 = min(w, s0 + 1);
#pragma unroll
                          for (int i = 0; i < 16; ++i) if (i < c0) sum += sc[-i * 512]; }
                      float ucur = sc[0];
#pragma unroll 8
                      for (int tt = 0; tt < 32; ++tt) { const int s = s0 + tt; const int cn = min(w, s + 1);
                          *(LAS u16*)(PL + tt * PRS + c * 2) = f2bf(sum / (float)cn - ucur);
                          if (tt < 31) { ucur = sc[(tt + 1) * 512]; sum += ucur; if (s + 1 >= w) sum -= sc[(tt + 1 - w) * 512]; } } }
                    __syncthreads();
                    const int li = lane & 15, g4 = lane >> 4, gq = wave >> 1, eh = wave & 1;
                    f32x4 acc[4][2];
#pragma unroll
                    for (int et = 0; et < 4; ++et) { acc[et][0] = (f32x4){0.f, 0.f, 0.f, 0.f}; acc[et][1] = (f32x4){0.f, 0.f, 0.f, 0.f}; }
#pragma unroll
                    for (int ks = 0; ks < 4; ++ks) {
                        bf16x8 pf[2];
#pragma unroll
                        for (int tt = 0; tt < 2; ++tt) pf[tt] = *(const LAS bf16x8*)(PL + (tt * 16 + li) * PRS + (gq * 128 + ks * 32 + g4 * 8) * 2);
#pragma unroll
                        for (int et = 0; et < 4; ++et) { const bf16x8 wf = *(const bf16x8*)(wpt + gq * 16384 + (eh * 64 + et * 16 + li) * 128 + ks * 32 + g4 * 8);
                            acc[et][0] = __builtin_amdgcn_mfma_f32_16x16x32_bf16(wf, pf[0], acc[et][0], 0, 0, 0);
                            acc[et][1] = __builtin_amdgcn_mfma_f32_16x16x32_bf16(wf, pf[1], acc[et][1], 0, 0, 0); }
                    }
#pragma unroll
                    for (int tt = 0; tt < 2; ++tt)
#pragma unroll
                        for (int et = 0; et < 4; ++et) { const int col = gq * 128 + eh * 64 + et * 16 + 4 * g4; const float4 sc = *(const float4*)(psc + col);
                            *(uint2*)(p.MIXED + (size_t)(tb0 + tt * 16 + li) * D + 1536 + col) =
                                make_uint2(pk2(acc[et][tt][0] * sc.x, acc[et][tt][1] * sc.y), pk2(acc[et][tt][2] * sc.z, acc[et][tt][3] * sc.w)); }
                }
            }
        }
        xcd_barrier(bar);
        { IDS
        {
            for (int e = (int)gtid; e < NB * 8 * 8192; e += (int)gsize) {
                const int b = e >> 16, h = (e >> 13) & 7, pn = e & 8191; float st = 0.f;
                float ssv[32], atv[32];
#pragma unroll
                for (int c = 0; c < 32; ++c) { const size_t cu = ((size_t)b * 32 + c) * 8 + h; ssv[c] = p.SS[(cu << 13) + pn]; atv[c] = p.ATOT[cu]; }
#pragma unroll
                for (int c = 0; c < 32; ++c) { const size_t cu = ((size_t)b * 32 + c) * 8 + h; p.PREV[(cu << 13) + pn] = f2bf(st); st = st * __expf(atv[c]) + ssv[c]; }
            }
            int* d2done = p.ctrl + 530 + l;
            asm volatile("s_waitcnt vmcnt(0)" ::: "memory");
            __syncthreads();
            if (tid == 0) { __builtin_amdgcn_fence(__ATOMIC_RELEASE, "agent"); __hip_atomic_fetch_add(d2done, 1, __ATOMIC_RELAXED, __HIP_MEMORY_SCOPE_AGENT); }
            LAS char* vl = (LAS char*)(smem + 16) + wave * ATT_VBYTES;
            LAS float* red = (LAS float*)((LAS char*)(smem + 16) + NWAVE * ATT_VBYTES);
            LAS int* qslot = (LAS int*)(red + 1024); int* qctr = p.ctrl + 520 + l;
            int par = 0;
            for (;; par ^= 1) {
                __syncthreads();
                if (tid == 0) *qslot = atomicAdd(qctr, 1);
                __syncthreads();
                const int u = *qslot; if (u >= 256 + 256 + NB * 128) break;
                if (u >= 512) {
                    if (tid == 0) { while (__hip_atomic_load(d2done, __ATOMIC_RELAXED, __HIP_MEMORY_SCOPE_AGENT) < G) __builtin_amdgcn_s_sleep(1); __builtin_amdgcn_fence(__ATOMIC_ACQUIRE, "agent"); }
                    __syncthreads();
                    const int v = u - 512;
                    ssd_out_unit(p.PZ0, p.PZ1, p.PREV, p.CG, p.YD, p.ACS, p.ssd_ng + l * 512, v >> 7, v & 127, wave, lane, red + par * 512, p.MIXED);
                } else if (u >= 256) { const int v = u - 256; sb_unit(p.PROJ, v >> 7, v & 127, wave, lane, vl, red + par * 512, p.sbo_g + l * 512, p.MIXED, p.sbq_g + l * 64); }
                else dil_unit(p.PROJ, u >> 7, (u >> 3) & 15, u & 7, wave, lane, vl, red + par * 512, p.do_g + l * 512, p.MIXED, p.dq_g + l * 64);
            }
        }
        }
        xcd_barrier(bar);
        {
            PARAMS
            pg8::Gemm g{p.MIXED, p.WoutT + (size_t)l * D * D, T, D, D, D};
            pg8::StaticOrder so; so.init(T, D, G, blockIdx.x);
            pg8::EpiAddF32 ep{p.X, l == 0 ? p.x_in : (const float*)p.X, D};
            pg8::gemm_phase(glds, g, so, ep, nullptr);
        }
        xcd_barrier(bar);
        { IDS
            const u16* RTl = (const u16*)p.RT + (size_t)l * 80 * D; int* cnt = p.ctrl + l * 64;
            LAS float* part = (LAS float*)(smem + 16);
            LAS float* ssp = part + 8 * 32 * 80;
            LAS float* lg = ssp + 256;
            LAS float* rbias = lg + 32 * 80;
            LAS float* g2 = rbias + 128;
            for (int i = tid; i < D; i += NTHR) g2[i] = p.norm2_g[l * D + i];
            if (tid < 72) rbias[tid] = tid < 8 ? p.rg_b[l * 8 + tid] : p.re_b[l * 64 + tid - 8];
            for (int u = blockIdx.x; u < T / 32; u += G) {
                const int t0 = u * 32;
                __syncthreads();
                norm_router_unit32(p.X, t0, g2, RTl, p.HB, part, ssp, wave, lane);
                for (int i = tid; i < 32 * 72; i += NTHR) { const int tk = i / 72, c = i % 72; float s = 0.f, tot = 0.f;
#pragma unroll
                    for (int w = 0; w < 8; ++w) { s += part[(w * 32 + tk) * 80 + c]; tot += ssp[w * 32 + tk]; }
                    lg[tk * 80 + c] = s * rsqrtf(tot / D + EPS) + rbias[c]; }
                __syncthreads();
                if (tid < 64) {
                    LAS int* hc = (LAS int*)(g2 + D);
                    hc[tid] = 0;
                    asm volatile("s_waitcnt lgkmcnt(0)" ::: "memory");
                    int e1 = 0, e2 = 0, r1 = 0, r2 = 0; const int t = t0 + tid;
                    if (tid < 32) {
                        const LAS float* gl = lg + tid * 80;
                        int gi = 0; float gm = gl[0];
                        for (int j = 1; j < 8; ++j) if (gl[j] > gm) { gm = gl[j]; gi = j; }
                        float gs = 0.f;
                        for (int j = 0; j < 8; ++j) gs += __expf(gl[j] - gm);
                        const float gp = 1.f / gs;
                        const LAS float* el = gl + 8 + gi * 8;
                        int i1 = 0; float m1 = el[0];
                        for (int j = 1; j < 8; ++j) if (el[j] > m1) { m1 = el[j]; i1 = j; }
                        int i2 = -1; float m2 = -1e30f;
                        for (int j = 0; j < 8; ++j) if (j != i1 && el[j] > m2) { m2 = el[j]; i2 = j; }
                        const float p2 = __expf(m2 - m1); const float ga = gp / (1.f + p2), gb = gp * p2 / (1.f + p2);
                        e1 = gi * 8 + i1; e2 = gi * 8 + i2;
                        p.tok_e[t * 2] = e1; p.tok_e[t * 2 + 1] = e2; p.tok_g[t * 2] = ga; p.tok_g[t * 2 + 1] = gb;
                        r1 = __hip_atomic_fetch_add(hc + e1, 1, __ATOMIC_RELAXED, __HIP_MEMORY_SCOPE_WORKGROUP);
                        r2 = __hip_atomic_fetch_add(hc + e2, 1, __ATOMIC_RELAXED, __HIP_MEMORY_SCOPE_WORKGROUP);
                    }
                    asm volatile("s_waitcnt lgkmcnt(0)" ::: "memory");
                    { const int c = hc[tid]; int base = 0; if (c > 0) base = atomicAdd(&cnt[tid], c); hc[64 + tid] = base; }
                    asm volatile("s_waitcnt lgkmcnt(0)" ::: "memory");
                    if (tid < 32) { const int q1 = hc[64 + e1] + r1, q2 = hc[64 + e2] + r2;
                        p.tok_pos[t * 2] = q1; p.tok_pos[t * 2 + 1] = q2; p.tlist[e1 * T + q1] = t; p.tlist[e2 * T + q2] = t; }
                }
            }
        }
        xcd_barrier(bar);
        { IDS
            LAS char* L = (LAS char*)(smem + 16); LAS int* tab = (LAS int*)(L + MOE_LDS_TAB + 2048); LAS int* rowtab = (LAS int*)(L + MOE_LDS_TAB);
            const int* cnt = p.ctrl + l * 64;
            const int nblk = moe_tables(cnt, tab, tid);
            moe_order(cnt, tab, nblk, tid);
            int* qc = p.ctrl + 540 + l * 8; int* done = p.ctrl + 600 + l * 192;
            int hq = (int)(xb_xcc_id() & 7u), tried = 0;
            for (;;) {
                const int nq = (nblk - hq + 7) >> 3;
                const int nu1 = nq * 8, nu = nq * 24;
                const int ui = moe_dequeue(qc + hq, tab, tid);
                if (ui >= nu) { if (++tried == 8) break; hq = (hq + 1) & 7; continue; }
                if (ui < nu1) {
                    const int mb = tab[322 + (ui >> 3) * 8 + hq], nt = ui & 7; const int em = tab[64 + mb], e = em >> 8, mt = em & 255; const int valid = min(cnt[e] - mt * MOE_TR, MOE_TR);
                    __syncthreads();
                    { const int* tl = p.tlist + e * T + mt * MOE_TR; rowtab[tid] = tl[tid < valid ? tid : 0]; }
                    __syncthreads();
                    const size_t wo = ((size_t)l * NE + e) * (size_t)D * DFF;
                    if (valid <= 256)      moe_unit<true, D / 32, 2>(p.HB, D, p.wg + wo, p.wu + wo, DFF, nt * 64, valid, tab[e] + mt * MOE_TR, nt * 64, p.Hb, nullptr, L, tid);
                    else if (valid <= 384) moe_unit<true, D / 32, 3>(p.HB, D, p.wg + wo, p.wu + wo, DFF, nt * 64, valid, tab[e] + mt * MOE_TR, nt * 64, p.Hb, nullptr, L, tid);
                    else                   moe_unit<true, D / 32, 4>(p.HB, D, p.wg + wo, p.wu + wo, DFF, nt * 64, valid, tab[e] + mt * MOE_TR, nt * 64, p.Hb, nullptr, L, tid);
                    asm volatile("s_waitcnt vmcnt(0)" ::: "memory");
                    __syncthreads();
                    if (tid == 0) { __builtin_amdgcn_fence(__ATOMIC_RELEASE, "agent"); __hip_atomic_fetch_add(done + mb, 1, __ATOMIC_RELAXED, __HIP_MEMORY_SCOPE_AGENT); }
                } else {
                    const int di = ui - nu1;
                    const int mb = tab[322 + (di >> 4) * 8 + hq], nt = di & 15; const int em = tab[64 + mb], e = em >> 8, mt = em & 255; const int valid = min(cnt[e] - mt * MOE_TR, MOE_TR); const int r0 = tab[e] + mt * MOE_TR;
                    if (tid == 0) { while (__hip_atomic_load(done + mb, __ATOMIC_RELAXED, __HIP_MEMORY_SCOPE_AGENT) < 8) __builtin_amdgcn_s_sleep(1); __builtin_amdgcn_fence(__ATOMIC_ACQUIRE, "agent"); }
                    __syncthreads();
                    rowtab[tid] = r0 + (tid < valid ? tid : 0);
                    __syncthreads();
                    { const float* wdp = p.wd + ((size_t)l * NE + e) * (size_t)D * DFF;
                      if (valid <= 256)      moe_unit<false, DFF / 32, 2>(p.Hb, DFF, wdp, nullptr, D, nt * 128, valid, r0, nt * 128, nullptr, p.Yb, L, tid);
                      else if (valid <= 384) moe_unit<false, DFF / 32, 3>(p.Hb, DFF, wdp, nullptr, D, nt * 128, valid, r0, nt * 128, nullptr, p.Yb, L, tid);
                      else                   moe_unit<false, DFF / 32, 4>(p.Hb, DFF, wdp, nullptr, D, nt * 128, valid, r0, nt * 128, nullptr, p.Yb, L, tid); }
                }
            }
        }
        xcd_barrier(bar);
    }
    { IDS
    LAS int* mtab = (LAS int*)(smem + 16);
    moe_tables(p.ctrl + 64, mtab, tid);
    for (int tb = gw; tb < T; tb += 4 * NGW) {
    int te0[4], te1[4], tp0[4], tp1[4]; float tg0[4], tg1[4];
#pragma unroll
    for (int k = 0; k < 4; ++k) { const int t = min(tb + k * NGW, T - 1); te0[k] = p.tok_e[2 * t]; te1[k] = p.tok_e[2 * t + 1]; tp0[k] = p.tok_pos[2 * t]; tp1[k] = p.tok_pos[2 * t + 1]; tg0[k] = p.tok_g[2 * t]; tg1[k] = p.tok_g[2 * t + 1]; }
#pragma unroll
    for (int k = 0; k < 4; ++k) { const int t = tb + k * NGW; if (t >= T) break;
        float4* xr = (float4*)(p.X + (size_t)t * D) + lane;
        const int r0 = mtab[te0[k]] + tp0[k], r1 = mtab[te1[k]] + tp1[k]; const float g0 = tg0[k], g1 = tg1[k];
        const uint2* y0 = (const uint2*)(p.Yb + (size_t)r0 * D) + lane; const uint2* y1 = (const uint2*)(p.Yb + (size_t)r1 * D) + lane;
#pragma unroll
        for (int j = 0; j < 8; ++j) { float4 v = xr[64 * j]; const uint2 ua = y0[64 * j], ub = y1[64 * j];
            const float4 a = make_float4(__uint_as_float(ua.x << 16), __uint_as_float(ua.x & 0xffff0000u), __uint_as_float(ua.y << 16), __uint_as_float(ua.y & 0xffff0000u));
            const float4 b = make_float4(__uint_as_float(ub.x << 16), __uint_as_float(ub.x & 0xffff0000u), __uint_as_float(ub.y << 16), __uint_as_float(ub.y & 0xffff0000u));
            v.x += g0 * a.x + g1 * b.x; v.y += g0 * a.y + g1 * b.y; v.z += g0 * a.z + g1 * b.z; v.w += g0 * a.w + g1 * b.w; xr[64 * j] = v; }
    }
    }
    }
}

extern "C" void kernel_launch(void* const* d_in, const int* in_sizes, int n_in, void* d_out, int out_size, void* d_ws, size_t ws_size, hipStream_t stream) {
    Params p{};
    const float** pin = (const float**)&p;
    for (int i = 0; i < 26; ++i) pin[i] = (const float*)d_in[i];
    p.X = (float*)d_out;
    char* ws = (char*)d_ws; size_t off = 0;
    auto alloc = [&](size_t bytes) { void* q = ws + off; off += (bytes + 255) & ~(size_t)255; return q; };
    constexpr size_t CTL_BYTES = (size_t)XCD_BAR_WORDS * 4 + CTRL_INTS * 4;
    p.bar = (unsigned*)alloc(CTL_BYTES); p.ctrl = (int*)(p.bar + XCD_BAR_WORDS);
    p.HB = (u16*)alloc((size_t)T * D * 2);
    p.MIXED = (u16*)alloc((size_t)T * D * 2);
    p.PROJ = (u16*)alloc((size_t)T * DP * 2);
    p.PZ0 = (u16*)alloc((size_t)T * 1024 * 2); p.PZ1 = (u16*)alloc((size_t)T * 1024 * 2);
    p.DTR = (float*)alloc((size_t)T * 8 * 4);
    p.YD = (float*)alloc((size_t)T * 512 * 4);
    p.SS = (float*)alloc((size_t)NB * 32 * 8 * 8192 * 4);
    p.PREV = (u16*)alloc((size_t)NB * 32 * 8 * 8192 * 2);
    p.ATOT = (float*)alloc((size_t)NB * 32 * 8 * 4);
    p.ACS = (float*)alloc((size_t)T * 8 * 4);
    p.CG = (u16*)alloc((size_t)T * 256 * 2);
    p.WinT = (u16*)alloc((size_t)2 * DP * D * 2);
    p.WoutT = (u16*)alloc((size_t)2 * D * D * 2);
    p.RT = (float*)alloc((size_t)2 * 80 * D * 4);
    p.WpT = (u16*)alloc((size_t)2 * 4 * 128 * 128 * 2);
    p.WDT = (float*)alloc((size_t)2 * 16 * D * 4);
    p.tok_e = (int*)alloc((size_t)T * 2 * 4); p.tok_pos = (int*)alloc((size_t)T * 2 * 4); p.tlist = (int*)alloc((size_t)NE * T * 4);
    p.tok_g = (float*)alloc((size_t)T * 2 * 4);
    p.Hb = (u16*)alloc((size_t)2 * T * DFF * 2);
    p.Yb = (u16*)alloc((size_t)2 * T * D * 2);
    static int grid = 0;
    if (grid == 0) {
        if (off > ws_size || n_in != 26) { fprintf(stderr, "kernel_launch: workspace too small (%zu > %zu) or n_in %d\n", off, ws_size, n_in); grid = -1; return; }
        int dev = 0, cus = 0, per_cu = 0;
        if (hipGetDevice(&dev) != hipSuccess || hipDeviceGetAttribute(&cus, hipDeviceAttributeMultiprocessorCount, dev) != hipSuccess) { grid = -1; return; }
        if (hipFuncSetAttribute((const void*)mega, hipFuncAttributeMaxDynamicSharedMemorySize, LDS_BYTES) != hipSuccess) { fprintf(stderr, "hipFuncSetAttribute failed\n"); grid = -1; return; }
        if (hipOccupancyMaxActiveBlocksPerMultiprocessor(&per_cu, (const void*)mega, NTHR, LDS_BYTES) != hipSuccess || per_cu < 1)
            fprintf(stderr, "kernel_launch: occupancy query reports %d blocks per CU\n", per_cu);
        (void)hipGetLastError();
        grid = cus;
    }
    if (grid < 0) return;
    if (hipMemsetAsync(p.bar, 0, CTL_BYTES, stream) != hipSuccess) return;
    hipLaunchKernelGGL(mega, dim3(grid), dim3(NTHR), LDS_BYTES, stream, p);
}
```
